# Optimizing an MI355X kernel written in HIP

```python
import jax
import jax.numpy as jnp
from jax import lax
import numpy as np

D_MODEL = 1024
BATCH = 4
SEQ = 4096
DEPTH = 4
DEC_BATCH = 128
DEC_SEQ = 4
PAST_LEN = 8192
PAGE_SIZE = 128

MIX_WIDTH = D_MODEL
HEAD_DIM = 64
ATTN_WIDTH = D_MODEL // 2
N_HEADS = ATTN_WIDTH // HEAD_DIM
N_KV_HEADS = 2
GQA_GROUP = N_HEADS // N_KV_HEADS
KV_WIDTH = N_KV_HEADS * HEAD_DIM
WINDOW = 128
BLOCK_Q = 128
RWKV_WIDTH = D_MODEL // 4
RWKV_HEAD = 64
RWKV_HEADS = RWKV_WIDTH // RWKV_HEAD
LORA_W = 64
LORA_A = 64
LORA_G = 128
RWKV_PROJ = 3 * RWKV_WIDTH + LORA_W + LORA_A + LORA_G
LRU_WIDTH = D_MODEL // 4
LRU_BLOCKS = 4
LRU_BLOCK = LRU_WIDTH // LRU_BLOCKS
CONV_W = 4
LRU_C = 8.0
IN_COLS = ATTN_WIDTH + 2 * KV_WIDTH + RWKV_PROJ + 2 * LRU_WIDTH
IN_SPLITS = (ATTN_WIDTH, ATTN_WIDTH + KV_WIDTH, ATTN_WIDTH + 2 * KV_WIDTH,
             ATTN_WIDTH + 2 * KV_WIDTH + RWKV_PROJ, ATTN_WIDTH + 2 * KV_WIDTH + RWKV_PROJ + LRU_WIDTH)
RWKV_SPLITS = (RWKV_WIDTH, 2 * RWKV_WIDTH, 3 * RWKV_WIDTH, 3 * RWKV_WIDTH + LORA_W,
               3 * RWKV_WIDTH + LORA_W + LORA_A)
D_FF = -(-(8 * D_MODEL) // (3 * 256)) * 256
PLE_DIM = 256
RMS_EPS = 1e-6
GN_EPS = 64e-5

kernel_name = 'hymba_swa_rwkv7_rglru_step'


def rmsnorm(x, g):
    xf = x.astype(jnp.float32)
    y = xf * lax.rsqrt(jnp.mean(xf * xf, -1, keepdims=True) + RMS_EPS)
    return (y * g.astype(jnp.float32)).astype(x.dtype)


def _sink_probs(s, sink, mask):
    s = jnp.where(mask, s, -jnp.inf)
    m = jnp.maximum(jnp.max(s, -1, keepdims=True), sink)
    e = jnp.exp(s - m)
    return e / (jnp.sum(e, -1, keepdims=True) + jnp.exp(sink - m))


def swa_prompt(q, k, v, sinks):
    b, t = q.shape[:2]
    nb = t // BLOCK_Q
    qb = q.reshape(b, nb, BLOCK_Q, N_KV_HEADS, GQA_GROUP, HEAD_DIM)
    kb = k.reshape(b, nb, BLOCK_Q, N_KV_HEADS, HEAD_DIM)
    vb = v.reshape(b, nb, BLOCK_Q, N_KV_HEADS, HEAD_DIM)
    pad = ((0, 0), (1, 0), (0, 0), (0, 0), (0, 0))
    k_ext = jnp.concatenate([jnp.pad(kb[:, :-1], pad), kb], axis=2)
    v_ext = jnp.concatenate([jnp.pad(vb[:, :-1], pad), vb], axis=2)
    s = jnp.einsum('bnqhgd,bnkhd->bhgnqk', qb, k_ext,
                   preferred_element_type=jnp.float32) * (HEAD_DIM ** -0.5)
    qi = jnp.arange(BLOCK_Q)[:, None] + BLOCK_Q
    kj = jnp.arange(2 * BLOCK_Q)[None, :]
    d = qi - kj
    blk = jnp.arange(nb)[:, None, None]
    mask = (d >= 0) & (d <= WINDOW) & ((blk > 0) | (kj >= BLOCK_Q))
    sink = sinks.astype(jnp.float32).reshape(N_KV_HEADS, GQA_GROUP)[None, :, :, None, None, None]
    p = _sink_probs(s, sink, mask)
    o = jnp.einsum('bhgnqk,bnkhd->bnqhgd', p.astype(v.dtype), v_ext)
    return o.reshape(b, t, ATTN_WIDTH)


def swa_sample(q, k, v, ck, cv, sinks):
    b, tn = q.shape[:2]
    k_all = jnp.concatenate([ck.astype(k.dtype), k], axis=1)
    v_all = jnp.concatenate([cv.astype(v.dtype), v], axis=1)
    qg = q.reshape(b, tn, N_KV_HEADS, GQA_GROUP, HEAD_DIM)
    s = jnp.einsum('bqhgd,bkhd->bhgqk', qg, k_all,
                   preferred_element_type=jnp.float32) * (HEAD_DIM ** -0.5)
    d = (jnp.arange(tn)[:, None] + WINDOW) - jnp.arange(WINDOW + tn)[None, :]
    mask = (d >= 0) & (d <= WINDOW)
    sink = sinks.astype(jnp.float32).reshape(N_KV_HEADS, GQA_GROUP)[None, :, :, None, None]
    p = _sink_probs(s, sink, mask)
    o = jnp.einsum('bhgqk,bkhd->bqhgd', p.astype(v.dtype), v_all)
    return o.reshape(b, tn, ATTN_WIDTH), k_all[:, tn:], v_all[:, tn:]


def rwkv7_mix(proj, shift0, wkv0, lw):
    b, t = proj.shape[:2]
    f32 = jnp.float32
    prev = jnp.concatenate([shift0[:, None].astype(proj.dtype), proj[:, :-1]], axis=1)
    xs = proj + (prev - proj) * lw['rwkv_mu']
    r, k, v, xw, xa, xg = jnp.split(xs, RWKV_SPLITS, axis=-1)
    w_log = -jax.nn.softplus(-(lw['rwkv_w0'] + jnp.tanh(xw) @ lw['rwkv_w_up']).astype(f32)) - 0.5
    decay = jnp.exp(-jnp.exp(w_log))
    a = jax.nn.sigmoid((lw['rwkv_a0'] + xa @ lw['rwkv_a_up']).astype(f32))
    g = (jax.nn.sigmoid(xg) @ lw['rwkv_g_up']).astype(f32)

    def heads(z):
        return z.astype(f32).reshape(b, t, RWKV_HEADS, RWKV_HEAD)

    kk = heads(k * lw['rwkv_k_k'])
    kk = kk * lax.rsqrt(jnp.maximum(jnp.sum(kk * kk, -1, keepdims=True), 1e-24))
    k2 = k.astype(f32) * (1.0 + (a - 1.0) * lw['rwkv_k_a'].astype(f32))
    r_h, k_h, v_h, w_h, a_h = heads(r), heads(k2), heads(v), heads(decay), heads(a)

    def step(S, inp):
        r_t, w_t, k_t, v_t, kk_t, b_t = inp
        S = (S * w_t[:, :, None, :]
             - jnp.einsum('bhvk,bhk->bhv', S, kk_t)[..., None] * b_t[:, :, None, :]
             + v_t[..., None] * k_t[:, :, None, :])
        return S, jnp.einsum('bhvk,bhk->bhv', S, r_t)

    seq = tuple(jnp.moveaxis(z, 1, 0) for z in (r_h, w_h, k_h, v_h, kk, kk * a_h))
    wkv, y = lax.scan(step, wkv0.astype(f32), seq)
    y = jnp.moveaxis(y, 0, 1)
    mean = jnp.mean(y, -1, keepdims=True)
    var = jnp.mean(jnp.square(y - mean), -1, keepdims=True)
    y = (y - mean) * lax.rsqrt(var + GN_EPS)
    y = y.reshape(b, t, RWKV_WIDTH) * lw['rwkv_ln_w'] + lw['rwkv_ln_b']
    bonus = jnp.sum(r_h * k_h * lw['rwkv_r_k'].astype(f32), -1, keepdims=True) * v_h
    y = y + bonus.reshape(b, t, RWKV_WIDTH)
    return (y * g).astype(proj.dtype), proj[:, -1], wkv


def rglru_mix(xb, gb, conv0, h0, lw):
    b, t = xb.shape[:2]
    f32 = jnp.float32
    ext = jnp.concatenate([conv0.astype(xb.dtype), xb], axis=1)
    xc = lw['lru_conv_b'] + sum(ext[:, j:j + t] * lw['lru_conv_w'][j] for j in range(CONV_W))
    xh = xc.reshape(b, t, LRU_BLOCKS, LRU_BLOCK)
    r = jax.nn.sigmoid((jnp.einsum('bthi,hij->bthj', xh, lw['lru_w_a']).reshape(b, t, LRU_WIDTH)
                        + lw['lru_b_a']).astype(f32))
    i = jax.nn.sigmoid((jnp.einsum('bthi,hij->bthj', xh, lw['lru_w_i']).reshape(b, t, LRU_WIDTH)
                        + lw['lru_b_i']).astype(f32))
    log_a = LRU_C * r * jax.nn.log_sigmoid(lw['lru_L'].astype(f32))
    a = jnp.exp(log_a)
    u = jnp.sqrt(-jnp.expm1(2.0 * log_a)) * (i * xc.astype(f32))
    u = u.at[:, 0].add(a[:, 0] * h0.astype(f32))

    def combine(c1, c2):
        a1, b1 = c1
        a2, b2 = c2
        return a1 * a2, a2 * b1 + b2

    _, h = lax.associative_scan(combine, (a, u), axis=1)
    out = (h * jax.nn.gelu(gb.astype(f32))).astype(xb.dtype)
    return out, ext[:, -(CONV_W - 1):], h[:, -1]


def _layer(x, p, st, lw, sample):
    b, t = x.shape[:2]
    ck, cv, sh0, wkv0, conv0, h0 = st
    h = rmsnorm(x, lw['norm_mix_pre'])
    proj = h @ lw['w_in'] + lw['b_in']
    q, k, v, pb, xb, gb = jnp.split(proj, IN_SPLITS, axis=-1)
    q = q.reshape(b, t, N_HEADS, HEAD_DIM)
    k = k.reshape(b, t, N_KV_HEADS, HEAD_DIM)
    v = v.reshape(b, t, N_KV_HEADS, HEAD_DIM)
    if sample:
        o_a, nk, nv = swa_sample(q, k, v, ck, cv, lw['attn_sinks'])
    else:
        o_a = swa_prompt(q, k, v, lw['attn_sinks'])
        nk, nv = k[:, -WINDOW:], v[:, -WINDOW:]
    o_b, nsh, nwkv = rwkv7_mix(pb, sh0, wkv0, lw)
    o_c, nconv, nh = rglru_mix(xb, gb, conv0, h0, lw)
    mix = jnp.concatenate([o_a, o_b, o_c], axis=-1) @ lw['w_out'] + lw['b_out']
    x = x + rmsnorm(mix, lw['norm_mix_post'])
    f = rmsnorm(x, lw['norm_ffn_pre'])
    f = (jax.nn.silu(f @ lw['ffn_w_gate']) * (f @ lw['ffn_w_up'])) @ lw['ffn_w_down']
    x = x + rmsnorm(f, lw['norm_ffn_post'])
    x = x + jax.nn.sigmoid(x @ lw['ple_gate_w']) * (p @ lw['ple_w'])
    return x, (nk, nv, nsh, nwkv, nconv, nh)


def setup_inputs(seed: int = 0) -> dict:
    key = jax.random.key(seed)
    ks = jax.random.split(key, 64)
    cnt = iter(range(64))

    def nrm(shape, scale):
        return jax.random.normal(ks[next(cnt)], shape, jnp.float32) * scale

    def unif(shape, lo, hi):
        return jax.random.uniform(ks[next(cnt)], shape, jnp.float32, lo, hi)

    def gain(shape):
        return 1.0 + nrm(shape, 0.05)

    L = DEPTH
    inp = {}
    inp['x_prompt'] = nrm((BATCH, SEQ, D_MODEL), 1.0)
    inp['x_sample'] = nrm((DEC_BATCH, DEC_SEQ, D_MODEL), 1.0)
    inp['cache_k'] = nrm((L, DEC_BATCH, WINDOW, N_KV_HEADS, HEAD_DIM), 1.0)
    inp['cache_v'] = nrm((L, DEC_BATCH, WINDOW, N_KV_HEADS, HEAD_DIM), 1.0)
    inp['state_shift'] = nrm((L, DEC_BATCH, RWKV_PROJ), 1.0)
    inp['state_wkv'] = nrm((L, DEC_BATCH, RWKV_HEADS, RWKV_HEAD, RWKV_HEAD), 0.3)
    inp['state_conv'] = nrm((L, DEC_BATCH, CONV_W - 1, LRU_WIDTH), 1.0)
    inp['state_lru'] = nrm((L, DEC_BATCH, LRU_WIDTH), 0.5)
    inp['p_prompt'] = nrm((L, BATCH, SEQ, PLE_DIM), 1.0)
    inp['p_sample'] = nrm((L, DEC_BATCH, DEC_SEQ, PLE_DIM), 1.0)
    inp['norm_mix_pre'] = gain((L, D_MODEL))
    inp['norm_mix_post'] = gain((L, D_MODEL))
    inp['norm_ffn_pre'] = gain((L, D_MODEL))
    inp['norm_ffn_post'] = gain((L, D_MODEL))
    inp['w_in'] = nrm((L, D_MODEL, IN_COLS), D_MODEL ** -0.5)
    inp['b_in'] = nrm((L, IN_COLS), 0.02)
    inp['attn_sinks'] = nrm((L, N_HEADS), 1.0)
    inp['rwkv_mu'] = unif((L, RWKV_PROJ), 0.0, 1.0)
    inp['rwkv_w0'] = nrm((L, RWKV_WIDTH), 1.0)
    inp['rwkv_w_up'] = nrm((L, LORA_W, RWKV_WIDTH), 0.1)
    inp['rwkv_a0'] = nrm((L, RWKV_WIDTH), 0.5)
    inp['rwkv_a_up'] = nrm((L, LORA_A, RWKV_WIDTH), 0.1)
    inp['rwkv_g_up'] = nrm((L, LORA_G, RWKV_WIDTH), LORA_G ** -0.5)
    inp['rwkv_k_k'] = 0.85 + nrm((L, RWKV_WIDTH), 0.05)
    inp['rwkv_k_a'] = gain((L, RWKV_WIDTH))
    inp['rwkv_r_k'] = nrm((L, RWKV_HEADS, RWKV_HEAD), 0.1)
    inp['rwkv_ln_w'] = gain((L, RWKV_WIDTH))
    inp['rwkv_ln_b'] = nrm((L, RWKV_WIDTH), 0.02)
    inp['lru_conv_w'] = nrm((L, CONV_W, LRU_WIDTH), CONV_W ** -0.5)
    inp['lru_conv_b'] = nrm((L, LRU_WIDTH), 0.02)
    inp['lru_w_a'] = nrm((L, LRU_BLOCKS, LRU_BLOCK, LRU_BLOCK), LRU_BLOCK ** -0.5)
    inp['lru_b_a'] = nrm((L, LRU_WIDTH), 0.02)
    inp['lru_w_i'] = nrm((L, LRU_BLOCKS, LRU_BLOCK, LRU_BLOCK), LRU_BLOCK ** -0.5)
    inp['lru_b_i'] = nrm((L, LRU_WIDTH), 0.02)
    inp['lru_L'] = unif((L, LRU_WIDTH), 4.3, 9.0)
    inp['w_out'] = nrm((L, MIX_WIDTH, D_MODEL), MIX_WIDTH ** -0.5)
    inp['b_out'] = nrm((L, D_MODEL), 0.02)
    inp['ffn_w_gate'] = nrm((L, D_MODEL, D_FF), D_MODEL ** -0.5)
    inp['ffn_w_up'] = nrm((L, D_MODEL, D_FF), D_MODEL ** -0.5)
    inp['ffn_w_down'] = nrm((L, D_FF, D_MODEL), D_FF ** -0.5)
    inp['ple_w'] = nrm((L, PLE_DIM, D_MODEL), PLE_DIM ** -0.5)
    inp['ple_gate_w'] = nrm((L, D_MODEL, D_MODEL), D_MODEL ** -0.5)
    return inp


def reference(x_prompt, x_sample, cache_k, cache_v, state_shift, state_wkv, state_conv, state_lru,
              p_prompt, p_sample, norm_mix_pre, norm_mix_post, norm_ffn_pre, norm_ffn_post,
              w_in, b_in, attn_sinks, rwkv_mu, rwkv_w0, rwkv_w_up, rwkv_a0, rwkv_a_up, rwkv_g_up,
              rwkv_k_k, rwkv_k_a, rwkv_r_k, rwkv_ln_w, rwkv_ln_b, lru_conv_w, lru_conv_b,
              lru_w_a, lru_b_a, lru_w_i, lru_b_i, lru_L, w_out, b_out, ffn_w_gate, ffn_w_up,
              ffn_w_down, ple_w, ple_gate_w):
    f32 = jnp.float32
    bp = x_prompt.shape[0]
    xp, xs = x_prompt, x_sample
    new_p, new_s = [], []
    for i in range(DEPTH):
        lw = dict(norm_mix_pre=norm_mix_pre[i], norm_mix_post=norm_mix_post[i],
                  norm_ffn_pre=norm_ffn_pre[i], norm_ffn_post=norm_ffn_post[i],
                  w_in=w_in[i], b_in=b_in[i], attn_sinks=attn_sinks[i],
                  rwkv_mu=rwkv_mu[i], rwkv_w0=rwkv_w0[i], rwkv_w_up=rwkv_w_up[i],
                  rwkv_a0=rwkv_a0[i], rwkv_a_up=rwkv_a_up[i], rwkv_g_up=rwkv_g_up[i],
                  rwkv_k_k=rwkv_k_k[i], rwkv_k_a=rwkv_k_a[i], rwkv_r_k=rwkv_r_k[i],
                  rwkv_ln_w=rwkv_ln_w[i], rwkv_ln_b=rwkv_ln_b[i],
                  lru_conv_w=lru_conv_w[i], lru_conv_b=lru_conv_b[i],
                  lru_w_a=lru_w_a[i], lru_b_a=lru_b_a[i], lru_w_i=lru_w_i[i], lru_b_i=lru_b_i[i],
                  lru_L=lru_L[i], w_out=w_out[i], b_out=b_out[i],
                  ffn_w_gate=ffn_w_gate[i], ffn_w_up=ffn_w_up[i], ffn_w_down=ffn_w_down[i],
                  ple_w=ple_w[i], ple_gate_w=ple_gate_w[i])
        st_p = (None, None,
                jnp.zeros((bp, RWKV_PROJ), x_prompt.dtype),
                jnp.zeros((bp, RWKV_HEADS, RWKV_HEAD, RWKV_HEAD), f32),
                jnp.zeros((bp, CONV_W - 1, LRU_WIDTH), x_prompt.dtype),
                jnp.zeros((bp, LRU_WIDTH), f32))
        xp, sp = _layer(xp, p_prompt[i], st_p, lw, False)
        st_s = (cache_k[i], cache_v[i], state_shift[i], state_wkv[i], state_conv[i], state_lru[i])
        xs, ss = _layer(xs, p_sample[i], st_s, lw, True)
        new_p.append(sp)
        new_s.append(ss)

    def stk(lst, j):
        return jnp.stack([s[j] for s in lst], axis=0)

    return (xp, xs,
            stk(new_p, 0), stk(new_p, 1), stk(new_p, 2), stk(new_p, 3), stk(new_p, 4), stk(new_p, 5),
            stk(new_s, 0), stk(new_s, 1), stk(new_s, 2), stk(new_s, 3), stk(new_s, 4), stk(new_s, 5))
```

```cpp
#include <hip/hip_runtime.h>
#include <hip/hip_cooperative_groups.h>
#include <cstdio>
#include <cstdint>
#include <cstddef>
#include <cmath>
namespace cg = cooperative_groups;
namespace pg8 {
#define PG8_LAS __attribute__((address_space(3)))
typedef unsigned short bf16_t;
typedef short bf16x8 __attribute__((ext_vector_type(8)));
typedef float f32x4 __attribute__((ext_vector_type(4)));
typedef unsigned u32x4 __attribute__((ext_vector_type(4)));
constexpr int BM = 256, BK = 64, HALF = 128, HTB = HALF * BK * 2  , STAGE_BYTES = 8 * HTB, NXCD = 8, WGM = 8;

__host__ __device__ __forceinline__ int lds_byte(int r, int c) { const int st = (r >> 4) * 2 + (c >> 5), rr = r & 15, cc = c & 31, ob = rr * 64 + cc * 2; return st * 1024 + (ob ^ (((ob >> 9) & 1) << 5)); }
__host__ __device__ __forceinline__ void stage_rc(int b, int& R, int& C) { const int st = b / 1024, sb = b % 1024, swz = sb ^ (((sb >> 9) & 1) << 5); R = (st >> 1) * 16 + swz / 64; C = (st & 1) * 32 + (swz % 64) / 2; }
__host__ __device__ __forceinline__ int perm32(int rho) { const int n = rho >> 4, i = rho & 15; return 8 * (i >> 2) + 4 * n + (i & 3); }

struct Unit { int pm, pn; };
struct Gemm { const bf16_t* A; const bf16_t* Bt; int M, N, K; };

struct StaticOrder {
    int nM, nN, nwg, G, c;
    __host__ __device__ void init(int M, int N, int G_, int c_) { nM = M / BM; nN = N / BM; nwg = nM * nN; G = G_; c = c_; }
    __host__ __device__ bool next(int i, Unit& u) const {
        const long L = (long)i * G + c; if (L >= nwg) return false;
        int wgid = (int)L; { const int q = nwg / NXCD, r = nwg % NXCD, xcd = wgid % NXCD, off = wgid / NXCD; wgid = (xcd < r ? xcd * (q + 1) : r * (q + 1) + (xcd - r) * q) + off; }
        const int nig = WGM * nN, gid = wgid / nig, fm = gid * WGM, gsz = (nM - fm) < WGM ? (nM - fm) : WGM;
        u.pm = fm + ((wgid % nig) % gsz); u.pn = (wgid % nig) / gsz; return true;
    }
    __device__ __forceinline__ void a_ready(const Unit&) const {}
    __device__ __forceinline__ void done(const Unit&) const {}
};

__device__ __forceinline__ unsigned cvt_pk_bf16(float lo, float hi) { unsigned r; asm volatile("v_cvt_pk_bf16_f32 %0, %1, %2" : "=v"(r) : "v"(lo), "v"(hi)); return r; }
typedef float f32x2 __attribute__((ext_vector_type(2)));
__device__ __forceinline__ f32x2 gelu_pk(f32x2 v) {
    const f32x2 av = __builtin_elementwise_abs(v), d = av * 0.2316418882f + 1.0f;
    f32x2 t; t.x = __builtin_amdgcn_rcpf(d.x); t.y = __builtin_amdgcn_rcpf(d.y);
    f32x2 q = t * 0.5307027145f + (-0.7265760135f); q = q * t + 0.7107068705f; q = q * t + (-0.142248368f); q = q * t + 0.127414796f; q = q * t;
    const f32x2 s = (v * v) * (-0.72134752044f);
    f32x2 e; e.x = __builtin_amdgcn_exp2f(s.x); e.y = __builtin_amdgcn_exp2f(s.y);
    const f32x2 m = v * (q * e), r = v - m;
    f32x2 o; o.x = v.x < 0.f ? m.x : r.x; o.y = v.y < 0.f ? m.y : r.y; return o;
}

template <int ACT  > struct EpiBf16 {
    static constexpr bool PERM = true, AFTER_DRAIN = false; static_assert(ACT == 0 || ACT == 1, "EpiBf16: ACT is 0 (none) or 1 (gelu_pk)");
    bf16_t* O; int ldc; const float* bias; int split_cols; size_t split_stride; float scale0;
    __device__ __forceinline__ void operator()(const f32x4 (&acc)[2][2][4][2], const Unit& u, int wr, int wc, int fr, int fq) const {
        const int row0 = u.pm * BM + wr * 64 + fr; int colt = u.pn * BM; bf16_t* base = O;
        float sc = 1.f; if (split_cols) { const int t = colt / split_cols; base += (size_t)t * split_stride; colt -= t * split_cols; if (t == 0) sc = scale0; }
        const int col0 = colt + wc * 32 + 8 * fq, bcol0 = u.pn * BM + wc * 32 + 8 * fq;
        f32x4 bv[2][2];
#pragma unroll
        for (int bj = 0; bj < 2; ++bj)
#pragma unroll
            for (int n = 0; n < 2; ++n) bv[bj][n] = bias ? *(const f32x4*)(bias + bcol0 + bj * HALF + 4 * n) : (f32x4){0.f, 0.f, 0.f, 0.f};
#pragma unroll
        for (int ai = 0; ai < 2; ++ai)
#pragma unroll
            for (int m = 0; m < 4; ++m) { bf16_t* rowp = base + (size_t)(row0 + ai * HALF + m * 16) * ldc + col0;
#pragma unroll
                for (int bj = 0; bj < 2; ++bj) { f32x4 v0 = acc[ai][bj][m][0] + bv[bj][0], v1 = acc[ai][bj][m][1] + bv[bj][1];
                    if (ACT == 1) { f32x2 a = gelu_pk((f32x2){v0[0], v0[1]}), b = gelu_pk((f32x2){v0[2], v0[3]}), c = gelu_pk((f32x2){v1[0], v1[1]}), d = gelu_pk((f32x2){v1[2], v1[3]});
                        v0 = (f32x4){a.x, a.y, b.x, b.y}; v1 = (f32x4){c.x, c.y, d.x, d.y}; }
                    v0 = v0 * sc; v1 = v1 * sc; u32x4 w; w.x = cvt_pk_bf16(v0[0], v0[1]); w.y = cvt_pk_bf16(v0[2], v0[3]); w.z = cvt_pk_bf16(v1[0], v1[1]); w.w = cvt_pk_bf16(v1[2], v1[3]);
                    *(u32x4*)(rowp + bj * HALF) = w; } }
    }
};
template <class Epi, class Sched, bool ALIGN_EPI = false, bool SP2 = false>
__device__ __forceinline__ void gemm_phase(PG8_LAS unsigned char* lds, const Gemm g, const Sched& S, const Epi& E, int tid_in) {
    int tid_ = tid_in; asm volatile("" : "+v"(tid_));
    const int tid = tid_, wid = __builtin_amdgcn_readfirstlane(tid >> 6), lane = tid & 63, wr = wid >> 2, wc = wid & 3, fr = lane & 15, fq = lane >> 4;
    const int K = g.K, nt = K / BK;
    unsigned voffA[2], voffB[2];
#pragma unroll
    for (int i = 0; i < 2; ++i) { int R, C; stage_rc(tid * 16 + i * 8192, R, C); const int Rb = Epi::PERM ? ((R & ~31) + perm32(R & 31)) : R;
        voffA[i] = (unsigned)(R * K + C) * 2u; voffB[i] = (unsigned)(Rb * K + C) * 2u; }
    const size_t kstep = (size_t)(BK * 2);
    const size_t hstep = (size_t)HALF * K * 2;
    const size_t tstep = 2 * hstep;
    const unsigned ldsw = (unsigned)wid * 1024u;
    const int aoff = lds_byte(wr * 64 + fr, fq * 8), boff = lds_byte(wc * 32 + fr, fq * 8);
#define PG8_SA(b, h) (((b) * 2 + (h)) * HTB)
#define PG8_SB(b, h) ((4 + (b) * 2 + (h)) * HTB)
#define PG8_STAGE(bufoff, gbase, voff) do { _Pragma("unroll") for (int _i = 0; _i < 2; ++_i) \
        __builtin_amdgcn_global_load_lds((const unsigned*)((const char*)(gbase) + (voff)[_i]), (PG8_LAS unsigned*)(lds + (bufoff) + ldsw + _i * 8192), 16, 0, 0); } while (0)
#define PG8_LDA(dst, b, h) do { _Pragma("unroll") for (int m = 0; m < 4; ++m) _Pragma("unroll") for (int k = 0; k < 2; ++k) dst[m][k] = *(const PG8_LAS bf16x8*)(lds + PG8_SA(b, h) + aoff + m * 2048 + k * 1024); } while (0)
#define PG8_LDB(dst, b, h) do { _Pragma("unroll") for (int n = 0; n < 2; ++n) _Pragma("unroll") for (int k = 0; k < 2; ++k) dst[n][k] = *(const PG8_LAS bf16x8*)(lds + PG8_SB(b, h) + boff + n * 2048 + k * 1024); } while (0)
#define PG8_MMA(ai, bj, At, Bt) do { __builtin_amdgcn_s_setprio(1); _Pragma("unroll") for (int m = 0; m < 4; ++m) _Pragma("unroll") for (int n = 0; n < 2; ++n) _Pragma("unroll") for (int k = 0; k < 2; ++k) \
        acc[ai][bj][m][n] = __builtin_amdgcn_mfma_f32_16x16x32_bf16(Bt[n][k], At[m][k], acc[ai][bj][m][n], 0, 0, 0); __builtin_amdgcn_s_setprio(0); } while (0)
#define PG8_WAIT_V(n) asm volatile("s_waitcnt vmcnt(" #n ")" ::: "memory")
#define PG8_WAIT_L(n) asm volatile("s_waitcnt lgkmcnt(" #n ")" ::: "memory")
#define PG8_BAR __builtin_amdgcn_s_barrier()
#define PG8_SCHED __builtin_amdgcn_sched_barrier(0)
    Unit cur, nxt; int ui = 0;
    if (!S.next(0, cur)) return;
    f32x4 acc[2][2][4][2];
#pragma unroll
    for (int a = 0; a < 2; ++a)
#pragma unroll
        for (int b = 0; b < 2; ++b)
#pragma unroll
            for (int m = 0; m < 4; ++m)
#pragma unroll
                for (int n = 0; n < 2; ++n) acc[a][b][m][n] = (f32x4){0.f, 0.f, 0.f, 0.f};
    bf16x8 At[4][2], B0[2][2], B1[2][2];
    const char* cA = (const char*)g.A + (size_t)cur.pm * tstep; const char* cB = (const char*)g.Bt + (size_t)cur.pn * tstep;
    S.a_ready(cur);
    if constexpr (SP2) {
        PG8_STAGE(PG8_SB(0, 0), cB, voffB); PG8_STAGE(PG8_SB(0, 1), cB + hstep, voffB); PG8_STAGE(PG8_SA(0, 0), cA, voffA); PG8_STAGE(PG8_SA(0, 1), cA + hstep, voffA);
        if (wr == 1) PG8_BAR;
        PG8_WAIT_V(2); PG8_BAR;
        PG8_STAGE(PG8_SB(1, 0), cB + kstep, voffB); PG8_STAGE(PG8_SA(1, 0), cA + kstep, voffA); PG8_STAGE(PG8_SB(1, 1), cB + hstep + kstep, voffB);
        PG8_WAIT_V(6); PG8_BAR;
    } else {
        PG8_STAGE(PG8_SB(0, 0), cB, voffB); PG8_STAGE(PG8_SA(0, 0), cA, voffA); PG8_STAGE(PG8_SB(0, 1), cB + hstep, voffB); PG8_STAGE(PG8_SA(0, 1), cA + hstep, voffA);
        if (wr == 1) PG8_BAR;
        PG8_WAIT_V(4); PG8_BAR;
        PG8_STAGE(PG8_SB(1, 0), cB + kstep, voffB); PG8_STAGE(PG8_SA(1, 0), cA + kstep, voffA); PG8_STAGE(PG8_SB(1, 1), cB + hstep + kstep, voffB);
        PG8_WAIT_V(6); PG8_BAR;
    }
    for (;;) {
        const bool has_next = S.next(ui + 1, nxt);
        const char* nA = has_next ? (const char*)g.A + (size_t)nxt.pm * tstep : cA; const char* nB = has_next ? (const char*)g.Bt + (size_t)nxt.pn * tstep : cB;
        for (int t = 0; t < nt; t += 2) {
            const bool last = (t == nt - 2);
            const char* a1 = cA + (size_t)(t + 1) * kstep;
            const char* a2 = last ? nA : cA + (size_t)(t + 2) * kstep; const char* b2 = last ? nB : cB + (size_t)(t + 2) * kstep;
            const char* a3 = a2 + kstep; const char* b3 = b2 + kstep;
            if (last && has_next) S.a_ready(nxt);
            if constexpr (SP2) {
            PG8_LDB(B0, 0, 0); PG8_LDB(B1, 0, 1); PG8_SCHED; PG8_LDA(At, 0, 0); PG8_STAGE(PG8_SA(1, 1), a1 + hstep, voffA);
            PG8_WAIT_V(8); PG8_WAIT_L(0); PG8_BAR; PG8_MMA(0, 0, At, B0); PG8_MMA(0, 1, At, B1); PG8_BAR; PG8_SCHED;
            PG8_LDA(At, 0, 1); PG8_STAGE(PG8_SB(0, 0), b2, voffB); PG8_STAGE(PG8_SB(0, 1), b2 + hstep, voffB); PG8_STAGE(PG8_SA(0, 0), a2, voffA);
            PG8_WAIT_V(8); PG8_WAIT_L(0); PG8_BAR; PG8_MMA(1, 0, At, B0); PG8_MMA(1, 1, At, B1); PG8_BAR; PG8_SCHED;
            PG8_LDB(B0, 1, 0); PG8_LDB(B1, 1, 1); PG8_SCHED; PG8_LDA(At, 1, 0); PG8_STAGE(PG8_SA(0, 1), a2 + hstep, voffA);
            PG8_WAIT_V(8); PG8_WAIT_L(0); PG8_BAR; PG8_MMA(0, 0, At, B0); PG8_MMA(0, 1, At, B1); PG8_BAR; PG8_SCHED;
            PG8_LDA(At, 1, 1); PG8_STAGE(PG8_SB(1, 0), b3, voffB); PG8_STAGE(PG8_SB(1, 1), b3 + hstep, voffB); PG8_STAGE(PG8_SA(1, 0), a3, voffA);
            PG8_WAIT_V(8); PG8_WAIT_L(0); PG8_BAR; PG8_MMA(1, 0, At, B0); PG8_MMA(1, 1, At, B1); PG8_BAR; PG8_SCHED;
            } else {
            PG8_LDB(B0, 0, 0); PG8_SCHED; PG8_LDA(At, 0, 0); PG8_STAGE(PG8_SA(1, 1), a1 + hstep, voffA);
            PG8_WAIT_L(8); PG8_BAR; PG8_WAIT_L(0); PG8_MMA(0, 0, At, B0); PG8_BAR; PG8_SCHED;
            PG8_LDB(B1, 0, 1); PG8_STAGE(PG8_SB(0, 0), b2, voffB);
            PG8_BAR; PG8_WAIT_L(0); PG8_MMA(0, 1, At, B1); PG8_BAR;
            PG8_LDA(At, 0, 1); PG8_STAGE(PG8_SA(0, 0), a2, voffA);
            PG8_BAR; PG8_WAIT_L(0); PG8_MMA(1, 0, At, B0); PG8_BAR; PG8_SCHED;
            PG8_STAGE(PG8_SB(0, 1), b2 + hstep, voffB);
            PG8_WAIT_V(6); PG8_BAR; PG8_MMA(1, 1, At, B1); PG8_BAR;
            PG8_LDB(B0, 1, 0); PG8_SCHED; PG8_LDA(At, 1, 0); PG8_STAGE(PG8_SA(0, 1), a2 + hstep, voffA);
            PG8_WAIT_L(8); PG8_BAR; PG8_WAIT_L(0); PG8_MMA(0, 0, At, B0); PG8_BAR; PG8_SCHED;
            PG8_LDB(B1, 1, 1); PG8_STAGE(PG8_SB(1, 0), b3, voffB);
            PG8_BAR; PG8_WAIT_L(0); PG8_MMA(0, 1, At, B1); PG8_BAR;
            PG8_LDA(At, 1, 1); PG8_STAGE(PG8_SA(1, 0), a3, voffA);
            PG8_BAR; PG8_WAIT_L(0); PG8_MMA(1, 0, At, B0); PG8_BAR; PG8_SCHED;
            PG8_STAGE(PG8_SB(1, 1), b3 + hstep, voffB);
            PG8_WAIT_V(6); PG8_BAR; PG8_MMA(1, 1, At, B1); PG8_BAR;
            }
        }
        if constexpr (ALIGN_EPI) { if (wr == 0) PG8_BAR; }
        if constexpr (!Epi::AFTER_DRAIN) { E(acc, cur, wr, wc, fr, fq); S.done(cur); }
        if (!has_next) break;
#pragma unroll
        for (int a = 0; a < 2; ++a)
#pragma unroll
            for (int b = 0; b < 2; ++b)
#pragma unroll
                for (int m = 0; m < 4; ++m)
#pragma unroll
                    for (int n = 0; n < 2; ++n) acc[a][b][m][n] = (f32x4){0.f, 0.f, 0.f, 0.f};
        cur = nxt; cA = nA; cB = nB; ++ui;
        if constexpr (ALIGN_EPI) { if (wr == 1) PG8_BAR; }
    }
    PG8_WAIT_V(0);
    if constexpr (!ALIGN_EPI) { if (wr == 0) PG8_BAR; }
    PG8_BAR;
    if constexpr (Epi::AFTER_DRAIN) { E.fused(acc, cur, wr, wc, fr, fq, lds, wid, lane); S.done(cur); }
#undef PG8_SA
#undef PG8_SB
#undef PG8_STAGE
#undef PG8_LDA
#undef PG8_LDB
#undef PG8_MMA
#undef PG8_WAIT_V
#undef PG8_WAIT_L
#undef PG8_BAR
#undef PG8_SCHED
}
}
namespace mk {
typedef pg8::bf16_t bf16;
typedef pg8::f32x4 f32x4;
typedef pg8::u32x4 u32x4;
typedef pg8::bf16x8 bf16x8;
typedef pg8::Unit Unit;
typedef float f32x16 __attribute__((ext_vector_type(16)));
typedef unsigned u32x2 __attribute__((ext_vector_type(2)));
#define LAS __attribute__((address_space(3)))
#define LDS_WAIT() asm volatile("s_waitcnt lgkmcnt(0)" ::: "memory")

constexpr int DM = 1024, T = 4096, NBP = 4, MP = NBP * T, DB = 128, DS = 4, MS = DB * DS, M = MP + MS, NL = 4;
constexpr int INC = 2304, DFF = 2816, K2 = 512, N2 = 1280, PLE = 256;
constexpr int C_K = 512, C_V = 640, C_RW = 768, C_XB = 1792, C_GB = 2048;

constexpr size_t SZ_WIN = (size_t)INC * DM * 2, SZ_W2 = (size_t)N2 * K2 * 2, SZ_WOUT = (size_t)DM * DM * 2, SZ_WGU = (size_t)2 * DFF * DM * 2,
                 SZ_WD = (size_t)DM * DFF * 2, SZ_WPG = (size_t)DM * DM * 2, SZ_WP = (size_t)DM * PLE * 2;
constexpr size_t O_WIN = 0, O_W2 = O_WIN + SZ_WIN, O_WOUT = O_W2 + SZ_W2, O_WGU = O_WOUT + SZ_WOUT, O_WD = O_WGU + SZ_WGU, O_WPG = O_WD + SZ_WD,
                 O_WP = O_WPG + SZ_WPG, WL = O_WP + SZ_WP;
constexpr size_t WS_W = 1u << 20, SZ_PBL = (size_t)M * PLE * 2, WS_PB = WS_W + NL * WL, SZ_ACT = (size_t)M * DM * 2, WS_HN = WS_PB + NL * SZ_PBL,
                 WS_R1 = WS_HN + SZ_ACT, SZ_R1 = (size_t)M * INC * 2, WS_R2 = WS_R1 + SZ_R1, SZ_F256 = (size_t)M * 256 * 4, WS_R3 = WS_R2 + 7 * SZ_F256,
                 WS_END = WS_R3 + 3 * SZ_F256;
static_assert(WL % 256 == 0 && SZ_R1 >= (size_t)M * DM * 4 && 7 * SZ_F256 >= (size_t)M * DFF * 2, "ws map");

constexpr size_t OUT_Y = 0, OUT_KP = (size_t)M * DM, OUT_VP = OUT_KP + (size_t)NL * NBP * 128 * 128, OUT_SHP = OUT_VP + (size_t)NL * NBP * 128 * 128,
                 OUT_WKVP = OUT_SHP + (size_t)NL * NBP * 1024, OUT_CVP = OUT_WKVP + (size_t)NL * NBP * 4 * 4096, OUT_LRP = OUT_CVP + (size_t)NL * NBP * 768,
                 OUT_KS = OUT_LRP + (size_t)NL * NBP * 256, OUT_VS = OUT_KS + (size_t)NL * DB * 128 * 128, OUT_SHS = OUT_VS + (size_t)NL * DB * 128 * 128,
                 OUT_WKVS = OUT_SHS + (size_t)NL * DB * 1024, OUT_CVS = OUT_WKVS + (size_t)NL * DB * 4 * 4096, OUT_LRS = OUT_CVS + (size_t)NL * DB * 768,
                 OUT_END = OUT_LRS + (size_t)NL * DB * 256;

enum { I_XP = 0, I_XS, I_CK, I_CV, I_SSH, I_SWKV, I_SCV, I_SLRU, I_PP, I_PS, I_NMPRE, I_NMPOST, I_NFPRE, I_NFPOST, I_WIN, I_BIN, I_SINK, I_MU, I_W0, I_WUP,
       I_A0, I_AUP, I_GUP, I_KK, I_KA, I_RK, I_LNW, I_LNB, I_CW, I_CB, I_WA, I_BA, I_WI, I_BI, I_L, I_WOUT, I_BOUT, I_WG, I_WU, I_WDN, I_PW, I_PGW, N_IN };

__device__ __forceinline__ unsigned f2bf(float f) { unsigned u = __float_as_uint(f); return (u + 0x7fffu + ((u >> 16) & 1u)) >> 16; }
__device__ __forceinline__ unsigned pk2(float lo, float hi) { return f2bf(lo) | (f2bf(hi) << 16); }
__device__ __forceinline__ float bflo(unsigned w) { return __uint_as_float(w << 16); }
__device__ __forceinline__ float bfhi(unsigned w) { return __uint_as_float(w & 0xffff0000u); }
__device__ __forceinline__ float bf1(bf16 b) { return __uint_as_float((unsigned)b << 16); }
__device__ __forceinline__ f32x4 ld_bf4(const bf16* p) { const u32x2 w = *(const u32x2*)p; return (f32x4){bflo(w.x), bfhi(w.x), bflo(w.y), bfhi(w.y)}; }
__device__ __forceinline__ void st_bf4(bf16* p, f32x4 v) { u32x2 w; w.x = pk2(v.x, v.y); w.y = pk2(v.z, v.w); *(u32x2*)p = w; }
__device__ __forceinline__ float sigm(float x) { return 1.f / (1.f + __expf(-x)); }
__device__ __forceinline__ float tanh_(float x) { return 1.f - 2.f / (__expf(2.f * x) + 1.f); }
__device__ __forceinline__ float gelu_t(float x) { return 0.5f * x * (1.f + tanh_(0.7978845608f * (x + 0.044715f * x * x * x))); }
__device__ __forceinline__ float wave_sum(float v) {
#pragma unroll
    for (int o = 1; o < 64; o <<= 1) v += __shfl_xor(v, o);
    return v;
}
template <int CTRL> __device__ __forceinline__ float dppf(float x) { return __builtin_bit_cast(float, __builtin_amdgcn_mov_dpp(__builtin_bit_cast(int, x), CTRL, 0xf, 0xf, true)); }
__device__ __forceinline__ float red16(float x) { x += dppf<0xB1>(x); x += dppf<0x4E>(x); x += dppf<0x141>(x); x += dppf<0x128>(x); return x; }
__device__ __forceinline__ float dot4(f32x4 a, f32x4 b) { return (a.x * b.x + a.y * b.y) + (a.z * b.z + a.w * b.w); }

struct EpiF32 {
    static constexpr bool PERM = false, AFTER_DRAIN = false;
    float* O; int ldc; const float* bias;
    __device__ __forceinline__ void operator()(const f32x4 (&acc)[2][2][4][2], const Unit& u, int wr, int wc, int fr, int fq) const {
        asm volatile("" : "+v"(fr), "+v"(fq));
        const int row0 = u.pm * 256 + wr * 64 + fr, col0 = u.pn * 256 + wc * 32 + 4 * fq;
        f32x4 bv[2][2];
#pragma unroll
        for (int bj = 0; bj < 2; ++bj)
#pragma unroll
            for (int n = 0; n < 2; ++n) bv[bj][n] = bias ? *(const f32x4*)(bias + col0 + bj * 128 + n * 16) : (f32x4){0.f, 0.f, 0.f, 0.f};
#pragma unroll
        for (int ai = 0; ai < 2; ++ai)
#pragma unroll
            for (int m = 0; m < 4; ++m) { float* rowp = O + (size_t)(row0 + ai * 128 + m * 16) * ldc + col0;
#pragma unroll
                for (int bj = 0; bj < 2; ++bj)
#pragma unroll
                    for (int n = 0; n < 2; ++n) *(f32x4*)(rowp + bj * 128 + n * 16) = acc[ai][bj][m][n] + bv[bj][n]; }
    }
};
struct EpiPle {
    static constexpr bool PERM = false, AFTER_DRAIN = false;
    float* X; const float* PP;
    __device__ __forceinline__ void operator()(const f32x4 (&acc)[2][2][4][2], const Unit& u, int wr, int wc, int fr, int fq) const {
        asm volatile("" : "+v"(fr), "+v"(fq));
        const int row0 = u.pm * 256 + wr * 64 + fr, col0 = u.pn * 256 + wc * 32 + 4 * fq;
#pragma unroll
        for (int ai = 0; ai < 2; ++ai)
#pragma unroll
            for (int m = 0; m < 4; ++m) { const size_t off = (size_t)(row0 + ai * 128 + m * 16) * DM + col0;
#pragma unroll
                for (int bj = 0; bj < 2; ++bj)
#pragma unroll
                    for (int n = 0; n < 2; ++n) { const size_t o = off + bj * 128 + n * 16; const f32x4 x = *(const f32x4*)(X + o), p = *(const f32x4*)(PP + o), a = acc[ai][bj][m][n];
                        *(f32x4*)(X + o) = (f32x4){x.x + sigm(a.x) * p.x, x.y + sigm(a.y) * p.y, x.z + sigm(a.z) * p.z, x.w + sigm(a.w) * p.w}; }
                asm volatile("" ::: "memory"); }
    }
};
struct EpiSwiglu {
    static constexpr bool PERM = true, AFTER_DRAIN = false;
    bf16* O;
    __device__ __forceinline__ void operator()(const f32x4 (&acc)[2][2][4][2], const Unit& u, int wr, int wc, int fr, int fq) const {
        asm volatile("" : "+v"(fr), "+v"(fq));
        const int row0 = u.pm * 256 + wr * 64 + fr, col0 = u.pn * 128 + wc * 32 + 8 * fq;
#pragma unroll
        for (int ai = 0; ai < 2; ++ai)
#pragma unroll
            for (int m = 0; m < 4; ++m) { bf16* p = O + (size_t)(row0 + ai * 128 + m * 16) * DFF + col0;
                const f32x4 g0 = acc[ai][0][m][0], g1 = acc[ai][0][m][1], u0 = acc[ai][1][m][0], u1 = acc[ai][1][m][1];
                u32x4 w; w.x = pk2(g0.x * sigm(g0.x) * u0.x, g0.y * sigm(g0.y) * u0.y); w.y = pk2(g0.z * sigm(g0.z) * u0.z, g0.w * sigm(g0.w) * u0.w);
                w.z = pk2(g1.x * sigm(g1.x) * u1.x, g1.y * sigm(g1.y) * u1.y); w.w = pk2(g1.z * sigm(g1.z) * u1.z, g1.w * sigm(g1.w) * u1.w);
                *(u32x4*)p = w; }
    }
};
struct EpiMix {
    static constexpr bool PERM = false, AFTER_DRAIN = false;
    const float *w0, *a0, *k_a, *b_a, *b_i, *Lp; float *Wd, *Ks, *KK, *BV, *G, *AL, *U; const bf16* A2;
    __device__ __forceinline__ void operator()(const f32x4 (&acc)[2][2][4][2], const Unit& u, int wr, int wc, int fr, int fq) const {
        asm volatile("" : "+v"(fr), "+v"(fq));
        const int row0 = u.pm * 256 + wr * 64 + fr;
        if (u.pn < 3) {
#pragma unroll
            for (int ai = 0; ai < 2; ++ai)
#pragma unroll
                for (int m = 0; m < 4; ++m) { const size_t ro = (size_t)(row0 + ai * 128 + m * 16) * 256;
#pragma unroll
                    for (int bj = 0; bj < 2; ++bj)
#pragma unroll
                        for (int n = 0; n < 2; ++n) { const int c = bj * 128 + wc * 32 + n * 16 + 4 * fq; const f32x4 z = acc[ai][bj][m][n];
                            if (u.pn == 0) { const f32x4 b = *(const f32x4*)(w0 + c); f32x4 d;
                                d.x = __expf(-0.60653066f * sigm(z.x + b.x)); d.y = __expf(-0.60653066f * sigm(z.y + b.y)); d.z = __expf(-0.60653066f * sigm(z.z + b.z)); d.w = __expf(-0.60653066f * sigm(z.w + b.w));
                                *(f32x4*)(Wd + ro + c) = d; }
                            else if (u.pn == 1) { const f32x4 b = *(const f32x4*)(a0 + c), ka = *(const f32x4*)(k_a + c), ks = *(const f32x4*)(Ks + ro + c), kk = *(const f32x4*)(KK + ro + c);
                                f32x4 a; a.x = sigm(z.x + b.x); a.y = sigm(z.y + b.y); a.z = sigm(z.z + b.z); a.w = sigm(z.w + b.w);
                                *(f32x4*)(Ks + ro + c) = ks * (1.f + (a - 1.f) * ka); *(f32x4*)(BV + ro + c) = kk * a; }
                            else { *(f32x4*)(G + ro + c) = z; } }
                    asm volatile("" ::: "memory"); }
        } else {
            const int t = u.pn - 3;
#pragma unroll
            for (int ai = 0; ai < 2; ++ai)
#pragma unroll
                for (int m = 0; m < 4; ++m) { const size_t r = (size_t)(row0 + ai * 128 + m * 16);
#pragma unroll
                    for (int n = 0; n < 2; ++n) { const int cc = 128 * t + wc * 32 + n * 16 + 4 * fq;
                        const f32x4 zr = acc[ai][0][m][n] + *(const f32x4*)(b_a + cc), zi = acc[ai][1][m][n] + *(const f32x4*)(b_i + cc), Lv = *(const f32x4*)(Lp + cc), xc = ld_bf4(A2 + r * K2 + 256 + cc);
                        f32x4 al, uu;
#define LRU1(e) { const float xe = __expf(-Lv.e); const float ls = -xe * (1.f + xe * (-0.5f + xe * 0.33333334f)); const float la = 8.f * sigm(zr.e) * ls; al.e = __expf(la); const float z2 = 2.f * la; \
    const float om = -z2 * (1.f + z2 * (0.5f + z2 * (0.16666667f + z2 * (0.041666668f + z2 * 0.0083333338f)))); uu.e = sqrtf(om) * sigm(zi.e) * xc.e; }
                        LRU1(x) LRU1(y) LRU1(z) LRU1(w)
#undef LRU1
                        *(f32x4*)(AL + r * 256 + cc) = al; *(f32x4*)(U + r * 256 + cc) = uu; }
                    asm volatile("" ::: "memory"); }
        }
    }
};
#define RLX_AGENT __ATOMIC_RELAXED, __HIP_MEMORY_SCOPE_AGENT
#define XB_TMO      128
#define XB_XCNT(j)  (256  + 64 * (j))
#define XB_XSUB(j)  (1280 + 64 * (j))
#define XB_XGEN(j)  (2304 + 64 * (j))
#define XB_TOP      3328
#define XB_TOPGEN   3392
#define XCD_BAR_WORDS 3456
#define XB_SPIN_CAP (1u << 18)

__device__ __forceinline__ unsigned xb_ld(unsigned* p)              { return __hip_atomic_load(p, __ATOMIC_RELAXED, __HIP_MEMORY_SCOPE_AGENT); }
__device__ __forceinline__ unsigned xb_add(unsigned* p, unsigned v) { return __hip_atomic_fetch_add(p, v, __ATOMIC_RELAXED, __HIP_MEMORY_SCOPE_AGENT); }
__device__ __forceinline__ unsigned xb_xcc_id() { return (unsigned)__builtin_amdgcn_s_getreg((3 << 11) | 20) & 0xFu; }
#define XB_SPIN(cond, bar) do { unsigned _sp = 0; while (cond) { __builtin_amdgcn_s_sleep(1); \
    if ((++_sp & 255u) == 0u) { if (xb_ld(&(bar)[XB_TMO])) break; if (_sp > XB_SPIN_CAP) { atomicAdd(&(bar)[XB_TMO], 1u); break; } } } } while (0)

struct XcdBarrier {
    unsigned* bar; unsigned x;
    volatile LAS unsigned* st;
};

__device__ __forceinline__ XcdBarrier xcd_barrier_post(unsigned* bar, volatile LAS unsigned* st, int tid) {
    XcdBarrier b; b.bar = bar; b.x = xb_xcc_id(); b.st = st;
    if (tid == 0) (void)xb_add(&bar[XB_XCNT(b.x)], 1u);
    return b;
}
__device__ __forceinline__ void xcd_barrier_complete(unsigned* bar, unsigned x, unsigned& nloc, unsigned& nx) {
    const unsigned G = gridDim.x * gridDim.y * gridDim.z;
    unsigned sum, cnt, mine, sp = 0u;
    for (;;) {
        sum = 0u; cnt = 0u; mine = 0u;
#pragma unroll
        for (unsigned j = 0; j < 16; ++j) { const unsigned c = xb_ld(&bar[XB_XCNT(j)]); sum += c; cnt += (c > 0u) ? 1u : 0u; mine = (j == x) ? c : mine; }
        if (sum == G) break;
        __builtin_amdgcn_s_sleep(1);
        if ((++sp & 255u) == 0u) { if (xb_ld(&bar[XB_TMO])) break; if (sp > XB_SPIN_CAP) { atomicAdd(&bar[XB_TMO], 1u); break; } }
    }
    nloc = mine > 0u ? mine : 1u; nx = cnt > 0u ? cnt : 1u;
}

__device__ __forceinline__ void xcd_barrier(const XcdBarrier& b, int tid) {
    asm volatile("s_waitcnt vmcnt(0)" ::: "memory");
    __syncthreads();
    if (tid == 0) {
        unsigned* bar = b.bar;
        __builtin_amdgcn_s_waitcnt(0);
        unsigned nloc = b.st[0], nx = b.st[1];
        if (nloc == 0u) { xcd_barrier_complete(bar, b.x, nloc, nx); b.st[0] = nloc; b.st[1] = nx; }
        const unsigned old = xb_add(&bar[XB_XSUB(b.x)], 1u);
        const unsigned gen = old / nloc;
        if (old + 1u == (gen + 1u) * nloc) {
            __builtin_amdgcn_fence(__ATOMIC_RELEASE, "agent");
            asm volatile("s_waitcnt vmcnt(0)" ::: "memory");
            const unsigned og = xb_add(&bar[XB_TOP], 1u);
            const unsigned tg = og / nx;
            if (og + 1u == (tg + 1u) * nx) xb_add(&bar[XB_TOPGEN], 1u);
            else XB_SPIN(xb_ld(&bar[XB_TOPGEN]) == tg, bar);
            __builtin_amdgcn_fence(__ATOMIC_ACQUIRE, "agent");
            xb_add(&bar[XB_XGEN(b.x)], 1u);
            asm volatile("s_waitcnt vmcnt(0)" ::: "memory");
        } else {
            XB_SPIN(xb_ld(&bar[XB_XGEN(b.x)]) == gen, bar);
            __builtin_amdgcn_fence(__ATOMIC_ACQUIRE, "agent");
            asm volatile("s_waitcnt vmcnt(0)" ::: "memory");
        }
    }
    __syncthreads();
}
struct Args { const float* in[N_IN]; float* out; unsigned char* ws; };
struct Ctx {
    LAS unsigned char* lds; unsigned char* ws; float* out;
    int tid, lane, wave, bid, G, gw, NGW;
};
__device__ __forceinline__ const float* inp_ld(int k) {
    asm volatile("" : "+s"(k));
    const __attribute__((address_space(4))) unsigned long long* tab = (const __attribute__((address_space(4))) unsigned long long*)__builtin_amdgcn_kernarg_segment_ptr();
    return (const float*)tab[k];
}
#define INP(k) inp_ld(k)

__device__ __forceinline__ void tr_item(const float* W, int ldw, bf16* WT, int ldt, int k0, int n0, int drow, int dcol, LAS float* scr, int lane) {
#pragma unroll 8
    for (int i = 0; i < 32; ++i) { const int kk = 2 * i + (lane >> 5); scr[kk * 33 + (lane & 31)] = W[(size_t)(k0 + kk) * ldw + n0 + (lane & 31)]; }
    LDS_WAIT(); asm volatile("" ::: "memory");
    const int c = lane & 7;
#pragma unroll
    for (int j = 0; j < 4; ++j) { const int n = (lane >> 3) + 8 * j; const LAS float* s = scr + (8 * c) * 33 + n;
        u32x4 o; o.x = pk2(s[0 * 33], s[1 * 33]); o.y = pk2(s[2 * 33], s[3 * 33]); o.z = pk2(s[4 * 33], s[5 * 33]); o.w = pk2(s[6 * 33], s[7 * 33]);
        *(u32x4*)(WT + (size_t)(drow + n) * ldt + dcol + 8 * c) = o; }
    LDS_WAIT(); asm volatile("" ::: "memory");
}
__device__ __forceinline__ void row_norm(const float* xrow, const float* g, bf16* orow, float* xcopy, int lane) {
    f32x4 v[4]; float ss = 0.f;
#pragma unroll
    for (int j = 0; j < 4; ++j) { v[j] = *(const f32x4*)(xrow + 4 * lane + 256 * j); ss += dot4(v[j], v[j]); }
    const float rs = rsqrtf(wave_sum(ss) * (1.f / DM) + 1e-6f);
#pragma unroll
    for (int j = 0; j < 4; ++j) { const f32x4 gg = *(const f32x4*)(g + 4 * lane + 256 * j); if (xcopy) *(f32x4*)(xcopy + 4 * lane + 256 * j) = v[j]; st_bf4(orow + 4 * lane + 256 * j, v[j] * rs * gg); }
}
__device__ __forceinline__ void row_update(const float* add, const float* gA, float* X, const float* gB, bf16* outB, int lane) {
    f32x4 a[4], x[4]; float ss = 0.f;
#pragma unroll
    for (int j = 0; j < 4; ++j) { a[j] = *(const f32x4*)(add + 4 * lane + 256 * j); x[j] = *(const f32x4*)(X + 4 * lane + 256 * j); ss += dot4(a[j], a[j]); }
    const float rs = rsqrtf(wave_sum(ss) * (1.f / DM) + 1e-6f); float s2 = 0.f;
#pragma unroll
    for (int j = 0; j < 4; ++j) { const f32x4 gg = *(const f32x4*)(gA + 4 * lane + 256 * j); x[j] = x[j] + a[j] * rs * gg; *(f32x4*)(X + 4 * lane + 256 * j) = x[j]; s2 += dot4(x[j], x[j]); }
    float r2 = 1.f;
    if (gB) r2 = rsqrtf(wave_sum(s2) * (1.f / DM) + 1e-6f);
#pragma unroll
    for (int j = 0; j < 4; ++j) { f32x4 o = x[j]; if (gB) o = o * r2 * *(const f32x4*)(gB + 4 * lane + 256 * j); st_bf4(outB + 4 * lane + 256 * j, o); }
}

__device__ __forceinline__ void p0_prologue(const Ctx& C, const Args& A) {
    LAS float* scr = (LAS float*)(C.lds + C.wave * 16384);
    constexpr int J0 = 16 * 72, J1 = 16 * 32, J2 = 16 * 88, J4 = 44 * 32, J5 = 16 * 32, J6 = 4 * 32, JL = J0 + J1 + 2 * J2 + J4 + J5 + J6;
    for (int it = C.gw; it < NL * JL; it += C.NGW) {
        const int l = it / JL; int r = it % JL; unsigned char* wl = C.ws + WS_W + (size_t)l * WL;
        const float* W; int ldw, ldt, kb, nb, drow; bf16* WT;
        if (r < J0) { W = INP(I_WIN) + (size_t)l * DM * INC; ldw = INC; WT = (bf16*)(wl + O_WIN); ldt = DM; kb = r / 72; nb = r % 72; drow = 32 * nb; }
        else if ((r -= J0) < J1) { W = INP(I_WOUT) + (size_t)l * DM * DM; ldw = DM; WT = (bf16*)(wl + O_WOUT); ldt = DM; kb = r / 32; nb = r % 32; drow = 32 * nb; }
        else if ((r -= J1) < J2) { W = INP(I_WG) + (size_t)l * DM * DFF; ldw = DFF; WT = (bf16*)(wl + O_WGU); ldt = DM; kb = r / 88; nb = r % 88; drow = (nb >> 2) * 256 + (nb & 3) * 32; }
        else if ((r -= J2) < J2) { W = INP(I_WU) + (size_t)l * DM * DFF; ldw = DFF; WT = (bf16*)(wl + O_WGU); ldt = DM; kb = r / 88; nb = r % 88; drow = (nb >> 2) * 256 + 128 + (nb & 3) * 32; }
        else if ((r -= J2) < J4) { W = INP(I_WDN) + (size_t)l * DFF * DM; ldw = DM; WT = (bf16*)(wl + O_WD); ldt = DFF; kb = r / 32; nb = r % 32; drow = 32 * nb; }
        else if ((r -= J4) < J5) { W = INP(I_PGW) + (size_t)l * DM * DM; ldw = DM; WT = (bf16*)(wl + O_WPG); ldt = DM; kb = r / 32; nb = r % 32; drow = 32 * nb; }
        else { r -= J5; W = INP(I_PW) + (size_t)l * PLE * DM; ldw = DM; WT = (bf16*)(wl + O_WP); ldt = PLE; kb = r / 32; nb = r % 32; drow = 32 * nb; }
        tr_item(W, ldw, WT, ldt, 64 * kb, 32 * nb, drow, 64 * kb, scr, C.lane);
    }
    const int gt = C.bid * 512 + C.tid, NT = C.G * 512;
    for (int e = gt; e < NL * N2 * K2; e += NT) {
        const int l = e / (N2 * K2), r = e % (N2 * K2), n = r / K2, k = r % K2; float v = 0.f;
        if (n < 256) { if (k < 64) v = INP(I_WUP)[((size_t)l * 64 + k) * 256 + n]; }
        else if (n < 512) { if (k >= 64 && k < 128) v = INP(I_AUP)[((size_t)l * 64 + (k - 64)) * 256 + (n - 256)]; }
        else if (n < 768) { if (k >= 128 && k < 256) v = INP(I_GUP)[((size_t)l * 128 + (k - 128)) * 256 + (n - 512)]; }
        else { const int tt = (n - 768) >> 8, rr = (n - 768) & 255, cc = 128 * tt + (rr & 127), h = cc >> 6, j = cc & 63;
            if (k >= 256 && ((k - 256) >> 6) == h) v = ((rr >> 7) ? INP(I_WI) : INP(I_WA))[(((size_t)l * 4 + h) * 64 + ((k - 256) & 63)) * 64 + j]; }
        ((bf16*)(C.ws + WS_W + (size_t)l * WL + O_W2))[r] = (bf16)f2bf(v);
    }
    for (int e = gt; e < NL * M * (PLE / 4); e += NT) {
        const int l = e / (M * 64), r = e % (M * 64), m = r >> 6, c4 = (r & 63) * 4;
        const float* src = m < MP ? INP(I_PP) + ((size_t)l * MP + m) * PLE + c4 : INP(I_PS) + ((size_t)l * MS + (m - MP)) * PLE + c4;
        st_bf4((bf16*)(C.ws + WS_PB + (size_t)l * SZ_PBL) + (size_t)m * PLE + c4, *(const f32x4*)src);
    }
    for (int m = C.gw; m < M; m += C.NGW) {
        const float* src = m < MP ? INP(I_XP) + (size_t)m * DM : INP(I_XS) + (size_t)(m - MP) * DM;
        row_norm(src, INP(I_NMPRE), (bf16*)(C.ws + WS_HN) + (size_t)m * DM, C.out + (size_t)m * DM, C.lane);
    }
}

__device__ __forceinline__ void e1_prep(const Ctx& C, const Args& A, int l) {
    const bf16* PROJ = (const bf16*)(C.ws + WS_R1);
    float* R = (float*)(C.ws + WS_R2); float* Ks = R + (size_t)M * 256; float* V = Ks + (size_t)M * 256; float* KK = V + (size_t)M * 256;
    bf16* A2 = (bf16*)(C.ws + WS_R3);
    const int lane = C.lane, c4 = 4 * lane;
    for (int m = C.gw; m < M; m += C.NGW) {
        const bool samp = m >= MP; int b, t;
        if (!samp) { b = m >> 12; t = m & 4095; } else { b = (m - MP) >> 2; t = (m - MP) & 3; }
        const bf16* pr = PROJ + (size_t)m * INC;
#pragma unroll
        for (int cg = 0; cg < 4; ++cg) {
            const int col = 256 * cg + c4;
            const f32x4 cur = ld_bf4(pr + C_RW + col); f32x4 prv = (f32x4){0.f, 0.f, 0.f, 0.f};
            if (t > 0) prv = ld_bf4(pr - INC + C_RW + col);
            else if (samp) prv = *(const f32x4*)(INP(I_SSH) + ((size_t)l * DB + b) * 1024 + col);
            const f32x4 mu = *(const f32x4*)(INP(I_MU) + l * 1024 + col);
            const f32x4 xs = cur + (prv - cur) * mu;
            if (cg == 0) *(f32x4*)(R + (size_t)m * 256 + c4) = xs;
            else if (cg == 1) { *(f32x4*)(Ks + (size_t)m * 256 + c4) = xs; f32x4 kk = xs * *(const f32x4*)(INP(I_KK) + l * 256 + c4);
                const float ss = red16(dot4(kk, kk)); kk = kk * rsqrtf(fmaxf(ss, 1e-24f)); *(f32x4*)(KK + (size_t)m * 256 + c4) = kk; }
            else if (cg == 2) *(f32x4*)(V + (size_t)m * 256 + c4) = xs;
            else { f32x4 o;
                if (lane < 16) o = (f32x4){tanh_(xs.x), tanh_(xs.y), tanh_(xs.z), tanh_(xs.w)};
                else if (lane < 32) o = xs;
                else o = (f32x4){sigm(xs.x), sigm(xs.y), sigm(xs.z), sigm(xs.w)};
                st_bf4(A2 + (size_t)m * K2 + c4, o); }
        }
        f32x4 xc = *(const f32x4*)(INP(I_CB) + l * 256 + c4);
#pragma unroll
        for (int j = 0; j < 4; ++j) { const int tt = t - 3 + j; f32x4 val = (f32x4){0.f, 0.f, 0.f, 0.f};
            if (tt >= 0) val = ld_bf4(pr + (ptrdiff_t)(j - 3) * INC + C_XB + c4);
            else if (samp) val = *(const f32x4*)(INP(I_SCV) + (((size_t)l * DB + b) * 3 + (tt + 3)) * 256 + c4);
            xc = xc + val * *(const f32x4*)(INP(I_CW) + ((size_t)l * 4 + j) * 256 + c4); }
        st_bf4(A2 + (size_t)m * K2 + 256 + c4, xc);
    }
    const int gt = C.bid * 512 + C.tid, NT = C.G * 512;
    float* out = C.out;
    for (int e = gt; e < 2 * NBP * 128 * 128; e += NT) {
        const int kv = e / (NBP * 16384), r = e % (NBP * 16384), b = r >> 14, rr = (r >> 7) & 127, c = r & 127;
        out[(kv ? OUT_VP : OUT_KP) + (size_t)l * NBP * 16384 + r] = bf1(PROJ[(size_t)(b * T + T - 128 + rr) * INC + (kv ? C_V : C_K) + c]);
    }
    for (int e = gt; e < NBP * 1024; e += NT) { const int b = e >> 10, c = e & 1023; out[OUT_SHP + (size_t)l * NBP * 1024 + e] = bf1(PROJ[(size_t)(b * T + T - 1) * INC + C_RW + c]); }
    for (int e = gt; e < DB * 1024; e += NT) { const int b = e >> 10, c = e & 1023; out[OUT_SHS + (size_t)l * DB * 1024 + e] = bf1(PROJ[(size_t)(MP + 4 * b + 3) * INC + C_RW + c]); }
    for (int e = gt; e < NBP * 768; e += NT) { const int b = e / 768, j = (e % 768) >> 8, c = e & 255; out[OUT_CVP + (size_t)l * NBP * 768 + e] = bf1(PROJ[(size_t)(b * T + T - 3 + j) * INC + C_XB + c]); }
    for (int e = gt; e < DB * 768; e += NT) { const int b = e / 768, j = (e % 768) >> 8, c = e & 255; out[OUT_CVS + (size_t)l * DB * 768 + e] = bf1(PROJ[(size_t)(MP + 4 * b + 1 + j) * INC + C_XB + c]); }
}

struct RwkvPtrs { const float *R, *K, *V, *KK, *BV, *W; float* YR; };
__device__ __forceinline__ void rwkv_step(f32x4& s, const f32x4 w, const f32x4 kk, const f32x4 bv, const f32x4 k2, const f32x4 r, const float v, float& y) {
    const float sa = red16(dot4(s, kk));
    s = s * w + (k2 * v - bv * sa);
    y = red16(dot4(s, r));
}
__device__ __forceinline__ void rwkv_prompt(const Ctx& C, const RwkvPtrs& P, int wg, float* wkv_out  ) {
    constexpr int TC = 32, VEC = TC * 64 * 4, BUF = 5 * VEC + TC * 16 * 4;
    const int chain = wg >> 2, b = chain >> 2, h = chain & 3, qr = wg & 3, tid = C.tid, lane = C.lane, wave = C.wave;
    const size_t m0 = (size_t)b * T;
    const float* src[5] = {P.W, P.KK, P.BV, P.K, P.R};
    const int lstep = tid >> 4, lq = tid & 15;
    const int vstep = tid >> 2, vq = tid & 3;
    f32x4 st[5], stv;
    f32x4 s = (f32x4){0.f, 0.f, 0.f, 0.f};
    const int row = 16 * qr + 4 * wave + (lane >> 4), cq = lane & 15;
#define RW_LOAD(c) do { _Pragma("unroll") for (int i = 0; i < 5; ++i) st[i] = *(const f32x4*)(src[i] + (m0 + (size_t)(c) * TC + lstep) * 256 + h * 64 + 4 * lq); \
        if (tid < 128) stv = *(const f32x4*)(P.V + (m0 + (size_t)(c) * TC + vstep) * 256 + h * 64 + 16 * qr + 4 * vq); } while (0)
#define RW_STORE(bufi) do { LAS unsigned char* bb = C.lds + (bufi) * BUF; _Pragma("unroll") for (int i = 0; i < 5; ++i) *(LAS f32x4*)(bb + i * VEC + (lstep * 64 + 4 * lq) * 4) = st[i]; \
        if (tid < 128) *(LAS f32x4*)(bb + 5 * VEC + (vstep * 16 + 4 * vq) * 4) = stv; } while (0)
    RW_LOAD(0); RW_STORE(0); __syncthreads();
    for (int c = 0; c < T / TC; ++c) {
        if (c + 1 < T / TC) RW_LOAD(c + 1);
        if (wave < 4) {
            const LAS unsigned char* bb = C.lds + (c & 1) * BUF;
#pragma unroll 4
            for (int i = 0; i < TC; ++i) {
                const f32x4 w = *(const LAS f32x4*)(bb + 0 * VEC + (i * 64 + 4 * cq) * 4), kk = *(const LAS f32x4*)(bb + 1 * VEC + (i * 64 + 4 * cq) * 4),
                            bv = *(const LAS f32x4*)(bb + 2 * VEC + (i * 64 + 4 * cq) * 4), k2 = *(const LAS f32x4*)(bb + 3 * VEC + (i * 64 + 4 * cq) * 4),
                            r = *(const LAS f32x4*)(bb + 4 * VEC + (i * 64 + 4 * cq) * 4);
                const float v = *(const LAS float*)(bb + 5 * VEC + (i * 16 + 4 * wave + (lane >> 4)) * 4);
                float y; rwkv_step(s, w, kk, bv, k2, r, v, y);
                if (cq == 0) P.YR[(m0 + (size_t)c * TC + i) * 256 + h * 64 + row] = y;
            }
        }
        if (c + 1 < T / TC) RW_STORE((c + 1) & 1);
        __syncthreads();
    }
#undef RW_LOAD
#undef RW_STORE
    if (wave < 4) *(f32x4*)(wkv_out + (((size_t)b * 4 + h) * 64 + row) * 64 + 4 * cq) = s;
}
__device__ __forceinline__ void rwkv_sample_item(const RwkvPtrs& P, int item, const float* wkv_in, float* wkv_out, int lane) {
    const int rg = item & 15, h = (item >> 4) & 3, b = item >> 6, row = 4 * rg + (lane >> 4), cq = lane & 15;
    const size_t so = (((size_t)b * 4 + h) * 64 + row) * 64 + 4 * cq;
    f32x4 s = *(const f32x4*)(wkv_in + so);
#pragma unroll
    for (int i = 0; i < DS; ++i) { const size_t m = (size_t)MP + 4 * b + i, o = m * 256 + h * 64 + 4 * cq;
        float y; rwkv_step(s, *(const f32x4*)(P.W + o), *(const f32x4*)(P.KK + o), *(const f32x4*)(P.BV + o), *(const f32x4*)(P.K + o), *(const f32x4*)(P.R + o), P.V[m * 256 + h * 64 + row], y);
        if (cq == 0) P.YR[m * 256 + h * 64 + row] = y; }
    *(f32x4*)(wkv_out + so) = s;
}
__device__ __forceinline__ void lru_prompt_item(const Ctx& C, int item, const float* AL, const float* U, const bf16* PROJ, bf16* MIXCAT, float* lru_out  ) {
    const int b = item >> 4, c = (item & 15) * 16 + (C.tid & 15), seg = C.tid >> 4; constexpr int SL = T / 32;
    const size_t m0 = (size_t)b * T + (size_t)seg * SL;
    LAS float* sA = (LAS float*)C.lds; LAS float* sH = sA + 512;
    float Ap = 1.f, H = 0.f;
#pragma unroll 8
    for (int i = 0; i < SL; ++i) { const float a = AL[(m0 + i) * 256 + c], u = U[(m0 + i) * 256 + c]; H = a * H + u; Ap *= a; }
    sA[C.tid] = Ap; sH[C.tid] = H;
    __syncthreads();
    float h = 0.f;
    for (int sp = 0; sp < seg; ++sp) h = sA[sp * 16 + (C.tid & 15)] * h + sH[sp * 16 + (C.tid & 15)];
#pragma unroll 8
    for (int i = 0; i < SL; ++i) { const float a = AL[(m0 + i) * 256 + c], u = U[(m0 + i) * 256 + c]; h = a * h + u;
        const float gb = bf1(PROJ[(m0 + i) * INC + C_GB + c]); MIXCAT[(m0 + i) * DM + 768 + c] = (bf16)f2bf(h * gelu_t(gb)); }
    if (seg == 31) lru_out[b * 256 + c] = h;
    __syncthreads();
}
__device__ __forceinline__ void swa_prompt_item(const Ctx& C, int item, const bf16* PROJ, bf16* MIXCAT, const float* sinks  ) {
    constexpr int KP = 72, VP = 264;
    const int kvh = item & 1, n = (item >> 1) & 31, b = item >> 6, tid = C.tid, lane = C.lane, wave = C.wave;
    LAS bf16* Ks = (LAS bf16*)C.lds; LAS bf16* Vt = Ks + 256 * KP;
    const size_t rowq0 = (size_t)b * T + (size_t)n * 128;
    { const int key = tid >> 1, hf = tid & 1; size_t kr = rowq0 + key; kr = (kr >= 128 + (size_t)b * T) ? kr - 128 : kr;
        const bf16* kp = PROJ + kr * INC + C_K + kvh * 64 + hf * 32;
#pragma unroll
        for (int i = 0; i < 4; ++i) *(LAS u32x4*)(Ks + key * KP + hf * 32 + 8 * i) = *(const u32x4*)(kp + 8 * i);
#pragma unroll
        for (int i = 0; i < 4; ++i) { const int ch = tid + 512 * i, vk = ch >> 3, d0 = (ch & 7) * 8; size_t vr = rowq0 + vk; vr = (vr >= 128 + (size_t)b * T) ? vr - 128 : vr;
            const u32x4 w = *(const u32x4*)(PROJ + vr * INC + C_V + kvh * 64 + d0);
            Vt[(d0 + 0) * VP + vk] = (bf16)(w.x & 0xffff); Vt[(d0 + 1) * VP + vk] = (bf16)(w.x >> 16); Vt[(d0 + 2) * VP + vk] = (bf16)(w.y & 0xffff); Vt[(d0 + 3) * VP + vk] = (bf16)(w.y >> 16);
            Vt[(d0 + 4) * VP + vk] = (bf16)(w.z & 0xffff); Vt[(d0 + 5) * VP + vk] = (bf16)(w.z >> 16); Vt[(d0 + 6) * VP + vk] = (bf16)(w.w & 0xffff); Vt[(d0 + 7) * VP + vk] = (bf16)(w.w >> 16); } }
    __syncthreads();
    const int q = lane & 31, hi = lane >> 5;
#pragma unroll 1
    for (int qi = 0; qi < 2; ++qi) {
        const int qt = wave * 2 + qi, g = qt >> 2, j = qt & 3, hh = kvh * 4 + g;
        const size_t qrow = rowq0 + 32 * j + q;
        bf16x8 qf[4];
#pragma unroll
        for (int dk = 0; dk < 4; ++dk) qf[dk] = *(const bf16x8*)(PROJ + qrow * INC + hh * 64 + 16 * dk + 8 * hi);
        f32x16 sc[5];
#pragma unroll
        for (int kt = 0; kt < 5; ++kt) {
            f32x16 acc;
#pragma unroll
            for (int i = 0; i < 16; ++i) acc[i] = 0.f;
#pragma unroll
            for (int dk = 0; dk < 4; ++dk) { const bf16x8 kf = *(const LAS bf16x8*)(Ks + (32 * (j + kt) + q) * KP + 16 * dk + 8 * hi); acc = __builtin_amdgcn_mfma_f32_32x32x16_bf16(kf, qf[dk], acc, 0, 0, 0); }
            sc[kt] = acc;
        }
        const int qpos = 128 + 32 * j + q; float mx = -INFINITY;
#pragma unroll
        for (int kt = 0; kt < 5; ++kt)
#pragma unroll
            for (int i = 0; i < 16; ++i) { const int kj = 32 * (j + kt) + (i & 3) + 8 * (i >> 2) + 4 * hi, d = qpos - kj; const bool ok = d >= 0 && d <= 128 && (n > 0 || kj >= 128);
                const float sv = ok ? sc[kt][i] * 0.125f : -INFINITY; sc[kt][i] = sv; mx = fmaxf(mx, sv); }
        mx = fmaxf(mx, __shfl_xor(mx, 32)); const float sink = sinks[hh]; mx = fmaxf(mx, sink);
        float sum = 0.f;
#pragma unroll
        for (int kt = 0; kt < 5; ++kt)
#pragma unroll
            for (int i = 0; i < 16; ++i) { const float e = __expf(sc[kt][i] - mx); sc[kt][i] = e; sum += e; }
        sum += __shfl_xor(sum, 32);
        const float inv = 1.f / (sum + __expf(sink - mx));
#pragma unroll
        for (int dt = 0; dt < 2; ++dt) {
            f32x16 o;
#pragma unroll
            for (int i = 0; i < 16; ++i) o[i] = 0.f;
#pragma unroll
            for (int kt = 0; kt < 5; ++kt)
#pragma unroll
                for (int s2 = 0; s2 < 2; ++s2) {
                    u32x4 pw; pw.x = pk2(sc[kt][8 * s2 + 0], sc[kt][8 * s2 + 1]); pw.y = pk2(sc[kt][8 * s2 + 2], sc[kt][8 * s2 + 3]); pw.z = pk2(sc[kt][8 * s2 + 4], sc[kt][8 * s2 + 5]); pw.w = pk2(sc[kt][8 * s2 + 6], sc[kt][8 * s2 + 7]);
                    const LAS bf16* vp = Vt + (32 * dt + q) * VP + 32 * (j + kt) + 16 * s2 + 4 * hi;
                    const u32x2 v0 = *(const LAS u32x2*)vp, v1 = *(const LAS u32x2*)(vp + 8);
                    u32x4 vw; vw.x = v0.x; vw.y = v0.y; vw.z = v1.x; vw.w = v1.y;
                    o = __builtin_amdgcn_mfma_f32_32x32x16_bf16(__builtin_bit_cast(bf16x8, vw), __builtin_bit_cast(bf16x8, pw), o, 0, 0, 0);
                }
#pragma unroll
            for (int g4 = 0; g4 < 4; ++g4) st_bf4(MIXCAT + qrow * DM + hh * 64 + 32 * dt + 8 * g4 + 4 * hi, (f32x4){o[4 * g4] * inv, o[4 * g4 + 1] * inv, o[4 * g4 + 2] * inv, o[4 * g4 + 3] * inv});
        }
    }
    __syncthreads();
}
__device__ __forceinline__ void swa_sample_item(const Ctx& C, int item, const bf16* PROJ, bf16* MIXCAT, const float* sinks, const float* ck, const float* cv, float* ko, float* vo) {
    const int kvh = item & 1, b = item >> 1, tid = C.tid;
    LAS float* Kf = (LAS float*)C.lds; LAS float* Vf = Kf + 132 * 65; LAS float* Qf = Vf + 132 * 64; LAS float* Pf = Qf + 16 * 64;
    for (int e = tid; e < 132 * 64; e += 512) { const int key = e >> 6, d = e & 63; float kx, vx;
        if (key < 128) { const size_t o = (((size_t)b * 128 + key) * 2 + kvh) * 64 + d; kx = ck[o]; vx = cv[o]; }
        else { const size_t r = (size_t)MP + 4 * b + (key - 128); kx = bf1(PROJ[r * INC + C_K + kvh * 64 + d]); vx = bf1(PROJ[r * INC + C_V + kvh * 64 + d]); }
        Kf[key * 65 + d] = kx; Vf[key * 64 + d] = vx;
        if (key >= 4) { const size_t o = (((size_t)b * 128 + (key - 4)) * 2 + kvh) * 64 + d; ko[o] = kx; vo[o] = vx; } }
    for (int e = tid; e < 16 * 64; e += 512) { const int qr = e >> 6, d = e & 63, i = qr >> 2, g = qr & 3; Qf[e] = bf1(PROJ[((size_t)MP + 4 * b + i) * INC + (kvh * 4 + g) * 64 + d]); }
    __syncthreads();
    { const int qr = tid >> 5, kl = tid & 31, i = qr >> 2, g = qr & 3; float sc[5]; float mx = -INFINITY;
#pragma unroll
        for (int k5 = 0; k5 < 5; ++k5) { const int key = kl + 32 * k5; float sv = -INFINITY;
            if (key < 132 && key >= i && key <= i + 128) { float a = 0.f;
#pragma unroll 16
                for (int d = 0; d < 64; ++d) a += Qf[qr * 64 + d] * Kf[key * 65 + d];
                sv = a * 0.125f; }
            sc[k5] = sv; mx = fmaxf(mx, sv); }
#pragma unroll
        for (int o = 1; o < 32; o <<= 1) mx = fmaxf(mx, __shfl_xor(mx, o));
        const float sink = sinks[kvh * 4 + g]; mx = fmaxf(mx, sink); float sum = 0.f;
#pragma unroll
        for (int k5 = 0; k5 < 5; ++k5) { sc[k5] = __expf(sc[k5] - mx); sum += sc[k5]; }
#pragma unroll
        for (int o = 1; o < 32; o <<= 1) sum += __shfl_xor(sum, o);
        const float inv = 1.f / (sum + __expf(sink - mx));
#pragma unroll
        for (int k5 = 0; k5 < 5; ++k5) { const int key = kl + 32 * k5; if (key < 136) Pf[qr * 136 + key] = sc[k5] * inv; } }
    __syncthreads();
    { const int qr = tid >> 5, d = (tid & 31) * 2, i = qr >> 2, g = qr & 3; float o0 = 0.f, o1 = 0.f;
#pragma unroll 4
        for (int key = 0; key < 132; ++key) { const float p = Pf[qr * 136 + key]; o0 += p * Vf[key * 64 + d]; o1 += p * Vf[key * 64 + d + 1]; }
        *(unsigned*)(MIXCAT + ((size_t)MP + 4 * b + i) * DM + (kvh * 4 + g) * 64 + d) = pk2(o0, o1); }
    __syncthreads();
}

__device__ __forceinline__ void s_phase(const Ctx& C, const Args& A, int l) {
    const bf16* PROJ = (const bf16*)(C.ws + WS_R1); bf16* MIXCAT = (bf16*)(C.ws + WS_HN);
    float* R = (float*)(C.ws + WS_R2); const size_t S = (size_t)M * 256;
    RwkvPtrs P{R, R + S, R + 2 * S, R + 3 * S, R + 4 * S, R + 5 * S, (float*)(C.ws + WS_R3)};
    const float* AL = (const float*)(C.ws + WS_R3) + S; const float* U = AL + S;
    float* out = C.out;
    constexpr int NSCAN = 64;
    if (C.bid < NSCAN) { rwkv_prompt(C, P, C.bid, out + OUT_WKVP + (size_t)l * NBP * 4 * 4096); return; }
    constexpr int N0 = 256, N1 = N0 + 64, N2_ = N1 + 256, N3 = N2_ + 1024, N4 = N3 + 64;
    for (int it = C.bid - NSCAN; it < N4; it += C.G - NSCAN) {
        if (it < N0) swa_prompt_item(C, it, PROJ, MIXCAT, INP(I_SINK) + l * 8);
        else if (it < N1) lru_prompt_item(C, it - N0, AL, U, PROJ, MIXCAT, out + OUT_LRP + (size_t)l * NBP * 256);
        else if (it < N2_) swa_sample_item(C, it - N1, PROJ, MIXCAT, INP(I_SINK) + l * 8, INP(I_CK) + (size_t)l * DB * 16384, INP(I_CV) + (size_t)l * DB * 16384,
                                          out + OUT_KS + (size_t)l * DB * 16384, out + OUT_VS + (size_t)l * DB * 16384);
        else if (it < N3) rwkv_sample_item(P, (it - N2_) * 8 + C.wave, INP(I_SWKV) + (size_t)l * DB * 4 * 4096, out + OUT_WKVS + (size_t)l * DB * 4 * 4096, C.lane);
        else { const int e = (it - N3) * 512 + C.tid, b = e >> 8, c = e & 255; float h = INP(I_SLRU)[((size_t)l * DB + b) * 256 + c];
#pragma unroll
            for (int i = 0; i < DS; ++i) { const size_t m = (size_t)MP + 4 * b + i; h = AL[m * 256 + c] * h + U[m * 256 + c];
                MIXCAT[m * DM + 768 + c] = (bf16)f2bf(h * gelu_t(bf1(PROJ[m * INC + C_GB + c]))); }
            out[OUT_LRS + ((size_t)l * DB + b) * 256 + c] = h; }
    }
}

__device__ __forceinline__ void e3_post(const Ctx& C, const Args& A, int l) {
    const float* R = (const float*)(C.ws + WS_R2); const size_t S = (size_t)M * 256;
    const float *K = R + S, *V = R + 2 * S, *G = R + 6 * S, *YR = (const float*)(C.ws + WS_R3);
    bf16* MIXCAT = (bf16*)(C.ws + WS_HN); const int c4 = 4 * C.lane;
    const f32x4 lw = *(const f32x4*)(INP(I_LNW) + l * 256 + c4), lb = *(const f32x4*)(INP(I_LNB) + l * 256 + c4), rk = *(const f32x4*)(INP(I_RK) + l * 256 + c4);
    for (int m = C.gw; m < M; m += C.NGW) {
        const size_t o = (size_t)m * 256 + c4;
        const f32x4 y = *(const f32x4*)(YR + o), r = *(const f32x4*)(R + o), k = *(const f32x4*)(K + o), v = *(const f32x4*)(V + o), g = *(const f32x4*)(G + o);
        const float mean = red16((y.x + y.y) + (y.z + y.w)) * (1.f / 64.f); const f32x4 d = y - mean;
        const float var = red16(dot4(d, d)) * (1.f / 64.f); const float rs = rsqrtf(var + 64e-5f);
        const float bonus = red16(dot4(r * k, rk));
        st_bf4(MIXCAT + (size_t)m * DM + 512 + c4, (d * rs * lw + lb + v * bonus) * g);
    }
}
constexpr int LDS_BYTES = 131072 + 64;
#ifndef MK_MULTI
#define MK_MULTI 0
#endif
enum { PH_P0 = 0, PH_G1, PH_E1, PH_G2, PH_S, PH_E3, PH_G3, PH_E4, PH_G4, PH_G5, PH_E5, PH_G6, PH_E0, PH_N };

__device__ __forceinline__ Ctx make_ctx(int wave0, LAS unsigned char* lds) {
    Ctx D; int z_ = 0; asm volatile("" : "+v"(z_)); int ln_ = __builtin_amdgcn_mbcnt_hi(-1, __builtin_amdgcn_mbcnt_lo(-1, z_));
    D.lane = ln_; D.wave = wave0; D.tid = wave0 * 64 + ln_;
    int b_ = blockIdx.x; asm volatile("" : "+s"(b_)); D.bid = b_; D.gw = b_ * 8 + wave0; D.G = gridDim.x; D.NGW = D.G * 8;
    D.lds = lds; D.out = (float*)inp_ld(N_IN); D.ws = (unsigned char*)inp_ld(N_IN + 1);
    return D;
}
template <int PH> __device__ __forceinline__ void run_phase(const Args& A, int wave0, LAS unsigned char* lds, int l_in) {
    const Ctx C = make_ctx(wave0, lds);
    int l = l_in; asm volatile("" : "+s"(l));
    unsigned char* ws = C.ws; unsigned char* wl = ws + WS_W + (size_t)l * WL; (void)wl;
    bf16* HN = (bf16*)(ws + WS_HN); float* MIX = (float*)(ws + WS_R1); float* R2 = (float*)(ws + WS_R2); float* R3 = (float*)(ws + WS_R3); float* X = C.out;
    const size_t S = (size_t)M * 256; (void)HN; (void)MIX; (void)R2; (void)R3; (void)X; (void)S;
    if constexpr (PH == PH_P0) p0_prologue(C, A);
    if constexpr (PH == PH_G1) {
        pg8::Gemm g{HN, (const bf16*)(wl + O_WIN), M, INC, DM}; pg8::StaticOrder So; So.init(M, INC, C.G, C.bid);
        pg8::EpiBf16<0> E{(bf16*)(ws + WS_R1), INC, INP(I_BIN) + (size_t)l * INC, 0, 0, 1.f};
        pg8::gemm_phase<pg8::EpiBf16<0>, pg8::StaticOrder, true, true>(C.lds, g, So, E, C.tid); }
    if constexpr (PH == PH_E1) e1_prep(C, A, l);
    if constexpr (PH == PH_G2) {
        pg8::Gemm g{(const bf16*)(ws + WS_R3), (const bf16*)(wl + O_W2), M, N2, K2}; pg8::StaticOrder So; So.init(M, N2, C.G, C.bid);
        EpiMix E{INP(I_W0) + l * 256, INP(I_A0) + l * 256, INP(I_KA) + l * 256, INP(I_BA) + l * 256, INP(I_BI) + l * 256, INP(I_L) + l * 256,
                 R2 + 5 * S, R2 + 1 * S, R2 + 3 * S, R2 + 4 * S, R2 + 6 * S, R3 + S, R3 + 2 * S, (const bf16*)(ws + WS_R3)};
        pg8::gemm_phase<EpiMix, pg8::StaticOrder, true, true>(C.lds, g, So, E, C.tid); }
    if constexpr (PH == PH_S) s_phase(C, A, l);
    if constexpr (PH == PH_E3) e3_post(C, A, l);
    if constexpr (PH == PH_G3) {
        pg8::Gemm g{HN, (const bf16*)(wl + O_WOUT), M, DM, DM}; pg8::StaticOrder So; So.init(M, DM, C.G, C.bid);
        EpiF32 E{MIX, DM, INP(I_BOUT) + (size_t)l * DM};
        pg8::gemm_phase<EpiF32, pg8::StaticOrder, true, true>(C.lds, g, So, E, C.tid); }
    if constexpr (PH == PH_E4)
        for (int m = C.gw; m < M; m += C.NGW) row_update(MIX + (size_t)m * DM, INP(I_NMPOST) + l * DM, X + (size_t)m * DM, INP(I_NFPRE) + l * DM, HN + (size_t)m * DM, C.lane);
    if constexpr (PH == PH_G4) {
        pg8::Gemm g{HN, (const bf16*)(wl + O_WGU), M, 2 * DFF, DM}; pg8::StaticOrder So; So.init(M, 2 * DFF, C.G, C.bid);
        EpiSwiglu E{(bf16*)(ws + WS_R2)};
        pg8::gemm_phase<EpiSwiglu, pg8::StaticOrder, true, true>(C.lds, g, So, E, C.tid); }
    if constexpr (PH == PH_G5) {
        pg8::Gemm g{(const bf16*)(ws + WS_R2), (const bf16*)(wl + O_WD), M, DM, DFF}; pg8::StaticOrder So; So.init(M, DM, C.G, C.bid);
        EpiF32 E{MIX, DM, nullptr};
        pg8::gemm_phase<EpiF32, pg8::StaticOrder, true, true>(C.lds, g, So, E, C.tid); }
    if constexpr (PH == PH_E5)
        for (int m = C.gw; m < M; m += C.NGW) row_update(MIX + (size_t)m * DM, INP(I_NFPOST) + l * DM, X + (size_t)m * DM, nullptr, HN + (size_t)m * DM, C.lane);
    if constexpr (PH == PH_G6) {
        pg8::StaticOrder So; So.init(M, DM, C.G, C.bid);
        { pg8::Gemm g{(const bf16*)(ws + WS_PB + (size_t)l * SZ_PBL), (const bf16*)(wl + O_WP), M, DM, PLE}; EpiF32 E{R2, DM, nullptr};
          pg8::gemm_phase<EpiF32, pg8::StaticOrder, true, true>(C.lds, g, So, E, C.tid); }
        { pg8::Gemm g{HN, (const bf16*)(wl + O_WPG), M, DM, DM}; EpiPle E{X, R2};
          pg8::gemm_phase<EpiPle, pg8::StaticOrder, true, true>(C.lds, g, So, E, C.tid); } }
    if constexpr (PH == PH_E0)
        for (int m = C.gw; m < M; m += C.NGW) row_norm(X + (size_t)m * DM, INP(I_NMPRE) + (l + 1) * DM, HN + (size_t)m * DM, nullptr, C.lane);
}

#if MK_MULTI
template <int PH> __global__ void __launch_bounds__(512, 2) mk_one(Args A, int l) {
    extern __shared__ __attribute__((aligned(16))) unsigned char lds_raw[];
    const int wave0 = __builtin_amdgcn_readfirstlane((int)threadIdx.x >> 6);
    run_phase<PH>(A, wave0, (LAS unsigned char*)lds_raw, l);
}
#else
__global__ void __launch_bounds__(512, 2) mk_fwd(Args A) {
    extern __shared__ __attribute__((aligned(16))) unsigned char lds_raw[];
    cg::grid_group grid = cg::this_grid();
    const int wave0 = __builtin_amdgcn_readfirstlane((int)threadIdx.x >> 6);
    LAS unsigned char* lds = (LAS unsigned char*)lds_raw;
    if (threadIdx.x < 16) ((LAS unsigned*)lds)[131072 / 4 + threadIdx.x] = 0u;
    __syncthreads();
    const unsigned xbar_x = __builtin_amdgcn_readfirstlane(xcd_barrier_post((unsigned*)inp_ld(N_IN + 1), (volatile LAS unsigned*)(lds + 131072), (int)threadIdx.x).x);
#define GRID_BAR() do { int z_ = 0; asm volatile("" : "+v"(z_)); int ln_ = __builtin_amdgcn_mbcnt_hi(-1, __builtin_amdgcn_mbcnt_lo(-1, z_)); XcdBarrier xb_; xb_.bar = (unsigned*)inp_ld(N_IN + 1); xb_.x = xbar_x; \
        xb_.st = (volatile LAS unsigned*)(lds + 131072); xcd_barrier(xb_, wave0 * 64 + ln_); } while (0)
    run_phase<PH_P0>(A, wave0, lds, 0);
    grid.sync();
#pragma unroll 1
    for (int l = 0; l < NL; ++l) {
        run_phase<PH_G1>(A, wave0, lds, l); GRID_BAR();
        run_phase<PH_E1>(A, wave0, lds, l); GRID_BAR();
        run_phase<PH_G2>(A, wave0, lds, l); GRID_BAR();
        run_phase<PH_S>(A, wave0, lds, l); GRID_BAR();
        run_phase<PH_E3>(A, wave0, lds, l); GRID_BAR();
        run_phase<PH_G3>(A, wave0, lds, l); GRID_BAR();
        run_phase<PH_E4>(A, wave0, lds, l); GRID_BAR();
        run_phase<PH_G4>(A, wave0, lds, l); GRID_BAR();
        run_phase<PH_G5>(A, wave0, lds, l); GRID_BAR();
        run_phase<PH_E5>(A, wave0, lds, l); GRID_BAR();
        run_phase<PH_G6>(A, wave0, lds, l);
        if (l + 1 < NL) { GRID_BAR(); run_phase<PH_E0>(A, wave0, lds, l); GRID_BAR(); }
    }
}
#endif
}

#if MK_MULTI
template <int PH> static void launch_one(const mk::Args& a, int l, int grid, hipStream_t stream) {
    static bool attr = false;
    if (!attr) { (void)hipFuncSetAttribute((const void*)mk::mk_one<PH>, hipFuncAttributeMaxDynamicSharedMemorySize, mk::LDS_BYTES); attr = true; }
    hipLaunchKernelGGL(mk::mk_one<PH>, dim3(grid), dim3(512), mk::LDS_BYTES, stream, a, l);
}
#endif
extern "C" void kernel_launch(void* const* d_in, const int* in_sizes, int n_in, void* d_out, int out_size, void* d_ws, size_t ws_size, hipStream_t stream) {
    using namespace mk;
    static int grid = 0;
    if (grid == 0) {
        if (n_in != N_IN || (size_t)out_size != OUT_END || ws_size < WS_END) {
            fprintf(stderr, "kernel_launch: shape mismatch: n_in %d (want %d), out %d (want %zu), ws %zu (want >= %zu); nothing launched\n", n_in, (int)N_IN, out_size, (size_t)OUT_END, ws_size, (size_t)WS_END);
            grid = -1; return; }
        int dev = 0, cus = 0;
        (void)hipGetDevice(&dev); (void)hipDeviceGetAttribute(&cus, hipDeviceAttributeMultiprocessorCount, dev);
#if !MK_MULTI
        int per_cu = 0;
        if (hipFuncSetAttribute((const void*)mk_fwd, hipFuncAttributeMaxDynamicSharedMemorySize, LDS_BYTES) != hipSuccess) { fprintf(stderr, "kernel_launch: hipFuncSetAttribute failed\n"); grid = -1; return; }
        if (hipOccupancyMaxActiveBlocksPerMultiprocessor(&per_cu, (const void*)mk_fwd, 512, LDS_BYTES) != hipSuccess || per_cu < 1) fprintf(stderr, "kernel_launch: note: occupancy query gave %d\n", per_cu);
        (void)hipGetLastError();
#endif
        grid = cus;
        if (grid < 128) { fprintf(stderr, "kernel_launch: %d CUs: too few for this kernel\n", grid); grid = -1; return; }
    }
    if (grid < 0) return;
    Args a{};
    for (int i = 0; i < N_IN; ++i) a.in[i] = (const float*)d_in[i];
    a.out = (float*)d_out; a.ws = (unsigned char*)d_ws;
#if MK_MULTI
    launch_one<PH_P0>(a, 0, grid, stream);
    for (int l = 0; l < NL; ++l) {
        launch_one<PH_G1>(a, l, grid, stream); launch_one<PH_E1>(a, l, grid, stream); launch_one<PH_G2>(a, l, grid, stream); launch_one<PH_S>(a, l, grid, stream);
        launch_one<PH_E3>(a, l, grid, stream); launch_one<PH_G3>(a, l, grid, stream); launch_one<PH_E4>(a, l, grid, stream); launch_one<PH_G4>(a, l, grid, stream);
        launch_one<PH_G5>(a, l, grid, stream); launch_one<PH_E5>(a, l, grid, stream); launch_one<PH_G6>(a, l, grid, stream);
        if (l + 1 < NL) launch_one<PH_E0>(a, l, grid, stream);
    }
#else
    if (hipMemsetAsync(d_ws, 0, 65536, stream) != hipSuccess) { fprintf(stderr, "kernel_launch: hipMemsetAsync failed\n"); return; }
    void* args[] = {&a};
    const hipError_t e = hipLaunchCooperativeKernel((const void*)mk_fwd, dim3(grid), dim3(512), args, LDS_BYTES, stream);
    if (e != hipSuccess) fprintf(stderr, "kernel_launch: cooperative launch failed: %s (grid %d)\n", hipGetErrorString(e), grid);
#endif
}
```

```cpp
#include <hip/hip_runtime.h>
#include <hip/hip_cooperative_groups.h>
#include <cstdio>
#include <cstdint>
#include <cstddef>
#include <cmath>
namespace cg = cooperative_groups;
namespace pg8 {
#define PG8_LAS __attribute__((address_space(3)))
typedef unsigned short bf16_t;
typedef short bf16x8 __attribute__((ext_vector_type(8)));
typedef float f32x4 __attribute__((ext_vector_type(4)));
typedef unsigned u32x4 __attribute__((ext_vector_type(4)));
constexpr int BM = 256, BK = 64, HALF = 128, HTB = HALF * BK * 2  , STAGE_BYTES = 8 * HTB, NXCD = 8, WGM = 8;

__host__ __device__ __forceinline__ int lds_byte(int r, int c) { const int st = (r >> 4) * 2 + (c >> 5), rr = r & 15, cc = c & 31, ob = rr * 64 + cc * 2; return st * 1024 + (ob ^ (((ob >> 9) & 1) << 5)); }
__host__ __device__ __forceinline__ void stage_rc(int b, int& R, int& C) { const int st = b / 1024, sb = b % 1024, swz = sb ^ (((sb >> 9) & 1) << 5); R = (st >> 1) * 16 + swz / 64; C = (st & 1) * 32 + (swz % 64) / 2; }
__host__ __device__ __forceinline__ int perm32(int rho) { const int n = rho >> 4, i = rho & 15; return 8 * (i >> 2) + 4 * n + (i & 3); }

struct Unit { int pm, pn; };
struct Gemm { const bf16_t* A; const bf16_t* Bt; int M, N, K; };

struct StaticOrder {
    int nM, nN, nwg, G, c;
    __host__ __device__ void init(int M, int N, int G_, int c_) { nM = M / BM; nN = N / BM; nwg = nM * nN; G = G_; c = c_; }
    __host__ __device__ bool next(int i, Unit& u) const {
        const long L = (long)i * G + c; if (L >= nwg) return false;
        int wgid = (int)L; { const int q = nwg / NXCD, r = nwg % NXCD, xcd = wgid % NXCD, off = wgid / NXCD; wgid = (xcd < r ? xcd * (q + 1) : r * (q + 1) + (xcd - r) * q) + off; }
        const int nig = WGM * nN, gid = wgid / nig, fm = gid * WGM, gsz = (nM - fm) < WGM ? (nM - fm) : WGM;
        u.pm = fm + ((wgid % nig) % gsz); u.pn = (wgid % nig) / gsz; return true;
    }
    __device__ __forceinline__ void a_ready(const Unit&) const {}
    __device__ __forceinline__ void done(const Unit&) const {}
};

__device__ __forceinline__ unsigned cvt_pk_bf16(float lo, float hi) { unsigned r; asm volatile("v_cvt_pk_bf16_f32 %0, %1, %2" : "=v"(r) : "v"(lo), "v"(hi)); return r; }
typedef float f32x2 __attribute__((ext_vector_type(2)));
__device__ __forceinline__ f32x2 gelu_pk(f32x2 v) {
    const f32x2 av = __builtin_elementwise_abs(v), d = av * 0.2316418882f + 1.0f;
    f32x2 t; t.x = __builtin_amdgcn_rcpf(d.x); t.y = __builtin_amdgcn_rcpf(d.y);
    f32x2 q = t * 0.5307027145f + (-0.7265760135f); q = q * t + 0.7107068705f; q = q * t + (-0.142248368f); q = q * t + 0.127414796f; q = q * t;
    const f32x2 s = (v * v) * (-0.72134752044f);
    f32x2 e; e.x = __builtin_amdgcn_exp2f(s.x); e.y = __builtin_amdgcn_exp2f(s.y);
    const f32x2 m = v * (q * e), r = v - m;
    f32x2 o; o.x = v.x < 0.f ? m.x : r.x; o.y = v.y < 0.f ? m.y : r.y; return o;
}

template <int ACT  > struct EpiBf16 {
    static constexpr bool PERM = true, AFTER_DRAIN = false; static_assert(ACT == 0 || ACT == 1, "EpiBf16: ACT is 0 (none) or 1 (gelu_pk)");
    bf16_t* O; int ldc; const float* bias; int split_cols; size_t split_stride; float scale0;
    __device__ __forceinline__ void operator()(const f32x4 (&acc)[2][2][4][2], const Unit& u, int wr, int wc, int fr, int fq) const {
        const int row0 = u.pm * BM + wr * 64 + fr; int colt = u.pn * BM; bf16_t* base = O;
        float sc = 1.f; if (split_cols) { const int t = colt / split_cols; base += (size_t)t * split_stride; colt -= t * split_cols; if (t == 0) sc = scale0; }
        const int col0 = colt + wc * 32 + 8 * fq, bcol0 = u.pn * BM + wc * 32 + 8 * fq;
        f32x4 bv[2][2];
#pragma unroll
        for (int bj = 0; bj < 2; ++bj)
#pragma unroll
            for (int n = 0; n < 2; ++n) bv[bj][n] = bias ? *(const f32x4*)(bias + bcol0 + bj * HALF + 4 * n) : (f32x4){0.f, 0.f, 0.f, 0.f};
#pragma unroll
        for (int ai = 0; ai < 2; ++ai)
#pragma unroll
            for (int m = 0; m < 4; ++m) { bf16_t* rowp = base + (size_t)(row0 + ai * HALF + m * 16) * ldc + col0;
#pragma unroll
                for (int bj = 0; bj < 2; ++bj) { f32x4 v0 = acc[ai][bj][m][0] + bv[bj][0], v1 = acc[ai][bj][m][1] + bv[bj][1];
                    if (ACT == 1) { f32x2 a = gelu_pk((f32x2){v0[0], v0[1]}), b = gelu_pk((f32x2){v0[2], v0[3]}), c = gelu_pk((f32x2){v1[0], v1[1]}), d = gelu_pk((f32x2){v1[2], v1[3]});
                        v0 = (f32x4){a.x, a.y, b.x, b.y}; v1 = (f32x4){c.x, c.y, d.x, d.y}; }
                    v0 = v0 * sc; v1 = v1 * sc; u32x4 w; w.x = cvt_pk_bf16(v0[0], v0[1]); w.y = cvt_pk_bf16(v0[2], v0[3]); w.z = cvt_pk_bf16(v1[0], v1[1]); w.w = cvt_pk_bf16(v1[2], v1[3]);
                    *(u32x4*)(rowp + bj * HALF) = w; } }
    }
};
template <class Epi, class Sched, bool ALIGN_EPI = false, bool SP2 = false>
__device__ __forceinline__ void gemm_phase(PG8_LAS unsigned char* lds, const Gemm g, const Sched& S, const Epi& E, int tid_in) {
    int tid_ = tid_in; asm volatile("" : "+v"(tid_));
    const int tid = tid_, wid = __builtin_amdgcn_readfirstlane(tid >> 6), lane = tid & 63, wr = wid >> 2, wc = wid & 3, fr = lane & 15, fq = lane >> 4;
    const int K = g.K, nt = K / BK;
    unsigned voffA[2], voffB[2];
#pragma unroll
    for (int i = 0; i < 2; ++i) { int R, C; stage_rc(tid * 16 + i * 8192, R, C); const int Rb = Epi::PERM ? ((R & ~31) + perm32(R & 31)) : R;
        voffA[i] = (unsigned)(R * K + C) * 2u; voffB[i] = (unsigned)(Rb * K + C) * 2u; }
    const size_t kstep = (size_t)(BK * 2);
    const size_t hstep = (size_t)HALF * K * 2;
    const size_t tstep = 2 * hstep;
    const unsigned ldsw = (unsigned)wid * 1024u;
    const int aoff = lds_byte(wr * 64 + fr, fq * 8), boff = lds_byte(wc * 32 + fr, fq * 8);
#define PG8_SA(b, h) (((b) * 2 + (h)) * HTB)
#define PG8_SB(b, h) ((4 + (b) * 2 + (h)) * HTB)
#define PG8_STAGE(bufoff, gbase, voff) do { _Pragma("unroll") for (int _i = 0; _i < 2; ++_i) \
        __builtin_amdgcn_global_load_lds((const unsigned*)((const char*)(gbase) + (voff)[_i]), (PG8_LAS unsigned*)(lds + (bufoff) + ldsw + _i * 8192), 16, 0, 0); } while (0)
#define PG8_LDA(dst, b, h) do { _Pragma("unroll") for (int m = 0; m < 4; ++m) _Pragma("unroll") for (int k = 0; k < 2; ++k) dst[m][k] = *(const PG8_LAS bf16x8*)(lds + PG8_SA(b, h) + aoff + m * 2048 + k * 1024); } while (0)
#define PG8_LDB(dst, b, h) do { _Pragma("unroll") for (int n = 0; n < 2; ++n) _Pragma("unroll") for (int k = 0; k < 2; ++k) dst[n][k] = *(const PG8_LAS bf16x8*)(lds + PG8_SB(b, h) + boff + n * 2048 + k * 1024); } while (0)
#define PG8_MMA(ai, bj, At, Bt) do { __builtin_amdgcn_s_setprio(1); _Pragma("unroll") for (int m = 0; m < 4; ++m) _Pragma("unroll") for (int n = 0; n < 2; ++n) _Pragma("unroll") for (int k = 0; k < 2; ++k) \
        acc[ai][bj][m][n] = __builtin_amdgcn_mfma_f32_16x16x32_bf16(Bt[n][k], At[m][k], acc[ai][bj][m][n], 0, 0, 0); __builtin_amdgcn_s_setprio(0); } while (0)
#define PG8_WAIT_V(n) asm volatile("s_waitcnt vmcnt(" #n ")" ::: "memory")
#define PG8_WAIT_L(n) asm volatile("s_waitcnt lgkmcnt(" #n ")" ::: "memory")
#define PG8_BAR __builtin_amdgcn_s_barrier()
#define PG8_SCHED __builtin_amdgcn_sched_barrier(0)
    Unit cur, nxt; int ui = 0;
    if (!S.next(0, cur)) return;
    f32x4 acc[2][2][4][2];
#pragma unroll
    for (int a = 0; a < 2; ++a)
#pragma unroll
        for (int b = 0; b < 2; ++b)
#pragma unroll
            for (int m = 0; m < 4; ++m)
#pragma unroll
                for (int n = 0; n < 2; ++n) acc[a][b][m][n] = (f32x4){0.f, 0.f, 0.f, 0.f};
    bf16x8 At[4][2], B0[2][2], B1[2][2];
    const char* cA = (const char*)g.A + (size_t)cur.pm * tstep; const char* cB = (const char*)g.Bt + (size_t)cur.pn * tstep;
    S.a_ready(cur);
    if constexpr (SP2) {
        PG8_STAGE(PG8_SB(0, 0), cB, voffB); PG8_STAGE(PG8_SB(0, 1), cB + hstep, voffB); PG8_STAGE(PG8_SA(0, 0), cA, voffA); PG8_STAGE(PG8_SA(0, 1), cA + hstep, voffA);
        if (wr == 1) PG8_BAR;
        PG8_WAIT_V(2); PG8_BAR;
        PG8_STAGE(PG8_SB(1, 0), cB + kstep, voffB); PG8_STAGE(PG8_SA(1, 0), cA + kstep, voffA); PG8_STAGE(PG8_SB(1, 1), cB + hstep + kstep, voffB);
        PG8_WAIT_V(6); PG8_BAR;
    } else {
        PG8_STAGE(PG8_SB(0, 0), cB, voffB); PG8_STAGE(PG8_SA(0, 0), cA, voffA); PG8_STAGE(PG8_SB(0, 1), cB + hstep, voffB); PG8_STAGE(PG8_SA(0, 1), cA + hstep, voffA);
        if (wr == 1) PG8_BAR;
        PG8_WAIT_V(4); PG8_BAR;
        PG8_STAGE(PG8_SB(1, 0), cB + kstep, voffB); PG8_STAGE(PG8_SA(1, 0), cA + kstep, voffA); PG8_STAGE(PG8_SB(1, 1), cB + hstep + kstep, voffB);
        PG8_WAIT_V(6); PG8_BAR;
    }
    for (;;) {
        const bool has_next = S.next(ui + 1, nxt);
        const char* nA = has_next ? (const char*)g.A + (size_t)nxt.pm * tstep : cA; const char* nB = has_next ? (const char*)g.Bt + (size_t)nxt.pn * tstep : cB;
        for (int t = 0; t < nt; t += 2) {
            const bool last = (t == nt - 2);
            const char* a1 = cA + (size_t)(t + 1) * kstep;
            const char* a2 = last ? nA : cA + (size_t)(t + 2) * kstep; const char* b2 = last ? nB : cB + (size_t)(t + 2) * kstep;
            const char* a3 = a2 + kstep; const char* b3 = b2 + kstep;
            if (last && has_next) S.a_ready(nxt);
            if constexpr (SP2) {
            PG8_LDB(B0, 0, 0); PG8_LDB(B1, 0, 1); PG8_SCHED; PG8_LDA(At, 0, 0); PG8_STAGE(PG8_SA(1, 1), a1 + hstep, voffA);
            PG8_WAIT_V(8); PG8_WAIT_L(0); PG8_BAR; PG8_MMA(0, 0, At, B0); PG8_MMA(0, 1, At, B1); PG8_BAR; PG8_SCHED;
            PG8_LDA(At, 0, 1); PG8_STAGE(PG8_SB(0, 0), b2, voffB); PG8_STAGE(PG8_SB(0, 1), b2 + hstep, voffB); PG8_STAGE(PG8_SA(0, 0), a2, voffA);
            PG8_WAIT_V(8); PG8_WAIT_L(0); PG8_BAR; PG8_MMA(1, 0, At, B0); PG8_MMA(1, 1, At, B1); PG8_BAR; PG8_SCHED;
            PG8_LDB(B0, 1, 0); PG8_LDB(B1, 1, 1); PG8_SCHED; PG8_LDA(At, 1, 0); PG8_STAGE(PG8_SA(0, 1), a2 + hstep, voffA);
            PG8_WAIT_V(8); PG8_WAIT_L(0); PG8_BAR; PG8_MMA(0, 0, At, B0); PG8_MMA(0, 1, At, B1); PG8_BAR; PG8_SCHED;
            PG8_LDA(At, 1, 1); PG8_STAGE(PG8_SB(1, 0), b3, voffB); PG8_STAGE(PG8_SB(1, 1), b3 + hstep, voffB); PG8_STAGE(PG8_SA(1, 0), a3, voffA);
            PG8_WAIT_V(8); PG8_WAIT_L(0); PG8_BAR; PG8_MMA(1, 0, At, B0); PG8_MMA(1, 1, At, B1); PG8_BAR; PG8_SCHED;
            } else {
            PG8_LDB(B0, 0, 0); PG8_SCHED; PG8_LDA(At, 0, 0); PG8_STAGE(PG8_SA(1, 1), a1 + hstep, voffA);
            PG8_WAIT_L(8); PG8_BAR; PG8_WAIT_L(0); PG8_MMA(0, 0, At, B0); PG8_BAR; PG8_SCHED;
            PG8_LDB(B1, 0, 1); PG8_STAGE(PG8_SB(0, 0), b2, voffB);
            PG8_BAR; PG8_WAIT_L(0); PG8_MMA(0, 1, At, B1); PG8_BAR;
            PG8_LDA(At, 0, 1); PG8_STAGE(PG8_SA(0, 0), a2, voffA);
            PG8_BAR; PG8_WAIT_L(0); PG8_MMA(1, 0, At, B0); PG8_BAR; PG8_SCHED;
            PG8_STAGE(PG8_SB(0, 1), b2 + hstep, voffB);
            PG8_WAIT_V(6); PG8_BAR; PG8_MMA(1, 1, At, B1); PG8_BAR;
            PG8_LDB(B0, 1, 0); PG8_SCHED; PG8_LDA(At, 1, 0); PG8_STAGE(PG8_SA(0, 1), a2 + hstep, voffA);
            PG8_WAIT_L(8); PG8_BAR; PG8_WAIT_L(0); PG8_MMA(0, 0, At, B0); PG8_BAR; PG8_SCHED;
            PG8_LDB(B1, 1, 1); PG8_STAGE(PG8_SB(1, 0), b3, voffB);
            PG8_BAR; PG8_WAIT_L(0); PG8_MMA(0, 1, At, B1); PG8_BAR;
            PG8_LDA(At, 1, 1); PG8_STAGE(PG8_SA(1, 0), a3, voffA);
            PG8_BAR; PG8_WAIT_L(0); PG8_MMA(1, 0, At, B0); PG8_BAR; PG8_SCHED;
            PG8_STAGE(PG8_SB(1, 1), b3 + hstep, voffB);
            PG8_WAIT_V(6); PG8_BAR; PG8_MMA(1, 1, At, B1); PG8_BAR;
            }
        }
        if constexpr (ALIGN_EPI) { if (wr == 0) PG8_BAR; }
        if constexpr (!Epi::AFTER_DRAIN) { E(acc, cur, wr, wc, fr, fq); S.done(cur); }
        if (!has_next) break;
#pragma unroll
        for (int a = 0; a < 2; ++a)
#pragma unroll
            for (int b = 0; b < 2; ++b)
#pragma unroll
                for (int m = 0; m < 4; ++m)
#pragma unroll
                    for (int n = 0; n < 2; ++n) acc[a][b][m][n] = (f32x4){0.f, 0.f, 0.f, 0.f};
        cur = nxt; cA = nA; cB = nB; ++ui;
        if constexpr (ALIGN_EPI) { if (wr == 1) PG8_BAR; }
    }
    PG8_WAIT_V(0);
    if constexpr (!ALIGN_EPI) { if (wr == 0) PG8_BAR; }
    PG8_BAR;
    if constexpr (Epi::AFTER_DRAIN) { E.fused(acc, cur, wr, wc, fr, fq, lds, wid, lane); S.done(cur); }
#undef PG8_SA
#undef PG8_SB
#undef PG8_STAGE
#undef PG8_LDA
#undef PG8_LDB
#undef PG8_MMA
#undef PG8_WAIT_V
#undef PG8_WAIT_L
#undef PG8_BAR
#undef PG8_SCHED
}
}
namespace mk {
typedef pg8::bf16_t bf16;
typedef pg8::f32x4 f32x4;
typedef pg8::u32x4 u32x4;
typedef pg8::bf16x8 bf16x8;
typedef pg8::Unit Unit;
typedef float f32x16 __attribute__((ext_vector_type(16)));
typedef unsigned u32x2 __attribute__((ext_vector_type(2)));
typedef float f32x2 __attribute__((ext_vector_type(2)));
#define LAS __attribute__((address_space(3)))
#define LDS_WAIT() asm volatile("s_waitcnt lgkmcnt(0)" ::: "memory")

constexpr int DM = 1024, T = 4096, NBP = 4, MP = NBP * T, DB = 128, DS = 4, MS = DB * DS, M = MP + MS, NL = 4;
constexpr int INC = 2304, DFF = 2816, K2 = 512, N2 = 1280, PLE = 256;
constexpr int C_K = 512, C_V = 640, C_RW = 768, C_XB = 1792, C_GB = 2048;

constexpr size_t SZ_WIN = (size_t)INC * DM * 2, SZ_W2 = (size_t)N2 * K2 * 2, SZ_WOUT = (size_t)DM * DM * 2, SZ_WGU = (size_t)2 * DFF * DM * 2,
                 SZ_WD = (size_t)DM * DFF * 2, SZ_WPG = (size_t)DM * DM * 2, SZ_WP = (size_t)DM * PLE * 2;
constexpr size_t O_WIN = 0, O_W2 = O_WIN + SZ_WIN, O_WOUT = O_W2 + SZ_W2, O_WGU = O_WOUT + SZ_WOUT, O_WD = O_WGU + SZ_WGU, O_WPG = O_WD + SZ_WD,
                 O_WP = O_WPG + SZ_WPG, WL = O_WP + SZ_WP;
constexpr size_t WS_W = 1u << 20, SZ_PBL = (size_t)M * PLE * 2, WS_PB = WS_W + NL * WL, SZ_ACT = (size_t)M * DM * 2, WS_HN = WS_PB + NL * SZ_PBL,
                 WS_R1 = WS_HN + SZ_ACT, SZ_R1 = (size_t)M * INC * 2, WS_R2 = WS_R1 + SZ_R1, SZ_F256 = (size_t)M * 256 * 4, WS_R3 = WS_R2 + 7 * SZ_F256,
                 WS_END = WS_R3 + 3 * SZ_F256;
static_assert(WL % 256 == 0 && SZ_R1 >= (size_t)M * DM * 4 && 7 * SZ_F256 >= (size_t)M * DFF * 2, "ws map");

constexpr size_t OUT_Y = 0, OUT_KP = (size_t)M * DM, OUT_VP = OUT_KP + (size_t)NL * NBP * 128 * 128, OUT_SHP = OUT_VP + (size_t)NL * NBP * 128 * 128,
                 OUT_WKVP = OUT_SHP + (size_t)NL * NBP * 1024, OUT_CVP = OUT_WKVP + (size_t)NL * NBP * 4 * 4096, OUT_LRP = OUT_CVP + (size_t)NL * NBP * 768,
                 OUT_KS = OUT_LRP + (size_t)NL * NBP * 256, OUT_VS = OUT_KS + (size_t)NL * DB * 128 * 128, OUT_SHS = OUT_VS + (size_t)NL * DB * 128 * 128,
                 OUT_WKVS = OUT_SHS + (size_t)NL * DB * 1024, OUT_CVS = OUT_WKVS + (size_t)NL * DB * 4 * 4096, OUT_LRS = OUT_CVS + (size_t)NL * DB * 768,
                 OUT_END = OUT_LRS + (size_t)NL * DB * 256;

enum { I_XP = 0, I_XS, I_CK, I_CV, I_SSH, I_SWKV, I_SCV, I_SLRU, I_PP, I_PS, I_NMPRE, I_NMPOST, I_NFPRE, I_NFPOST, I_WIN, I_BIN, I_SINK, I_MU, I_W0, I_WUP,
       I_A0, I_AUP, I_GUP, I_KK, I_KA, I_RK, I_LNW, I_LNB, I_CW, I_CB, I_WA, I_BA, I_WI, I_BI, I_L, I_WOUT, I_BOUT, I_WG, I_WU, I_WDN, I_PW, I_PGW, N_IN };

__device__ __forceinline__ unsigned f2bf(float f) { unsigned u = __float_as_uint(f); return (u + 0x7fffu + ((u >> 16) & 1u)) >> 16; }
__device__ __forceinline__ unsigned pk2(float lo, float hi) { return f2bf(lo) | (f2bf(hi) << 16); }
__device__ __forceinline__ float bflo(unsigned w) { return __uint_as_float(w << 16); }
__device__ __forceinline__ float bfhi(unsigned w) { return __uint_as_float(w & 0xffff0000u); }
__device__ __forceinline__ float bf1(bf16 b) { return __uint_as_float((unsigned)b << 16); }
__device__ __forceinline__ f32x4 ld_bf4(const bf16* p) { const u32x2 w = *(const u32x2*)p; return (f32x4){bflo(w.x), bfhi(w.x), bflo(w.y), bfhi(w.y)}; }
__device__ __forceinline__ void st_bf4(bf16* p, f32x4 v) { u32x2 w; w.x = pk2(v.x, v.y); w.y = pk2(v.z, v.w); *(u32x2*)p = w; }
__device__ __forceinline__ float sigm(float x) { return 1.f / (1.f + __expf(-x)); }
__device__ __forceinline__ float tanh_(float x) { return 1.f - 2.f / (__expf(2.f * x) + 1.f); }
__device__ __forceinline__ float gelu_t(float x) { return 0.5f * x * (1.f + tanh_(0.7978845608f * (x + 0.044715f * x * x * x))); }
__device__ __forceinline__ float wave_sum(float v) {
#pragma unroll
    for (int o = 1; o < 64; o <<= 1) v += __shfl_xor(v, o);
    return v;
}
template <int CTRL> __device__ __forceinline__ float dppf(float x) { return __builtin_bit_cast(float, __builtin_amdgcn_mov_dpp(__builtin_bit_cast(int, x), CTRL, 0xf, 0xf, true)); }
__device__ __forceinline__ float red16(float x) { x += dppf<0xB1>(x); x += dppf<0x4E>(x); x += dppf<0x141>(x); x += dppf<0x128>(x); return x; }
__device__ __forceinline__ void red16x2(float& p, float& q) {
    asm volatile("v_add_f32_dpp %0, %0, %0 quad_perm:[1,0,3,2] row_mask:0xf bank_mask:0xf bound_ctrl:1\n\t"
                 "v_add_f32_dpp %1, %1, %1 quad_perm:[1,0,3,2] row_mask:0xf bank_mask:0xf bound_ctrl:1\n\ts_nop 0\n\t"
                 "v_add_f32_dpp %0, %0, %0 quad_perm:[2,3,0,1] row_mask:0xf bank_mask:0xf bound_ctrl:1\n\t"
                 "v_add_f32_dpp %1, %1, %1 quad_perm:[2,3,0,1] row_mask:0xf bank_mask:0xf bound_ctrl:1\n\ts_nop 0\n\t"
                 "v_add_f32_dpp %0, %0, %0 row_half_mirror row_mask:0xf bank_mask:0xf bound_ctrl:1\n\t"
                 "v_add_f32_dpp %1, %1, %1 row_half_mirror row_mask:0xf bank_mask:0xf bound_ctrl:1\n\ts_nop 0\n\t"
                 "v_add_f32_dpp %0, %0, %0 row_ror:8 row_mask:0xf bank_mask:0xf bound_ctrl:1\n\t"
                 "v_add_f32_dpp %1, %1, %1 row_ror:8 row_mask:0xf bank_mask:0xf bound_ctrl:1\n\ts_nop 1"
                 : "+v"(p), "+v"(q));
}
__device__ __forceinline__ float dot4(f32x4 a, f32x4 b) { return (a.x * b.x + a.y * b.y) + (a.z * b.z + a.w * b.w); }

struct EpiF32 {
    static constexpr bool PERM = false, AFTER_DRAIN = false;
    float* O; int ldc; const float* bias;
    __device__ __forceinline__ void operator()(const f32x4 (&acc)[2][2][4][2], const Unit& u, int wr, int wc, int fr, int fq) const {
        asm volatile("" : "+v"(fr), "+v"(fq));
        const int row0 = u.pm * 256 + wr * 64 + fr, col0 = u.pn * 256 + wc * 32 + 4 * fq;
        f32x4 bv[2][2];
#pragma unroll
        for (int bj = 0; bj < 2; ++bj)
#pragma unroll
            for (int n = 0; n < 2; ++n) bv[bj][n] = bias ? *(const f32x4*)(bias + col0 + bj * 128 + n * 16) : (f32x4){0.f, 0.f, 0.f, 0.f};
#pragma unroll
        for (int ai = 0; ai < 2; ++ai)
#pragma unroll
            for (int m = 0; m < 4; ++m) { float* rowp = O + (size_t)(row0 + ai * 128 + m * 16) * ldc + col0;
#pragma unroll
                for (int bj = 0; bj < 2; ++bj)
#pragma unroll
                    for (int n = 0; n < 2; ++n) *(f32x4*)(rowp + bj * 128 + n * 16) = acc[ai][bj][m][n] + bv[bj][n]; }
    }
};
struct EpiPle {
    static constexpr bool PERM = false, AFTER_DRAIN = false;
    float* X; const float* PP;
    __device__ __forceinline__ void operator()(const f32x4 (&acc)[2][2][4][2], const Unit& u, int wr, int wc, int fr, int fq) const {
        asm volatile("" : "+v"(fr), "+v"(fq));
        const int row0 = u.pm * 256 + wr * 64 + fr, col0 = u.pn * 256 + wc * 32 + 4 * fq;
#pragma unroll
        for (int ai = 0; ai < 2; ++ai)
#pragma unroll
            for (int m = 0; m < 4; ++m) { const size_t off = (size_t)(row0 + ai * 128 + m * 16) * DM + col0;
#pragma unroll
                for (int bj = 0; bj < 2; ++bj)
#pragma unroll
                    for (int n = 0; n < 2; ++n) { const size_t o = off + bj * 128 + n * 16; const f32x4 x = *(const f32x4*)(X + o), p = *(const f32x4*)(PP + o), a = acc[ai][bj][m][n];
                        *(f32x4*)(X + o) = (f32x4){x.x + sigm(a.x) * p.x, x.y + sigm(a.y) * p.y, x.z + sigm(a.z) * p.z, x.w + sigm(a.w) * p.w}; }
                asm volatile("" ::: "memory"); }
    }
};
struct EpiSwiglu {
    static constexpr bool PERM = true, AFTER_DRAIN = false;
    bf16* O;
    __device__ __forceinline__ void operator()(const f32x4 (&acc)[2][2][4][2], const Unit& u, int wr, int wc, int fr, int fq) const {
        asm volatile("" : "+v"(fr), "+v"(fq));
        const int row0 = u.pm * 256 + wr * 64 + fr, col0 = u.pn * 128 + wc * 32 + 8 * fq;
#pragma unroll
        for (int ai = 0; ai < 2; ++ai)
#pragma unroll
            for (int m = 0; m < 4; ++m) { bf16* p = O + (size_t)(row0 + ai * 128 + m * 16) * DFF + col0;
                const f32x4 g0 = acc[ai][0][m][0], g1 = acc[ai][0][m][1], u0 = acc[ai][1][m][0], u1 = acc[ai][1][m][1];
                u32x4 w; w.x = pk2(g0.x * sigm(g0.x) * u0.x, g0.y * sigm(g0.y) * u0.y); w.y = pk2(g0.z * sigm(g0.z) * u0.z, g0.w * sigm(g0.w) * u0.w);
                w.z = pk2(g1.x * sigm(g1.x) * u1.x, g1.y * sigm(g1.y) * u1.y); w.w = pk2(g1.z * sigm(g1.z) * u1.z, g1.w * sigm(g1.w) * u1.w);
                *(u32x4*)p = w; }
    }
};
struct EpiMix {
    static constexpr bool PERM = false, AFTER_DRAIN = false;
    const float *w0, *a0, *k_a, *b_a, *b_i, *Lp; float *Wd, *Ks, *KK, *BV, *G, *AL, *U; const bf16* A2;
    __device__ __forceinline__ void operator()(const f32x4 (&acc)[2][2][4][2], const Unit& u, int wr, int wc, int fr, int fq) const {
        asm volatile("" : "+v"(fr), "+v"(fq));
        const int row0 = u.pm * 256 + wr * 64 + fr;
        if (u.pn < 3) {
#pragma unroll
            for (int ai = 0; ai < 2; ++ai)
#pragma unroll
                for (int m = 0; m < 4; ++m) { const size_t ro = (size_t)(row0 + ai * 128 + m * 16) * 256;
#pragma unroll
                    for (int bj = 0; bj < 2; ++bj)
#pragma unroll
                        for (int n = 0; n < 2; ++n) { const int c = bj * 128 + wc * 32 + n * 16 + 4 * fq; const f32x4 z = acc[ai][bj][m][n];
                            if (u.pn == 0) { const f32x4 b = *(const f32x4*)(w0 + c); f32x4 d;
                                d.x = __expf(-0.60653066f * sigm(z.x + b.x)); d.y = __expf(-0.60653066f * sigm(z.y + b.y)); d.z = __expf(-0.60653066f * sigm(z.z + b.z)); d.w = __expf(-0.60653066f * sigm(z.w + b.w));
                                *(f32x4*)(Wd + ro + c) = d; }
                            else if (u.pn == 1) { const f32x4 b = *(const f32x4*)(a0 + c), ka = *(const f32x4*)(k_a + c), ks = *(const f32x4*)(Ks + ro + c), kk = *(const f32x4*)(KK + ro + c);
                                f32x4 a; a.x = sigm(z.x + b.x); a.y = sigm(z.y + b.y); a.z = sigm(z.z + b.z); a.w = sigm(z.w + b.w);
                                *(f32x4*)(Ks + ro + c) = ks * (1.f + (a - 1.f) * ka); *(f32x4*)(BV + ro + c) = kk * a; }
                            else { *(f32x4*)(G + ro + c) = z; } }
                    asm volatile("" ::: "memory"); }
        } else {
            const int t = u.pn - 3;
#pragma unroll
            for (int ai = 0; ai < 2; ++ai)
#pragma unroll
                for (int m = 0; m < 4; ++m) { const size_t r = (size_t)(row0 + ai * 128 + m * 16);
#pragma unroll
                    for (int n = 0; n < 2; ++n) { const int cc = 128 * t + wc * 32 + n * 16 + 4 * fq;
                        const f32x4 zr = acc[ai][0][m][n] + *(const f32x4*)(b_a + cc), zi = acc[ai][1][m][n] + *(const f32x4*)(b_i + cc), Lv = *(const f32x4*)(Lp + cc), xc = ld_bf4(A2 + r * K2 + 256 + cc);
                        f32x4 al, uu;
#define LRU1(e) { const float xe = __expf(-Lv.e); const float ls = -xe * (1.f + xe * (-0.5f + xe * 0.33333334f)); const float la = 8.f * sigm(zr.e) * ls; al.e = __expf(la); const float z2 = 2.f * la; \
    const float om = -z2 * (1.f + z2 * (0.5f + z2 * (0.16666667f + z2 * (0.041666668f + z2 * 0.0083333338f)))); uu.e = sqrtf(om) * sigm(zi.e) * xc.e; }
                        LRU1(x) LRU1(y) LRU1(z) LRU1(w)
#undef LRU1
                        *(f32x4*)(AL + r * 256 + cc) = al; *(f32x4*)(U + r * 256 + cc) = uu; }
                    asm volatile("" ::: "memory"); }
        }
    }
};
#define RLX_AGENT __ATOMIC_RELAXED, __HIP_MEMORY_SCOPE_AGENT
#define XB_TMO      128
#define XB_XCNT(j)  (256  + 64 * (j))
#define XB_XSUB(j)  (1280 + 64 * (j))
#define XB_XGEN(j)  (2304 + 64 * (j))
#define XB_TOP      3328
#define XB_TOPGEN   3392
#define XCD_BAR_WORDS 3456
#define XB_SPIN_CAP (1u << 18)

__device__ __forceinline__ unsigned xb_ld(unsigned* p)              { return __hip_atomic_load(p, __ATOMIC_RELAXED, __HIP_MEMORY_SCOPE_AGENT); }
__device__ __forceinline__ unsigned xb_add(unsigned* p, unsigned v) { return __hip_atomic_fetch_add(p, v, __ATOMIC_RELAXED, __HIP_MEMORY_SCOPE_AGENT); }
__device__ __forceinline__ unsigned xb_xcc_id() { return (unsigned)__builtin_amdgcn_s_getreg((3 << 11) | 20) & 0xFu; }
#define XB_SPIN(cond, bar) do { unsigned _sp = 0; while (cond) { __builtin_amdgcn_s_sleep(1); \
    if ((++_sp & 255u) == 0u) { if (xb_ld(&(bar)[XB_TMO])) break; if (_sp > XB_SPIN_CAP) { atomicAdd(&(bar)[XB_TMO], 1u); break; } } } } while (0)

struct XcdBarrier {
    unsigned* bar; unsigned x;
    volatile LAS unsigned* st;
};

__device__ __forceinline__ XcdBarrier xcd_barrier_post(unsigned* bar, volatile LAS unsigned* st, int tid) {
    XcdBarrier b; b.bar = bar; b.x = xb_xcc_id(); b.st = st;
    if (tid == 0) (void)xb_add(&bar[XB_XCNT(b.x)], 1u);
    return b;
}
__device__ __forceinline__ void xcd_barrier_complete(unsigned* bar, unsigned x, unsigned& nloc, unsigned& nx) {
    const unsigned G = gridDim.x * gridDim.y * gridDim.z;
    unsigned sum, cnt, mine, sp = 0u;
    for (;;) {
        sum = 0u; cnt = 0u; mine = 0u;
#pragma unroll
        for (unsigned j = 0; j < 16; ++j) { const unsigned c = xb_ld(&bar[XB_XCNT(j)]); sum += c; cnt += (c > 0u) ? 1u : 0u; mine = (j == x) ? c : mine; }
        if (sum == G) break;
        __builtin_amdgcn_s_sleep(1);
        if ((++sp & 255u) == 0u) { if (xb_ld(&bar[XB_TMO])) break; if (sp > XB_SPIN_CAP) { atomicAdd(&bar[XB_TMO], 1u); break; } }
    }
    nloc = mine > 0u ? mine : 1u; nx = cnt > 0u ? cnt : 1u;
}

__device__ __forceinline__ void xcd_barrier(const XcdBarrier& b, int tid) {
    asm volatile("s_waitcnt vmcnt(0)" ::: "memory");
    __syncthreads();
    if (tid == 0) {
        unsigned* bar = b.bar;
        __builtin_amdgcn_s_waitcnt(0);
        unsigned nloc = b.st[0], nx = b.st[1];
        if (nloc == 0u) { xcd_barrier_complete(bar, b.x, nloc, nx); b.st[0] = nloc; b.st[1] = nx; }
        const unsigned old = xb_add(&bar[XB_XSUB(b.x)], 1u);
        const unsigned gen = old / nloc;
        if (old + 1u == (gen + 1u) * nloc) {
            __builtin_amdgcn_fence(__ATOMIC_RELEASE, "agent");
            asm volatile("s_waitcnt vmcnt(0)" ::: "memory");
            const unsigned og = xb_add(&bar[XB_TOP], 1u);
            const unsigned tg = og / nx;
            if (og + 1u == (tg + 1u) * nx) xb_add(&bar[XB_TOPGEN], 1u);
            else XB_SPIN(xb_ld(&bar[XB_TOPGEN]) == tg, bar);
            __builtin_amdgcn_fence(__ATOMIC_ACQUIRE, "agent");
            xb_add(&bar[XB_XGEN(b.x)], 1u);
            asm volatile("s_waitcnt vmcnt(0)" ::: "memory");
        } else {
            XB_SPIN(xb_ld(&bar[XB_XGEN(b.x)]) == gen, bar);
            __builtin_amdgcn_fence(__ATOMIC_ACQUIRE, "agent");
            asm volatile("s_waitcnt vmcnt(0)" ::: "memory");
        }
    }
    __syncthreads();
}
struct Args { const float* in[N_IN]; float* out; unsigned char* ws; };
struct Ctx {
    LAS unsigned char* lds; unsigned char* ws; float* out;
    int tid, lane, wave, bid, G, gw, NGW;
};
__device__ __forceinline__ const float* inp_ld(int k) {
    asm volatile("" : "+s"(k));
    const __attribute__((address_space(4))) unsigned long long* tab = (const __attribute__((address_space(4))) unsigned long long*)__builtin_amdgcn_kernarg_segment_ptr();
    return (const float*)tab[k];
}
#define INP(k) inp_ld(k)

__device__ __forceinline__ void tr_item(const float* W, int ldw, bf16* WT, int ldt, int k0, int n0, int drow, int dcol, LAS float* scr, int lane) {
#pragma unroll 8
    for (int i = 0; i < 32; ++i) { const int kk = 2 * i + (lane >> 5); scr[kk * 33 + (lane & 31)] = W[(size_t)(k0 + kk) * ldw + n0 + (lane & 31)]; }
    LDS_WAIT(); asm volatile("" ::: "memory");
    const int c = lane & 7;
#pragma unroll
    for (int j = 0; j < 4; ++j) { const int n = (lane >> 3) + 8 * j; const LAS float* s = scr + (8 * c) * 33 + n;
        u32x4 o; o.x = pk2(s[0 * 33], s[1 * 33]); o.y = pk2(s[2 * 33], s[3 * 33]); o.z = pk2(s[4 * 33], s[5 * 33]); o.w = pk2(s[6 * 33], s[7 * 33]);
        *(u32x4*)(WT + (size_t)(drow + n) * ldt + dcol + 8 * c) = o; }
    LDS_WAIT(); asm volatile("" ::: "memory");
}
__device__ __forceinline__ void row_norm(const float* xrow, const float* g, bf16* orow, float* xcopy, int lane) {
    f32x4 v[4]; float ss = 0.f;
#pragma unroll
    for (int j = 0; j < 4; ++j) { v[j] = *(const f32x4*)(xrow + 4 * lane + 256 * j); ss += dot4(v[j], v[j]); }
    const float rs = rsqrtf(wave_sum(ss) * (1.f / DM) + 1e-6f);
#pragma unroll
    for (int j = 0; j < 4; ++j) { const f32x4 gg = *(const f32x4*)(g + 4 * lane + 256 * j); if (xcopy) *(f32x4*)(xcopy + 4 * lane + 256 * j) = v[j]; st_bf4(orow + 4 * lane + 256 * j, v[j] * rs * gg); }
}
__device__ __forceinline__ void row_update(const float* add, const float* gA, float* X, const float* gB, bf16* outB, int lane) {
    f32x4 a[4], x[4]; float ss = 0.f;
#pragma unroll
    for (int j = 0; j < 4; ++j) { a[j] = *(const f32x4*)(add + 4 * lane + 256 * j); x[j] = *(const f32x4*)(X + 4 * lane + 256 * j); ss += dot4(a[j], a[j]); }
    const float rs = rsqrtf(wave_sum(ss) * (1.f / DM) + 1e-6f); float s2 = 0.f;
#pragma unroll
    for (int j = 0; j < 4; ++j) { const f32x4 gg = *(const f32x4*)(gA + 4 * lane + 256 * j); x[j] = x[j] + a[j] * rs * gg; *(f32x4*)(X + 4 * lane + 256 * j) = x[j]; s2 += dot4(x[j], x[j]); }
    float r2 = 1.f;
    if (gB) r2 = rsqrtf(wave_sum(s2) * (1.f / DM) + 1e-6f);
#pragma unroll
    for (int j = 0; j < 4; ++j) { f32x4 o = x[j]; if (gB) o = o * r2 * *(const f32x4*)(gB + 4 * lane + 256 * j); st_bf4(outB + 4 * lane + 256 * j, o); }
}

__device__ __forceinline__ void p0_prologue(const Ctx& C, const Args& A) {
    LAS float* scr = (LAS float*)(C.lds + C.wave * 16384);
    constexpr int J0 = 16 * 72, J1 = 16 * 32, J2 = 16 * 88, J4 = 44 * 32, J5 = 16 * 32, J6 = 4 * 32, JL = J0 + J1 + 2 * J2 + J4 + J5 + J6;
    for (int it = C.gw; it < NL * JL; it += C.NGW) {
        const int l = it / JL; int r = it % JL; unsigned char* wl = C.ws + WS_W + (size_t)l * WL;
        const float* W; int ldw, ldt, kb, nb, drow; bf16* WT;
        if (r < J0) { W = INP(I_WIN) + (size_t)l * DM * INC; ldw = INC; WT = (bf16*)(wl + O_WIN); ldt = DM; kb = r / 72; nb = r % 72; drow = 32 * nb; }
        else if ((r -= J0) < J1) { W = INP(I_WOUT) + (size_t)l * DM * DM; ldw = DM; WT = (bf16*)(wl + O_WOUT); ldt = DM; kb = r / 32; nb = r % 32; drow = 32 * nb; }
        else if ((r -= J1) < J2) { W = INP(I_WG) + (size_t)l * DM * DFF; ldw = DFF; WT = (bf16*)(wl + O_WGU); ldt = DM; kb = r / 88; nb = r % 88; drow = (nb >> 2) * 256 + (nb & 3) * 32; }
        else if ((r -= J2) < J2) { W = INP(I_WU) + (size_t)l * DM * DFF; ldw = DFF; WT = (bf16*)(wl + O_WGU); ldt = DM; kb = r / 88; nb = r % 88; drow = (nb >> 2) * 256 + 128 + (nb & 3) * 32; }
        else if ((r -= J2) < J4) { W = INP(I_WDN) + (size_t)l * DFF * DM; ldw = DM; WT = (bf16*)(wl + O_WD); ldt = DFF; kb = r / 32; nb = r % 32; drow = 32 * nb; }
        else if ((r -= J4) < J5) { W = INP(I_PGW) + (size_t)l * DM * DM; ldw = DM; WT = (bf16*)(wl + O_WPG); ldt = DM; kb = r / 32; nb = r % 32; drow = 32 * nb; }
        else { r -= J5; W = INP(I_PW) + (size_t)l * PLE * DM; ldw = DM; WT = (bf16*)(wl + O_WP); ldt = PLE; kb = r / 32; nb = r % 32; drow = 32 * nb; }
        tr_item(W, ldw, WT, ldt, 64 * kb, 32 * nb, drow, 64 * kb, scr, C.lane);
    }
    const int gt = C.bid * 512 + C.tid, NT = C.G * 512;
    for (int e = gt; e < NL * N2 * K2; e += NT) {
        const int l = e / (N2 * K2), r = e % (N2 * K2), n = r / K2, k = r % K2; float v = 0.f;
        if (n < 256) { if (k < 64) v = INP(I_WUP)[((size_t)l * 64 + k) * 256 + n]; }
        else if (n < 512) { if (k >= 64 && k < 128) v = INP(I_AUP)[((size_t)l * 64 + (k - 64)) * 256 + (n - 256)]; }
        else if (n < 768) { if (k >= 128 && k < 256) v = INP(I_GUP)[((size_t)l * 128 + (k - 128)) * 256 + (n - 512)]; }
        else { const int tt = (n - 768) >> 8, rr = (n - 768) & 255, cc = 128 * tt + (rr & 127), h = cc >> 6, j = cc & 63;
            if (k >= 256 && ((k - 256) >> 6) == h) v = ((rr >> 7) ? INP(I_WI) : INP(I_WA))[(((size_t)l * 4 + h) * 64 + ((k - 256) & 63)) * 64 + j]; }
        ((bf16*)(C.ws + WS_W + (size_t)l * WL + O_W2))[r] = (bf16)f2bf(v);
    }
    for (int e = gt; e < NL * M * (PLE / 4); e += NT) {
        const int l = e / (M * 64), r = e % (M * 64), m = r >> 6, c4 = (r & 63) * 4;
        const float* src = m < MP ? INP(I_PP) + ((size_t)l * MP + m) * PLE + c4 : INP(I_PS) + ((size_t)l * MS + (m - MP)) * PLE + c4;
        st_bf4((bf16*)(C.ws + WS_PB + (size_t)l * SZ_PBL) + (size_t)m * PLE + c4, *(const f32x4*)src);
    }
    for (int m = C.gw; m < M; m += C.NGW) {
        const float* src = m < MP ? INP(I_XP) + (size_t)m * DM : INP(I_XS) + (size_t)(m - MP) * DM;
        row_norm(src, INP(I_NMPRE), (bf16*)(C.ws + WS_HN) + (size_t)m * DM, C.out + (size_t)m * DM, C.lane);
    }
}

__device__ __forceinline__ void e1_prep(const Ctx& C, const Args& A, int l) {
    const bf16* PROJ = (const bf16*)(C.ws + WS_R1);
    float* R = (float*)(C.ws + WS_R2); float* Ks = R + (size_t)M * 256; float* V = Ks + (size_t)M * 256; float* KK = V + (size_t)M * 256;
    bf16* A2 = (bf16*)(C.ws + WS_R3);
    const int lane = C.lane, c4 = 4 * lane;
    for (int m = C.gw; m < M; m += C.NGW) {
        const bool samp = m >= MP; int b, t;
        if (!samp) { b = m >> 12; t = m & 4095; } else { b = (m - MP) >> 2; t = (m - MP) & 3; }
        const bf16* pr = PROJ + (size_t)m * INC;
#pragma unroll
        for (int cg = 0; cg < 4; ++cg) {
            const int col = 256 * cg + c4;
            const f32x4 cur = ld_bf4(pr + C_RW + col); f32x4 prv = (f32x4){0.f, 0.f, 0.f, 0.f};
            if (t > 0) prv = ld_bf4(pr - INC + C_RW + col);
            else if (samp) prv = *(const f32x4*)(INP(I_SSH) + ((size_t)l * DB + b) * 1024 + col);
            const f32x4 mu = *(const f32x4*)(INP(I_MU) + l * 1024 + col);
            const f32x4 xs = cur + (prv - cur) * mu;
            if (cg == 0) *(f32x4*)(R + (size_t)m * 256 + c4) = xs;
            else if (cg == 1) { *(f32x4*)(Ks + (size_t)m * 256 + c4) = xs; f32x4 kk = xs * *(const f32x4*)(INP(I_KK) + l * 256 + c4);
                const float ss = red16(dot4(kk, kk)); kk = kk * rsqrtf(fmaxf(ss, 1e-24f)); *(f32x4*)(KK + (size_t)m * 256 + c4) = kk; }
            else if (cg == 2) *(f32x4*)(V + (size_t)m * 256 + c4) = xs;
            else { f32x4 o;
                if (lane < 16) o = (f32x4){tanh_(xs.x), tanh_(xs.y), tanh_(xs.z), tanh_(xs.w)};
                else if (lane < 32) o = xs;
                else o = (f32x4){sigm(xs.x), sigm(xs.y), sigm(xs.z), sigm(xs.w)};
                st_bf4(A2 + (size_t)m * K2 + c4, o); }
        }
        f32x4 xc = *(const f32x4*)(INP(I_CB) + l * 256 + c4);
#pragma unroll
        for (int j = 0; j < 4; ++j) { const int tt = t - 3 + j; f32x4 val = (f32x4){0.f, 0.f, 0.f, 0.f};
            if (tt >= 0) val = ld_bf4(pr + (ptrdiff_t)(j - 3) * INC + C_XB + c4);
            else if (samp) val = *(const f32x4*)(INP(I_SCV) + (((size_t)l * DB + b) * 3 + (tt + 3)) * 256 + c4);
            xc = xc + val * *(const f32x4*)(INP(I_CW) + ((size_t)l * 4 + j) * 256 + c4); }
        st_bf4(A2 + (size_t)m * K2 + 256 + c4, xc);
    }
    const int gt = C.bid * 512 + C.tid, NT = C.G * 512;
    float* out = C.out;
    for (int e = gt; e < 2 * NBP * 128 * 128; e += NT) {
        const int kv = e / (NBP * 16384), r = e % (NBP * 16384), b = r >> 14, rr = (r >> 7) & 127, c = r & 127;
        out[(kv ? OUT_VP : OUT_KP) + (size_t)l * NBP * 16384 + r] = bf1(PROJ[(size_t)(b * T + T - 128 + rr) * INC + (kv ? C_V : C_K) + c]);
    }
    for (int e = gt; e < NBP * 1024; e += NT) { const int b = e >> 10, c = e & 1023; out[OUT_SHP + (size_t)l * NBP * 1024 + e] = bf1(PROJ[(size_t)(b * T + T - 1) * INC + C_RW + c]); }
    for (int e = gt; e < DB * 1024; e += NT) { const int b = e >> 10, c = e & 1023; out[OUT_SHS + (size_t)l * DB * 1024 + e] = bf1(PROJ[(size_t)(MP + 4 * b + 3) * INC + C_RW + c]); }
    for (int e = gt; e < NBP * 768; e += NT) { const int b = e / 768, j = (e % 768) >> 8, c = e & 255; out[OUT_CVP + (size_t)l * NBP * 768 + e] = bf1(PROJ[(size_t)(b * T + T - 3 + j) * INC + C_XB + c]); }
    for (int e = gt; e < DB * 768; e += NT) { const int b = e / 768, j = (e % 768) >> 8, c = e & 255; out[OUT_CVS + (size_t)l * DB * 768 + e] = bf1(PROJ[(size_t)(MP + 4 * b + 1 + j) * INC + C_XB + c]); }
}

struct RwkvPtrs { const float *R, *K, *V, *KK, *BV, *W; float* YR; };
__device__ __forceinline__ void rwkv_step(f32x4& s, const f32x4 w, const f32x4 kk, const f32x4 bv, const f32x4 k2, const f32x4 r, const float v, float& y) {
    const float sa = red16(dot4(s, kk));
    s = s * w + (k2 * v - bv * sa);
    y = red16(dot4(s, r));
}
__device__ __forceinline__ void rwkv_prompt(const Ctx& C, const RwkvPtrs& P, int wg, float* wkv_out  ) {
    constexpr int TC = 32, VEC = TC * 64 * 4, O_V = 5 * VEC, O_CC = O_V + TC * 16 * 4, BUF = O_CC + TC * 8, O_Y = 2 * BUF, O_DUMP = O_Y + 2 * TC * 64;
    const int chain = wg >> 2, b = chain >> 2, h = chain & 3, qr = wg & 3, tid = C.tid, lane = C.lane, wave = C.wave;
    const size_t m0 = (size_t)b * T;
    const int lstep = tid >> 4, lq = tid & 15;
    const int vstep = tid >> 2, vq = tid & 3;
    f32x4 st[5], stv; float c1 = 0.f, c2 = 0.f;
    f32x4 s = (f32x4){0.f, 0.f, 0.f, 0.f};
    const int row = 16 * qr + 4 * wave + (lane >> 4), cq = lane & 15;
#define RW_LOAD(c) do { const size_t o_ = (m0 + (size_t)(c) * TC + lstep) * 256 + h * 64 + 4 * lq; \
        st[0] = *(const f32x4*)(P.W + o_); st[1] = *(const f32x4*)(P.KK + o_); st[2] = *(const f32x4*)(P.BV + o_); st[3] = *(const f32x4*)(P.K + o_); st[4] = *(const f32x4*)(P.R + o_); \
        if (tid < 128) stv = *(const f32x4*)(P.V + (m0 + (size_t)(c) * TC + vstep) * 256 + h * 64 + 16 * qr + 4 * vq); } while (0)
#define RW_STORE(bufi) do { LAS unsigned char* bb = C.lds + (bufi) * BUF; c1 = red16(dot4(st[3], st[4])); c2 = red16(dot4(st[2], st[4])); st[4] = st[4] * st[0]; \
        _Pragma("unroll") for (int i = 0; i < 5; ++i) *(LAS f32x4*)(bb + i * VEC + (lstep * 64 + 4 * lq) * 4) = st[i]; \
        if (lq == 0) { *(LAS float*)(bb + O_CC + lstep * 8) = c1; *(LAS float*)(bb + O_CC + lstep * 8 + 4) = c2; } \
        if (tid < 128) *(LAS f32x4*)(bb + O_V + (vstep * 16 + 4 * vq) * 4) = stv; } while (0)
    RW_LOAD(0); RW_STORE(0); __syncthreads();
    for (int c = 0; c < T / TC; ++c) {
        if (c > 0) P.YR[(m0 + (size_t)(c - 1) * TC + lstep) * 256 + h * 64 + 16 * qr + lq] = *(const LAS float*)(C.lds + O_Y + ((c - 1) & 1) * (TC * 64) + (lstep * 16 + lq) * 4);
        if (c + 1 < T / TC) RW_LOAD(c + 1);
        if (wave < 4) {
            const LAS unsigned char* bb = C.lds + (c & 1) * BUF; LAS float* yb = (LAS float*)(C.lds + O_Y + (c & 1) * (TC * 64));
            const int vo = O_V + (4 * wave + (lane >> 4)) * 4, lo = 16 * cq;
            LAS unsigned char* ya = (cq == 0) ? (LAS unsigned char*)(yb + 4 * wave + (lane >> 4)) : (C.lds + O_DUMP + C.tid * 4);
            f32x4 w = *(const LAS f32x4*)(bb + 0 * VEC + lo), kk = *(const LAS f32x4*)(bb + 1 * VEC + lo), bv = *(const LAS f32x4*)(bb + 2 * VEC + lo),
                  k2 = *(const LAS f32x4*)(bb + 3 * VEC + lo), wr = *(const LAS f32x4*)(bb + 4 * VEC + lo);
            float v = *(const LAS float*)(bb + vo), a1 = *(const LAS float*)(bb + O_CC), a2 = *(const LAS float*)(bb + O_CC + 4);
            float yprev = 0.f;
#pragma unroll 8
            for (int i = 0; i < TC; ++i) {
                if (i > 0) *(LAS float*)(ya + (i - 1) * 64) = yprev;
                const int in = (i + 1 < TC) ? i + 1 : i;
                const f32x4 nw = *(const LAS f32x4*)(bb + 0 * VEC + in * 256 + lo), nkk = *(const LAS f32x4*)(bb + 1 * VEC + in * 256 + lo), nbv = *(const LAS f32x4*)(bb + 2 * VEC + in * 256 + lo),
                            nk2 = *(const LAS f32x4*)(bb + 3 * VEC + in * 256 + lo), nwr = *(const LAS f32x4*)(bb + 4 * VEC + in * 256 + lo);
                const float nv = *(const LAS float*)(bb + vo + in * 64), na1 = *(const LAS float*)(bb + O_CC + in * 8), na2 = *(const LAS float*)(bb + O_CC + in * 8 + 4);
                f32x2 pa = s.xy * kk.xy, pq = s.xy * wr.xy; pa = s.zw * kk.zw + pa; pq = s.zw * wr.zw + pq;
                float sa = pa.x + pa.y, qs = pq.x + pq.y; asm volatile("s_nop 1" ::: ); red16x2(sa, qs);
                const float y = qs + v * a1 - sa * a2;
                s = s * w + (k2 * v - bv * sa);
                yprev = y;
                w = nw; kk = nkk; bv = nbv; k2 = nk2; wr = nwr; v = nv; a1 = na1; a2 = na2;
            }
            *(LAS float*)(ya + (TC - 1) * 64) = yprev;
        }
        if (c + 1 < T / TC) RW_STORE((c + 1) & 1);
        __syncthreads();
    }
    P.YR[(m0 + (size_t)(T / TC - 1) * TC + lstep) * 256 + h * 64 + 16 * qr + lq] = *(const LAS float*)(C.lds + O_Y + ((T / TC - 1) & 1) * (TC * 64) + (lstep * 16 + lq) * 4);
#undef RW_LOAD
#undef RW_STORE
    if (wave < 4) *(f32x4*)(wkv_out + (((size_t)b * 4 + h) * 64 + row) * 64 + 4 * cq) = s;
    __syncthreads();
}
__device__ __forceinline__ void rwkv_sample_item(const RwkvPtrs& P, int item, const float* wkv_in, float* wkv_out, int lane) {
    const int rg = item & 15, h = (item >> 4) & 3, b = item >> 6, row = 4 * rg + (lane >> 4), cq = lane & 15;
    const size_t so = (((size_t)b * 4 + h) * 64 + row) * 64 + 4 * cq;
    f32x4 s = *(const f32x4*)(wkv_in + so);
#pragma unroll
    for (int i = 0; i < DS; ++i) { const size_t m = (size_t)MP + 4 * b + i, o = m * 256 + h * 64 + 4 * cq;
        float y; rwkv_step(s, *(const f32x4*)(P.W + o), *(const f32x4*)(P.KK + o), *(const f32x4*)(P.BV + o), *(const f32x4*)(P.K + o), *(const f32x4*)(P.R + o), P.V[m * 256 + h * 64 + row], y);
        if (cq == 0) P.YR[m * 256 + h * 64 + row] = y; }
    *(f32x4*)(wkv_out + so) = s;
}
__device__ __forceinline__ void lru_prompt_item(const Ctx& C, int item, const float* AL, const float* U, const bf16* PROJ, bf16* MIXCAT, float* lru_out  ) {
    const int b = item >> 4, c = (item & 15) * 16 + (C.tid & 15), seg = C.tid >> 4; constexpr int SL = T / 32;
    const size_t m0 = (size_t)b * T + (size_t)seg * SL;
    LAS float* sA = (LAS float*)C.lds; LAS float* sH = sA + 512;
    float Ap = 1.f, H = 0.f;
#pragma unroll 8
    for (int i = 0; i < SL; ++i) { const float a = AL[(m0 + i) * 256 + c], u = U[(m0 + i) * 256 + c]; H = a * H + u; Ap *= a; }
    sA[C.tid] = Ap; sH[C.tid] = H;
    __syncthreads();
    float h = 0.f;
    for (int sp = 0; sp < seg; ++sp) h = sA[sp * 16 + (C.tid & 15)] * h + sH[sp * 16 + (C.tid & 15)];
#pragma unroll 8
    for (int i = 0; i < SL; ++i) { const float a = AL[(m0 + i) * 256 + c], u = U[(m0 + i) * 256 + c]; h = a * h + u;
        const float gb = bf1(PROJ[(m0 + i) * INC + C_GB + c]); MIXCAT[(m0 + i) * DM + 768 + c] = (bf16)f2bf(h * gelu_t(gb)); }
    if (seg == 31) lru_out[b * 256 + c] = h;
    __syncthreads();
}
__device__ __forceinline__ void swa_prompt_item(const Ctx& C, int item, const bf16* PROJ, bf16* MIXCAT, const float* sinks  ) {
    constexpr int KP = 72, VP = 264;
    const int kvh = item & 1, n = (item >> 1) & 31, b = item >> 6, tid = C.tid, lane = C.lane, wave = C.wave;
    LAS bf16* Ks = (LAS bf16*)C.lds; LAS bf16* Vt = Ks + 256 * KP;
    const size_t rowq0 = (size_t)b * T + (size_t)n * 128;
    { const int key = tid >> 1, hf = tid & 1; size_t kr = rowq0 + key; kr = (kr >= 128 + (size_t)b * T) ? kr - 128 : kr;
        const bf16* kp = PROJ + kr * INC + C_K + kvh * 64 + hf * 32;
#pragma unroll
        for (int i = 0; i < 4; ++i) *(LAS u32x4*)(Ks + key * KP + hf * 32 + 8 * i) = *(const u32x4*)(kp + 8 * i);
#pragma unroll
        for (int i = 0; i < 4; ++i) { const int ch = tid + 512 * i, vk = ch >> 3, d0 = (ch & 7) * 8; size_t vr = rowq0 + vk; vr = (vr >= 128 + (size_t)b * T) ? vr - 128 : vr;
            const u32x4 w = *(const u32x4*)(PROJ + vr * INC + C_V + kvh * 64 + d0);
            Vt[(d0 + 0) * VP + vk] = (bf16)(w.x & 0xffff); Vt[(d0 + 1) * VP + vk] = (bf16)(w.x >> 16); Vt[(d0 + 2) * VP + vk] = (bf16)(w.y & 0xffff); Vt[(d0 + 3) * VP + vk] = (bf16)(w.y >> 16);
            Vt[(d0 + 4) * VP + vk] = (bf16)(w.z & 0xffff); Vt[(d0 + 5) * VP + vk] = (bf16)(w.z >> 16); Vt[(d0 + 6) * VP + vk] = (bf16)(w.w & 0xffff); Vt[(d0 + 7) * VP + vk] = (bf16)(w.w >> 16); } }
    __syncthreads();
    const int q = lane & 31, hi = lane >> 5;
#pragma unroll 1
    for (int qi = 0; qi < 2; ++qi) {
        const int qt = wave * 2 + qi, g = qt >> 2, j = qt & 3, hh = kvh * 4 + g;
        const size_t qrow = rowq0 + 32 * j + q;
        bf16x8 qf[4];
#pragma unroll
        for (int dk = 0; dk < 4; ++dk) qf[dk] = *(const bf16x8*)(PROJ + qrow * INC + hh * 64 + 16 * dk + 8 * hi);
        f32x16 sc[5];
#pragma unroll
        for (int kt = 0; kt < 5; ++kt) {
            f32x16 acc;
#pragma unroll
            for (int i = 0; i < 16; ++i) acc[i] = 0.f;
#pragma unroll
            for (int dk = 0; dk < 4; ++dk) { const bf16x8 kf = *(const LAS bf16x8*)(Ks + (32 * (j + kt) + q) * KP + 16 * dk + 8 * hi); acc = __builtin_amdgcn_mfma_f32_32x32x16_bf16(kf, qf[dk], acc, 0, 0, 0); }
            sc[kt] = acc;
        }
        const int qpos = 128 + 32 * j + q; float mx = -INFINITY;
#pragma unroll
        for (int kt = 0; kt < 5; ++kt)
#pragma unroll
            for (int i = 0; i < 16; ++i) { const int kj = 32 * (j + kt) + (i & 3) + 8 * (i >> 2) + 4 * hi, d = qpos - kj; const bool ok = d >= 0 && d <= 128 && (n > 0 || kj >= 128);
                const float sv = ok ? sc[kt][i] * 0.125f : -INFINITY; sc[kt][i] = sv; mx = fmaxf(mx, sv); }
        mx = fmaxf(mx, __shfl_xor(mx, 32)); const float sink = sinks[hh]; mx = fmaxf(mx, sink);
        float sum = 0.f;
#pragma unroll
        for (int kt = 0; kt < 5; ++kt)
#pragma unroll
            for (int i = 0; i < 16; ++i) { const float e = __expf(sc[kt][i] - mx); sc[kt][i] = e; sum += e; }
        sum += __shfl_xor(sum, 32);
        const float inv = 1.f / (sum + __expf(sink - mx));
#pragma unroll
        for (int dt = 0; dt < 2; ++dt) {
            f32x16 o;
#pragma unroll
            for (int i = 0; i < 16; ++i) o[i] = 0.f;
#pragma unroll
            for (int kt = 0; kt < 5; ++kt)
#pragma unroll
                for (int s2 = 0; s2 < 2; ++s2) {
                    u32x4 pw; pw.x = pk2(sc[kt][8 * s2 + 0], sc[kt][8 * s2 + 1]); pw.y = pk2(sc[kt][8 * s2 + 2], sc[kt][8 * s2 + 3]); pw.z = pk2(sc[kt][8 * s2 + 4], sc[kt][8 * s2 + 5]); pw.w = pk2(sc[kt][8 * s2 + 6], sc[kt][8 * s2 + 7]);
                    const LAS bf16* vp = Vt + (32 * dt + q) * VP + 32 * (j + kt) + 16 * s2 + 4 * hi;
                    const u32x2 v0 = *(const LAS u32x2*)vp, v1 = *(const LAS u32x2*)(vp + 8);
                    u32x4 vw; vw.x = v0.x; vw.y = v0.y; vw.z = v1.x; vw.w = v1.y;
                    o = __builtin_amdgcn_mfma_f32_32x32x16_bf16(__builtin_bit_cast(bf16x8, vw), __builtin_bit_cast(bf16x8, pw), o, 0, 0, 0);
                }
#pragma unroll
            for (int g4 = 0; g4 < 4; ++g4) st_bf4(MIXCAT + qrow * DM + hh * 64 + 32 * dt + 8 * g4 + 4 * hi, (f32x4){o[4 * g4] * inv, o[4 * g4 + 1] * inv, o[4 * g4 + 2] * inv, o[4 * g4 + 3] * inv});
        }
    }
    __syncthreads();
}
__device__ __forceinline__ void swa_sample_item(const Ctx& C, int item, const bf16* PROJ, bf16* MIXCAT, const float* sinks, const float* ck, const float* cv, float* ko, float* vo) {
    const int kvh = item & 1, b = item >> 1, tid = C.tid;
    LAS float* Kf = (LAS float*)C.lds; LAS float* Vf = Kf + 132 * 65; LAS float* Qf = Vf + 132 * 64; LAS float* Pf = Qf + 16 * 64;
    for (int e = tid; e < 132 * 64; e += 512) { const int key = e >> 6, d = e & 63; float kx, vx;
        if (key < 128) { const size_t o = (((size_t)b * 128 + key) * 2 + kvh) * 64 + d; kx = ck[o]; vx = cv[o]; }
        else { const size_t r = (size_t)MP + 4 * b + (key - 128); kx = bf1(PROJ[r * INC + C_K + kvh * 64 + d]); vx = bf1(PROJ[r * INC + C_V + kvh * 64 + d]); }
        Kf[key * 65 + d] = kx; Vf[key * 64 + d] = vx;
        if (key >= 4) { const size_t o = (((size_t)b * 128 + (key - 4)) * 2 + kvh) * 64 + d; ko[o] = kx; vo[o] = vx; } }
    for (int e = tid; e < 16 * 64; e += 512) { const int qr = e >> 6, d = e & 63, i = qr >> 2, g = qr & 3; Qf[e] = bf1(PROJ[((size_t)MP + 4 * b + i) * INC + (kvh * 4 + g) * 64 + d]); }
    __syncthreads();
    { const int qr = tid >> 5, kl = tid & 31, i = qr >> 2, g = qr & 3; float sc[5]; float mx = -INFINITY;
#pragma unroll
        for (int k5 = 0; k5 < 5; ++k5) { const int key = kl + 32 * k5; float sv = -INFINITY;
            if (key < 132 && key >= i && key <= i + 128) { float a = 0.f;
#pragma unroll 16
                for (int d = 0; d < 64; ++d) a += Qf[qr * 64 + d] * Kf[key * 65 + d];
                sv = a * 0.125f; }
            sc[k5] = sv; mx = fmaxf(mx, sv); }
#pragma unroll
        for (int o = 1; o < 32; o <<= 1) mx = fmaxf(mx, __shfl_xor(mx, o));
        const float sink = sinks[kvh * 4 + g]; mx = fmaxf(mx, sink); float sum = 0.f;
#pragma unroll
        for (int k5 = 0; k5 < 5; ++k5) { sc[k5] = __expf(sc[k5] - mx); sum += sc[k5]; }
#pragma unroll
        for (int o = 1; o < 32; o <<= 1) sum += __shfl_xor(sum, o);
        const float inv = 1.f / (sum + __expf(sink - mx));
#pragma unroll
        for (int k5 = 0; k5 < 5; ++k5) { const int key = kl + 32 * k5; if (key < 136) Pf[qr * 136 + key] = sc[k5] * inv; } }
    __syncthreads();
    { const int qr = tid >> 5, d = (tid & 31) * 2, i = qr >> 2, g = qr & 3; float o0 = 0.f, o1 = 0.f;
#pragma unroll 4
        for (int key = 0; key < 132; ++key) { const float p = Pf[qr * 136 + key]; o0 += p * Vf[key * 64 + d]; o1 += p * Vf[key * 64 + d + 1]; }
        *(unsigned*)(MIXCAT + ((size_t)MP + 4 * b + i) * DM + (kvh * 4 + g) * 64 + d) = pk2(o0, o1); }
    __syncthreads();
}

__device__ __forceinline__ void s_phase(const Ctx& C, const Args& A, int l) {
    const bf16* PROJ = (const bf16*)(C.ws + WS_R1); bf16* MIXCAT = (bf16*)(C.ws + WS_HN);
    float* R = (float*)(C.ws + WS_R2); const size_t S = (size_t)M * 256;
    RwkvPtrs P{R, R + S, R + 2 * S, R + 3 * S, R + 4 * S, R + 5 * S, (float*)(C.ws + WS_R3)};
    const float* AL = (const float*)(C.ws + WS_R3) + S; const float* U = AL + S;
    float* out = C.out;
    constexpr int NSCAN = 64;
    if (C.bid < NSCAN) { rwkv_prompt(C, P, C.bid, out + OUT_WKVP + (size_t)l * NBP * 4 * 4096); return; }
    constexpr int N0 = 256, N1 = N0 + 64, N2_ = N1 + 256, N3 = N2_ + 1024, N4 = N3 + 64;
    for (int it = C.bid - NSCAN; it < N4; it += C.G - NSCAN) {
        if (it < N0) swa_prompt_item(C, it, PROJ, MIXCAT, INP(I_SINK) + l * 8);
        else if (it < N1) lru_prompt_item(C, it - N0, AL, U, PROJ, MIXCAT, out + OUT_LRP + (size_t)l * NBP * 256);
        else if (it < N2_) swa_sample_item(C, it - N1, PROJ, MIXCAT, INP(I_SINK) + l * 8, INP(I_CK) + (size_t)l * DB * 16384, INP(I_CV) + (size_t)l * DB * 16384,
                                          out + OUT_KS + (size_t)l * DB * 16384, out + OUT_VS + (size_t)l * DB * 16384);
        else if (it < N3) rwkv_sample_item(P, (it - N2_) * 8 + C.wave, INP(I_SWKV) + (size_t)l * DB * 4 * 4096, out + OUT_WKVS + (size_t)l * DB * 4 * 4096, C.lane);
        else { const int e = (it - N3) * 512 + C.tid, b = e >> 8, c = e & 255; float h = INP(I_SLRU)[((size_t)l * DB + b) * 256 + c];
#pragma unroll
            for (int i = 0; i < DS; ++i) { const size_t m = (size_t)MP + 4 * b + i; h = AL[m * 256 + c] * h + U[m * 256 + c];
                MIXCAT[m * DM + 768 + c] = (bf16)f2bf(h * gelu_t(bf1(PROJ[m * INC + C_GB + c]))); }
            out[OUT_LRS + ((size_t)l * DB + b) * 256 + c] = h; }
    }
}

__device__ __forceinline__ void e3_post(const Ctx& C, const Args& A, int l) {
    const float* R = (const float*)(C.ws + WS_R2); const size_t S = (size_t)M * 256;
    const float *K = R + S, *V = R + 2 * S, *G = R + 6 * S, *YR = (const float*)(C.ws + WS_R3);
    bf16* MIXCAT = (bf16*)(C.ws + WS_HN); const int c4 = 4 * C.lane;
    const f32x4 lw = *(const f32x4*)(INP(I_LNW) + l * 256 + c4), lb = *(const f32x4*)(INP(I_LNB) + l * 256 + c4), rk = *(const f32x4*)(INP(I_RK) + l * 256 + c4);
    for (int m = C.gw; m < M; m += C.NGW) {
        const size_t o = (size_t)m * 256 + c4;
        const f32x4 y = *(const f32x4*)(YR + o), r = *(const f32x4*)(R + o), k = *(const f32x4*)(K + o), v = *(const f32x4*)(V + o), g = *(const f32x4*)(G + o);
        const float mean = red16((y.x + y.y) + (y.z + y.w)) * (1.f / 64.f); const f32x4 d = y - mean;
        const float var = red16(dot4(d, d)) * (1.f / 64.f); const float rs = rsqrtf(var + 64e-5f);
        const float bonus = red16(dot4(r * k, rk));
        st_bf4(MIXCAT + (size_t)m * DM + 512 + c4, (d * rs * lw + lb + v * bonus) * g);
    }
}
constexpr int LDS_BYTES = 131072 + 64;
#ifndef MK_MULTI
#define MK_MULTI 0
#endif
#ifndef MK_DUP
#define MK_DUP 0
#endif
enum { PH_P0 = 0, PH_G1, PH_E1, PH_G2, PH_S, PH_E3, PH_G3, PH_E4, PH_G4, PH_G5, PH_E5, PH_G6, PH_E0, PH_N };

__device__ __forceinline__ Ctx make_ctx(int wave0, LAS unsigned char* lds) {
    Ctx D; int z_ = 0; asm volatile("" : "+v"(z_)); int ln_ = __builtin_amdgcn_mbcnt_hi(-1, __builtin_amdgcn_mbcnt_lo(-1, z_));
    D.lane = ln_; D.wave = wave0; D.tid = wave0 * 64 + ln_;
    int b_ = blockIdx.x; asm volatile("" : "+s"(b_)); D.bid = b_; D.gw = b_ * 8 + wave0; D.G = gridDim.x; D.NGW = D.G * 8;
    D.lds = lds; D.out = (float*)inp_ld(N_IN); D.ws = (unsigned char*)inp_ld(N_IN + 1);
    return D;
}
template <int PH> __device__ __forceinline__ void run_phase(const Args& A, int wave0, LAS unsigned char* lds, int l_in) {
    const Ctx C = make_ctx(wave0, lds);
    int l = l_in; asm volatile("" : "+s"(l));
    unsigned char* ws = C.ws; unsigned char* wl = ws + WS_W + (size_t)l * WL; (void)wl;
    bf16* HN = (bf16*)(ws + WS_HN); float* MIX = (float*)(ws + WS_R1); float* R2 = (float*)(ws + WS_R2); float* R3 = (float*)(ws + WS_R3); float* X = C.out;
    const size_t S = (size_t)M * 256; (void)HN; (void)MIX; (void)R2; (void)R3; (void)X; (void)S;
    if constexpr (PH == PH_P0) p0_prologue(C, A);
    if constexpr (PH == PH_G1) {
        pg8::Gemm g{HN, (const bf16*)(wl + O_WIN), M, INC, DM}; pg8::StaticOrder So; So.init(M, INC, C.G, C.bid);
        pg8::EpiBf16<0> E{(bf16*)(ws + WS_R1), INC, INP(I_BIN) + (size_t)l * INC, 0, 0, 1.f};
        pg8::gemm_phase<pg8::EpiBf16<0>, pg8::StaticOrder, true, true>(C.lds, g, So, E, C.tid); }
    if constexpr (PH == PH_E1) e1_prep(C, A, l);
    if constexpr (PH == PH_G2) {
        pg8::Gemm g{(const bf16*)(ws + WS_R3), (const bf16*)(wl + O_W2), M, N2, K2}; pg8::StaticOrder So; So.init(M, N2, C.G, C.bid);
        EpiMix E{INP(I_W0) + l * 256, INP(I_A0) + l * 256, INP(I_KA) + l * 256, INP(I_BA) + l * 256, INP(I_BI) + l * 256, INP(I_L) + l * 256,
                 R2 + 5 * S, R2 + 1 * S, R2 + 3 * S, R2 + 4 * S, R2 + 6 * S, R3 + S, R3 + 2 * S, (const bf16*)(ws + WS_R3)};
        pg8::gemm_phase<EpiMix, pg8::StaticOrder, true, true>(C.lds, g, So, E, C.tid); }
    if constexpr (PH == PH_S) s_phase(C, A, l);
    if constexpr (PH == PH_E3) e3_post(C, A, l);
    if constexpr (PH == PH_G3) {
        pg8::Gemm g{HN, (const bf16*)(wl + O_WOUT), M, DM, DM}; pg8::StaticOrder So; So.init(M, DM, C.G, C.bid);
        EpiF32 E{MIX, DM, INP(I_BOUT) + (size_t)l * DM};
        pg8::gemm_phase<EpiF32, pg8::StaticOrder, true, true>(C.lds, g, So, E, C.tid); }
    if constexpr (PH == PH_E4)
        for (int m = C.gw; m < M; m += C.NGW) row_update(MIX + (size_t)m * DM, INP(I_NMPOST) + l * DM, X + (size_t)m * DM, INP(I_NFPRE) + l * DM, HN + (size_t)m * DM, C.lane);
    if constexpr (PH == PH_G4) {
        pg8::Gemm g{HN, (const bf16*)(wl + O_WGU), M, 2 * DFF, DM}; pg8::StaticOrder So; So.init(M, 2 * DFF, C.G, C.bid);
        EpiSwiglu E{(bf16*)(ws + WS_R2)};
        pg8::gemm_phase<EpiSwiglu, pg8::StaticOrder, true, true>(C.lds, g, So, E, C.tid); }
    if constexpr (PH == PH_G5) {
        pg8::Gemm g{(const bf16*)(ws + WS_R2), (const bf16*)(wl + O_WD), M, DM, DFF}; pg8::StaticOrder So; So.init(M, DM, C.G, C.bid);
        EpiF32 E{MIX, DM, nullptr};
        pg8::gemm_phase<EpiF32, pg8::StaticOrder, true, true>(C.lds, g, So, E, C.tid); }
    if constexpr (PH == PH_E5)
        for (int m = C.gw; m < M; m += C.NGW) row_update(MIX + (size_t)m * DM, INP(I_NFPOST) + l * DM, X + (size_t)m * DM, nullptr, HN + (size_t)m * DM, C.lane);
    if constexpr (PH == PH_G6) {
        pg8::StaticOrder So; So.init(M, DM, C.G, C.bid);
        { pg8::Gemm g{(const bf16*)(ws + WS_PB + (size_t)l * SZ_PBL), (const bf16*)(wl + O_WP), M, DM, PLE}; EpiF32 E{R2, DM, nullptr};
          pg8::gemm_phase<EpiF32, pg8::StaticOrder, true, true>(C.lds, g, So, E, C.tid); }
        { pg8::Gemm g{HN, (const bf16*)(wl + O_WPG), M, DM, DM}; EpiPle E{X, R2};
          pg8::gemm_phase<EpiPle, pg8::StaticOrder, true, true>(C.lds, g, So, E, C.tid); } }
    if constexpr (PH == PH_E0)
        for (int m = C.gw; m < M; m += C.NGW) row_norm(X + (size_t)m * DM, INP(I_NMPRE) + (l + 1) * DM, HN + (size_t)m * DM, nullptr, C.lane);
}

#if MK_MULTI
template <int PH> __global__ void __launch_bounds__(512, 2) mk_one(Args A, int l) {
    extern __shared__ __attribute__((aligned(16))) unsigned char lds_raw[];
    const int wave0 = __builtin_amdgcn_readfirstlane((int)threadIdx.x >> 6);
    run_phase<PH>(A, wave0, (LAS unsigned char*)lds_raw, l);
}
#else
__global__ void __launch_bounds__(512, 2) mk_fwd(Args A) {
    extern __shared__ __attribute__((aligned(16))) unsigned char lds_raw[];
    cg::grid_group grid = cg::this_grid();
    const int wave0 = __builtin_amdgcn_readfirstlane((int)threadIdx.x >> 6);
    LAS unsigned char* lds = (LAS unsigned char*)lds_raw;
    if (threadIdx.x < 16) ((LAS unsigned*)lds)[131072 / 4 + threadIdx.x] = 0u;
    __syncthreads();
    const unsigned xbar_x = __builtin_amdgcn_readfirstlane(xcd_barrier_post((unsigned*)inp_ld(N_IN + 1), (volatile LAS unsigned*)(lds + 131072), (int)threadIdx.x).x);
#define GRID_BAR() do { int z_ = 0; asm volatile("" : "+v"(z_)); int ln_ = __builtin_amdgcn_mbcnt_hi(-1, __builtin_amdgcn_mbcnt_lo(-1, z_)); XcdBarrier xb_; xb_.bar = (unsigned*)inp_ld(N_IN + 1); xb_.x = xbar_x; \
        xb_.st = (volatile LAS unsigned*)(lds + 131072); xcd_barrier(xb_, wave0 * 64 + ln_); } while (0)
    run_phase<PH_P0>(A, wave0, lds, 0);
    grid.sync();
#pragma unroll 1
    for (int l = 0; l < NL; ++l) {
#define RP(PH) do { run_phase<PH>(A, wave0, lds, l); GRID_BAR(); if (MK_DUP & (1 << PH)) { run_phase<PH>(A, wave0, lds, l); GRID_BAR(); } } while (0)
        RP(PH_G1); RP(PH_E1); RP(PH_G2); RP(PH_S); RP(PH_E3); RP(PH_G3); RP(PH_E4); RP(PH_G4); RP(PH_G5); RP(PH_E5);
        run_phase<PH_G6>(A, wave0, lds, l);
        if (l + 1 < NL) { GRID_BAR(); RP(PH_E0); }
    }
}
#endif
}

#if MK_MULTI
template <int PH> static void launch_one(const mk::Args& a, int l, int grid, hipStream_t stream) {
    static bool attr = false;
    if (!attr) { (void)hipFuncSetAttribute((const void*)mk::mk_one<PH>, hipFuncAttributeMaxDynamicSharedMemorySize, mk::LDS_BYTES); attr = true; }
    hipLaunchKernelGGL(mk::mk_one<PH>, dim3(grid), dim3(512), mk::LDS_BYTES, stream, a, l);
}
#endif
extern "C" void kernel_launch(void* const* d_in, const int* in_sizes, int n_in, void* d_out, int out_size, void* d_ws, size_t ws_size, hipStream_t stream) {
    using namespace mk;
    static int grid = 0;
    if (grid == 0) {
        if (n_in != N_IN || (size_t)out_size != OUT_END || ws_size < WS_END) {
            fprintf(stderr, "kernel_launch: shape mismatch: n_in %d (want %d), out %d (want %zu), ws %zu (want >= %zu); nothing launched\n", n_in, (int)N_IN, out_size, (size_t)OUT_END, ws_size, (size_t)WS_END);
            grid = -1; return; }
        int dev = 0, cus = 0;
        (void)hipGetDevice(&dev); (void)hipDeviceGetAttribute(&cus, hipDeviceAttributeMultiprocessorCount, dev);
#if !MK_MULTI
        int per_cu = 0;
        if (hipFuncSetAttribute((const void*)mk_fwd, hipFuncAttributeMaxDynamicSharedMemorySize, LDS_BYTES) != hipSuccess) { fprintf(stderr, "kernel_launch: hipFuncSetAttribute failed\n"); grid = -1; return; }
        if (hipOccupancyMaxActiveBlocksPerMultiprocessor(&per_cu, (const void*)mk_fwd, 512, LDS_BYTES) != hipSuccess || per_cu < 1) fprintf(stderr, "kernel_launch: note: occupancy query gave %d\n", per_cu);
        (void)hipGetLastError();
#endif
        grid = cus;
        if (grid < 128) { fprintf(stderr, "kernel_launch: %d CUs: too few for this kernel\n", grid); grid = -1; return; }
    }
    if (grid < 0) return;
    Args a{};
    for (int i = 0; i < N_IN; ++i) a.in[i] = (const float*)d_in[i];
    a.out = (float*)d_out; a.ws = (unsigned char*)d_ws;
#if MK_MULTI
    launch_one<PH_P0>(a, 0, grid, stream);
    for (int l = 0; l < NL; ++l) {
        launch_one<PH_G1>(a, l, grid, stream); launch_one<PH_E1>(a, l, grid, stream); launch_one<PH_G2>(a, l, grid, stream); launch_one<PH_S>(a, l, grid, stream);
        launch_one<PH_E3>(a, l, grid, stream); launch_one<PH_G3>(a, l, grid, stream); launch_one<PH_E4>(a, l, grid, stream); launch_one<PH_G4>(a, l, grid, stream);
        launch_one<PH_G5>(a, l, grid, stream); launch_one<PH_E5>(a, l, grid, stream); launch_one<PH_G6>(a, l, grid, stream);
        if (l + 1 < NL) launch_one<PH_E0>(a, l, grid, stream);
    }
#else
    if (hipMemsetAsync(d_ws, 0, 65536, stream) != hipSuccess) { fprintf(stderr, "kernel_launch: hipMemsetAsync failed\n"); return; }
    void* args[] = {&a};
    const hipError_t e = hipLaunchCooperativeKernel((const void*)mk_fwd, dim3(grid), dim3(512), args, LDS_BYTES, stream);
    if (e != hipSuccess) fprintf(stderr, "kernel_launch: cooperative launch failed: %s (grid %d)\n", hipGetErrorString(e), grid);
#endif
}
```

```cpp
#include <hip/hip_runtime.h>
#include <hip/hip_cooperative_groups.h>
#include <cstdio>
#include <cstdint>
#include <cstddef>
#include <cmath>
namespace cg = cooperative_groups;
namespace pg8 {
#define PG8_LAS __attribute__((address_space(3)))
typedef unsigned short bf16_t;
typedef short bf16x8 __attribute__((ext_vector_type(8)));
typedef float f32x4 __attribute__((ext_vector_type(4)));
typedef unsigned u32x4 __attribute__((ext_vector_type(4)));
constexpr int BM = 256, BK = 64, HALF = 128, HTB = HALF * BK * 2  , STAGE_BYTES = 8 * HTB, NXCD = 8, WGM = 8;

__host__ __device__ __forceinline__ int lds_byte(int r, int c) { const int st = (r >> 4) * 2 + (c >> 5), rr = r & 15, cc = c & 31, ob = rr * 64 + cc * 2; return st * 1024 + (ob ^ (((ob >> 9) & 1) << 5)); }
__host__ __device__ __forceinline__ void stage_rc(int b, int& R, int& C) { const int st = b / 1024, sb = b % 1024, swz = sb ^ (((sb >> 9) & 1) << 5); R = (st >> 1) * 16 + swz / 64; C = (st & 1) * 32 + (swz % 64) / 2; }
__host__ __device__ __forceinline__ int perm32(int rho) { const int n = rho >> 4, i = rho & 15; return 8 * (i >> 2) + 4 * n + (i & 3); }

struct Unit { int pm, pn; };
struct Gemm { const bf16_t* A; const bf16_t* Bt; int M, N, K; };

struct StaticOrder {
    int nM, nN, nwg, G, c;
    __host__ __device__ void init(int M, int N, int G_, int c_) { nM = M / BM; nN = N / BM; nwg = nM * nN; G = G_; c = c_; }
    __host__ __device__ bool next(int i, Unit& u) const {
        const long L = (long)i * G + c; if (L >= nwg) return false;
        int wgid = (int)L; { const int q = nwg / NXCD, r = nwg % NXCD, xcd = wgid % NXCD, off = wgid / NXCD; wgid = (xcd < r ? xcd * (q + 1) : r * (q + 1) + (xcd - r) * q) + off; }
        const int nig = WGM * nN, gid = wgid / nig, fm = gid * WGM, gsz = (nM - fm) < WGM ? (nM - fm) : WGM;
        u.pm = fm + ((wgid % nig) % gsz); u.pn = (wgid % nig) / gsz; return true;
    }
    __device__ __forceinline__ void a_ready(const Unit&) const {}
    __device__ __forceinline__ void done(const Unit&) const {}
};

__device__ __forceinline__ unsigned cvt_pk_bf16(float lo, float hi) { unsigned r; asm volatile("v_cvt_pk_bf16_f32 %0, %1, %2" : "=v"(r) : "v"(lo), "v"(hi)); return r; }
typedef float f32x2 __attribute__((ext_vector_type(2)));
__device__ __forceinline__ f32x2 gelu_pk(f32x2 v) {
    const f32x2 av = __builtin_elementwise_abs(v), d = av * 0.2316418882f + 1.0f;
    f32x2 t; t.x = __builtin_amdgcn_rcpf(d.x); t.y = __builtin_amdgcn_rcpf(d.y);
    f32x2 q = t * 0.5307027145f + (-0.7265760135f); q = q * t + 0.7107068705f; q = q * t + (-0.142248368f); q = q * t + 0.127414796f; q = q * t;
    const f32x2 s = (v * v) * (-0.72134752044f);
    f32x2 e; e.x = __builtin_amdgcn_exp2f(s.x); e.y = __builtin_amdgcn_exp2f(s.y);
    const f32x2 m = v * (q * e), r = v - m;
    f32x2 o; o.x = v.x < 0.f ? m.x : r.x; o.y = v.y < 0.f ? m.y : r.y; return o;
}

template <int ACT  > struct EpiBf16 {
    static constexpr bool PERM = true, AFTER_DRAIN = false; static_assert(ACT == 0 || ACT == 1, "EpiBf16: ACT is 0 (none) or 1 (gelu_pk)");
    bf16_t* O; int ldc; const float* bias; int split_cols; size_t split_stride; float scale0;
    __device__ __forceinline__ void operator()(const f32x4 (&acc)[2][2][4][2], const Unit& u, int wr, int wc, int fr, int fq) const {
        const int row0 = u.pm * BM + wr * 64 + fr; int colt = u.pn * BM; bf16_t* base = O;
        float sc = 1.f; if (split_cols) { const int t = colt / split_cols; base += (size_t)t * split_stride; colt -= t * split_cols; if (t == 0) sc = scale0; }
        const int col0 = colt + wc * 32 + 8 * fq, bcol0 = u.pn * BM + wc * 32 + 8 * fq;
        f32x4 bv[2][2];
#pragma unroll
        for (int bj = 0; bj < 2; ++bj)
#pragma unroll
            for (int n = 0; n < 2; ++n) bv[bj][n] = bias ? *(const f32x4*)(bias + bcol0 + bj * HALF + 4 * n) : (f32x4){0.f, 0.f, 0.f, 0.f};
#pragma unroll
        for (int ai = 0; ai < 2; ++ai)
#pragma unroll
            for (int m = 0; m < 4; ++m) { bf16_t* rowp = base + (size_t)(row0 + ai * HALF + m * 16) * ldc + col0;
#pragma unroll
                for (int bj = 0; bj < 2; ++bj) { f32x4 v0 = acc[ai][bj][m][0] + bv[bj][0], v1 = acc[ai][bj][m][1] + bv[bj][1];
                    if (ACT == 1) { f32x2 a = gelu_pk((f32x2){v0[0], v0[1]}), b = gelu_pk((f32x2){v0[2], v0[3]}), c = gelu_pk((f32x2){v1[0], v1[1]}), d = gelu_pk((f32x2){v1[2], v1[3]});
                        v0 = (f32x4){a.x, a.y, b.x, b.y}; v1 = (f32x4){c.x, c.y, d.x, d.y}; }
                    v0 = v0 * sc; v1 = v1 * sc; u32x4 w; w.x = cvt_pk_bf16(v0[0], v0[1]); w.y = cvt_pk_bf16(v0[2], v0[3]); w.z = cvt_pk_bf16(v1[0], v1[1]); w.w = cvt_pk_bf16(v1[2], v1[3]);
                    *(u32x4*)(rowp + bj * HALF) = w; } }
    }
};
template <class Epi, class Sched, bool ALIGN_EPI = false, bool SP2 = false>
__device__ __forceinline__ void gemm_phase(PG8_LAS unsigned char* lds, const Gemm g, const Sched& S, const Epi& E, int tid_in) {
    int tid_ = tid_in; asm volatile("" : "+v"(tid_));
    const int tid = tid_, wid = __builtin_amdgcn_readfirstlane(tid >> 6), lane = tid & 63, wr = wid >> 2, wc = wid & 3, fr = lane & 15, fq = lane >> 4;
    const int K = g.K, nt = K / BK;
    unsigned voffA[2], voffB[2];
#pragma unroll
    for (int i = 0; i < 2; ++i) { int R, C; stage_rc(tid * 16 + i * 8192, R, C); const int Rb = Epi::PERM ? ((R & ~31) + perm32(R & 31)) : R;
        voffA[i] = (unsigned)(R * K + C) * 2u; voffB[i] = (unsigned)(Rb * K + C) * 2u; }
    const size_t kstep = (size_t)(BK * 2);
    const size_t hstep = (size_t)HALF * K * 2;
    const size_t tstep = 2 * hstep;
    const unsigned ldsw = (unsigned)wid * 1024u;
    const int aoff = lds_byte(wr * 64 + fr, fq * 8), boff = lds_byte(wc * 32 + fr, fq * 8);
#define PG8_SA(b, h) (((b) * 2 + (h)) * HTB)
#define PG8_SB(b, h) ((4 + (b) * 2 + (h)) * HTB)
#define PG8_STAGE(bufoff, gbase, voff) do { _Pragma("unroll") for (int _i = 0; _i < 2; ++_i) \
        __builtin_amdgcn_global_load_lds((const unsigned*)((const char*)(gbase) + (voff)[_i]), (PG8_LAS unsigned*)(lds + (bufoff) + ldsw + _i * 8192), 16, 0, 0); } while (0)
#define PG8_LDA(dst, b, h) do { _Pragma("unroll") for (int m = 0; m < 4; ++m) _Pragma("unroll") for (int k = 0; k < 2; ++k) dst[m][k] = *(const PG8_LAS bf16x8*)(lds + PG8_SA(b, h) + aoff + m * 2048 + k * 1024); } while (0)
#define PG8_LDB(dst, b, h) do { _Pragma("unroll") for (int n = 0; n < 2; ++n) _Pragma("unroll") for (int k = 0; k < 2; ++k) dst[n][k] = *(const PG8_LAS bf16x8*)(lds + PG8_SB(b, h) + boff + n * 2048 + k * 1024); } while (0)
#define PG8_MMA(ai, bj, At, Bt) do { __builtin_amdgcn_s_setprio(1); _Pragma("unroll") for (int m = 0; m < 4; ++m) _Pragma("unroll") for (int n = 0; n < 2; ++n) _Pragma("unroll") for (int k = 0; k < 2; ++k) \
        acc[ai][bj][m][n] = __builtin_amdgcn_mfma_f32_16x16x32_bf16(Bt[n][k], At[m][k], acc[ai][bj][m][n], 0, 0, 0); __builtin_amdgcn_s_setprio(0); } while (0)
#define PG8_WAIT_V(n) asm volatile("s_waitcnt vmcnt(" #n ")" ::: "memory")
#define PG8_WAIT_L(n) asm volatile("s_waitcnt lgkmcnt(" #n ")" ::: "memory")
#define PG8_BAR __builtin_amdgcn_s_barrier()
#define PG8_SCHED __builtin_amdgcn_sched_barrier(0)
    Unit cur, nxt; int ui = 0;
    if (!S.next(0, cur)) return;
    f32x4 acc[2][2][4][2];
#pragma unroll
    for (int a = 0; a < 2; ++a)
#pragma unroll
        for (int b = 0; b < 2; ++b)
#pragma unroll
            for (int m = 0; m < 4; ++m)
#pragma unroll
                for (int n = 0; n < 2; ++n) acc[a][b][m][n] = (f32x4){0.f, 0.f, 0.f, 0.f};
    bf16x8 At[4][2], B0[2][2], B1[2][2];
    const char* cA = (const char*)g.A + (size_t)cur.pm * tstep; const char* cB = (const char*)g.Bt + (size_t)cur.pn * tstep;
    S.a_ready(cur);
    if constexpr (SP2) {
        PG8_STAGE(PG8_SB(0, 0), cB, voffB); PG8_STAGE(PG8_SB(0, 1), cB + hstep, voffB); PG8_STAGE(PG8_SA(0, 0), cA, voffA); PG8_STAGE(PG8_SA(0, 1), cA + hstep, voffA);
        if (wr == 1) PG8_BAR;
        PG8_WAIT_V(2); PG8_BAR;
        PG8_STAGE(PG8_SB(1, 0), cB + kstep, voffB); PG8_STAGE(PG8_SA(1, 0), cA + kstep, voffA); PG8_STAGE(PG8_SB(1, 1), cB + hstep + kstep, voffB);
        PG8_WAIT_V(6); PG8_BAR;
    } else {
        PG8_STAGE(PG8_SB(0, 0), cB, voffB); PG8_STAGE(PG8_SA(0, 0), cA, voffA); PG8_STAGE(PG8_SB(0, 1), cB + hstep, voffB); PG8_STAGE(PG8_SA(0, 1), cA + hstep, voffA);
        if (wr == 1) PG8_BAR;
        PG8_WAIT_V(4); PG8_BAR;
        PG8_STAGE(PG8_SB(1, 0), cB + kstep, voffB); PG8_STAGE(PG8_SA(1, 0), cA + kstep, voffA); PG8_STAGE(PG8_SB(1, 1), cB + hstep + kstep, voffB);
        PG8_WAIT_V(6); PG8_BAR;
    }
    for (;;) {
        const bool has_next = S.next(ui + 1, nxt);
        const char* nA = has_next ? (const char*)g.A + (size_t)nxt.pm * tstep : cA; const char* nB = has_next ? (const char*)g.Bt + (size_t)nxt.pn * tstep : cB;
        for (int t = 0; t < nt; t += 2) {
            const bool last = (t == nt - 2);
            const char* a1 = cA + (size_t)(t + 1) * kstep;
            const char* a2 = last ? nA : cA + (size_t)(t + 2) * kstep; const char* b2 = last ? nB : cB + (size_t)(t + 2) * kstep;
            const char* a3 = a2 + kstep; const char* b3 = b2 + kstep;
            if (last && has_next) S.a_ready(nxt);
            if constexpr (SP2) {
            PG8_LDB(B0, 0, 0); PG8_LDB(B1, 0, 1); PG8_SCHED; PG8_LDA(At, 0, 0); PG8_STAGE(PG8_SA(1, 1), a1 + hstep, voffA);
            PG8_WAIT_V(8); PG8_WAIT_L(0); PG8_BAR; PG8_MMA(0, 0, At, B0); PG8_MMA(0, 1, At, B1); PG8_BAR; PG8_SCHED;
            PG8_LDA(At, 0, 1); PG8_STAGE(PG8_SB(0, 0), b2, voffB); PG8_STAGE(PG8_SB(0, 1), b2 + hstep, voffB); PG8_STAGE(PG8_SA(0, 0), a2, voffA);
            PG8_WAIT_V(8); PG8_WAIT_L(0); PG8_BAR; PG8_MMA(1, 0, At, B0); PG8_MMA(1, 1, At, B1); PG8_BAR; PG8_SCHED;
            PG8_LDB(B0, 1, 0); PG8_LDB(B1, 1, 1); PG8_SCHED; PG8_LDA(At, 1, 0); PG8_STAGE(PG8_SA(0, 1), a2 + hstep, voffA);
            PG8_WAIT_V(8); PG8_WAIT_L(0); PG8_BAR; PG8_MMA(0, 0, At, B0); PG8_MMA(0, 1, At, B1); PG8_BAR; PG8_SCHED;
            PG8_LDA(At, 1, 1); PG8_STAGE(PG8_SB(1, 0), b3, voffB); PG8_STAGE(PG8_SB(1, 1), b3 + hstep, voffB); PG8_STAGE(PG8_SA(1, 0), a3, voffA);
            PG8_WAIT_V(8); PG8_WAIT_L(0); PG8_BAR; PG8_MMA(1, 0, At, B0); PG8_MMA(1, 1, At, B1); PG8_BAR; PG8_SCHED;
            } else {
            PG8_LDB(B0, 0, 0); PG8_SCHED; PG8_LDA(At, 0, 0); PG8_STAGE(PG8_SA(1, 1), a1 + hstep, voffA);
            PG8_WAIT_L(8); PG8_BAR; PG8_WAIT_L(0); PG8_MMA(0, 0, At, B0); PG8_BAR; PG8_SCHED;
            PG8_LDB(B1, 0, 1); PG8_STAGE(PG8_SB(0, 0), b2, voffB);
            PG8_BAR; PG8_WAIT_L(0); PG8_MMA(0, 1, At, B1); PG8_BAR;
            PG8_LDA(At, 0, 1); PG8_STAGE(PG8_SA(0, 0), a2, voffA);
            PG8_BAR; PG8_WAIT_L(0); PG8_MMA(1, 0, At, B0); PG8_BAR; PG8_SCHED;
            PG8_STAGE(PG8_SB(0, 1), b2 + hstep, voffB);
            PG8_WAIT_V(6); PG8_BAR; PG8_MMA(1, 1, At, B1); PG8_BAR;
            PG8_LDB(B0, 1, 0); PG8_SCHED; PG8_LDA(At, 1, 0); PG8_STAGE(PG8_SA(0, 1), a2 + hstep, voffA);
            PG8_WAIT_L(8); PG8_BAR; PG8_WAIT_L(0); PG8_MMA(0, 0, At, B0); PG8_BAR; PG8_SCHED;
            PG8_LDB(B1, 1, 1); PG8_STAGE(PG8_SB(1, 0), b3, voffB);
            PG8_BAR; PG8_WAIT_L(0); PG8_MMA(0, 1, At, B1); PG8_BAR;
            PG8_LDA(At, 1, 1); PG8_STAGE(PG8_SA(1, 0), a3, voffA);
            PG8_BAR; PG8_WAIT_L(0); PG8_MMA(1, 0, At, B0); PG8_BAR; PG8_SCHED;
            PG8_STAGE(PG8_SB(1, 1), b3 + hstep, voffB);
            PG8_WAIT_V(6); PG8_BAR; PG8_MMA(1, 1, At, B1); PG8_BAR;
            }
        }
        if constexpr (ALIGN_EPI) { if (wr == 0) PG8_BAR; }
        if constexpr (!Epi::AFTER_DRAIN) { E(acc, cur, wr, wc, fr, fq); S.done(cur); }
        if (!has_next) break;
#pragma unroll
        for (int a = 0; a < 2; ++a)
#pragma unroll
            for (int b = 0; b < 2; ++b)
#pragma unroll
                for (int m = 0; m < 4; ++m)
#pragma unroll
                    for (int n = 0; n < 2; ++n) acc[a][b][m][n] = (f32x4){0.f, 0.f, 0.f, 0.f};
        cur = nxt; cA = nA; cB = nB; ++ui;
        if constexpr (ALIGN_EPI) { if (wr == 1) PG8_BAR; }
    }
    PG8_WAIT_V(0);
    if constexpr (!ALIGN_EPI) { if (wr == 0) PG8_BAR; }
    PG8_BAR;
    if constexpr (Epi::AFTER_DRAIN) { E.fused(acc, cur, wr, wc, fr, fq, lds, wid, lane); S.done(cur); }
#undef PG8_SA
#undef PG8_SB
#undef PG8_STAGE
#undef PG8_LDA
#undef PG8_LDB
#undef PG8_MMA
#undef PG8_WAIT_V
#undef PG8_WAIT_L
#undef PG8_BAR
#undef PG8_SCHED
}
}
namespace mk {
typedef pg8::bf16_t bf16;
typedef pg8::f32x4 f32x4;
typedef pg8::u32x4 u32x4;
typedef pg8::bf16x8 bf16x8;
typedef pg8::Unit Unit;
typedef float f32x16 __attribute__((ext_vector_type(16)));
typedef unsigned u32x2 __attribute__((ext_vector_type(2)));
typedef float f32x2 __attribute__((ext_vector_type(2)));
#define LAS __attribute__((address_space(3)))
#define LDS_WAIT() asm volatile("s_waitcnt lgkmcnt(0)" ::: "memory")

constexpr int DM = 1024, T = 4096, NBP = 4, MP = NBP * T, DB = 128, DS = 4, MS = DB * DS, M = MP + MS, NL = 4;
constexpr int INC = 2304, DFF = 2816, K2 = 512, N2 = 1280, PLE = 256;
constexpr int C_K = 512, C_V = 640, C_RW = 768, C_XB = 1792, C_GB = 2048;

constexpr size_t SZ_WIN = (size_t)INC * DM * 2, SZ_W2 = (size_t)N2 * K2 * 2, SZ_WOUT = (size_t)DM * DM * 2, SZ_WGU = (size_t)2 * DFF * DM * 2,
                 SZ_WD = (size_t)DM * DFF * 2, SZ_WPG = (size_t)DM * DM * 2, SZ_WP = (size_t)DM * PLE * 2;
constexpr size_t O_WIN = 0, O_W2 = O_WIN + SZ_WIN, O_WOUT = O_W2 + SZ_W2, O_WGU = O_WOUT + SZ_WOUT, O_WD = O_WGU + SZ_WGU, O_WPG = O_WD + SZ_WD,
                 O_WP = O_WPG + SZ_WPG, WL = O_WP + SZ_WP;
constexpr size_t WS_W = 1u << 20, SZ_PBL = (size_t)M * PLE * 2, WS_PB = WS_W + NL * WL, SZ_ACT = (size_t)M * DM * 2, WS_HN = WS_PB + NL * SZ_PBL,
                 WS_R1 = WS_HN + SZ_ACT, SZ_R1 = (size_t)M * INC * 2, WS_R2 = WS_R1 + SZ_R1, SZ_F256 = (size_t)M * 256 * 4, WS_R3 = WS_R2 + 7 * SZ_F256,
                 WS_END = WS_R3 + 3 * SZ_F256;
static_assert(WL % 256 == 0 && SZ_R1 >= (size_t)M * DM * 4 && 7 * SZ_F256 >= (size_t)M * DFF * 2, "ws map");

constexpr size_t OUT_Y = 0, OUT_KP = (size_t)M * DM, OUT_VP = OUT_KP + (size_t)NL * NBP * 128 * 128, OUT_SHP = OUT_VP + (size_t)NL * NBP * 128 * 128,
                 OUT_WKVP = OUT_SHP + (size_t)NL * NBP * 1024, OUT_CVP = OUT_WKVP + (size_t)NL * NBP * 4 * 4096, OUT_LRP = OUT_CVP + (size_t)NL * NBP * 768,
                 OUT_KS = OUT_LRP + (size_t)NL * NBP * 256, OUT_VS = OUT_KS + (size_t)NL * DB * 128 * 128, OUT_SHS = OUT_VS + (size_t)NL * DB * 128 * 128,
                 OUT_WKVS = OUT_SHS + (size_t)NL * DB * 1024, OUT_CVS = OUT_WKVS + (size_t)NL * DB * 4 * 4096, OUT_LRS = OUT_CVS + (size_t)NL * DB * 768,
                 OUT_END = OUT_LRS + (size_t)NL * DB * 256;

enum { I_XP = 0, I_XS, I_CK, I_CV, I_SSH, I_SWKV, I_SCV, I_SLRU, I_PP, I_PS, I_NMPRE, I_NMPOST, I_NFPRE, I_NFPOST, I_WIN, I_BIN, I_SINK, I_MU, I_W0, I_WUP,
       I_A0, I_AUP, I_GUP, I_KK, I_KA, I_RK, I_LNW, I_LNB, I_CW, I_CB, I_WA, I_BA, I_WI, I_BI, I_L, I_WOUT, I_BOUT, I_WG, I_WU, I_WDN, I_PW, I_PGW, N_IN };

__device__ __forceinline__ unsigned f2bf(float f) { unsigned u = __float_as_uint(f); return (u + 0x7fffu + ((u >> 16) & 1u)) >> 16; }
__device__ __forceinline__ unsigned pk2(float lo, float hi) { return f2bf(lo) | (f2bf(hi) << 16); }
__device__ __forceinline__ float bflo(unsigned w) { return __uint_as_float(w << 16); }
__device__ __forceinline__ float bfhi(unsigned w) { return __uint_as_float(w & 0xffff0000u); }
__device__ __forceinline__ float bf1(bf16 b) { return __uint_as_float((unsigned)b << 16); }
__device__ __forceinline__ f32x4 ld_bf4(const bf16* p) { const u32x2 w = *(const u32x2*)p; return (f32x4){bflo(w.x), bfhi(w.x), bflo(w.y), bfhi(w.y)}; }
__device__ __forceinline__ void st_bf4(bf16* p, f32x4 v) { u32x2 w; w.x = pk2(v.x, v.y); w.y = pk2(v.z, v.w); *(u32x2*)p = w; }
__device__ __forceinline__ float sigm(float x) { return 1.f / (1.f + __expf(-x)); }
__device__ __forceinline__ float tanh_(float x) { return 1.f - 2.f / (__expf(2.f * x) + 1.f); }
__device__ __forceinline__ float gelu_t(float x) { return 0.5f * x * (1.f + tanh_(0.7978845608f * (x + 0.044715f * x * x * x))); }
__device__ __forceinline__ float wave_sum(float v) {
#pragma unroll
    for (int o = 1; o < 64; o <<= 1) v += __shfl_xor(v, o);
    return v;
}
template <int CTRL> __device__ __forceinline__ float dppf(float x) { return __builtin_bit_cast(float, __builtin_amdgcn_mov_dpp(__builtin_bit_cast(int, x), CTRL, 0xf, 0xf, true)); }
__device__ __forceinline__ float red16(float x) { x += dppf<0xB1>(x); x += dppf<0x4E>(x); x += dppf<0x141>(x); x += dppf<0x128>(x); return x; }
__device__ __forceinline__ float vmul(float a, float b) { float d; asm("v_mul_f32 %0, %1, %2" : "=v"(d) : "v"(a), "v"(b)); return d; }
__device__ __forceinline__ float vfma(float a, float b, float c) { float d; asm("v_fma_f32 %0, %1, %2, %3" : "=v"(d) : "v"(a), "v"(b), "v"(c)); return d; }
__device__ __forceinline__ float vfnma(float a, float b, float c) { float d; asm("v_fma_f32 %0, -%1, %2, %3" : "=v"(d) : "v"(a), "v"(b), "v"(c)); return d; }
__device__ __forceinline__ void red16x2(float& p, float& q) {
    asm volatile("v_add_f32_dpp %0, %0, %0 quad_perm:[1,0,3,2] row_mask:0xf bank_mask:0xf bound_ctrl:1\n\t"
                 "v_add_f32_dpp %1, %1, %1 quad_perm:[1,0,3,2] row_mask:0xf bank_mask:0xf bound_ctrl:1\n\ts_nop 0\n\t"
                 "v_add_f32_dpp %0, %0, %0 quad_perm:[2,3,0,1] row_mask:0xf bank_mask:0xf bound_ctrl:1\n\t"
                 "v_add_f32_dpp %1, %1, %1 quad_perm:[2,3,0,1] row_mask:0xf bank_mask:0xf bound_ctrl:1\n\ts_nop 0\n\t"
                 "v_add_f32_dpp %0, %0, %0 row_half_mirror row_mask:0xf bank_mask:0xf bound_ctrl:1\n\t"
                 "v_add_f32_dpp %1, %1, %1 row_half_mirror row_mask:0xf bank_mask:0xf bound_ctrl:1\n\ts_nop 0\n\t"
                 "v_add_f32_dpp %0, %0, %0 row_ror:8 row_mask:0xf bank_mask:0xf bound_ctrl:1\n\t"
                 "v_add_f32_dpp %1, %1, %1 row_ror:8 row_mask:0xf bank_mask:0xf bound_ctrl:1\n\ts_nop 1"
                 : "+v"(p), "+v"(q));
}
__device__ __forceinline__ float dot4(f32x4 a, f32x4 b) { return (a.x * b.x + a.y * b.y) + (a.z * b.z + a.w * b.w); }

struct EpiF32 {
    static constexpr bool PERM = false, AFTER_DRAIN = false;
    float* O; int ldc; const float* bias;
    __device__ __forceinline__ void operator()(const f32x4 (&acc)[2][2][4][2], const Unit& u, int wr, int wc, int fr, int fq) const {
        asm volatile("" : "+v"(fr), "+v"(fq));
        const int row0 = u.pm * 256 + wr * 64 + fr, col0 = u.pn * 256 + wc * 32 + 4 * fq;
        f32x4 bv[2][2];
#pragma unroll
        for (int bj = 0; bj < 2; ++bj)
#pragma unroll
            for (int n = 0; n < 2; ++n) bv[bj][n] = bias ? *(const f32x4*)(bias + col0 + bj * 128 + n * 16) : (f32x4){0.f, 0.f, 0.f, 0.f};
#pragma unroll
        for (int ai = 0; ai < 2; ++ai)
#pragma unroll
            for (int m = 0; m < 4; ++m) { float* rowp = O + (size_t)(row0 + ai * 128 + m * 16) * ldc + col0;
#pragma unroll
                for (int bj = 0; bj < 2; ++bj)
#pragma unroll
                    for (int n = 0; n < 2; ++n) *(f32x4*)(rowp + bj * 128 + n * 16) = acc[ai][bj][m][n] + bv[bj][n]; }
    }
};
struct EpiPle {
    static constexpr bool PERM = false, AFTER_DRAIN = false;
    float* X; const float* PP;
    __device__ __forceinline__ void operator()(const f32x4 (&acc)[2][2][4][2], const Unit& u, int wr, int wc, int fr, int fq) const {
        asm volatile("" : "+v"(fr), "+v"(fq));
        const int row0 = u.pm * 256 + wr * 64 + fr, col0 = u.pn * 256 + wc * 32 + 4 * fq;
#pragma unroll
        for (int ai = 0; ai < 2; ++ai)
#pragma unroll
            for (int m = 0; m < 4; ++m) { const size_t off = (size_t)(row0 + ai * 128 + m * 16) * DM + col0;
#pragma unroll
                for (int bj = 0; bj < 2; ++bj)
#pragma unroll
                    for (int n = 0; n < 2; ++n) { const size_t o = off + bj * 128 + n * 16; const f32x4 x = *(const f32x4*)(X + o), p = *(const f32x4*)(PP + o), a = acc[ai][bj][m][n];
                        *(f32x4*)(X + o) = (f32x4){x.x + sigm(a.x) * p.x, x.y + sigm(a.y) * p.y, x.z + sigm(a.z) * p.z, x.w + sigm(a.w) * p.w}; }
                asm volatile("" ::: "memory"); }
    }
};
struct EpiSwiglu {
    static constexpr bool PERM = true, AFTER_DRAIN = false;
    bf16* O;
    __device__ __forceinline__ void operator()(const f32x4 (&acc)[2][2][4][2], const Unit& u, int wr, int wc, int fr, int fq) const {
        asm volatile("" : "+v"(fr), "+v"(fq));
        const int row0 = u.pm * 256 + wr * 64 + fr, col0 = u.pn * 128 + wc * 32 + 8 * fq;
#pragma unroll
        for (int ai = 0; ai < 2; ++ai)
#pragma unroll
            for (int m = 0; m < 4; ++m) { bf16* p = O + (size_t)(row0 + ai * 128 + m * 16) * DFF + col0;
                const f32x4 g0 = acc[ai][0][m][0], g1 = acc[ai][0][m][1], u0 = acc[ai][1][m][0], u1 = acc[ai][1][m][1];
                u32x4 w; w.x = pk2(g0.x * sigm(g0.x) * u0.x, g0.y * sigm(g0.y) * u0.y); w.y = pk2(g0.z * sigm(g0.z) * u0.z, g0.w * sigm(g0.w) * u0.w);
                w.z = pk2(g1.x * sigm(g1.x) * u1.x, g1.y * sigm(g1.y) * u1.y); w.w = pk2(g1.z * sigm(g1.z) * u1.z, g1.w * sigm(g1.w) * u1.w);
                *(u32x4*)p = w; }
    }
};
struct EpiMix {
    static constexpr bool PERM = false, AFTER_DRAIN = false;
    const float *w0, *a0, *k_a, *b_a, *b_i, *Lp; float *Wd, *Ks, *KK, *BV, *G, *AL, *U; const bf16* A2;
    __device__ __forceinline__ void operator()(const f32x4 (&acc)[2][2][4][2], const Unit& u, int wr, int wc, int fr, int fq) const {
        asm volatile("" : "+v"(fr), "+v"(fq));
        const int row0 = u.pm * 256 + wr * 64 + fr;
        if (u.pn < 3) {
#pragma unroll
            for (int ai = 0; ai < 2; ++ai)
#pragma unroll
                for (int m = 0; m < 4; ++m) { const size_t ro = (size_t)(row0 + ai * 128 + m * 16) * 256;
#pragma unroll
                    for (int bj = 0; bj < 2; ++bj)
#pragma unroll
                        for (int n = 0; n < 2; ++n) { const int c = bj * 128 + wc * 32 + n * 16 + 4 * fq; const f32x4 z = acc[ai][bj][m][n];
                            if (u.pn == 0) { const f32x4 b = *(const f32x4*)(w0 + c); f32x4 d;
                                d.x = __expf(-0.60653066f * sigm(z.x + b.x)); d.y = __expf(-0.60653066f * sigm(z.y + b.y)); d.z = __expf(-0.60653066f * sigm(z.z + b.z)); d.w = __expf(-0.60653066f * sigm(z.w + b.w));
                                *(f32x4*)(Wd + ro + c) = d; }
                            else if (u.pn == 1) { const f32x4 b = *(const f32x4*)(a0 + c), ka = *(const f32x4*)(k_a + c), ks = *(const f32x4*)(Ks + ro + c), kk = *(const f32x4*)(KK + ro + c);
                                f32x4 a; a.x = sigm(z.x + b.x); a.y = sigm(z.y + b.y); a.z = sigm(z.z + b.z); a.w = sigm(z.w + b.w);
                                *(f32x4*)(Ks + ro + c) = ks * (1.f + (a - 1.f) * ka); *(f32x4*)(BV + ro + c) = kk * a; }
                            else { *(f32x4*)(G + ro + c) = z; } }
                    asm volatile("" ::: "memory"); }
        } else {
            const int t = u.pn - 3;
#pragma unroll
            for (int ai = 0; ai < 2; ++ai)
#pragma unroll
                for (int m = 0; m < 4; ++m) { const size_t r = (size_t)(row0 + ai * 128 + m * 16);
#pragma unroll
                    for (int n = 0; n < 2; ++n) { const int cc = 128 * t + wc * 32 + n * 16 + 4 * fq;
                        const f32x4 zr = acc[ai][0][m][n] + *(const f32x4*)(b_a + cc), zi = acc[ai][1][m][n] + *(const f32x4*)(b_i + cc), Lv = *(const f32x4*)(Lp + cc), xc = ld_bf4(A2 + r * K2 + 256 + cc);
                        f32x4 al, uu;
#define LRU1(e) { const float xe = __expf(-Lv.e); const float ls = -xe * (1.f + xe * (-0.5f + xe * 0.33333334f)); const float la = 8.f * sigm(zr.e) * ls; al.e = __expf(la); const float z2 = 2.f * la; \
    const float om = -z2 * (1.f + z2 * (0.5f + z2 * (0.16666667f + z2 * (0.041666668f + z2 * 0.0083333338f)))); uu.e = sqrtf(om) * sigm(zi.e) * xc.e; }
                        LRU1(x) LRU1(y) LRU1(z) LRU1(w)
#undef LRU1
                        *(f32x4*)(AL + r * 256 + cc) = al; *(f32x4*)(U + r * 256 + cc) = uu; }
                    asm volatile("" ::: "memory"); }
        }
    }
};
#define RLX_AGENT __ATOMIC_RELAXED, __HIP_MEMORY_SCOPE_AGENT
#define XB_TMO      128
#define XB_XCNT(j)  (256  + 64 * (j))
#define XB_XSUB(j)  (1280 + 64 * (j))
#define XB_XGEN(j)  (2304 + 64 * (j))
#define XB_TOP      3328
#define XB_TOPGEN   3392
#define XCD_BAR_WORDS 3456
#define XB_SPIN_CAP (1u << 18)

__device__ __forceinline__ unsigned xb_ld(unsigned* p)              { return __hip_atomic_load(p, __ATOMIC_RELAXED, __HIP_MEMORY_SCOPE_AGENT); }
__device__ __forceinline__ unsigned xb_add(unsigned* p, unsigned v) { return __hip_atomic_fetch_add(p, v, __ATOMIC_RELAXED, __HIP_MEMORY_SCOPE_AGENT); }
__device__ __forceinline__ unsigned xb_xcc_id() { return (unsigned)__builtin_amdgcn_s_getreg((3 << 11) | 20) & 0xFu; }
#define XB_SPIN(cond, bar) do { unsigned _sp = 0; while (cond) { __builtin_amdgcn_s_sleep(1); \
    if ((++_sp & 255u) == 0u) { if (xb_ld(&(bar)[XB_TMO])) break; if (_sp > XB_SPIN_CAP) { atomicAdd(&(bar)[XB_TMO], 1u); break; } } } } while (0)

struct XcdBarrier {
    unsigned* bar; unsigned x;
    volatile LAS unsigned* st;
};

__device__ __forceinline__ XcdBarrier xcd_barrier_post(unsigned* bar, volatile LAS unsigned* st, int tid) {
    XcdBarrier b; b.bar = bar; b.x = xb_xcc_id(); b.st = st;
    if (tid == 0) (void)xb_add(&bar[XB_XCNT(b.x)], 1u);
    return b;
}
__device__ __forceinline__ void xcd_barrier_complete(unsigned* bar, unsigned x, unsigned& nloc, unsigned& nx) {
    const unsigned G = gridDim.x * gridDim.y * gridDim.z;
    unsigned sum, cnt, mine, sp = 0u;
    for (;;) {
        sum = 0u; cnt = 0u; mine = 0u;
#pragma unroll
        for (unsigned j = 0; j < 16; ++j) { const unsigned c = xb_ld(&bar[XB_XCNT(j)]); sum += c; cnt += (c > 0u) ? 1u : 0u; mine = (j == x) ? c : mine; }
        if (sum == G) break;
        __builtin_amdgcn_s_sleep(1);
        if ((++sp & 255u) == 0u) { if (xb_ld(&bar[XB_TMO])) break; if (sp > XB_SPIN_CAP) { atomicAdd(&bar[XB_TMO], 1u); break; } }
    }
    nloc = mine > 0u ? mine : 1u; nx = cnt > 0u ? cnt : 1u;
}

__device__ __forceinline__ void xcd_barrier(const XcdBarrier& b, int tid) {
    asm volatile("s_waitcnt vmcnt(0)" ::: "memory");
    __syncthreads();
    if (tid == 0) {
        unsigned* bar = b.bar;
        __builtin_amdgcn_s_waitcnt(0);
        unsigned nloc = b.st[0], nx = b.st[1];
        if (nloc == 0u) { xcd_barrier_complete(bar, b.x, nloc, nx); b.st[0] = nloc; b.st[1] = nx; }
        const unsigned old = xb_add(&bar[XB_XSUB(b.x)], 1u);
        const unsigned gen = old / nloc;
        if (old + 1u == (gen + 1u) * nloc) {
            __builtin_amdgcn_fence(__ATOMIC_RELEASE, "agent");
            asm volatile("s_waitcnt vmcnt(0)" ::: "memory");
            const unsigned og = xb_add(&bar[XB_TOP], 1u);
            const unsigned tg = og / nx;
            if (og + 1u == (tg + 1u) * nx) xb_add(&bar[XB_TOPGEN], 1u);
            else XB_SPIN(xb_ld(&bar[XB_TOPGEN]) == tg, bar);
            __builtin_amdgcn_fence(__ATOMIC_ACQUIRE, "agent");
            xb_add(&bar[XB_XGEN(b.x)], 1u);
            asm volatile("s_waitcnt vmcnt(0)" ::: "memory");
        } else {
            XB_SPIN(xb_ld(&bar[XB_XGEN(b.x)]) == gen, bar);
            __builtin_amdgcn_fence(__ATOMIC_ACQUIRE, "agent");
            asm volatile("s_waitcnt vmcnt(0)" ::: "memory");
        }
    }
    __syncthreads();
}
struct Args { const float* in[N_IN]; float* out; unsigned char* ws; };
struct Ctx {
    LAS unsigned char* lds; unsigned char* ws; float* out;
    int tid, lane, wave, bid, G, gw, NGW;
};
__device__ __forceinline__ const float* inp_ld(int k) {
    asm volatile("" : "+s"(k));
    const __attribute__((address_space(4))) unsigned long long* tab = (const __attribute__((address_space(4))) unsigned long long*)__builtin_amdgcn_kernarg_segment_ptr();
    return (const float*)tab[k];
}
#define INP(k) inp_ld(k)

__device__ __forceinline__ void tr_item(const float* W, int ldw, bf16* WT, int ldt, int k0, int n0, int drow, int dcol, LAS float* scr, int lane) {
#pragma unroll 8
    for (int i = 0; i < 32; ++i) { const int kk = 2 * i + (lane >> 5); scr[kk * 33 + (lane & 31)] = W[(size_t)(k0 + kk) * ldw + n0 + (lane & 31)]; }
    LDS_WAIT(); asm volatile("" ::: "memory");
    const int c = lane & 7;
#pragma unroll
    for (int j = 0; j < 4; ++j) { const int n = (lane >> 3) + 8 * j; const LAS float* s = scr + (8 * c) * 33 + n;
        u32x4 o; o.x = pk2(s[0 * 33], s[1 * 33]); o.y = pk2(s[2 * 33], s[3 * 33]); o.z = pk2(s[4 * 33], s[5 * 33]); o.w = pk2(s[6 * 33], s[7 * 33]);
        *(u32x4*)(WT + (size_t)(drow + n) * ldt + dcol + 8 * c) = o; }
    LDS_WAIT(); asm volatile("" ::: "memory");
}
__device__ __forceinline__ void row_norm(const float* xrow, const float* g, bf16* orow, float* xcopy, int lane) {
    f32x4 v[4]; float ss = 0.f;
#pragma unroll
    for (int j = 0; j < 4; ++j) { v[j] = *(const f32x4*)(xrow + 4 * lane + 256 * j); ss += dot4(v[j], v[j]); }
    const float rs = rsqrtf(wave_sum(ss) * (1.f / DM) + 1e-6f);
#pragma unroll
    for (int j = 0; j < 4; ++j) { const f32x4 gg = *(const f32x4*)(g + 4 * lane + 256 * j); if (xcopy) *(f32x4*)(xcopy + 4 * lane + 256 * j) = v[j]; st_bf4(orow + 4 * lane + 256 * j, v[j] * rs * gg); }
}
__device__ __forceinline__ void row_update(const float* add, const float* gA, float* X, const float* gB, bf16* outB, int lane) {
    f32x4 a[4], x[4]; float ss = 0.f;
#pragma unroll
    for (int j = 0; j < 4; ++j) { a[j] = *(const f32x4*)(add + 4 * lane + 256 * j); x[j] = *(const f32x4*)(X + 4 * lane + 256 * j); ss += dot4(a[j], a[j]); }
    const float rs = rsqrtf(wave_sum(ss) * (1.f / DM) + 1e-6f); float s2 = 0.f;
#pragma unroll
    for (int j = 0; j < 4; ++j) { const f32x4 gg = *(const f32x4*)(gA + 4 * lane + 256 * j); x[j] = x[j] + a[j] * rs * gg; *(f32x4*)(X + 4 * lane + 256 * j) = x[j]; s2 += dot4(x[j], x[j]); }
    float r2 = 1.f;
    if (gB) r2 = rsqrtf(wave_sum(s2) * (1.f / DM) + 1e-6f);
#pragma unroll
    for (int j = 0; j < 4; ++j) { f32x4 o = x[j]; if (gB) o = o * r2 * *(const f32x4*)(gB + 4 * lane + 256 * j); st_bf4(outB + 4 * lane + 256 * j, o); }
}

__device__ __forceinline__ void convert_layer(const Ctx& C, const Args& A, int l, int gw0, int ngw, int gt, int NT) {
    LAS float* scr = (LAS float*)(C.lds + C.wave * 16384);
    constexpr int J0 = 16 * 72, J1 = 16 * 32, J2 = 16 * 88, J4 = 44 * 32, J5 = 16 * 32, J6 = 4 * 32, JL = J0 + J1 + 2 * J2 + J4 + J5 + J6;
    unsigned char* wl = C.ws + WS_W + (size_t)l * WL;
    for (int it = gw0; it < JL; it += ngw) {
        int r = it;
        const float* W; int ldw, ldt, kb, nb, drow; bf16* WT;
        if (r < J0) { W = INP(I_WIN) + (size_t)l * DM * INC; ldw = INC; WT = (bf16*)(wl + O_WIN); ldt = DM; kb = r / 72; nb = r % 72; drow = 32 * nb; }
        else if ((r -= J0) < J1) { W = INP(I_WOUT) + (size_t)l * DM * DM; ldw = DM; WT = (bf16*)(wl + O_WOUT); ldt = DM; kb = r / 32; nb = r % 32; drow = 32 * nb; }
        else if ((r -= J1) < J2) { W = INP(I_WG) + (size_t)l * DM * DFF; ldw = DFF; WT = (bf16*)(wl + O_WGU); ldt = DM; kb = r / 88; nb = r % 88; drow = (nb >> 2) * 256 + (nb & 3) * 32; }
        else if ((r -= J2) < J2) { W = INP(I_WU) + (size_t)l * DM * DFF; ldw = DFF; WT = (bf16*)(wl + O_WGU); ldt = DM; kb = r / 88; nb = r % 88; drow = (nb >> 2) * 256 + 128 + (nb & 3) * 32; }
        else if ((r -= J2) < J4) { W = INP(I_WDN) + (size_t)l * DFF * DM; ldw = DM; WT = (bf16*)(wl + O_WD); ldt = DFF; kb = r / 32; nb = r % 32; drow = 32 * nb; }
        else if ((r -= J4) < J5) { W = INP(I_PGW) + (size_t)l * DM * DM; ldw = DM; WT = (bf16*)(wl + O_WPG); ldt = DM; kb = r / 32; nb = r % 32; drow = 32 * nb; }
        else { r -= J5; W = INP(I_PW) + (size_t)l * PLE * DM; ldw = DM; WT = (bf16*)(wl + O_WP); ldt = PLE; kb = r / 32; nb = r % 32; drow = 32 * nb; }
        tr_item(W, ldw, WT, ldt, 64 * kb, 32 * nb, drow, 64 * kb, scr, C.lane);
    }
    for (int r = gt; r < N2 * K2; r += NT) {
        const int n = r / K2, k = r % K2; float v = 0.f;
        if (n < 256) { if (k < 64) v = INP(I_WUP)[((size_t)l * 64 + k) * 256 + n]; }
        else if (n < 512) { if (k >= 64 && k < 128) v = INP(I_AUP)[((size_t)l * 64 + (k - 64)) * 256 + (n - 256)]; }
        else if (n < 768) { if (k >= 128 && k < 256) v = INP(I_GUP)[((size_t)l * 128 + (k - 128)) * 256 + (n - 512)]; }
        else { const int tt = (n - 768) >> 8, rr = (n - 768) & 255, cc = 128 * tt + (rr & 127), h = cc >> 6, j = cc & 63;
            if (k >= 256 && ((k - 256) >> 6) == h) v = ((rr >> 7) ? INP(I_WI) : INP(I_WA))[(((size_t)l * 4 + h) * 64 + ((k - 256) & 63)) * 64 + j]; }
        ((bf16*)(wl + O_W2))[r] = (bf16)f2bf(v);
    }
    for (int r = gt; r < M * (PLE / 4); r += NT) {
        const int m = r >> 6, c4 = (r & 63) * 4;
        const float* src = m < MP ? INP(I_PP) + ((size_t)l * MP + m) * PLE + c4 : INP(I_PS) + ((size_t)l * MS + (m - MP)) * PLE + c4;
        st_bf4((bf16*)(C.ws + WS_PB + (size_t)l * SZ_PBL) + (size_t)m * PLE + c4, *(const f32x4*)src);
    }
}
__device__ __forceinline__ void p0_prologue(const Ctx& C, const Args& A) {
    convert_layer(C, A, 0, C.gw, C.NGW, C.bid * 512 + C.tid, C.G * 512);
    for (int m = C.gw; m < M; m += C.NGW) {
        const float* src = m < MP ? INP(I_XP) + (size_t)m * DM : INP(I_XS) + (size_t)(m - MP) * DM;
        row_norm(src, INP(I_NMPRE), (bf16*)(C.ws + WS_HN) + (size_t)m * DM, C.out + (size_t)m * DM, C.lane);
    }
}

__device__ __forceinline__ void e1_prep(const Ctx& C, const Args& A, int l) {
    const bf16* PROJ = (const bf16*)(C.ws + WS_R1);
    float* R = (float*)(C.ws + WS_R2); float* Ks = R + (size_t)M * 256; float* V = Ks + (size_t)M * 256; float* KK = V + (size_t)M * 256;
    bf16* A2 = (bf16*)(C.ws + WS_R3);
    const int lane = C.lane, c4 = 4 * lane;
    for (int m = C.gw; m < M; m += C.NGW) {
        const bool samp = m >= MP; int b, t;
        if (!samp) { b = m >> 12; t = m & 4095; } else { b = (m - MP) >> 2; t = (m - MP) & 3; }
        const bf16* pr = PROJ + (size_t)m * INC;
#pragma unroll
        for (int cg = 0; cg < 4; ++cg) {
            const int col = 256 * cg + c4;
            const f32x4 cur = ld_bf4(pr + C_RW + col); f32x4 prv = (f32x4){0.f, 0.f, 0.f, 0.f};
            if (t > 0) prv = ld_bf4(pr - INC + C_RW + col);
            else if (samp) prv = *(const f32x4*)(INP(I_SSH) + ((size_t)l * DB + b) * 1024 + col);
            const f32x4 mu = *(const f32x4*)(INP(I_MU) + l * 1024 + col);
            const f32x4 xs = cur + (prv - cur) * mu;
            if (cg == 0) *(f32x4*)(R + (size_t)m * 256 + c4) = xs;
            else if (cg == 1) { *(f32x4*)(Ks + (size_t)m * 256 + c4) = xs; f32x4 kk = xs * *(const f32x4*)(INP(I_KK) + l * 256 + c4);
                const float ss = red16(dot4(kk, kk)); kk = kk * rsqrtf(fmaxf(ss, 1e-24f)); *(f32x4*)(KK + (size_t)m * 256 + c4) = kk; }
            else if (cg == 2) *(f32x4*)(V + (size_t)m * 256 + c4) = xs;
            else { f32x4 o;
                if (lane < 16) o = (f32x4){tanh_(xs.x), tanh_(xs.y), tanh_(xs.z), tanh_(xs.w)};
                else if (lane < 32) o = xs;
                else o = (f32x4){sigm(xs.x), sigm(xs.y), sigm(xs.z), sigm(xs.w)};
                st_bf4(A2 + (size_t)m * K2 + c4, o); }
        }
        f32x4 xc = *(const f32x4*)(INP(I_CB) + l * 256 + c4);
#pragma unroll
        for (int j = 0; j < 4; ++j) { const int tt = t - 3 + j; f32x4 val = (f32x4){0.f, 0.f, 0.f, 0.f};
            if (tt >= 0) val = ld_bf4(pr + (ptrdiff_t)(j - 3) * INC + C_XB + c4);
            else if (samp) val = *(const f32x4*)(INP(I_SCV) + (((size_t)l * DB + b) * 3 + (tt + 3)) * 256 + c4);
            xc = xc + val * *(const f32x4*)(INP(I_CW) + ((size_t)l * 4 + j) * 256 + c4); }
        st_bf4(A2 + (size_t)m * K2 + 256 + c4, xc);
    }
    const int gt = C.bid * 512 + C.tid, NT = C.G * 512;
    float* out = C.out;
    for (int e = gt; e < 2 * NBP * 128 * 128; e += NT) {
        const int kv = e / (NBP * 16384), r = e % (NBP * 16384), b = r >> 14, rr = (r >> 7) & 127, c = r & 127;
        out[(kv ? OUT_VP : OUT_KP) + (size_t)l * NBP * 16384 + r] = bf1(PROJ[(size_t)(b * T + T - 128 + rr) * INC + (kv ? C_V : C_K) + c]);
    }
    for (int e = gt; e < NBP * 1024; e += NT) { const int b = e >> 10, c = e & 1023; out[OUT_SHP + (size_t)l * NBP * 1024 + e] = bf1(PROJ[(size_t)(b * T + T - 1) * INC + C_RW + c]); }
    for (int e = gt; e < DB * 1024; e += NT) { const int b = e >> 10, c = e & 1023; out[OUT_SHS + (size_t)l * DB * 1024 + e] = bf1(PROJ[(size_t)(MP + 4 * b + 3) * INC + C_RW + c]); }
    for (int e = gt; e < NBP * 768; e += NT) { const int b = e / 768, j = (e % 768) >> 8, c = e & 255; out[OUT_CVP + (size_t)l * NBP * 768 + e] = bf1(PROJ[(size_t)(b * T + T - 3 + j) * INC + C_XB + c]); }
    for (int e = gt; e < DB * 768; e += NT) { const int b = e / 768, j = (e % 768) >> 8, c = e & 255; out[OUT_CVS + (size_t)l * DB * 768 + e] = bf1(PROJ[(size_t)(MP + 4 * b + 1 + j) * INC + C_XB + c]); }
}

struct RwkvPtrs { const float *R, *K, *V, *KK, *BV, *W; float* YR; };
__device__ __forceinline__ void rwkv_step(f32x4& s, const f32x4 w, const f32x4 kk, const f32x4 bv, const f32x4 k2, const f32x4 r, const float v, float& y) {
    const float sa = red16(dot4(s, kk));
    s = s * w + (k2 * v - bv * sa);
    y = red16(dot4(s, r));
}
__device__ __forceinline__ void rwkv_prompt(const Ctx& C, const RwkvPtrs& P, int wg, float* wkv_out  ) {
    constexpr int TC = 32, VEC = TC * 64 * 4, O_V = 5 * VEC, O_CC = O_V + TC * 16 * 4, BUF = O_CC + TC * 8, O_Y = 2 * BUF, O_DUMP = O_Y + 2 * TC * 64;
    const int chain = wg >> 2, b = chain >> 2, h = chain & 3, qr = wg & 3, tid = C.tid, lane = C.lane, wave = C.wave;
    const size_t m0 = (size_t)b * T;
    const int lstep = tid >> 4, lq = tid & 15;
    const int vstep = tid >> 2, vq = tid & 3;
    f32x4 st[5], stv; float c1 = 0.f, c2 = 0.f;
    f32x4 s = (f32x4){0.f, 0.f, 0.f, 0.f};
    const int row = 16 * qr + 4 * wave + (lane >> 4), cq = lane & 15;
#define RW_LOAD(c) do { const size_t o_ = (m0 + (size_t)(c) * TC + lstep) * 256 + h * 64 + 4 * lq; \
        st[0] = *(const f32x4*)(P.W + o_); st[1] = *(const f32x4*)(P.KK + o_); st[2] = *(const f32x4*)(P.BV + o_); st[3] = *(const f32x4*)(P.K + o_); st[4] = *(const f32x4*)(P.R + o_); \
        if (tid < 128) stv = *(const f32x4*)(P.V + (m0 + (size_t)(c) * TC + vstep) * 256 + h * 64 + 16 * qr + 4 * vq); } while (0)
#define RW_STORE(bufi) do { LAS unsigned char* bb = C.lds + (bufi) * BUF; c1 = red16(dot4(st[3], st[4])); c2 = red16(dot4(st[2], st[4])); st[4] = st[4] * st[0]; \
        _Pragma("unroll") for (int i = 0; i < 5; ++i) *(LAS f32x4*)(bb + i * VEC + (lstep * 64 + 4 * lq) * 4) = st[i]; \
        if (lq == 0) { *(LAS float*)(bb + O_CC + lstep * 8) = c1; *(LAS float*)(bb + O_CC + lstep * 8 + 4) = c2; } \
        if (tid < 128) *(LAS f32x4*)(bb + O_V + (vstep * 16 + 4 * vq) * 4) = stv; } while (0)
    RW_LOAD(0); RW_STORE(0); __syncthreads();
    for (int c = 0; c < T / TC; ++c) {
        if (c > 0) P.YR[(m0 + (size_t)(c - 1) * TC + lstep) * 256 + h * 64 + 16 * qr + lq] = *(const LAS float*)(C.lds + O_Y + ((c - 1) & 1) * (TC * 64) + (lstep * 16 + lq) * 4);
        if (c + 1 < T / TC) RW_LOAD(c + 1);
        if (wave < 4) {
            const LAS unsigned char* bb = C.lds + (c & 1) * BUF; LAS float* yb = (LAS float*)(C.lds + O_Y + (c & 1) * (TC * 64));
            const int vo = O_V + (4 * wave + (lane >> 4)) * 4, lo = 16 * cq;
            LAS unsigned char* ya = (cq == 0) ? (LAS unsigned char*)(yb + 4 * wave + (lane >> 4)) : (C.lds + O_DUMP + C.tid * 4);
            f32x4 w = *(const LAS f32x4*)(bb + 0 * VEC + lo), kk = *(const LAS f32x4*)(bb + 1 * VEC + lo), bv = *(const LAS f32x4*)(bb + 2 * VEC + lo),
                  k2 = *(const LAS f32x4*)(bb + 3 * VEC + lo), wr = *(const LAS f32x4*)(bb + 4 * VEC + lo);
            float v = *(const LAS float*)(bb + vo), a1 = *(const LAS float*)(bb + O_CC), a2 = *(const LAS float*)(bb + O_CC + 4);
            float yprev = 0.f;
#pragma unroll 8
            for (int i = 0; i < TC; ++i) {
                float sa, qs, t0, t1, t2, t3, y;
                asm volatile("v_mul_f32 %0, %2, %6\n\tv_mul_f32 %1, %2, %10\n\tv_fma_f32 %0, %3, %7, %0\n\tv_fma_f32 %1, %3, %11, %1\n\t"
                             "v_fma_f32 %0, %4, %8, %0\n\tv_fma_f32 %1, %4, %12, %1\n\tv_fma_f32 %0, %5, %9, %0\n\tv_fma_f32 %1, %5, %13, %1"
                             : "=&v"(sa), "=&v"(qs)
                             : "v"(s.x), "v"(s.y), "v"(s.z), "v"(s.w), "v"(kk.x), "v"(kk.y), "v"(kk.z), "v"(kk.w), "v"(wr.x), "v"(wr.y), "v"(wr.z), "v"(wr.w));
                __builtin_amdgcn_sched_barrier(0);
                if (i > 0) *(LAS float*)(ya + (i - 1) * 64) = yprev;
                const int in = (i + 1 < TC) ? i + 1 : i;
                const f32x4 nw = *(const LAS f32x4*)(bb + 0 * VEC + in * 256 + lo), nkk = *(const LAS f32x4*)(bb + 1 * VEC + in * 256 + lo), nbv = *(const LAS f32x4*)(bb + 2 * VEC + in * 256 + lo),
                            nk2 = *(const LAS f32x4*)(bb + 3 * VEC + in * 256 + lo), nwr = *(const LAS f32x4*)(bb + 4 * VEC + in * 256 + lo);
                const float nv = *(const LAS float*)(bb + vo + in * 64), na1 = *(const LAS float*)(bb + O_CC + in * 8), na2 = *(const LAS float*)(bb + O_CC + in * 8 + 4);
                __builtin_amdgcn_sched_barrier(0);
                asm volatile("v_mul_f32 %2, %6, %10\n\tv_mul_f32 %3, %7, %10\n\t"
                             "v_add_f32_dpp %0, %0, %0 quad_perm:[1,0,3,2] row_mask:0xf bank_mask:0xf bound_ctrl:1\n\tv_add_f32_dpp %1, %1, %1 quad_perm:[1,0,3,2] row_mask:0xf bank_mask:0xf bound_ctrl:1\n\t"
                             "v_mul_f32 %4, %8, %10\n\t"
                             "v_add_f32_dpp %0, %0, %0 quad_perm:[2,3,0,1] row_mask:0xf bank_mask:0xf bound_ctrl:1\n\tv_add_f32_dpp %1, %1, %1 quad_perm:[2,3,0,1] row_mask:0xf bank_mask:0xf bound_ctrl:1\n\t"
                             "v_mul_f32 %5, %9, %10\n\t"
                             "v_add_f32_dpp %0, %0, %0 row_half_mirror row_mask:0xf bank_mask:0xf bound_ctrl:1\n\tv_add_f32_dpp %1, %1, %1 row_half_mirror row_mask:0xf bank_mask:0xf bound_ctrl:1\n\t"
                             "s_nop 0\n\t"
                             "v_add_f32_dpp %0, %0, %0 row_ror:8 row_mask:0xf bank_mask:0xf bound_ctrl:1\n\tv_add_f32_dpp %1, %1, %1 row_ror:8 row_mask:0xf bank_mask:0xf bound_ctrl:1"
                             : "+v"(sa), "+v"(qs), "=&v"(t0), "=&v"(t1), "=&v"(t2), "=&v"(t3)
                             : "v"(k2.x), "v"(k2.y), "v"(k2.z), "v"(k2.w), "v"(v));
                asm volatile("v_fma_f32 %5, -%9, %14, %5\n\tv_fma_f32 %6, -%9, %15, %6\n\tv_fma_f32 %7, -%9, %16, %7\n\tv_fma_f32 %8, -%9, %17, %8\n\t"
                             "v_fma_f32 %0, %11, %12, %10\n\t"
                             "v_fma_f32 %1, %1, %18, %5\n\tv_fma_f32 %2, %2, %19, %6\n\tv_fma_f32 %3, %3, %20, %7\n\tv_fma_f32 %4, %4, %21, %8\n\t"
                             "v_fma_f32 %0, -%9, %13, %0"
                             : "=&v"(y), "+v"(s.x), "+v"(s.y), "+v"(s.z), "+v"(s.w), "+v"(t0), "+v"(t1), "+v"(t2), "+v"(t3)
                             : "v"(sa), "v"(qs), "v"(v), "v"(a1), "v"(a2), "v"(bv.x), "v"(bv.y), "v"(bv.z), "v"(bv.w), "v"(w.x), "v"(w.y), "v"(w.z), "v"(w.w));
                __builtin_amdgcn_sched_barrier(0);
                yprev = y;
                w = nw; kk = nkk; bv = nbv; k2 = nk2; wr = nwr; v = nv; a1 = na1; a2 = na2;
            }
            *(LAS float*)(ya + (TC - 1) * 64) = yprev;
        }
        if (c + 1 < T / TC) RW_STORE((c + 1) & 1);
        __syncthreads();
    }
    P.YR[(m0 + (size_t)(T / TC - 1) * TC + lstep) * 256 + h * 64 + 16 * qr + lq] = *(const LAS float*)(C.lds + O_Y + ((T / TC - 1) & 1) * (TC * 64) + (lstep * 16 + lq) * 4);
#undef RW_LOAD
#undef RW_STORE
    if (wave < 4) *(f32x4*)(wkv_out + (((size_t)b * 4 + h) * 64 + row) * 64 + 4 * cq) = s;
    __syncthreads();
}
__device__ __forceinline__ void rwkv_sample_item(const RwkvPtrs& P, int item, const float* wkv_in, float* wkv_out, int lane) {
    const int rg = item & 15, h = (item >> 4) & 3, b = item >> 6, row = 4 * rg + (lane >> 4), cq = lane & 15;
    const size_t so = (((size_t)b * 4 + h) * 64 + row) * 64 + 4 * cq;
    f32x4 s = *(const f32x4*)(wkv_in + so);
#pragma unroll
    for (int i = 0; i < DS; ++i) { const size_t m = (size_t)MP + 4 * b + i, o = m * 256 + h * 64 + 4 * cq;
        float y; rwkv_step(s, *(const f32x4*)(P.W + o), *(const f32x4*)(P.KK + o), *(const f32x4*)(P.BV + o), *(const f32x4*)(P.K + o), *(const f32x4*)(P.R + o), P.V[m * 256 + h * 64 + row], y);
        if (cq == 0) P.YR[m * 256 + h * 64 + row] = y; }
    *(f32x4*)(wkv_out + so) = s;
}
__device__ __forceinline__ void lru_prompt_item(const Ctx& C, int item, const float* AL, const float* U, const bf16* PROJ, bf16* MIXCAT, float* lru_out  ) {
    const int b = item >> 4, c = (item & 15) * 16 + (C.tid & 15), seg = C.tid >> 4; constexpr int SL = T / 32;
    const size_t m0 = (size_t)b * T + (size_t)seg * SL;
    LAS float* sA = (LAS float*)C.lds; LAS float* sH = sA + 512;
    float Ap = 1.f, H = 0.f;
#pragma unroll 8
    for (int i = 0; i < SL; ++i) { const float a = AL[(m0 + i) * 256 + c], u = U[(m0 + i) * 256 + c]; H = a * H + u; Ap *= a; }
    sA[C.tid] = Ap; sH[C.tid] = H;
    __syncthreads();
    float h = 0.f;
    for (int sp = 0; sp < seg; ++sp) h = sA[sp * 16 + (C.tid & 15)] * h + sH[sp * 16 + (C.tid & 15)];
#pragma unroll 8
    for (int i = 0; i < SL; ++i) { const float a = AL[(m0 + i) * 256 + c], u = U[(m0 + i) * 256 + c]; h = a * h + u;
        const float gb = bf1(PROJ[(m0 + i) * INC + C_GB + c]); MIXCAT[(m0 + i) * DM + 768 + c] = (bf16)f2bf(h * gelu_t(gb)); }
    if (seg == 31) lru_out[b * 256 + c] = h;
    __syncthreads();
}
__device__ __forceinline__ void swa_prompt_item(const Ctx& C, int item, const bf16* PROJ, bf16* MIXCAT, const float* sinks  ) {
    constexpr int KP = 72, VP = 264;
    const int kvh = item & 1, n = (item >> 1) & 31, b = item >> 6, tid = C.tid, lane = C.lane, wave = C.wave;
    LAS bf16* Ks = (LAS bf16*)C.lds; LAS bf16* Vt = Ks + 256 * KP;
    const size_t rowq0 = (size_t)b * T + (size_t)n * 128;
    { const int key = tid >> 1, hf = tid & 1; size_t kr = rowq0 + key; kr = (kr >= 128 + (size_t)b * T) ? kr - 128 : kr;
        const bf16* kp = PROJ + kr * INC + C_K + kvh * 64 + hf * 32;
#pragma unroll
        for (int i = 0; i < 4; ++i) *(LAS u32x4*)(Ks + key * KP + hf * 32 + 8 * i) = *(const u32x4*)(kp + 8 * i);
#pragma unroll
        for (int i = 0; i < 4; ++i) { const int ch = tid + 512 * i, vk = ch >> 3, d0 = (ch & 7) * 8; size_t vr = rowq0 + vk; vr = (vr >= 128 + (size_t)b * T) ? vr - 128 : vr;
            const u32x4 w = *(const u32x4*)(PROJ + vr * INC + C_V + kvh * 64 + d0);
            Vt[(d0 + 0) * VP + vk] = (bf16)(w.x & 0xffff); Vt[(d0 + 1) * VP + vk] = (bf16)(w.x >> 16); Vt[(d0 + 2) * VP + vk] = (bf16)(w.y & 0xffff); Vt[(d0 + 3) * VP + vk] = (bf16)(w.y >> 16);
            Vt[(d0 + 4) * VP + vk] = (bf16)(w.z & 0xffff); Vt[(d0 + 5) * VP + vk] = (bf16)(w.z >> 16); Vt[(d0 + 6) * VP + vk] = (bf16)(w.w & 0xffff); Vt[(d0 + 7) * VP + vk] = (bf16)(w.w >> 16); } }
    __syncthreads();
    const int q = lane & 31, hi = lane >> 5;
#pragma unroll 1
    for (int qi = 0; qi < 2; ++qi) {
        const int qt = wave * 2 + qi, g = qt >> 2, j = qt & 3, hh = kvh * 4 + g;
        const size_t qrow = rowq0 + 32 * j + q;
        bf16x8 qf[4];
#pragma unroll
        for (int dk = 0; dk < 4; ++dk) qf[dk] = *(const bf16x8*)(PROJ + qrow * INC + hh * 64 + 16 * dk + 8 * hi);
        f32x16 sc[5];
#pragma unroll
        for (int kt = 0; kt < 5; ++kt) {
            f32x16 acc;
#pragma unroll
            for (int i = 0; i < 16; ++i) acc[i] = 0.f;
#pragma unroll
            for (int dk = 0; dk < 4; ++dk) { const bf16x8 kf = *(const LAS bf16x8*)(Ks + (32 * (j + kt) + q) * KP + 16 * dk + 8 * hi); acc = __builtin_amdgcn_mfma_f32_32x32x16_bf16(kf, qf[dk], acc, 0, 0, 0); }
            sc[kt] = acc;
        }
        const int qpos = 128 + 32 * j + q; float mx = -INFINITY;
#pragma unroll
        for (int kt = 0; kt < 5; ++kt)
#pragma unroll
            for (int i = 0; i < 16; ++i) { const int kj = 32 * (j + kt) + (i & 3) + 8 * (i >> 2) + 4 * hi, d = qpos - kj; const bool ok = d >= 0 && d <= 128 && (n > 0 || kj >= 128);
                const float sv = ok ? sc[kt][i] * 0.125f : -INFINITY; sc[kt][i] = sv; mx = fmaxf(mx, sv); }
        mx = fmaxf(mx, __shfl_xor(mx, 32)); const float sink = sinks[hh]; mx = fmaxf(mx, sink);
        float sum = 0.f;
#pragma unroll
        for (int kt = 0; kt < 5; ++kt)
#pragma unroll
            for (int i = 0; i < 16; ++i) { const float e = __expf(sc[kt][i] - mx); sc[kt][i] = e; sum += e; }
        sum += __shfl_xor(sum, 32);
        const float inv = 1.f / (sum + __expf(sink - mx));
#pragma unroll
        for (int dt = 0; dt < 2; ++dt) {
            f32x16 o;
#pragma unroll
            for (int i = 0; i < 16; ++i) o[i] = 0.f;
#pragma unroll
            for (int kt = 0; kt < 5; ++kt)
#pragma unroll
                for (int s2 = 0; s2 < 2; ++s2) {
                    u32x4 pw; pw.x = pk2(sc[kt][8 * s2 + 0], sc[kt][8 * s2 + 1]); pw.y = pk2(sc[kt][8 * s2 + 2], sc[kt][8 * s2 + 3]); pw.z = pk2(sc[kt][8 * s2 + 4], sc[kt][8 * s2 + 5]); pw.w = pk2(sc[kt][8 * s2 + 6], sc[kt][8 * s2 + 7]);
                    const LAS bf16* vp = Vt + (32 * dt + q) * VP + 32 * (j + kt) + 16 * s2 + 4 * hi;
                    const u32x2 v0 = *(const LAS u32x2*)vp, v1 = *(const LAS u32x2*)(vp + 8);
                    u32x4 vw; vw.x = v0.x; vw.y = v0.y; vw.z = v1.x; vw.w = v1.y;
                    o = __builtin_amdgcn_mfma_f32_32x32x16_bf16(__builtin_bit_cast(bf16x8, vw), __builtin_bit_cast(bf16x8, pw), o, 0, 0, 0);
                }
#pragma unroll
            for (int g4 = 0; g4 < 4; ++g4) st_bf4(MIXCAT + qrow * DM + hh * 64 + 32 * dt + 8 * g4 + 4 * hi, (f32x4){o[4 * g4] * inv, o[4 * g4 + 1] * inv, o[4 * g4 + 2] * inv, o[4 * g4 + 3] * inv});
        }
    }
    __syncthreads();
}
__device__ __forceinline__ void swa_sample_item(const Ctx& C, int item, const bf16* PROJ, bf16* MIXCAT, const float* sinks, const float* ck, const float* cv, float* ko, float* vo) {
    const int kvh = item & 1, b = item >> 1, tid = C.tid;
    LAS float* Kf = (LAS float*)C.lds; LAS float* Vf = Kf + 132 * 65; LAS float* Qf = Vf + 132 * 64; LAS float* Pf = Qf + 16 * 64;
    for (int e = tid; e < 132 * 64; e += 512) { const int key = e >> 6, d = e & 63; float kx, vx;
        if (key < 128) { const size_t o = (((size_t)b * 128 + key) * 2 + kvh) * 64 + d; kx = ck[o]; vx = cv[o]; }
        else { const size_t r = (size_t)MP + 4 * b + (key - 128); kx = bf1(PROJ[r * INC + C_K + kvh * 64 + d]); vx = bf1(PROJ[r * INC + C_V + kvh * 64 + d]); }
        Kf[key * 65 + d] = kx; Vf[key * 64 + d] = vx;
        if (key >= 4) { const size_t o = (((size_t)b * 128 + (key - 4)) * 2 + kvh) * 64 + d; ko[o] = kx; vo[o] = vx; } }
    for (int e = tid; e < 16 * 64; e += 512) { const int qr = e >> 6, d = e & 63, i = qr >> 2, g = qr & 3; Qf[e] = bf1(PROJ[((size_t)MP + 4 * b + i) * INC + (kvh * 4 + g) * 64 + d]); }
    __syncthreads();
    { const int qr = tid >> 5, kl = tid & 31, i = qr >> 2, g = qr & 3; float sc[5]; float mx = -INFINITY;
#pragma unroll
        for (int k5 = 0; k5 < 5; ++k5) { const int key = kl + 32 * k5; float sv = -INFINITY;
            if (key < 132 && key >= i && key <= i + 128) { float a = 0.f;
#pragma unroll 16
                for (int d = 0; d < 64; ++d) a += Qf[qr * 64 + d] * Kf[key * 65 + d];
                sv = a * 0.125f; }
            sc[k5] = sv; mx = fmaxf(mx, sv); }
#pragma unroll
        for (int o = 1; o < 32; o <<= 1) mx = fmaxf(mx, __shfl_xor(mx, o));
        const float sink = sinks[kvh * 4 + g]; mx = fmaxf(mx, sink); float sum = 0.f;
#pragma unroll
        for (int k5 = 0; k5 < 5; ++k5) { sc[k5] = __expf(sc[k5] - mx); sum += sc[k5]; }
#pragma unroll
        for (int o = 1; o < 32; o <<= 1) sum += __shfl_xor(sum, o);
        const float inv = 1.f / (sum + __expf(sink - mx));
#pragma unroll
        for (int k5 = 0; k5 < 5; ++k5) { const int key = kl + 32 * k5; if (key < 136) Pf[qr * 136 + key] = sc[k5] * inv; } }
    __syncthreads();
    { const int qr = tid >> 5, d = (tid & 31) * 2, i = qr >> 2, g = qr & 3; float o0 = 0.f, o1 = 0.f;
#pragma unroll 4
        for (int key = 0; key < 132; ++key) { const float p = Pf[qr * 136 + key]; o0 += p * Vf[key * 64 + d]; o1 += p * Vf[key * 64 + d + 1]; }
        *(unsigned*)(MIXCAT + ((size_t)MP + 4 * b + i) * DM + (kvh * 4 + g) * 64 + d) = pk2(o0, o1); }
    __syncthreads();
}

__device__ __forceinline__ void s_phase(const Ctx& C, const Args& A, int l) {
    const bf16* PROJ = (const bf16*)(C.ws + WS_R1); bf16* MIXCAT = (bf16*)(C.ws + WS_HN);
    float* R = (float*)(C.ws + WS_R2); const size_t S = (size_t)M * 256;
    RwkvPtrs P{R, R + S, R + 2 * S, R + 3 * S, R + 4 * S, R + 5 * S, (float*)(C.ws + WS_R3)};
    const float* AL = (const float*)(C.ws + WS_R3) + S; const float* U = AL + S;
    float* out = C.out;
    constexpr int NSCAN = 64;
    if (C.bid < NSCAN) { rwkv_prompt(C, P, C.bid, out + OUT_WKVP + (size_t)l * NBP * 4 * 4096); return; }
    constexpr int N0 = 256, N1 = N0 + 64, N2_ = N1 + 256, N3 = N2_ + 1024, N4 = N3 + 64;
    for (int it = C.bid - NSCAN; it < N4; it += C.G - NSCAN) {
        if (it < N0) swa_prompt_item(C, it, PROJ, MIXCAT, INP(I_SINK) + l * 8);
        else if (it < N1) lru_prompt_item(C, it - N0, AL, U, PROJ, MIXCAT, out + OUT_LRP + (size_t)l * NBP * 256);
        else if (it < N2_) swa_sample_item(C, it - N1, PROJ, MIXCAT, INP(I_SINK) + l * 8, INP(I_CK) + (size_t)l * DB * 16384, INP(I_CV) + (size_t)l * DB * 16384,
                                          out + OUT_KS + (size_t)l * DB * 16384, out + OUT_VS + (size_t)l * DB * 16384);
        else if (it < N3) rwkv_sample_item(P, (it - N2_) * 8 + C.wave, INP(I_SWKV) + (size_t)l * DB * 4 * 4096, out + OUT_WKVS + (size_t)l * DB * 4 * 4096, C.lane);
        else { const int e = (it - N3) * 512 + C.tid, b = e >> 8, c = e & 255; float h = INP(I_SLRU)[((size_t)l * DB + b) * 256 + c];
#pragma unroll
            for (int i = 0; i < DS; ++i) { const size_t m = (size_t)MP + 4 * b + i; h = AL[m * 256 + c] * h + U[m * 256 + c];
                MIXCAT[m * DM + 768 + c] = (bf16)f2bf(h * gelu_t(bf1(PROJ[m * INC + C_GB + c]))); }
            out[OUT_LRS + ((size_t)l * DB + b) * 256 + c] = h; }
    }
    if (l + 1 < NL) convert_layer(C, A, l + 1, (C.bid - NSCAN) * 8 + C.wave, (C.G - NSCAN) * 8, (C.bid - NSCAN) * 512 + C.tid, (C.G - NSCAN) * 512);
}

__device__ __forceinline__ void e3_post(const Ctx& C, const Args& A, int l) {
    const float* R = (const float*)(C.ws + WS_R2); const size_t S = (size_t)M * 256;
    const float *K = R + S, *V = R + 2 * S, *G = R + 6 * S, *YR = (const float*)(C.ws + WS_R3);
    bf16* MIXCAT = (bf16*)(C.ws + WS_HN); const int c4 = 4 * C.lane;
    const f32x4 lw = *(const f32x4*)(INP(I_LNW) + l * 256 + c4), lb = *(const f32x4*)(INP(I_LNB) + l * 256 + c4), rk = *(const f32x4*)(INP(I_RK) + l * 256 + c4);
    for (int m = C.gw; m < M; m += C.NGW) {
        const size_t o = (size_t)m * 256 + c4;
        const f32x4 y = *(const f32x4*)(YR + o), r = *(const f32x4*)(R + o), k = *(const f32x4*)(K + o), v = *(const f32x4*)(V + o), g = *(const f32x4*)(G + o);
        const float mean = red16((y.x + y.y) + (y.z + y.w)) * (1.f / 64.f); const f32x4 d = y - mean;
        const float var = red16(dot4(d, d)) * (1.f / 64.f); const float rs = rsqrtf(var + 64e-5f);
        const float bonus = red16(dot4(r * k, rk));
        st_bf4(MIXCAT + (size_t)m * DM + 512 + c4, (d * rs * lw + lb + v * bonus) * g);
    }
}
constexpr int LDS_BYTES = 131072 + 64;
#ifndef MK_MULTI
#define MK_MULTI 0
#endif
#ifndef MK_DUP
#define MK_DUP 0
#endif
enum { PH_P0 = 0, PH_G1, PH_E1, PH_G2, PH_S, PH_E3, PH_G3, PH_E4, PH_G4, PH_G5, PH_E5, PH_G6, PH_E0, PH_N };

__device__ __forceinline__ Ctx make_ctx(int wave0, LAS unsigned char* lds) {
    Ctx D; int z_ = 0; asm volatile("" : "+v"(z_)); int ln_ = __builtin_amdgcn_mbcnt_hi(-1, __builtin_amdgcn_mbcnt_lo(-1, z_));
    D.lane = ln_; D.wave = wave0; D.tid = wave0 * 64 + ln_;
    int b_ = blockIdx.x; asm volatile("" : "+s"(b_)); D.bid = b_; D.gw = b_ * 8 + wave0; D.G = gridDim.x; D.NGW = D.G * 8;
    D.lds = lds; D.out = (float*)inp_ld(N_IN); D.ws = (unsigned char*)inp_ld(N_IN + 1);
    return D;
}
template <int PH> __device__ __forceinline__ void run_phase(const Args& A, int wave0, LAS unsigned char* lds, int l_in) {
    const Ctx C = make_ctx(wave0, lds);
    int l = l_in; asm volatile("" : "+s"(l));
    unsigned char* ws = C.ws; unsigned char* wl = ws + WS_W + (size_t)l * WL; (void)wl;
    bf16* HN = (bf16*)(ws + WS_HN); float* MIX = (float*)(ws + WS_R1); float* R2 = (float*)(ws + WS_R2); float* R3 = (float*)(ws + WS_R3); float* X = C.out;
    const size_t S = (size_t)M * 256; (void)HN; (void)MIX; (void)R2; (void)R3; (void)X; (void)S;
    if constexpr (PH == PH_P0) p0_prologue(C, A);
    if constexpr (PH == PH_G1) {
        pg8::Gemm g{HN, (const bf16*)(wl + O_WIN), M, INC, DM}; pg8::StaticOrder So; So.init(M, INC, C.G, C.bid);
        pg8::EpiBf16<0> E{(bf16*)(ws + WS_R1), INC, INP(I_BIN) + (size_t)l * INC, 0, 0, 1.f};
        pg8::gemm_phase<pg8::EpiBf16<0>, pg8::StaticOrder, true, true>(C.lds, g, So, E, C.tid); }
    if constexpr (PH == PH_E1) e1_prep(C, A, l);
    if constexpr (PH == PH_G2) {
        pg8::Gemm g{(const bf16*)(ws + WS_R3), (const bf16*)(wl + O_W2), M, N2, K2}; pg8::StaticOrder So; So.init(M, N2, C.G, C.bid);
        EpiMix E{INP(I_W0) + l * 256, INP(I_A0) + l * 256, INP(I_KA) + l * 256, INP(I_BA) + l * 256, INP(I_BI) + l * 256, INP(I_L) + l * 256,
                 R2 + 5 * S, R2 + 1 * S, R2 + 3 * S, R2 + 4 * S, R2 + 6 * S, R3 + S, R3 + 2 * S, (const bf16*)(ws + WS_R3)};
        pg8::gemm_phase<EpiMix, pg8::StaticOrder, true, true>(C.lds, g, So, E, C.tid); }
    if constexpr (PH == PH_S) s_phase(C, A, l);
    if constexpr (PH == PH_E3) e3_post(C, A, l);
    if constexpr (PH == PH_G3) {
        pg8::Gemm g{HN, (const bf16*)(wl + O_WOUT), M, DM, DM}; pg8::StaticOrder So; So.init(M, DM, C.G, C.bid);
        EpiF32 E{MIX, DM, INP(I_BOUT) + (size_t)l * DM};
        pg8::gemm_phase<EpiF32, pg8::StaticOrder, true, true>(C.lds, g, So, E, C.tid); }
    if constexpr (PH == PH_E4)
        for (int m = C.gw; m < M; m += C.NGW) row_update(MIX + (size_t)m * DM, INP(I_NMPOST) + l * DM, X + (size_t)m * DM, INP(I_NFPRE) + l * DM, HN + (size_t)m * DM, C.lane);
    if constexpr (PH == PH_G4) {
        pg8::Gemm g{HN, (const bf16*)(wl + O_WGU), M, 2 * DFF, DM}; pg8::StaticOrder So; So.init(M, 2 * DFF, C.G, C.bid);
        EpiSwiglu E{(bf16*)(ws + WS_R2)};
        pg8::gemm_phase<EpiSwiglu, pg8::StaticOrder, true, true>(C.lds, g, So, E, C.tid); }
    if constexpr (PH == PH_G5) {
        pg8::Gemm g{(const bf16*)(ws + WS_R2), (const bf16*)(wl + O_WD), M, DM, DFF}; pg8::StaticOrder So; So.init(M, DM, C.G, C.bid);
        EpiF32 E{MIX, DM, nullptr};
        pg8::gemm_phase<EpiF32, pg8::StaticOrder, true, true>(C.lds, g, So, E, C.tid); }
    if constexpr (PH == PH_E5)
        for (int m = C.gw; m < M; m += C.NGW) row_update(MIX + (size_t)m * DM, INP(I_NFPOST) + l * DM, X + (size_t)m * DM, nullptr, HN + (size_t)m * DM, C.lane);
    if constexpr (PH == PH_G6) {
        pg8::StaticOrder So; So.init(M, DM, C.G, C.bid);
        { pg8::Gemm g{(const bf16*)(ws + WS_PB + (size_t)l * SZ_PBL), (const bf16*)(wl + O_WP), M, DM, PLE}; EpiF32 E{R2, DM, nullptr};
          pg8::gemm_phase<EpiF32, pg8::StaticOrder, true, true>(C.lds, g, So, E, C.tid); }
        { pg8::Gemm g{HN, (const bf16*)(wl + O_WPG), M, DM, DM}; EpiPle E{X, R2};
          pg8::gemm_phase<EpiPle, pg8::StaticOrder, true, true>(C.lds, g, So, E, C.tid); } }
    if constexpr (PH == PH_E0)
        for (int m = C.gw; m < M; m += C.NGW) row_norm(X + (size_t)m * DM, INP(I_NMPRE) + (l + 1) * DM, HN + (size_t)m * DM, nullptr, C.lane);
}

#if MK_MULTI
template <int PH> __global__ void __launch_bounds__(512, 2) mk_one(Args A, int l) {
    extern __shared__ __attribute__((aligned(16))) unsigned char lds_raw[];
    const int wave0 = __builtin_amdgcn_readfirstlane((int)threadIdx.x >> 6);
    run_phase<PH>(A, wave0, (LAS unsigned char*)lds_raw, l);
}
#else
__global__ void __launch_bounds__(512, 2) mk_fwd(Args A) {
    extern __shared__ __attribute__((aligned(16))) unsigned char lds_raw[];
    cg::grid_group grid = cg::this_grid();
    const int wave0 = __builtin_amdgcn_readfirstlane((int)threadIdx.x >> 6);
    LAS unsigned char* lds = (LAS unsigned char*)lds_raw;
    if (threadIdx.x < 16) ((LAS unsigned*)lds)[131072 / 4 + threadIdx.x] = 0u;
    __syncthreads();
    const unsigned xbar_x = __builtin_amdgcn_readfirstlane(xcd_barrier_post((unsigned*)inp_ld(N_IN + 1), (volatile LAS unsigned*)(lds + 131072), (int)threadIdx.x).x);
#define GRID_BAR() do { int z_ = 0; asm volatile("" : "+v"(z_)); int ln_ = __builtin_amdgcn_mbcnt_hi(-1, __builtin_amdgcn_mbcnt_lo(-1, z_)); XcdBarrier xb_; xb_.bar = (unsigned*)inp_ld(N_IN + 1); xb_.x = xbar_x; \
        xb_.st = (volatile LAS unsigned*)(lds + 131072); xcd_barrier(xb_, wave0 * 64 + ln_); } while (0)
    run_phase<PH_P0>(A, wave0, lds, 0);
    if (MK_DUP & 1) { GRID_BAR(); run_phase<PH_P0>(A, wave0, lds, 0); }
    grid.sync();
#pragma unroll 1
    for (int l = 0; l < NL; ++l) {
#define RP(PH) do { run_phase<PH>(A, wave0, lds, l); GRID_BAR(); if (MK_DUP & (1 << 20)) GRID_BAR(); if (MK_DUP & (1 << PH)) { run_phase<PH>(A, wave0, lds, l); GRID_BAR(); } } while (0)
        RP(PH_G1); RP(PH_E1); RP(PH_G2); RP(PH_S); RP(PH_E3); RP(PH_G3); RP(PH_E4); RP(PH_G4); RP(PH_G5); RP(PH_E5);
        run_phase<PH_G6>(A, wave0, lds, l);
        if (l + 1 < NL) { GRID_BAR(); RP(PH_E0); }
    }
}
#endif
}

#if MK_MULTI
template <int PH> static void launch_one(const mk::Args& a, int l, int grid, hipStream_t stream) {
    static bool attr = false;
    if (!attr) { (void)hipFuncSetAttribute((const void*)mk::mk_one<PH>, hipFuncAttributeMaxDynamicSharedMemorySize, mk::LDS_BYTES); attr = true; }
    hipLaunchKernelGGL(mk::mk_one<PH>, dim3(grid), dim3(512), mk::LDS_BYTES, stream, a, l);
}
#endif
extern "C" void kernel_launch(void* const* d_in, const int* in_sizes, int n_in, void* d_out, int out_size, void* d_ws, size_t ws_size, hipStream_t stream) {
    using namespace mk;
    static int grid = 0;
    if (grid == 0) {
        if (n_in != N_IN || (size_t)out_size != OUT_END || ws_size < WS_END) {
            fprintf(stderr, "kernel_launch: shape mismatch: n_in %d (want %d), out %d (want %zu), ws %zu (want >= %zu); nothing launched\n", n_in, (int)N_IN, out_size, (size_t)OUT_END, ws_size, (size_t)WS_END);
            grid = -1; return; }
        int dev = 0, cus = 0;
        (void)hipGetDevice(&dev); (void)hipDeviceGetAttribute(&cus, hipDeviceAttributeMultiprocessorCount, dev);
#if !MK_MULTI
        int per_cu = 0;
        if (hipFuncSetAttribute((const void*)mk_fwd, hipFuncAttributeMaxDynamicSharedMemorySize, LDS_BYTES) != hipSuccess) { fprintf(stderr, "kernel_launch: hipFuncSetAttribute failed\n"); grid = -1; return; }
        if (hipOccupancyMaxActiveBlocksPerMultiprocessor(&per_cu, (const void*)mk_fwd, 512, LDS_BYTES) != hipSuccess || per_cu < 1) fprintf(stderr, "kernel_launch: note: occupancy query gave %d\n", per_cu);
        (void)hipGetLastError();
#endif
        grid = cus;
        if (grid < 128) { fprintf(stderr, "kernel_launch: %d CUs: too few for this kernel\n", grid); grid = -1; return; }
    }
    if (grid < 0) return;
    Args a{};
    for (int i = 0; i < N_IN; ++i) a.in[i] = (const float*)d_in[i];
    a.out = (float*)d_out; a.ws = (unsigned char*)d_ws;
#if MK_MULTI
    launch_one<PH_P0>(a, 0, grid, stream);
    for (int l = 0; l < NL; ++l) {
        launch_one<PH_G1>(a, l, grid, stream); launch_one<PH_E1>(a, l, grid, stream); launch_one<PH_G2>(a, l, grid, stream); launch_one<PH_S>(a, l, grid, stream);
        launch_one<PH_E3>(a, l, grid, stream); launch_one<PH_G3>(a, l, grid, stream); launch_one<PH_E4>(a, l, grid, stream); launch_one<PH_G4>(a, l, grid, stream);
        launch_one<PH_G5>(a, l, grid, stream); launch_one<PH_E5>(a, l, grid, stream); launch_one<PH_G6>(a, l, grid, stream);
        if (l + 1 < NL) launch_one<PH_E0>(a, l, grid, stream);
    }
#else
    if (hipMemsetAsync(d_ws, 0, 65536, stream) != hipSuccess) { fprintf(stderr, "kernel_launch: hipMemsetAsync failed\n"); return; }
    void* args[] = {&a};
    const hipError_t e = hipLaunchCooperativeKernel((const void*)mk_fwd, dim3(grid), dim3(512), args, LDS_BYTES, stream);
    if (e != hipSuccess) fprintf(stderr, "kernel_launch: cooperative launch failed: %s (grid %d)\n", hipGetErrorString(e), grid);
#endif
}
```

```cpp
#include <hip/hip_runtime.h>
#include <hip/hip_cooperative_groups.h>
#include <cstdio>
#include <cstdint>
#include <cstddef>
#include <cmath>
namespace cg = cooperative_groups;
namespace pg8 {
#define PG8_LAS __attribute__((address_space(3)))
typedef unsigned short bf16_t;
typedef short bf16x8 __attribute__((ext_vector_type(8)));
typedef float f32x4 __attribute__((ext_vector_type(4)));
typedef unsigned u32x4 __attribute__((ext_vector_type(4)));
constexpr int BM = 256, BK = 64, HALF = 128, HTB = HALF * BK * 2  , STAGE_BYTES = 8 * HTB, NXCD = 8, WGM = 8;

__host__ __device__ __forceinline__ int lds_byte(int r, int c) { const int st = (r >> 4) * 2 + (c >> 5), rr = r & 15, cc = c & 31, ob = rr * 64 + cc * 2; return st * 1024 + (ob ^ (((ob >> 9) & 1) << 5)); }
__host__ __device__ __forceinline__ void stage_rc(int b, int& R, int& C) { const int st = b / 1024, sb = b % 1024, swz = sb ^ (((sb >> 9) & 1) << 5); R = (st >> 1) * 16 + swz / 64; C = (st & 1) * 32 + (swz % 64) / 2; }
__host__ __device__ __forceinline__ int perm32(int rho) { const int n = rho >> 4, i = rho & 15; return 8 * (i >> 2) + 4 * n + (i & 3); }

struct Unit { int pm, pn, ko = 0; };
struct Gemm { const bf16_t* A; const bf16_t* Bt; int M, N, K; int ld = 0; };

struct StaticOrder {
    int nM, nN, nwg, G, c;
    __host__ __device__ void init(int M, int N, int G_, int c_) { nM = M / BM; nN = N / BM; nwg = nM * nN; G = G_; c = c_; }
    __host__ __device__ bool next(int i, Unit& u) const {
        const long L = (long)i * G + c; if (L >= nwg) return false;
        int wgid = (int)L; { const int q = nwg / NXCD, r = nwg % NXCD, xcd = wgid % NXCD, off = wgid / NXCD; wgid = (xcd < r ? xcd * (q + 1) : r * (q + 1) + (xcd - r) * q) + off; }
        const int nig = WGM * nN, gid = wgid / nig, fm = gid * WGM, gsz = (nM - fm) < WGM ? (nM - fm) : WGM;
        u.pm = fm + ((wgid % nig) % gsz); u.pn = (wgid % nig) / gsz; return true;
    }
    __device__ __forceinline__ void a_ready(const Unit&) const {}
    __device__ __forceinline__ void done(const Unit&) const {}
};

__device__ __forceinline__ unsigned cvt_pk_bf16(float lo, float hi) { unsigned r; asm volatile("v_cvt_pk_bf16_f32 %0, %1, %2" : "=v"(r) : "v"(lo), "v"(hi)); return r; }
typedef float f32x2 __attribute__((ext_vector_type(2)));
__device__ __forceinline__ f32x2 gelu_pk(f32x2 v) {
    const f32x2 av = __builtin_elementwise_abs(v), d = av * 0.2316418882f + 1.0f;
    f32x2 t; t.x = __builtin_amdgcn_rcpf(d.x); t.y = __builtin_amdgcn_rcpf(d.y);
    f32x2 q = t * 0.5307027145f + (-0.7265760135f); q = q * t + 0.7107068705f; q = q * t + (-0.142248368f); q = q * t + 0.127414796f; q = q * t;
    const f32x2 s = (v * v) * (-0.72134752044f);
    f32x2 e; e.x = __builtin_amdgcn_exp2f(s.x); e.y = __builtin_amdgcn_exp2f(s.y);
    const f32x2 m = v * (q * e), r = v - m;
    f32x2 o; o.x = v.x < 0.f ? m.x : r.x; o.y = v.y < 0.f ? m.y : r.y; return o;
}

template <int ACT  > struct EpiBf16 {
    static constexpr bool PERM = true, AFTER_DRAIN = false; static_assert(ACT == 0 || ACT == 1, "EpiBf16: ACT is 0 (none) or 1 (gelu_pk)");
    bf16_t* O; int ldc; const float* bias; int split_cols; size_t split_stride; float scale0;
    __device__ __forceinline__ void operator()(const f32x4 (&acc)[2][2][4][2], const Unit& u, int wr, int wc, int fr, int fq) const {
        const int row0 = u.pm * BM + wr * 64 + fr; int colt = u.pn * BM; bf16_t* base = O;
        float sc = 1.f; if (split_cols) { const int t = colt / split_cols; base += (size_t)t * split_stride; colt -= t * split_cols; if (t == 0) sc = scale0; }
        const int col0 = colt + wc * 32 + 8 * fq, bcol0 = u.pn * BM + wc * 32 + 8 * fq;
        f32x4 bv[2][2];
#pragma unroll
        for (int bj = 0; bj < 2; ++bj)
#pragma unroll
            for (int n = 0; n < 2; ++n) bv[bj][n] = bias ? *(const f32x4*)(bias + bcol0 + bj * HALF + 4 * n) : (f32x4){0.f, 0.f, 0.f, 0.f};
#pragma unroll
        for (int ai = 0; ai < 2; ++ai)
#pragma unroll
            for (int m = 0; m < 4; ++m) { bf16_t* rowp = base + (size_t)(row0 + ai * HALF + m * 16) * ldc + col0;
#pragma unroll
                for (int bj = 0; bj < 2; ++bj) { f32x4 v0 = acc[ai][bj][m][0] + bv[bj][0], v1 = acc[ai][bj][m][1] + bv[bj][1];
                    if (ACT == 1) { f32x2 a = gelu_pk((f32x2){v0[0], v0[1]}), b = gelu_pk((f32x2){v0[2], v0[3]}), c = gelu_pk((f32x2){v1[0], v1[1]}), d = gelu_pk((f32x2){v1[2], v1[3]});
                        v0 = (f32x4){a.x, a.y, b.x, b.y}; v1 = (f32x4){c.x, c.y, d.x, d.y}; }
                    v0 = v0 * sc; v1 = v1 * sc; u32x4 w; w.x = cvt_pk_bf16(v0[0], v0[1]); w.y = cvt_pk_bf16(v0[2], v0[3]); w.z = cvt_pk_bf16(v1[0], v1[1]); w.w = cvt_pk_bf16(v1[2], v1[3]);
                    *(u32x4*)(rowp + bj * HALF) = w; } }
    }
};
template <class Epi, class Sched, bool ALIGN_EPI = false, bool SP2 = false>
__device__ __forceinline__ void gemm_phase(PG8_LAS unsigned char* lds, const Gemm g, const Sched& S, const Epi& E, int tid_in) {
    int tid_ = tid_in; asm volatile("" : "+v"(tid_));
    const int tid = tid_, wid = __builtin_amdgcn_readfirstlane(tid >> 6), lane = tid & 63, wr = wid >> 2, wc = wid & 3, fr = lane & 15, fq = lane >> 4;
    const int K = g.K, nt = K / BK, LD = g.ld ? g.ld : g.K;
    unsigned voffA[2], voffB[2];
#pragma unroll
    for (int i = 0; i < 2; ++i) { int R, C; stage_rc(tid * 16 + i * 8192, R, C); const int Rb = Epi::PERM ? ((R & ~31) + perm32(R & 31)) : R;
        voffA[i] = (unsigned)(R * LD + C) * 2u; voffB[i] = (unsigned)(Rb * LD + C) * 2u; }
    const size_t kstep = (size_t)(BK * 2);
    const size_t hstep = (size_t)HALF * LD * 2;
    const size_t tstep = 2 * hstep;
    const unsigned ldsw = (unsigned)wid * 1024u;
    const int aoff = lds_byte(wr * 64 + fr, fq * 8), boff = lds_byte(wc * 32 + fr, fq * 8);
#define PG8_SA(b, h) (((b) * 2 + (h)) * HTB)
#define PG8_SB(b, h) ((4 + (b) * 2 + (h)) * HTB)
#define PG8_STAGE(bufoff, gbase, voff) do { _Pragma("unroll") for (int _i = 0; _i < 2; ++_i) \
        __builtin_amdgcn_global_load_lds((const unsigned*)((const char*)(gbase) + (voff)[_i]), (PG8_LAS unsigned*)(lds + (bufoff) + ldsw + _i * 8192), 16, 0, 0); } while (0)
#define PG8_LDA(dst, b, h) do { _Pragma("unroll") for (int m = 0; m < 4; ++m) _Pragma("unroll") for (int k = 0; k < 2; ++k) dst[m][k] = *(const PG8_LAS bf16x8*)(lds + PG8_SA(b, h) + aoff + m * 2048 + k * 1024); } while (0)
#define PG8_LDB(dst, b, h) do { _Pragma("unroll") for (int n = 0; n < 2; ++n) _Pragma("unroll") for (int k = 0; k < 2; ++k) dst[n][k] = *(const PG8_LAS bf16x8*)(lds + PG8_SB(b, h) + boff + n * 2048 + k * 1024); } while (0)
#define PG8_MMA(ai, bj, At, Bt) do { __builtin_amdgcn_s_setprio(1); _Pragma("unroll") for (int m = 0; m < 4; ++m) _Pragma("unroll") for (int n = 0; n < 2; ++n) _Pragma("unroll") for (int k = 0; k < 2; ++k) \
        acc[ai][bj][m][n] = __builtin_amdgcn_mfma_f32_16x16x32_bf16(Bt[n][k], At[m][k], acc[ai][bj][m][n], 0, 0, 0); __builtin_amdgcn_s_setprio(0); } while (0)
#define PG8_WAIT_V(n) asm volatile("s_waitcnt vmcnt(" #n ")" ::: "memory")
#define PG8_WAIT_L(n) asm volatile("s_waitcnt lgkmcnt(" #n ")" ::: "memory")
#define PG8_BAR __builtin_amdgcn_s_barrier()
#define PG8_SCHED __builtin_amdgcn_sched_barrier(0)
    Unit cur, nxt; int ui = 0;
    if (!S.next(0, cur)) return;
    f32x4 acc[2][2][4][2];
#pragma unroll
    for (int a = 0; a < 2; ++a)
#pragma unroll
        for (int b = 0; b < 2; ++b)
#pragma unroll
            for (int m = 0; m < 4; ++m)
#pragma unroll
                for (int n = 0; n < 2; ++n) acc[a][b][m][n] = (f32x4){0.f, 0.f, 0.f, 0.f};
    bf16x8 At[4][2], B0[2][2], B1[2][2];
    const char* cA = (const char*)g.A + (size_t)cur.pm * tstep + (size_t)cur.ko * 2; const char* cB = (const char*)g.Bt + (size_t)cur.pn * tstep + (size_t)cur.ko * 2;
    S.a_ready(cur);
    if constexpr (SP2) {
        PG8_STAGE(PG8_SB(0, 0), cB, voffB); PG8_STAGE(PG8_SB(0, 1), cB + hstep, voffB); PG8_STAGE(PG8_SA(0, 0), cA, voffA); PG8_STAGE(PG8_SA(0, 1), cA + hstep, voffA);
        if (wr == 1) PG8_BAR;
        PG8_WAIT_V(2); PG8_BAR;
        PG8_STAGE(PG8_SB(1, 0), cB + kstep, voffB); PG8_STAGE(PG8_SA(1, 0), cA + kstep, voffA); PG8_STAGE(PG8_SB(1, 1), cB + hstep + kstep, voffB);
        PG8_WAIT_V(6); PG8_BAR;
    } else {
        PG8_STAGE(PG8_SB(0, 0), cB, voffB); PG8_STAGE(PG8_SA(0, 0), cA, voffA); PG8_STAGE(PG8_SB(0, 1), cB + hstep, voffB); PG8_STAGE(PG8_SA(0, 1), cA + hstep, voffA);
        if (wr == 1) PG8_BAR;
        PG8_WAIT_V(4); PG8_BAR;
        PG8_STAGE(PG8_SB(1, 0), cB + kstep, voffB); PG8_STAGE(PG8_SA(1, 0), cA + kstep, voffA); PG8_STAGE(PG8_SB(1, 1), cB + hstep + kstep, voffB);
        PG8_WAIT_V(6); PG8_BAR;
    }
    for (;;) {
        const bool has_next = S.next(ui + 1, nxt);
        const char* nA = has_next ? (const char*)g.A + (size_t)nxt.pm * tstep + (size_t)nxt.ko * 2 : cA; const char* nB = has_next ? (const char*)g.Bt + (size_t)nxt.pn * tstep + (size_t)nxt.ko * 2 : cB;
        for (int t = 0; t < nt; t += 2) {
            const bool last = (t == nt - 2);
            const char* a1 = cA + (size_t)(t + 1) * kstep;
            const char* a2 = last ? nA : cA + (size_t)(t + 2) * kstep; const char* b2 = last ? nB : cB + (size_t)(t + 2) * kstep;
            const char* a3 = a2 + kstep; const char* b3 = b2 + kstep;
            if (last && has_next) S.a_ready(nxt);
            if constexpr (SP2) {
            PG8_LDB(B0, 0, 0); PG8_LDB(B1, 0, 1); PG8_SCHED; PG8_LDA(At, 0, 0); PG8_STAGE(PG8_SA(1, 1), a1 + hstep, voffA);
            PG8_WAIT_V(8); PG8_WAIT_L(0); PG8_BAR; PG8_MMA(0, 0, At, B0); PG8_MMA(0, 1, At, B1); PG8_BAR; PG8_SCHED;
            PG8_LDA(At, 0, 1); PG8_STAGE(PG8_SB(0, 0), b2, voffB); PG8_STAGE(PG8_SB(0, 1), b2 + hstep, voffB); PG8_STAGE(PG8_SA(0, 0), a2, voffA);
            PG8_WAIT_V(8); PG8_WAIT_L(0); PG8_BAR; PG8_MMA(1, 0, At, B0); PG8_MMA(1, 1, At, B1); PG8_BAR; PG8_SCHED;
            PG8_LDB(B0, 1, 0); PG8_LDB(B1, 1, 1); PG8_SCHED; PG8_LDA(At, 1, 0); PG8_STAGE(PG8_SA(0, 1), a2 + hstep, voffA);
            PG8_WAIT_V(8); PG8_WAIT_L(0); PG8_BAR; PG8_MMA(0, 0, At, B0); PG8_MMA(0, 1, At, B1); PG8_BAR; PG8_SCHED;
            PG8_LDA(At, 1, 1); PG8_STAGE(PG8_SB(1, 0), b3, voffB); PG8_STAGE(PG8_SB(1, 1), b3 + hstep, voffB); PG8_STAGE(PG8_SA(1, 0), a3, voffA);
            PG8_WAIT_V(8); PG8_WAIT_L(0); PG8_BAR; PG8_MMA(1, 0, At, B0); PG8_MMA(1, 1, At, B1); PG8_BAR; PG8_SCHED;
            } else {
            PG8_LDB(B0, 0, 0); PG8_SCHED; PG8_LDA(At, 0, 0); PG8_STAGE(PG8_SA(1, 1), a1 + hstep, voffA);
            PG8_WAIT_L(8); PG8_BAR; PG8_WAIT_L(0); PG8_MMA(0, 0, At, B0); PG8_BAR; PG8_SCHED;
            PG8_LDB(B1, 0, 1); PG8_STAGE(PG8_SB(0, 0), b2, voffB);
            PG8_BAR; PG8_WAIT_L(0); PG8_MMA(0, 1, At, B1); PG8_BAR;
            PG8_LDA(At, 0, 1); PG8_STAGE(PG8_SA(0, 0), a2, voffA);
            PG8_BAR; PG8_WAIT_L(0); PG8_MMA(1, 0, At, B0); PG8_BAR; PG8_SCHED;
            PG8_STAGE(PG8_SB(0, 1), b2 + hstep, voffB);
            PG8_WAIT_V(6); PG8_BAR; PG8_MMA(1, 1, At, B1); PG8_BAR;
            PG8_LDB(B0, 1, 0); PG8_SCHED; PG8_LDA(At, 1, 0); PG8_STAGE(PG8_SA(0, 1), a2 + hstep, voffA);
            PG8_WAIT_L(8); PG8_BAR; PG8_WAIT_L(0); PG8_MMA(0, 0, At, B0); PG8_BAR; PG8_SCHED;
            PG8_LDB(B1, 1, 1); PG8_STAGE(PG8_SB(1, 0), b3, voffB);
            PG8_BAR; PG8_WAIT_L(0); PG8_MMA(0, 1, At, B1); PG8_BAR;
            PG8_LDA(At, 1, 1); PG8_STAGE(PG8_SA(1, 0), a3, voffA);
            PG8_BAR; PG8_WAIT_L(0); PG8_MMA(1, 0, At, B0); PG8_BAR; PG8_SCHED;
            PG8_STAGE(PG8_SB(1, 1), b3 + hstep, voffB);
            PG8_WAIT_V(6); PG8_BAR; PG8_MMA(1, 1, At, B1); PG8_BAR;
            }
        }
        if constexpr (ALIGN_EPI) { if (wr == 0) PG8_BAR; }
        if constexpr (!Epi::AFTER_DRAIN) { int z_ = 0; asm volatile("" : "+v"(z_)); const int ln_ = __builtin_amdgcn_mbcnt_hi(-1, __builtin_amdgcn_mbcnt_lo(-1, z_)); E(acc, cur, wr, wc, ln_ & 15, ln_ >> 4); S.done(cur); }
        if (!has_next) break;
#pragma unroll
        for (int a = 0; a < 2; ++a)
#pragma unroll
            for (int b = 0; b < 2; ++b)
#pragma unroll
                for (int m = 0; m < 4; ++m)
#pragma unroll
                    for (int n = 0; n < 2; ++n) acc[a][b][m][n] = (f32x4){0.f, 0.f, 0.f, 0.f};
        cur = nxt; cA = nA; cB = nB; ++ui;
        if constexpr (ALIGN_EPI) { if (wr == 1) PG8_BAR; }
    }
    PG8_WAIT_V(0);
    if constexpr (!ALIGN_EPI) { if (wr == 0) PG8_BAR; }
    PG8_BAR;
    if constexpr (Epi::AFTER_DRAIN) { E.fused(acc, cur, wr, wc, fr, fq, lds, wid, lane); S.done(cur); }
#undef PG8_SA
#undef PG8_SB
#undef PG8_STAGE
#undef PG8_LDA
#undef PG8_LDB
#undef PG8_MMA
#undef PG8_WAIT_V
#undef PG8_WAIT_L
#undef PG8_BAR
#undef PG8_SCHED
}
}
namespace mk {
typedef pg8::bf16_t bf16;
typedef pg8::f32x4 f32x4;
typedef pg8::u32x4 u32x4;
typedef pg8::bf16x8 bf16x8;
typedef pg8::Unit Unit;
typedef float f32x16 __attribute__((ext_vector_type(16)));
typedef unsigned u32x2 __attribute__((ext_vector_type(2)));
typedef float f32x2 __attribute__((ext_vector_type(2)));
#define LAS __attribute__((address_space(3)))
#define LDS_WAIT() asm volatile("s_waitcnt lgkmcnt(0)" ::: "memory")

constexpr int DM = 1024, T = 4096, NBP = 4, MP = NBP * T, DB = 128, DS = 4, MS = DB * DS, M = MP + MS, NL = 4;
constexpr int INC = 2304, DFF = 2816, K2 = 512, N2 = 1280, PLE = 256;
constexpr int C_K = 512, C_V = 640, C_RW = 768, C_XB = 1792, C_GB = 2048;

constexpr size_t SZ_WIN = (size_t)INC * DM * 2, SZ_W2 = (size_t)N2 * K2 * 2, SZ_WOUT = (size_t)DM * DM * 2, SZ_WGU = (size_t)2 * DFF * DM * 2,
                 SZ_WD = (size_t)DM * DFF * 2, SZ_WPG = (size_t)DM * DM * 2, SZ_WP = (size_t)DM * PLE * 2;
constexpr size_t O_WIN = 0, O_W2 = O_WIN + SZ_WIN, O_WOUT = O_W2 + SZ_W2, O_WGU = O_WOUT + SZ_WOUT, O_WD = O_WGU + SZ_WGU, O_WPG = O_WD + SZ_WD,
                 O_WP = O_WPG + SZ_WPG, WL = O_WP + SZ_WP;
constexpr size_t WS_W = 1u << 20  , SZ_PBL = (size_t)M * PLE * 2, WS_X16 = WS_W + 2 * WL  , WS_PB = WS_X16 + (size_t)M * DM * 2  , SZ_ACT = (size_t)M * DM * 2, WS_PP = WS_PB + 2 * SZ_PBL  , WS_HN = WS_PP + SZ_ACT,
                 WS_R1 = WS_HN + SZ_ACT, SZ_R1 = (size_t)M * INC * 2, WS_R2 = WS_R1 + SZ_R1, SZ_F256 = (size_t)M * 256 * 4, WS_R3 = WS_R2 + 7 * SZ_F256,
                 WS_END = WS_R3 + 3 * SZ_F256;
static_assert(WL % 256 == 0 && SZ_R1 >= (size_t)M * DM * 4 && 7 * SZ_F256 >= (size_t)M * DFF * 2, "ws map");

constexpr size_t OUT_Y = 0, OUT_KP = (size_t)M * DM, OUT_VP = OUT_KP + (size_t)NL * NBP * 128 * 128, OUT_SHP = OUT_VP + (size_t)NL * NBP * 128 * 128,
                 OUT_WKVP = OUT_SHP + (size_t)NL * NBP * 1024, OUT_CVP = OUT_WKVP + (size_t)NL * NBP * 4 * 4096, OUT_LRP = OUT_CVP + (size_t)NL * NBP * 768,
                 OUT_KS = OUT_LRP + (size_t)NL * NBP * 256, OUT_VS = OUT_KS + (size_t)NL * DB * 128 * 128, OUT_SHS = OUT_VS + (size_t)NL * DB * 128 * 128,
                 OUT_WKVS = OUT_SHS + (size_t)NL * DB * 1024, OUT_CVS = OUT_WKVS + (size_t)NL * DB * 4 * 4096, OUT_LRS = OUT_CVS + (size_t)NL * DB * 768,
                 OUT_END = OUT_LRS + (size_t)NL * DB * 256;

enum { I_XP = 0, I_XS, I_CK, I_CV, I_SSH, I_SWKV, I_SCV, I_SLRU, I_PP, I_PS, I_NMPRE, I_NMPOST, I_NFPRE, I_NFPOST, I_WIN, I_BIN, I_SINK, I_MU, I_W0, I_WUP,
       I_A0, I_AUP, I_GUP, I_KK, I_KA, I_RK, I_LNW, I_LNB, I_CW, I_CB, I_WA, I_BA, I_WI, I_BI, I_L, I_WOUT, I_BOUT, I_WG, I_WU, I_WDN, I_PW, I_PGW, N_IN };

__device__ __forceinline__ unsigned f2bf(float f) { unsigned u = __float_as_uint(f); return (u + 0x7fffu + ((u >> 16) & 1u)) >> 16; }
__device__ __forceinline__ unsigned pk2(float lo, float hi) { return f2bf(lo) | (f2bf(hi) << 16); }
__device__ __forceinline__ float bflo(unsigned w) { return __uint_as_float(w << 16); }
__device__ __forceinline__ float bfhi(unsigned w) { return __uint_as_float(w & 0xffff0000u); }
__device__ __forceinline__ float bf1(bf16 b) { return __uint_as_float((unsigned)b << 16); }
__device__ __forceinline__ f32x4 ld_bf4(const bf16* p) { const u32x2 w = *(const u32x2*)p; return (f32x4){bflo(w.x), bfhi(w.x), bflo(w.y), bfhi(w.y)}; }
__device__ __forceinline__ void st_bf4(bf16* p, f32x4 v) { u32x2 w; w.x = pk2(v.x, v.y); w.y = pk2(v.z, v.w); *(u32x2*)p = w; }
__device__ __forceinline__ float sigm(float x) { return __builtin_amdgcn_rcpf(1.f + __expf(-x)); }
__device__ __forceinline__ float tanh_(float x) { return 1.f - 2.f * __builtin_amdgcn_rcpf(__expf(2.f * x) + 1.f); }
__device__ __forceinline__ float gelu_t(float x) { return 0.5f * x * (1.f + tanh_(0.7978845608f * (x + 0.044715f * x * x * x))); }
template <int CTRL> __device__ __forceinline__ float dppf(float x) { return __builtin_bit_cast(float, __builtin_amdgcn_mov_dpp(__builtin_bit_cast(int, x), CTRL, 0xf, 0xf, true)); }
__device__ __forceinline__ float red16(float x) { x += dppf<0xB1>(x); x += dppf<0x4E>(x); x += dppf<0x141>(x); x += dppf<0x128>(x); return x; }
__device__ __forceinline__ float wave_sum(float v) {
    v = red16(v);
    v += __builtin_bit_cast(float, __builtin_amdgcn_update_dpp(0, __builtin_bit_cast(int, v), 0x142, 0xa, 0xf, false));
    v += __builtin_bit_cast(float, __builtin_amdgcn_update_dpp(0, __builtin_bit_cast(int, v), 0x143, 0xc, 0xf, false));
    return __builtin_bit_cast(float, __builtin_amdgcn_readlane(__builtin_bit_cast(int, v), 63));
}
__device__ __forceinline__ float vmul(float a, float b) { float d; asm("v_mul_f32 %0, %1, %2" : "=v"(d) : "v"(a), "v"(b)); return d; }
__device__ __forceinline__ float vfma(float a, float b, float c) { float d; asm("v_fma_f32 %0, %1, %2, %3" : "=v"(d) : "v"(a), "v"(b), "v"(c)); return d; }
__device__ __forceinline__ float vfnma(float a, float b, float c) { float d; asm("v_fma_f32 %0, -%1, %2, %3" : "=v"(d) : "v"(a), "v"(b), "v"(c)); return d; }
__device__ __forceinline__ void red16x2(float& p, float& q) {
    asm volatile("v_add_f32_dpp %0, %0, %0 quad_perm:[1,0,3,2] row_mask:0xf bank_mask:0xf bound_ctrl:1\n\t"
                 "v_add_f32_dpp %1, %1, %1 quad_perm:[1,0,3,2] row_mask:0xf bank_mask:0xf bound_ctrl:1\n\ts_nop 0\n\t"
                 "v_add_f32_dpp %0, %0, %0 quad_perm:[2,3,0,1] row_mask:0xf bank_mask:0xf bound_ctrl:1\n\t"
                 "v_add_f32_dpp %1, %1, %1 quad_perm:[2,3,0,1] row_mask:0xf bank_mask:0xf bound_ctrl:1\n\ts_nop 0\n\t"
                 "v_add_f32_dpp %0, %0, %0 row_half_mirror row_mask:0xf bank_mask:0xf bound_ctrl:1\n\t"
                 "v_add_f32_dpp %1, %1, %1 row_half_mirror row_mask:0xf bank_mask:0xf bound_ctrl:1\n\ts_nop 0\n\t"
                 "v_add_f32_dpp %0, %0, %0 row_ror:8 row_mask:0xf bank_mask:0xf bound_ctrl:1\n\t"
                 "v_add_f32_dpp %1, %1, %1 row_ror:8 row_mask:0xf bank_mask:0xf bound_ctrl:1\n\ts_nop 1"
                 : "+v"(p), "+v"(q));
}
__device__ __forceinline__ float shx(float v, int mask, int lane) { return __builtin_bit_cast(float, __builtin_amdgcn_ds_bpermute((lane ^ mask) << 2, __builtin_bit_cast(int, v))); }
__device__ __forceinline__ float dot4(f32x4 a, f32x4 b) { return (a.x * b.x + a.y * b.y) + (a.z * b.z + a.w * b.w); }

struct EpiF32 {
    static constexpr bool PERM = false, AFTER_DRAIN = false;
    float* O; int ldc; const float* bias;
    __device__ __forceinline__ void operator()(const f32x4 (&acc)[2][2][4][2], const Unit& u, int wr, int wc, int fr, int fq) const {
        asm volatile("" : "+v"(fr), "+v"(fq));
        const int row0 = u.pm * 256 + wr * 64 + fr, col0 = u.pn * 256 + wc * 32 + 4 * fq;
        f32x4 bv[2][2];
#pragma unroll
        for (int bj = 0; bj < 2; ++bj)
#pragma unroll
            for (int n = 0; n < 2; ++n) bv[bj][n] = bias ? *(const f32x4*)(bias + col0 + bj * 128 + n * 16) : (f32x4){0.f, 0.f, 0.f, 0.f};
#pragma unroll
        for (int ai = 0; ai < 2; ++ai)
#pragma unroll
            for (int m = 0; m < 4; ++m) { float* rowp = O + (size_t)(row0 + ai * 128 + m * 16) * ldc + col0;
#pragma unroll
                for (int bj = 0; bj < 2; ++bj)
#pragma unroll
                    for (int n = 0; n < 2; ++n) *(f32x4*)(rowp + bj * 128 + n * 16) = acc[ai][bj][m][n] + bv[bj][n]; }
    }
};
struct EpiPle {
    static constexpr bool PERM = false, AFTER_DRAIN = false;
    bf16* X; const bf16* PP; float* Y;
    __device__ __forceinline__ void operator()(const f32x4 (&acc)[2][2][4][2], const Unit& u, int wr, int wc, int fr, int fq) const {
        asm volatile("" : "+v"(fr), "+v"(fq));
        const int row0 = u.pm * 256 + wr * 64 + fr, col0 = u.pn * 256 + wc * 32 + 4 * fq;
#pragma unroll
        for (int ai = 0; ai < 2; ++ai)
#pragma unroll
            for (int m = 0; m < 4; ++m) { const size_t off = (size_t)(row0 + ai * 128 + m * 16) * DM + col0;
#pragma unroll
                for (int bj = 0; bj < 2; ++bj)
#pragma unroll
                    for (int n = 0; n < 2; ++n) { const size_t o = off + bj * 128 + n * 16; const f32x4 x = ld_bf4(X + o), p = ld_bf4(PP + o), a = acc[ai][bj][m][n];
                        const f32x4 r = (f32x4){x.x + sigm(a.x) * p.x, x.y + sigm(a.y) * p.y, x.z + sigm(a.z) * p.z, x.w + sigm(a.w) * p.w};
                        if (Y) *(f32x4*)(Y + o) = r; else st_bf4(X + o, r); }
                asm volatile("" ::: "memory"); }
    }
};
struct EpiSwiglu {
    static constexpr bool PERM = true, AFTER_DRAIN = false;
    bf16* O;
    __device__ __forceinline__ void operator()(const f32x4 (&acc)[2][2][4][2], const Unit& u, int wr, int wc, int fr, int fq) const {
        asm volatile("" : "+v"(fr), "+v"(fq));
        const int row0 = u.pm * 256 + wr * 64 + fr, col0 = u.pn * 128 + wc * 32 + 8 * fq;
#pragma unroll
        for (int ai = 0; ai < 2; ++ai)
#pragma unroll
            for (int m = 0; m < 4; ++m) { bf16* p = O + (size_t)(row0 + ai * 128 + m * 16) * DFF + col0;
                const f32x4 g0 = acc[ai][0][m][0], g1 = acc[ai][0][m][1], u0 = acc[ai][1][m][0], u1 = acc[ai][1][m][1];
                u32x4 w; w.x = pk2(g0.x * sigm(g0.x) * u0.x, g0.y * sigm(g0.y) * u0.y); w.y = pk2(g0.z * sigm(g0.z) * u0.z, g0.w * sigm(g0.w) * u0.w);
                w.z = pk2(g1.x * sigm(g1.x) * u1.x, g1.y * sigm(g1.y) * u1.y); w.w = pk2(g1.z * sigm(g1.z) * u1.z, g1.w * sigm(g1.w) * u1.w);
                *(u32x4*)p = w; }
    }
};
struct G2Order {
    pg8::StaticOrder b;
    __device__ bool next(int i, Unit& u) const { if (!b.next(i, u)) return false; u.ko = u.pn < 3 ? 0 : 256; return true; }
    __device__ __forceinline__ void a_ready(const Unit&) const {}
    __device__ __forceinline__ void done(const Unit&) const {}
};
struct SplitOrder {
    int c, G, kh;
    __device__ bool next(int i, Unit& u) const { const long L = (long)i * G + c; if (L >= 16) return false; u.pm = (int)L >> 3; u.pn = ((int)L >> 1) & 3; u.ko = ((int)L & 1) * kh; return true; }
    __device__ __forceinline__ void a_ready(const Unit&) const {}
    __device__ __forceinline__ void done(const Unit&) const {}
};
struct EpiPart {
    static constexpr bool PERM = false, AFTER_DRAIN = false;
    float* P;
    __device__ __forceinline__ void operator()(const f32x4 (&acc)[2][2][4][2], const Unit& u, int wr, int wc, int fr, int fq) const {
        asm volatile("" : "+v"(fr), "+v"(fq));
        const int row0 = u.pm * 256 + wr * 64 + fr, col0 = u.pn * 256 + wc * 32 + 4 * fq; float* O = P + (u.ko ? (size_t)MS * DM : 0);
#pragma unroll
        for (int ai = 0; ai < 2; ++ai)
#pragma unroll
            for (int m = 0; m < 4; ++m) { float* rowp = O + (size_t)(row0 + ai * 128 + m * 16) * DM + col0;
#pragma unroll
                for (int bj = 0; bj < 2; ++bj)
#pragma unroll
                    for (int n = 0; n < 2; ++n) *(f32x4*)(rowp + bj * 128 + n * 16) = acc[ai][bj][m][n]; }
    }
};
struct EpiMix {
    static constexpr bool PERM = false, AFTER_DRAIN = false;
    const float *w0, *a0, *k_a, *b_a, *b_i, *Lp; float *Wd, *Ks, *KK, *BV, *G, *AL, *U; const bf16* A2;
    __device__ __forceinline__ void operator()(const f32x4 (&acc)[2][2][4][2], const Unit& u, int wr, int wc, int fr, int fq) const {
        asm volatile("" : "+v"(fr), "+v"(fq));
        const int row0 = u.pm * 256 + wr * 64 + fr;
        if (u.pn < 3) {
#pragma unroll
            for (int ai = 0; ai < 2; ++ai)
#pragma unroll
                for (int m = 0; m < 4; ++m) { const size_t ro = (size_t)(row0 + ai * 128 + m * 16) * 256;
#pragma unroll
                    for (int bj = 0; bj < 2; ++bj)
#pragma unroll
                        for (int n = 0; n < 2; ++n) { const int c = bj * 128 + wc * 32 + n * 16 + 4 * fq; const f32x4 z = acc[ai][bj][m][n];
                            if (u.pn == 0) { const f32x4 b = *(const f32x4*)(w0 + c); f32x4 d;
                                d.x = __expf(-0.60653066f * sigm(z.x + b.x)); d.y = __expf(-0.60653066f * sigm(z.y + b.y)); d.z = __expf(-0.60653066f * sigm(z.z + b.z)); d.w = __expf(-0.60653066f * sigm(z.w + b.w));
                                *(f32x4*)(Wd + ro + c) = d; }
                            else if (u.pn == 1) { const f32x4 b = *(const f32x4*)(a0 + c), ka = *(const f32x4*)(k_a + c), ks = *(const f32x4*)(Ks + ro + c), kk = *(const f32x4*)(KK + ro + c);
                                f32x4 a; a.x = sigm(z.x + b.x); a.y = sigm(z.y + b.y); a.z = sigm(z.z + b.z); a.w = sigm(z.w + b.w);
                                *(f32x4*)(Ks + ro + c) = ks * (1.f + (a - 1.f) * ka); *(f32x4*)(BV + ro + c) = kk * a; }
                            else { *(f32x4*)(G + ro + c) = z; }
                            asm volatile("" ::: "memory"); } }
        } else {
            const int t = u.pn - 3;
#pragma unroll
            for (int ai = 0; ai < 2; ++ai)
#pragma unroll
                for (int m = 0; m < 4; ++m) { const size_t r = (size_t)(row0 + ai * 128 + m * 16);
#pragma unroll
                    for (int n = 0; n < 2; ++n) { const int cc = 128 * t + wc * 32 + n * 16 + 4 * fq;
                        const f32x4 zr = acc[ai][0][m][n] + *(const f32x4*)(b_a + cc), zi = acc[ai][1][m][n] + *(const f32x4*)(b_i + cc), Lv = *(const f32x4*)(Lp + cc), xc = ld_bf4(A2 + r * K2 + 256 + cc);
                        f32x4 al, uu;
#define LRU1(e) { const float xe = __expf(-Lv.e); const float ls = -xe * (1.f + xe * (-0.5f + xe * 0.33333334f)); const float la = 8.f * sigm(zr.e) * ls; al.e = __expf(la); const float z2 = 2.f * la; \
    const float om = -z2 * (1.f + z2 * (0.5f + z2 * (0.16666667f + z2 * (0.041666668f + z2 * 0.0083333338f)))); uu.e = __builtin_amdgcn_sqrtf(om) * sigm(zi.e) * xc.e; }
                        LRU1(x) LRU1(y) LRU1(z) LRU1(w)
#undef LRU1
                        *(f32x4*)(AL + r * 256 + cc) = al; *(f32x4*)(U + r * 256 + cc) = uu; asm volatile("" ::: "memory"); } }
        }
    }
};
#define RLX_AGENT __ATOMIC_RELAXED, __HIP_MEMORY_SCOPE_AGENT
#define XB_TMO      128
#define XB_XCNT(j)  (256  + 64 * (j))
#define XB_XSUB(j)  (1280 + 64 * (j))
#define XB_XGEN(j)  (2304 + 64 * (j))
#define XB_TOP      3328
#define XB_TOPGEN   3392
#define XCD_BAR_WORDS 3456
#define XB_SPIN_CAP (1u << 18)

__device__ __forceinline__ unsigned xb_ld(unsigned* p)              { return __hip_atomic_load(p, __ATOMIC_RELAXED, __HIP_MEMORY_SCOPE_AGENT); }
__device__ __forceinline__ unsigned xb_add(unsigned* p, unsigned v) { return __hip_atomic_fetch_add(p, v, __ATOMIC_RELAXED, __HIP_MEMORY_SCOPE_AGENT); }
__device__ __forceinline__ unsigned xb_xcc_id() { return (unsigned)__builtin_amdgcn_s_getreg((3 << 11) | 20) & 0xFu; }
#define XB_SPIN(cond, bar) do { unsigned _sp = 0; while (cond) { __builtin_amdgcn_s_sleep(1); \
    if ((++_sp & 255u) == 0u) { if (xb_ld(&(bar)[XB_TMO])) break; if (_sp > XB_SPIN_CAP) { atomicAdd(&(bar)[XB_TMO], 1u); break; } } } } while (0)

struct XcdBarrier {
    unsigned* bar; unsigned x;
    volatile LAS unsigned* st;
};

__device__ __forceinline__ XcdBarrier xcd_barrier_post(unsigned* bar, volatile LAS unsigned* st, int tid) {
    XcdBarrier b; b.bar = bar; b.x = xb_xcc_id(); b.st = st;
    if (tid == 0) (void)xb_add(&bar[XB_XCNT(b.x)], 1u);
    return b;
}
__device__ __forceinline__ void xcd_barrier_complete(unsigned* bar, unsigned x, unsigned& nloc, unsigned& nx) {
    const unsigned G = gridDim.x * gridDim.y * gridDim.z;
    unsigned sum, cnt, mine, sp = 0u;
    for (;;) {
        sum = 0u; cnt = 0u; mine = 0u;
#pragma unroll
        for (unsigned j = 0; j < 16; ++j) { const unsigned c = xb_ld(&bar[XB_XCNT(j)]); sum += c; cnt += (c > 0u) ? 1u : 0u; mine = (j == x) ? c : mine; }
        if (sum == G) break;
        __builtin_amdgcn_s_sleep(1);
        if ((++sp & 255u) == 0u) { if (xb_ld(&bar[XB_TMO])) break; if (sp > XB_SPIN_CAP) { atomicAdd(&bar[XB_TMO], 1u); break; } }
    }
    nloc = mine > 0u ? mine : 1u; nx = cnt > 0u ? cnt : 1u;
}

__device__ __forceinline__ void xcd_barrier(const XcdBarrier& b, int tid) {
    asm volatile("s_waitcnt vmcnt(0)" ::: "memory");
    __syncthreads();
    if (tid == 0) {
        unsigned* bar = b.bar;
        __builtin_amdgcn_s_waitcnt(0);
        unsigned nloc = b.st[0], nx = b.st[1];
        if (nloc == 0u) { xcd_barrier_complete(bar, b.x, nloc, nx); b.st[0] = nloc; b.st[1] = nx; }
        const unsigned old = xb_add(&bar[XB_XSUB(b.x)], 1u);
        const unsigned gen = old / nloc;
        if (old + 1u == (gen + 1u) * nloc) {
            __builtin_amdgcn_fence(__ATOMIC_RELEASE, "agent");
            asm volatile("s_waitcnt vmcnt(0)" ::: "memory");
            const unsigned og = xb_add(&bar[XB_TOP], 1u);
            const unsigned tg = og / nx;
            if (og + 1u == (tg + 1u) * nx) xb_add(&bar[XB_TOPGEN], 1u);
            else XB_SPIN(xb_ld(&bar[XB_TOPGEN]) == tg, bar);
            __builtin_amdgcn_fence(__ATOMIC_ACQUIRE, "agent");
            xb_add(&bar[XB_XGEN(b.x)], 1u);
            asm volatile("s_waitcnt vmcnt(0)" ::: "memory");
        } else {
            XB_SPIN(xb_ld(&bar[XB_XGEN(b.x)]) == gen, bar);
            __builtin_amdgcn_fence(__ATOMIC_ACQUIRE, "agent");
            asm volatile("s_waitcnt vmcnt(0)" ::: "memory");
        }
    }
    __syncthreads();
}
struct Args { const float* in[N_IN]; float* out; unsigned char* ws; };
struct Ctx {
    LAS unsigned char* lds; unsigned char* ws; float* out;
    int tid, lane, wave, bid, G, gw, NGW;
};
__device__ __forceinline__ const float* inp_ld(int k) {
    asm volatile("" : "+s"(k));
    const __attribute__((address_space(4))) unsigned long long* tab = (const __attribute__((address_space(4))) unsigned long long*)__builtin_amdgcn_kernarg_segment_ptr();
    return (const float*)tab[k];
}
#define INP(k) inp_ld(k)
__device__ __forceinline__ int opq(int v) { asm volatile("" : "+v"(v)); return v; }

__device__ __forceinline__ void tr_item(const float* W, int ldw, bf16* WT, int ldt, int k0, int n0, int drow, int dcol, LAS float* scr, int lane) {
#pragma unroll 8
    for (int i = 0; i < 32; ++i) { const int kk = 2 * i + (lane >> 5); scr[kk * 33 + (lane & 31)] = W[(size_t)(k0 + kk) * ldw + n0 + (lane & 31)]; }
    LDS_WAIT(); asm volatile("" ::: "memory");
    const int c = lane & 7;
#pragma unroll
    for (int j = 0; j < 4; ++j) { const int n = (lane >> 3) + 8 * j; const LAS float* s = scr + (8 * c) * 33 + n;
        u32x4 o; o.x = pk2(s[0 * 33], s[1 * 33]); o.y = pk2(s[2 * 33], s[3 * 33]); o.z = pk2(s[4 * 33], s[5 * 33]); o.w = pk2(s[6 * 33], s[7 * 33]);
        *(u32x4*)(WT + (size_t)(drow + n) * ldt + dcol + 8 * c) = o; }
    LDS_WAIT(); asm volatile("" ::: "memory");
}
__device__ __forceinline__ void row_norm_in(const float* xrow, const float* g, bf16* orow, bf16* xcopy, int lane) {
    f32x4 v[4]; float ss = 0.f;
#pragma unroll
    for (int j = 0; j < 4; ++j) { v[j] = *(const f32x4*)(xrow + 4 * lane + 256 * j); ss += dot4(v[j], v[j]); }
    const float rs = rsqrtf(wave_sum(ss) * (1.f / DM) + 1e-6f);
#pragma unroll
    for (int j = 0; j < 4; ++j) { const f32x4 gg = *(const f32x4*)(g + 4 * lane + 256 * j); if (xcopy) st_bf4(xcopy + 4 * lane + 256 * j, v[j]); st_bf4(orow + 4 * lane + 256 * j, v[j] * rs * gg); }
}
__device__ __forceinline__ void row_norm(const bf16* xrow, const float* g, bf16* orow, int lane) {
    f32x4 v[4]; float ss = 0.f;
#pragma unroll
    for (int j = 0; j < 4; ++j) { v[j] = ld_bf4(xrow + 4 * lane + 256 * j); ss += dot4(v[j], v[j]); }
    const float rs = rsqrtf(wave_sum(ss) * (1.f / DM) + 1e-6f);
#pragma unroll
    for (int j = 0; j < 4; ++j) st_bf4(orow + 4 * lane + 256 * j, v[j] * rs * *(const f32x4*)(g + 4 * lane + 256 * j));
}
__device__ __forceinline__ void row_update_parts(const float* p0, const float* p1, const float* bias, const float* gA, bf16* X, const float* gB, bf16* outB, int lane) {
    f32x4 a[4], x[4]; float ss = 0.f;
#pragma unroll
    for (int j = 0; j < 4; ++j) { a[j] = *(const f32x4*)(p0 + 4 * lane + 256 * j) + *(const f32x4*)(p1 + 4 * lane + 256 * j); if (bias) a[j] = a[j] + *(const f32x4*)(bias + 4 * lane + 256 * j);
        x[j] = ld_bf4(X + 4 * lane + 256 * j); ss += dot4(a[j], a[j]); }
    const float rs = rsqrtf(wave_sum(ss) * (1.f / DM) + 1e-6f); float s2 = 0.f;
#pragma unroll
    for (int j = 0; j < 4; ++j) { const f32x4 gg = *(const f32x4*)(gA + 4 * lane + 256 * j); x[j] = x[j] + a[j] * rs * gg; st_bf4(X + 4 * lane + 256 * j, x[j]); s2 += dot4(x[j], x[j]); }
    float r2 = 1.f;
    if (gB) r2 = rsqrtf(wave_sum(s2) * (1.f / DM) + 1e-6f);
#pragma unroll
    for (int j = 0; j < 4; ++j) { f32x4 o = x[j]; if (gB) o = o * r2 * *(const f32x4*)(gB + 4 * lane + 256 * j); st_bf4(outB + 4 * lane + 256 * j, o); }
}
__device__ __forceinline__ void row_update(const bf16* add, const float* gA, bf16* X, const float* gB, bf16* outB, int lane) {
    f32x4 a[4], x[4]; float ss = 0.f;
#pragma unroll
    for (int j = 0; j < 4; ++j) { a[j] = ld_bf4(add + 4 * lane + 256 * j); x[j] = ld_bf4(X + 4 * lane + 256 * j); ss += dot4(a[j], a[j]); }
    const float rs = rsqrtf(wave_sum(ss) * (1.f / DM) + 1e-6f); float s2 = 0.f;
#pragma unroll
    for (int j = 0; j < 4; ++j) { const f32x4 gg = *(const f32x4*)(gA + 4 * lane + 256 * j); x[j] = x[j] + a[j] * rs * gg; st_bf4(X + 4 * lane + 256 * j, x[j]); s2 += dot4(x[j], x[j]); }
    float r2 = 1.f;
    if (gB) r2 = rsqrtf(wave_sum(s2) * (1.f / DM) + 1e-6f);
#pragma unroll
    for (int j = 0; j < 4; ++j) { f32x4 o = x[j]; if (gB) o = o * r2 * *(const f32x4*)(gB + 4 * lane + 256 * j); st_bf4(outB + 4 * lane + 256 * j, o); }
}

__device__ __forceinline__ void convert_layer(const Ctx& C, const Args& A, int l, int gw0, int ngw, int gt, int NT) {
    LAS float* scr = (LAS float*)(C.lds + C.wave * 16384);
    constexpr int J0 = 16 * 72, J1 = 16 * 32, J2 = 16 * 88, J4 = 44 * 32, J5 = 16 * 32, J6 = 4 * 32, JL = J0 + J1 + 2 * J2 + J4 + J5 + J6;
    unsigned char* wl = C.ws + WS_W + (size_t)(l & 1) * WL;
    for (int it = gw0; it < JL; it += ngw) {
        int r = it;
        const float* W; int ldw, ldt, kb, nb, drow; bf16* WT;
        if (r < J0) { W = INP(I_WIN) + (size_t)l * DM * INC; ldw = INC; WT = (bf16*)(wl + O_WIN); ldt = DM; kb = r / 72; nb = r % 72; drow = 32 * nb; }
        else if ((r -= J0) < J1) { W = INP(I_WOUT) + (size_t)l * DM * DM; ldw = DM; WT = (bf16*)(wl + O_WOUT); ldt = DM; kb = r / 32; nb = r % 32; drow = 32 * nb; }
        else if ((r -= J1) < J2) { W = INP(I_WG) + (size_t)l * DM * DFF; ldw = DFF; WT = (bf16*)(wl + O_WGU); ldt = DM; kb = r / 88; nb = r % 88; drow = (nb >> 2) * 256 + (nb & 3) * 32; }
        else if ((r -= J2) < J2) { W = INP(I_WU) + (size_t)l * DM * DFF; ldw = DFF; WT = (bf16*)(wl + O_WGU); ldt = DM; kb = r / 88; nb = r % 88; drow = (nb >> 2) * 256 + 128 + (nb & 3) * 32; }
        else if ((r -= J2) < J4) { W = INP(I_WDN) + (size_t)l * DFF * DM; ldw = DM; WT = (bf16*)(wl + O_WD); ldt = DFF; kb = r / 32; nb = r % 32; drow = 32 * nb; }
        else if ((r -= J4) < J5) { W = INP(I_PGW) + (size_t)l * DM * DM; ldw = DM; WT = (bf16*)(wl + O_WPG); ldt = DM; kb = r / 32; nb = r % 32; drow = 32 * nb; }
        else { r -= J5; W = INP(I_PW) + (size_t)l * PLE * DM; ldw = DM; WT = (bf16*)(wl + O_WP); ldt = PLE; kb = r / 32; nb = r % 32; drow = 32 * nb; }
        tr_item(W, ldw, WT, ldt, 64 * kb, 32 * nb, drow, 64 * kb, scr, C.lane);
    }
#pragma unroll 1
    for (int r = gt; r < N2 * K2; r = opq(r + NT)) {
        const int n = r / K2, k = r % K2; float v = 0.f;
        if (n < 256) { if (k < 64) v = INP(I_WUP)[((size_t)l * 64 + k) * 256 + n]; }
        else if (n < 512) { if (k >= 64 && k < 128) v = INP(I_AUP)[((size_t)l * 64 + (k - 64)) * 256 + (n - 256)]; }
        else if (n < 768) { if (k >= 128 && k < 256) v = INP(I_GUP)[((size_t)l * 128 + (k - 128)) * 256 + (n - 512)]; }
        else { const int tt = (n - 768) >> 8, rr = (n - 768) & 255, cc = 128 * tt + (rr & 127), h = cc >> 6, j = cc & 63;
            if (k >= 256 && ((k - 256) >> 6) == h) v = ((rr >> 7) ? INP(I_WI) : INP(I_WA))[(((size_t)l * 4 + h) * 64 + ((k - 256) & 63)) * 64 + j]; }
        ((bf16*)(wl + O_W2))[r] = (bf16)f2bf(v);
    }
#pragma unroll 1
    for (int r = gt; r < M * (PLE / 4); r = opq(r + NT)) {
        const int m = r >> 6, c4 = (r & 63) * 4;
        const float* src = m < MP ? INP(I_PP) + ((size_t)l * MP + m) * PLE + c4 : INP(I_PS) + ((size_t)l * MS + (m - MP)) * PLE + c4;
        st_bf4((bf16*)(C.ws + WS_PB + (size_t)(l & 1) * SZ_PBL) + (size_t)m * PLE + c4, *(const f32x4*)src);
    }
}
__device__ __forceinline__ void p0_prologue(const Ctx& C, const Args& A) {
    convert_layer(C, A, 0, C.gw, C.NGW, C.bid * 512 + C.tid, C.G * 512);
    for (int m = C.gw; m < M; m += C.NGW) {
        const float* src = m < MP ? INP(I_XP) + (size_t)m * DM : INP(I_XS) + (size_t)(m - MP) * DM;
        row_norm_in(src, INP(I_NMPRE), (bf16*)(C.ws + WS_HN) + (size_t)m * DM, (bf16*)(C.ws + WS_X16) + (size_t)m * DM, C.lane);
    }
}

__device__ __forceinline__ void e1_prep(const Ctx& C, const Args& A, int l) {
    const bf16* PROJ = (const bf16*)(C.ws + WS_R1);
    float* R = (float*)(C.ws + WS_R2); float* Ks = R + (size_t)M * 256; float* V = Ks + (size_t)M * 256; float* KK = V + (size_t)M * 256;
    bf16* A2 = (bf16*)(C.ws + WS_R3);
    const int lane = C.lane, c4 = 4 * lane;
    for (int m = C.gw; m < M; m += C.NGW) {
        const bool samp = m >= MP; int b, t;
        if (!samp) { b = m >> 12; t = m & 4095; } else { b = (m - MP) >> 2; t = (m - MP) & 3; }
        const bf16* pr = PROJ + (size_t)m * INC;
#pragma unroll
        for (int cg = 0; cg < 4; ++cg) {
            const int col = 256 * cg + c4;
            const f32x4 cur = ld_bf4(pr + C_RW + col); f32x4 prv = (f32x4){0.f, 0.f, 0.f, 0.f};
            if (t > 0) prv = ld_bf4(pr - INC + C_RW + col);
            else if (samp) prv = *(const f32x4*)(INP(I_SSH) + ((size_t)l * DB + b) * 1024 + col);
            const f32x4 mu = *(const f32x4*)(INP(I_MU) + l * 1024 + col);
            const f32x4 xs = cur + (prv - cur) * mu;
            if (cg == 0) *(f32x4*)(R + (size_t)m * 256 + c4) = xs;
            else if (cg == 1) { *(f32x4*)(Ks + (size_t)m * 256 + c4) = xs; f32x4 kk = xs * *(const f32x4*)(INP(I_KK) + l * 256 + c4);
                const float ss = red16(dot4(kk, kk)); kk = kk * rsqrtf(fmaxf(ss, 1e-24f)); *(f32x4*)(KK + (size_t)m * 256 + c4) = kk; }
            else if (cg == 2) *(f32x4*)(V + (size_t)m * 256 + c4) = xs;
            else { f32x4 o;
                if (lane < 16) o = (f32x4){tanh_(xs.x), tanh_(xs.y), tanh_(xs.z), tanh_(xs.w)};
                else if (lane < 32) o = xs;
                else o = (f32x4){sigm(xs.x), sigm(xs.y), sigm(xs.z), sigm(xs.w)};
                st_bf4(A2 + (size_t)m * K2 + c4, o); }
        }
        f32x4 xc = *(const f32x4*)(INP(I_CB) + l * 256 + c4);
#pragma unroll
        for (int j = 0; j < 4; ++j) { const int tt = t - 3 + j; f32x4 val = (f32x4){0.f, 0.f, 0.f, 0.f};
            if (tt >= 0) val = ld_bf4(pr + (ptrdiff_t)(j - 3) * INC + C_XB + c4);
            else if (samp) val = *(const f32x4*)(INP(I_SCV) + (((size_t)l * DB + b) * 3 + (tt + 3)) * 256 + c4);
            xc = xc + val * *(const f32x4*)(INP(I_CW) + ((size_t)l * 4 + j) * 256 + c4); }
        st_bf4(A2 + (size_t)m * K2 + 256 + c4, xc);
    }
    const int gt = C.bid * 512 + C.tid, NT = C.G * 512;
    float* out = C.out;
#pragma unroll 1
    for (int e = gt; e < 2 * NBP * 128 * 128; e = opq(e + NT)) {
        const int kv = e / (NBP * 16384), r = e % (NBP * 16384), b = r >> 14, rr = (r >> 7) & 127, c = r & 127;
        out[(kv ? OUT_VP : OUT_KP) + (size_t)l * NBP * 16384 + r] = bf1(PROJ[(size_t)(b * T + T - 128 + rr) * INC + (kv ? C_V : C_K) + c]);
    }
#pragma unroll 1
    for (int e = gt; e < NBP * 1024; e = opq(e + NT)) { const int b = e >> 10, c = e & 1023; out[OUT_SHP + (size_t)l * NBP * 1024 + e] = bf1(PROJ[(size_t)(b * T + T - 1) * INC + C_RW + c]); }
#pragma unroll 1
    for (int e = gt; e < DB * 1024; e = opq(e + NT)) { const int b = e >> 10, c = e & 1023; out[OUT_SHS + (size_t)l * DB * 1024 + e] = bf1(PROJ[(size_t)(MP + 4 * b + 3) * INC + C_RW + c]); }
#pragma unroll 1
    for (int e = gt; e < NBP * 768; e = opq(e + NT)) { const int b = e / 768, j = (e % 768) >> 8, c = e & 255; out[OUT_CVP + (size_t)l * NBP * 768 + e] = bf1(PROJ[(size_t)(b * T + T - 3 + j) * INC + C_XB + c]); }
#pragma unroll 1
    for (int e = gt; e < DB * 768; e = opq(e + NT)) { const int b = e / 768, j = (e % 768) >> 8, c = e & 255; out[OUT_CVS + (size_t)l * DB * 768 + e] = bf1(PROJ[(size_t)(MP + 4 * b + 1 + j) * INC + C_XB + c]); }
}

struct RwkvPtrs { const float *R, *K, *V, *KK, *BV, *W; float* YR; };
__device__ __forceinline__ void rwkv_step(f32x4& s, const f32x4 w, const f32x4 kk, const f32x4 bv, const f32x4 k2, const f32x4 r, const float v, float& y) {
    const float sa = red16(dot4(s, kk));
    s = s * w + (k2 * v - bv * sa);
    y = red16(dot4(s, r));
}
__device__ __forceinline__ void rwkv_prompt(const Ctx& C, const RwkvPtrs& P, int wg, float* wkv_out  ) {
    constexpr int TC = 32, VEC = TC * 64 * 4, O_V = 5 * VEC, BUF = O_V + TC * 16 * 4, O_Q = 2 * BUF;
    static_assert(O_Q + TC * 1024 <= 131072, "LDS");
    const int chain = wg >> 2, b = chain >> 2, h = chain & 3, qr = wg & 3, tid = C.tid, lane = C.lane, wave = C.wave;
    const size_t m0 = (size_t)b * T;
    const int ltid = tid - 256, lstep = ltid >> 4, lq = tid & 15;
    const int vstep = ltid >> 2, vq = ltid & 3;
    f32x4 st[2][5], stv;
    f32x4 s = (f32x4){0.f, 0.f, 0.f, 0.f};
    const int row = 16 * qr + 4 * wave + (lane >> 4), cq = lane & 15;
#define RW_LOAD(c) do { if (wave >= 4) { _Pragma("unroll") for (int u = 0; u < 2; ++u) { const size_t o_ = (m0 + (size_t)(c) * TC + lstep + 16 * u) * 256 + h * 64 + 4 * lq; \
        st[u][0] = *(const f32x4*)(P.W + o_); st[u][1] = *(const f32x4*)(P.KK + o_); st[u][2] = *(const f32x4*)(P.BV + o_); st[u][3] = *(const f32x4*)(P.K + o_); st[u][4] = *(const f32x4*)(P.R + o_); } \
        if (ltid < 128) stv = *(const f32x4*)(P.V + (m0 + (size_t)(c) * TC + vstep) * 256 + h * 64 + 16 * qr + 4 * vq); } } while (0)
#define RW_STORE(bufi) do { if (wave >= 4) { LAS unsigned char* bb = C.lds + (bufi) * BUF; _Pragma("unroll") for (int u = 0; u < 2; ++u) { const int ls = lstep + 16 * u; \
        _Pragma("unroll") for (int i = 0; i < 5; ++i) *(LAS f32x4*)(bb + i * VEC + (ls * 64 + 4 * lq) * 4) = st[u][i]; } \
        if (ltid < 128) *(LAS f32x4*)(bb + O_V + (vstep * 16 + 4 * vq) * 4) = stv; } } while (0)
#define RW_FLUSH(cc, half) do { if (wave >= 4) { const int stp = lstep + 16 * (half); const LAS f32x4* qp = (const LAS f32x4*)(C.lds + O_Q + stp * 1024 + (lq >> 2) * 256 + (lq & 3) * 64); \
        const f32x4 a0 = qp[0], a1_ = qp[1], a2_ = qp[2], a3 = qp[3]; const f32x4 t_ = (a0 + a1_) + (a2_ + a3); \
        P.YR[(m0 + (size_t)(cc) * TC + stp) * 256 + h * 64 + 16 * qr + lq] = (t_.x + t_.y) + (t_.z + t_.w); } } while (0)
    RW_LOAD(0); RW_STORE(0); __syncthreads();
    for (int c = 0; c < T / TC; ++c) {
        if (c > 0) RW_FLUSH(c - 1, 1);
        if (c + 1 < T / TC) RW_LOAD(c + 1);
        if (wave < 4) {
            const LAS unsigned char* bb = C.lds + (c & 1) * BUF;
            const int vo = O_V + (4 * wave + (lane >> 4)) * 4, lo = 16 * cq;
            LAS float* ring = (LAS float*)(C.lds + O_Q) + wave * 64 + lane;
            f32x4 w = *(const LAS f32x4*)(bb + 0 * VEC + lo), kk = *(const LAS f32x4*)(bb + 1 * VEC + lo), bv = *(const LAS f32x4*)(bb + 2 * VEC + lo),
                  k2 = *(const LAS f32x4*)(bb + 3 * VEC + lo), r = *(const LAS f32x4*)(bb + 4 * VEC + lo), rp = r;
            float v = *(const LAS float*)(bb + vo), qpend = 0.f;
            const unsigned b1 = (unsigned)(unsigned long long)(bb + lo), b2 = (unsigned)(unsigned long long)(bb + vo), qa = (unsigned)(unsigned long long)ring;
            f32x4 nw, nkk, nbv, nk2, nr; float nv;
#define RW_A_DOT "v_mul_f32 %6, %10, %14\n\tv_fma_f32 %6, %11, %15, %6\n\tv_fma_f32 %6, %12, %16, %6\n\tv_fma_f32 %6, %13, %17, %6"
#define RW_A_RD "ds_read_b128 %0, %7 offset:%c19\n\tds_read_b128 %1, %7 offset:%c20\n\tds_read_b128 %2, %7 offset:%c21\n\tds_read_b128 %3, %7 offset:%c22\n\tds_read_b128 %4, %7 offset:%c23\n\tds_read_b32 %5, %8 offset:%c24\n\t"
#define RW_A_OPS(IN, WO) : "=&v"(nw), "=&v"(nkk), "=&v"(nbv), "=&v"(nk2), "=&v"(nr), "=&v"(nv), "=&v"(sa) \
                 : "v"(b1), "v"(b2), "v"(qa), "v"(s.x), "v"(s.y), "v"(s.z), "v"(s.w), "v"(kk.x), "v"(kk.y), "v"(kk.z), "v"(kk.w), "v"(qpend), \
                   "n"(0 * VEC + (IN) * 256), "n"(1 * VEC + (IN) * 256), "n"(2 * VEC + (IN) * 256), "n"(3 * VEC + (IN) * 256), "n"(4 * VEC + (IN) * 256), "n"((IN) * 64), "n"(WO) : "memory"
#define RW_STEP(I, IN) { float sa, q, t0, t1, t2, t3; \
                if ((I) < 2 || (I) == 16 || (I) == 17) asm volatile(RW_A_RD "s_waitcnt lgkmcnt(6)\n\t" RW_A_DOT RW_A_OPS(IN, 0)); \
                else asm volatile("ds_write_b32 %9, %18 offset:%c25\n\t" RW_A_RD "s_waitcnt lgkmcnt(7)\n\t" RW_A_DOT RW_A_OPS(IN, ((I) >= 2 ? (I) - 2 : 0) * 1024)); \
                asm volatile("v_mul_f32 %2, %6, %10\n\tv_mul_f32 %3, %7, %10\n\t" \
                             "v_add_f32_dpp %0, %0, %0 quad_perm:[1,0,3,2] row_mask:0xf bank_mask:0xf bound_ctrl:1\n\t" \
                             "v_mul_f32 %1, %11, %15\n\tv_fma_f32 %1, %12, %16, %1\n\t" \
                             "v_add_f32_dpp %0, %0, %0 quad_perm:[2,3,0,1] row_mask:0xf bank_mask:0xf bound_ctrl:1\n\t" \
                             "v_fma_f32 %1, %13, %17, %1\n\tv_fma_f32 %1, %14, %18, %1\n\t" \
                             "v_add_f32_dpp %0, %0, %0 row_half_mirror row_mask:0xf bank_mask:0xf bound_ctrl:1\n\t" \
                             "v_mul_f32 %4, %8, %10\n\tv_mul_f32 %5, %9, %10\n\t" \
                             "v_add_f32_dpp %0, %0, %0 row_ror:8 row_mask:0xf bank_mask:0xf bound_ctrl:1" \
                             : "+v"(sa), "=&v"(q), "=&v"(t0), "=&v"(t1), "=&v"(t2), "=&v"(t3) \
                             : "v"(k2.x), "v"(k2.y), "v"(k2.z), "v"(k2.w), "v"(v), "v"(s.x), "v"(s.y), "v"(s.z), "v"(s.w), "v"(rp.x), "v"(rp.y), "v"(rp.z), "v"(rp.w)); \
                asm volatile("v_fma_f32 %4, -%8, %9, %4\n\tv_fma_f32 %5, -%8, %10, %5\n\tv_fma_f32 %6, -%8, %11, %6\n\tv_fma_f32 %7, -%8, %12, %7\n\t" \
                             "v_fma_f32 %0, %0, %13, %4\n\tv_fma_f32 %1, %1, %14, %5\n\tv_fma_f32 %2, %2, %15, %6\n\tv_fma_f32 %3, %3, %16, %7" \
                             : "+v"(s.x), "+v"(s.y), "+v"(s.z), "+v"(s.w), "+v"(t0), "+v"(t1), "+v"(t2), "+v"(t3) \
                             : "v"(sa), "v"(bv.x), "v"(bv.y), "v"(bv.z), "v"(bv.w), "v"(w.x), "v"(w.y), "v"(w.z), "v"(w.w)); \
                qpend = q; rp = r; w = nw; kk = nkk; bv = nbv; k2 = nk2; r = nr; v = nv; }
#define RW_STEP4(I) RW_STEP(I, (I) + 1) RW_STEP((I) + 1, (I) + 2) RW_STEP((I) + 2, (I) + 3) RW_STEP((I) + 3, ((I) + 4 < TC ? (I) + 4 : TC - 1))
#define RW_HALF_END(h0) do { asm volatile("s_waitcnt lgkmcnt(0)" :: "v"(w), "v"(kk), "v"(bv), "v"(k2), "v"(r), "v"(v) : "memory"); \
                ring[((h0) + 14) * 256] = qpend; ring[((h0) + 15) * 256] = dot4(s, rp); } while (0)
            RW_STEP4(0) RW_STEP4(4) RW_STEP4(8) RW_STEP4(12)
            RW_HALF_END(0);
            __syncthreads();
            RW_STEP4(16) RW_STEP4(20) RW_STEP4(24) RW_STEP4(28)
            RW_HALF_END(16);
#undef RW_HALF_END
#undef RW_STEP4
#undef RW_STEP
#undef RW_A_OPS
#undef RW_A_RD
#undef RW_A_DOT
        } else {
            __syncthreads();
            RW_FLUSH(c, 0);
        }
        if (c + 1 < T / TC) RW_STORE((c + 1) & 1);
        __syncthreads();
    }
    RW_FLUSH(T / TC - 1, 1);
#undef RW_LOAD
#undef RW_STORE
#undef RW_FLUSH
    if (wave < 4) *(f32x4*)(wkv_out + (((size_t)b * 4 + h) * 64 + row) * 64 + 4 * cq) = s;
    __syncthreads();
}
__device__ __forceinline__ void rwkv_sample_item(const RwkvPtrs& P, int item, const float* wkv_in, float* wkv_out, int lane) {
    const int rg = item & 15, h = (item >> 4) & 3, b = item >> 6, row = 4 * rg + (lane >> 4), cq = lane & 15;
    const size_t so = (((size_t)b * 4 + h) * 64 + row) * 64 + 4 * cq;
    f32x4 s = *(const f32x4*)(wkv_in + so);
#pragma unroll
    for (int i = 0; i < DS; ++i) { const size_t m = (size_t)MP + 4 * b + i, o = m * 256 + h * 64 + 4 * cq;
        float y; rwkv_step(s, *(const f32x4*)(P.W + o), *(const f32x4*)(P.KK + o), *(const f32x4*)(P.BV + o), *(const f32x4*)(P.K + o), *(const f32x4*)(P.R + o), P.V[m * 256 + h * 64 + row], y);
        if (cq == 0) P.YR[m * 256 + h * 64 + row] = y; }
    *(f32x4*)(wkv_out + so) = s;
}
__device__ __forceinline__ void lru_prompt_item(const Ctx& C, int item, const float* AL, const float* U, const bf16* PROJ, bf16* MIXCAT, float* lru_out  ) {
    const int b = item >> 4, c = (item & 15) * 16 + (C.tid & 15), seg = C.tid >> 4; constexpr int SL = T / 32;
    const size_t m0 = (size_t)b * T + (size_t)seg * SL;
    LAS float* sA = (LAS float*)C.lds; LAS float* sH = sA + 512;
    float Ap = 1.f, H = 0.f;
#pragma unroll 8
    for (int i = 0; i < SL; ++i) { const float a = AL[(m0 + i) * 256 + c], u = U[(m0 + i) * 256 + c]; H = a * H + u; Ap *= a; }
    sA[C.tid] = Ap; sH[C.tid] = H;
    __syncthreads();
    float h = 0.f;
    for (int sp = 0; sp < seg; ++sp) h = sA[sp * 16 + (C.tid & 15)] * h + sH[sp * 16 + (C.tid & 15)];
#pragma unroll 8
    for (int i = 0; i < SL; ++i) { const float a = AL[(m0 + i) * 256 + c], u = U[(m0 + i) * 256 + c]; h = a * h + u;
        const float gb = bf1(PROJ[(m0 + i) * INC + C_GB + c]); MIXCAT[(m0 + i) * DM + 768 + c] = (bf16)f2bf(h * gelu_t(gb)); }
    if (seg == 31) lru_out[b * 256 + c] = h;
    __syncthreads();
}
__device__ __forceinline__ void swa_prompt_item(const Ctx& C, int item, const bf16* PROJ, bf16* MIXCAT, const float* sinks  ) {
    constexpr int KP = 72, VP = 264;
    const int kvh = item & 1, n = (item >> 1) & 31, b = item >> 6, tid = C.tid, lane = C.lane, wave = C.wave;
    LAS bf16* Ks = (LAS bf16*)C.lds; LAS bf16* Vt = Ks + 256 * KP;
    const size_t rowq0 = (size_t)b * T + (size_t)n * 128;
    { const int key = tid >> 1, hf = tid & 1; size_t kr = rowq0 + key; kr = (kr >= 128 + (size_t)b * T) ? kr - 128 : kr;
        const bf16* kp = PROJ + kr * INC + C_K + kvh * 64 + hf * 32;
#pragma unroll
        for (int i = 0; i < 4; ++i) *(LAS u32x4*)(Ks + key * KP + hf * 32 + 8 * i) = *(const u32x4*)(kp + 8 * i);
#pragma unroll
        for (int i = 0; i < 4; ++i) { const int ch = tid + 512 * i, vk = ch >> 3, d0 = (ch & 7) * 8; size_t vr = rowq0 + vk; vr = (vr >= 128 + (size_t)b * T) ? vr - 128 : vr;
            const u32x4 w = *(const u32x4*)(PROJ + vr * INC + C_V + kvh * 64 + d0);
            Vt[(d0 + 0) * VP + vk] = (bf16)(w.x & 0xffff); Vt[(d0 + 1) * VP + vk] = (bf16)(w.x >> 16); Vt[(d0 + 2) * VP + vk] = (bf16)(w.y & 0xffff); Vt[(d0 + 3) * VP + vk] = (bf16)(w.y >> 16);
            Vt[(d0 + 4) * VP + vk] = (bf16)(w.z & 0xffff); Vt[(d0 + 5) * VP + vk] = (bf16)(w.z >> 16); Vt[(d0 + 6) * VP + vk] = (bf16)(w.w & 0xffff); Vt[(d0 + 7) * VP + vk] = (bf16)(w.w >> 16); } }
    __syncthreads();
    const int q = lane & 31, hi = lane >> 5;
#pragma unroll 1
    for (int qi = 0; qi < 2; ++qi) {
        const int qt = wave * 2 + qi, g = qt >> 2, j = qt & 3, hh = kvh * 4 + g;
        const size_t qrow = rowq0 + 32 * j + q;
        bf16x8 qf[4];
#pragma unroll
        for (int dk = 0; dk < 4; ++dk) qf[dk] = *(const bf16x8*)(PROJ + qrow * INC + hh * 64 + 16 * dk + 8 * hi);
        f32x16 sc[5];
#pragma unroll
        for (int kt = 0; kt < 5; ++kt) {
            f32x16 acc;
#pragma unroll
            for (int i = 0; i < 16; ++i) acc[i] = 0.f;
#pragma unroll
            for (int dk = 0; dk < 4; ++dk) { const bf16x8 kf = *(const LAS bf16x8*)(Ks + (32 * (j + kt) + q) * KP + 16 * dk + 8 * hi); acc = __builtin_amdgcn_mfma_f32_32x32x16_bf16(kf, qf[dk], acc, 0, 0, 0); }
            sc[kt] = acc;
        }
        const int qpos = 128 + 32 * j + q; float mx = -INFINITY;
#pragma unroll
        for (int kt = 0; kt < 5; ++kt)
#pragma unroll
            for (int i = 0; i < 16; ++i) { const int kj = 32 * (j + kt) + (i & 3) + 8 * (i >> 2) + 4 * hi, d = qpos - kj; const bool ok = d >= 0 && d <= 128 && (n > 0 || kj >= 128);
                const float sv = ok ? sc[kt][i] * 0.125f : -INFINITY; sc[kt][i] = sv; mx = fmaxf(mx, sv); }
        mx = fmaxf(mx, shx(mx, 32, lane)); const float sink = sinks[hh]; mx = fmaxf(mx, sink);
        float sum = 0.f;
#pragma unroll
        for (int kt = 0; kt < 5; ++kt)
#pragma unroll
            for (int i = 0; i < 16; ++i) { const float e = __expf(sc[kt][i] - mx); sc[kt][i] = e; sum += e; }
        sum += shx(sum, 32, lane);
        const float inv = 1.f / (sum + __expf(sink - mx));
#pragma unroll
        for (int dt = 0; dt < 2; ++dt) {
            f32x16 o;
#pragma unroll
            for (int i = 0; i < 16; ++i) o[i] = 0.f;
#pragma unroll
            for (int kt = 0; kt < 5; ++kt)
#pragma unroll
                for (int s2 = 0; s2 < 2; ++s2) {
                    u32x4 pw; pw.x = pk2(sc[kt][8 * s2 + 0], sc[kt][8 * s2 + 1]); pw.y = pk2(sc[kt][8 * s2 + 2], sc[kt][8 * s2 + 3]); pw.z = pk2(sc[kt][8 * s2 + 4], sc[kt][8 * s2 + 5]); pw.w = pk2(sc[kt][8 * s2 + 6], sc[kt][8 * s2 + 7]);
                    const LAS bf16* vp = Vt + (32 * dt + q) * VP + 32 * (j + kt) + 16 * s2 + 4 * hi;
                    const u32x2 v0 = *(const LAS u32x2*)vp, v1 = *(const LAS u32x2*)(vp + 8);
                    u32x4 vw; vw.x = v0.x; vw.y = v0.y; vw.z = v1.x; vw.w = v1.y;
                    o = __builtin_amdgcn_mfma_f32_32x32x16_bf16(__builtin_bit_cast(bf16x8, vw), __builtin_bit_cast(bf16x8, pw), o, 0, 0, 0);
                }
#pragma unroll
            for (int g4 = 0; g4 < 4; ++g4) st_bf4(MIXCAT + qrow * DM + hh * 64 + 32 * dt + 8 * g4 + 4 * hi, (f32x4){o[4 * g4] * inv, o[4 * g4 + 1] * inv, o[4 * g4 + 2] * inv, o[4 * g4 + 3] * inv});
        }
    }
    __syncthreads();
}
__device__ __forceinline__ void swa_sample_item(const Ctx& C, int item, const bf16* PROJ, bf16* MIXCAT, const float* sinks, const float* ck, const float* cv, float* ko, float* vo) {
    const int kvh = item & 1, b = item >> 1, tid = C.tid;
    LAS float* Kf = (LAS float*)C.lds; LAS float* Vf = Kf + 132 * 65; LAS float* Qf = Vf + 132 * 64; LAS float* Pf = Qf + 16 * 64;
    for (int e = tid; e < 132 * 64; e += 512) { const int key = e >> 6, d = e & 63; float kx, vx;
        if (key < 128) { const size_t o = (((size_t)b * 128 + key) * 2 + kvh) * 64 + d; kx = ck[o]; vx = cv[o]; }
        else { const size_t r = (size_t)MP + 4 * b + (key - 128); kx = bf1(PROJ[r * INC + C_K + kvh * 64 + d]); vx = bf1(PROJ[r * INC + C_V + kvh * 64 + d]); }
        Kf[key * 65 + d] = kx; Vf[key * 64 + d] = vx;
        if (key >= 4) { const size_t o = (((size_t)b * 128 + (key - 4)) * 2 + kvh) * 64 + d; ko[o] = kx; vo[o] = vx; } }
    for (int e = tid; e < 16 * 64; e += 512) { const int qr = e >> 6, d = e & 63, i = qr >> 2, g = qr & 3; Qf[e] = bf1(PROJ[((size_t)MP + 4 * b + i) * INC + (kvh * 4 + g) * 64 + d]); }
    __syncthreads();
    { const int qr = tid >> 5, kl = tid & 31, i = qr >> 2, g = qr & 3; float sc[5]; float mx = -INFINITY;
#pragma unroll
        for (int k5 = 0; k5 < 5; ++k5) { const int key = kl + 32 * k5; float sv = -INFINITY;
            if (key < 132 && key >= i && key <= i + 128) { float a = 0.f;
#pragma unroll 16
                for (int d = 0; d < 64; ++d) a += Qf[qr * 64 + d] * Kf[key * 65 + d];
                sv = a * 0.125f; }
            sc[k5] = sv; mx = fmaxf(mx, sv); }
#pragma unroll
        for (int o = 1; o < 32; o <<= 1) mx = fmaxf(mx, shx(mx, o, C.lane));
        const float sink = sinks[kvh * 4 + g]; mx = fmaxf(mx, sink); float sum = 0.f;
#pragma unroll
        for (int k5 = 0; k5 < 5; ++k5) { sc[k5] = __expf(sc[k5] - mx); sum += sc[k5]; }
#pragma unroll
        for (int o = 1; o < 32; o <<= 1) sum += shx(sum, o, C.lane);
        const float inv = 1.f / (sum + __expf(sink - mx));
#pragma unroll
        for (int k5 = 0; k5 < 5; ++k5) { const int key = kl + 32 * k5; if (key < 136) Pf[qr * 136 + key] = sc[k5] * inv; } }
    __syncthreads();
    { const int qr = tid >> 5, d = (tid & 31) * 2, i = qr >> 2, g = qr & 3; float o0 = 0.f, o1 = 0.f;
#pragma unroll 4
        for (int key = 0; key < 132; ++key) { const float p = Pf[qr * 136 + key]; o0 += p * Vf[key * 64 + d]; o1 += p * Vf[key * 64 + d + 1]; }
        *(unsigned*)(MIXCAT + ((size_t)MP + 4 * b + i) * DM + (kvh * 4 + g) * 64 + d) = pk2(o0, o1); }
    __syncthreads();
}

__device__ __forceinline__ void s_phase(const Ctx& C, const Args& A, int l) {
    const bf16* PROJ = (const bf16*)(C.ws + WS_R1); bf16* MIXCAT = (bf16*)(C.ws + WS_HN);
    float* R = (float*)(C.ws + WS_R2); const size_t S = (size_t)M * 256;
    RwkvPtrs P{R, R + S, R + 2 * S, R + 3 * S, R + 4 * S, R + 5 * S, (float*)(C.ws + WS_R3)};
    const float* AL = (const float*)(C.ws + WS_R3) + S; const float* U = AL + S;
    float* out = C.out;
    constexpr int NSCAN = 64;
    if (C.bid < NSCAN) { rwkv_prompt(C, P, C.bid, out + OUT_WKVP + (size_t)l * NBP * 4 * 4096); return; }
    constexpr int N0 = 256, N1 = N0 + 64, N2_ = N1 + 256, N3 = N2_ + 1024, N4 = N3 + 64;
    for (int it = C.bid - NSCAN; it < N4; it += C.G - NSCAN) {
        if (it < N0) swa_prompt_item(C, it, PROJ, MIXCAT, INP(I_SINK) + l * 8);
        else if (it < N1) lru_prompt_item(C, it - N0, AL, U, PROJ, MIXCAT, out + OUT_LRP + (size_t)l * NBP * 256);
        else if (it < N2_) swa_sample_item(C, it - N1, PROJ, MIXCAT, INP(I_SINK) + l * 8, INP(I_CK) + (size_t)l * DB * 16384, INP(I_CV) + (size_t)l * DB * 16384,
                                          out + OUT_KS + (size_t)l * DB * 16384, out + OUT_VS + (size_t)l * DB * 16384);
        else if (it < N3) rwkv_sample_item(P, (it - N2_) * 8 + C.wave, INP(I_SWKV) + (size_t)l * DB * 4 * 4096, out + OUT_WKVS + (size_t)l * DB * 4 * 4096, C.lane);
        else { const int e = (it - N3) * 512 + C.tid, b = e >> 8, c = e & 255; float h = INP(I_SLRU)[((size_t)l * DB + b) * 256 + c];
#pragma unroll
            for (int i = 0; i < DS; ++i) { const size_t m = (size_t)MP + 4 * b + i; h = AL[m * 256 + c] * h + U[m * 256 + c];
                MIXCAT[m * DM + 768 + c] = (bf16)f2bf(h * gelu_t(bf1(PROJ[m * INC + C_GB + c]))); }
            out[OUT_LRS + ((size_t)l * DB + b) * 256 + c] = h; }
    }
    if (l + 1 < NL) convert_layer(C, A, l + 1, (C.bid - NSCAN) * 8 + C.wave, (C.G - NSCAN) * 8, (C.bid - NSCAN) * 512 + C.tid, (C.G - NSCAN) * 512);
    __syncthreads();
    { pg8::Gemm g{(const bf16*)(C.ws + WS_PB + (size_t)(l & 1) * SZ_PBL), (const bf16*)(C.ws + WS_W + (size_t)(l & 1) * WL + O_WP), M, DM, PLE}; pg8::StaticOrder So; So.init(M, DM, C.G - NSCAN, C.bid - NSCAN);
      pg8::EpiBf16<0> E{(bf16*)(C.ws + WS_PP), DM, nullptr, 0, 0, 1.f};
      pg8::gemm_phase<pg8::EpiBf16<0>, pg8::StaticOrder, true, true>(C.lds, g, So, E, C.tid); }
}

__device__ __forceinline__ void e3_post(const Ctx& C, const Args& A, int l) {
    const float* R = (const float*)(C.ws + WS_R2); const size_t S = (size_t)M * 256;
    const float *K = R + S, *V = R + 2 * S, *G = R + 6 * S, *YR = (const float*)(C.ws + WS_R3);
    bf16* MIXCAT = (bf16*)(C.ws + WS_HN); const int c4 = 4 * C.lane;
    const f32x4 lw = *(const f32x4*)(INP(I_LNW) + l * 256 + c4), lb = *(const f32x4*)(INP(I_LNB) + l * 256 + c4), rk = *(const f32x4*)(INP(I_RK) + l * 256 + c4);
    for (int m = C.gw; m < M; m += C.NGW) {
        const size_t o = (size_t)m * 256 + c4;
        const f32x4 y = *(const f32x4*)(YR + o), r = *(const f32x4*)(R + o), k = *(const f32x4*)(K + o), v = *(const f32x4*)(V + o), g = *(const f32x4*)(G + o);
        const float mean = red16((y.x + y.y) + (y.z + y.w)) * (1.f / 64.f); const f32x4 d = y - mean;
        const float var = red16(dot4(d, d)) * (1.f / 64.f); const float rs = rsqrtf(var + 64e-5f);
        const float bonus = red16(dot4(r * k, rk));
        st_bf4(MIXCAT + (size_t)m * DM + 512 + c4, (d * rs * lw + lb + v * bonus) * g);
    }
}
constexpr int LDS_BYTES = 131072 + 64;
#ifndef MK_MULTI
#define MK_MULTI 0
#endif
#ifndef MK_DUP
#define MK_DUP 0
#endif
enum { PH_P0 = 0, PH_G1, PH_E1, PH_G2, PH_S, PH_E3, PH_G3, PH_E4, PH_G4, PH_G5, PH_E5, PH_G6, PH_E0, PH_G3B, PH_E4S, PH_G5B, PH_E5S, PH_N };
constexpr int NSPLIT = 16;

__device__ __forceinline__ Ctx make_ctx(int wave0, LAS unsigned char* lds) {
    Ctx D; int z_ = 0; asm volatile("" : "+v"(z_)); int ln_ = __builtin_amdgcn_mbcnt_hi(-1, __builtin_amdgcn_mbcnt_lo(-1, z_));
    D.lane = ln_; D.wave = wave0; D.tid = wave0 * 64 + ln_;
    int b_ = blockIdx.x; asm volatile("" : "+s"(b_)); D.bid = b_; D.gw = b_ * 8 + wave0; D.G = gridDim.x; D.NGW = D.G * 8;
    D.lds = lds; D.out = (float*)inp_ld(N_IN); D.ws = (unsigned char*)inp_ld(N_IN + 1);
    return D;
}
template <int PH> __device__ __forceinline__ void run_phase(const Args& A, int wave0, LAS unsigned char* lds, int l_in) {
    const Ctx C = make_ctx(wave0, lds);
    int l = l_in; asm volatile("" : "+s"(l));
    unsigned char* ws = C.ws; unsigned char* wl = ws + WS_W + (size_t)(l & 1) * WL; (void)wl;
    bf16* HN = (bf16*)(ws + WS_HN); float* MIX = (float*)(ws + WS_R1); float* R2 = (float*)(ws + WS_R2); float* R3 = (float*)(ws + WS_R3); bf16* X = (bf16*)(ws + WS_X16);
    const size_t S = (size_t)M * 256; (void)HN; (void)MIX; (void)R2; (void)R3; (void)X; (void)S;
    if constexpr (PH == PH_P0) p0_prologue(C, A);
    if constexpr (PH == PH_G1) {
        pg8::Gemm g{HN, (const bf16*)(wl + O_WIN), M, INC, DM}; pg8::StaticOrder So; So.init(M, INC, C.G, C.bid);
        pg8::EpiBf16<0> E{(bf16*)(ws + WS_R1), INC, INP(I_BIN) + (size_t)l * INC, 0, 0, 1.f};
        pg8::gemm_phase<pg8::EpiBf16<0>, pg8::StaticOrder, true, true>(C.lds, g, So, E, C.tid); }
    if constexpr (PH == PH_E1) e1_prep(C, A, l);
    if constexpr (PH == PH_G2) {
        pg8::Gemm g{(const bf16*)(ws + WS_R3), (const bf16*)(wl + O_W2), M, N2, K2 / 2, K2}; G2Order So; So.b.init(M, N2, C.G, C.bid);
        EpiMix E{INP(I_W0) + l * 256, INP(I_A0) + l * 256, INP(I_KA) + l * 256, INP(I_BA) + l * 256, INP(I_BI) + l * 256, INP(I_L) + l * 256,
                 R2 + 5 * S, R2 + 1 * S, R2 + 3 * S, R2 + 4 * S, R2 + 6 * S, R3 + S, R3 + 2 * S, (const bf16*)(ws + WS_R3)};
        pg8::gemm_phase<EpiMix, G2Order, true, true>(C.lds, g, So, E, C.tid); }
    if constexpr (PH == PH_S) s_phase(C, A, l);
    if constexpr (PH == PH_E3) e3_post(C, A, l);
    if constexpr (PH == PH_G3) {
        pg8::Gemm g{HN, (const bf16*)(wl + O_WOUT), MP, DM, DM}; pg8::StaticOrder So; So.init(MP, DM, C.G, C.bid);
        pg8::EpiBf16<0> E{(bf16*)MIX, DM, INP(I_BOUT) + (size_t)l * DM, 0, 0, 1.f};
        pg8::gemm_phase<pg8::EpiBf16<0>, pg8::StaticOrder, true, true>(C.lds, g, So, E, C.tid); }
    if constexpr (PH == PH_G3B) {
        if (C.bid < NSPLIT) { pg8::Gemm g{HN + (size_t)MP * DM, (const bf16*)(wl + O_WOUT), MS, DM, DM / 2, DM}; SplitOrder So{C.bid, NSPLIT, DM / 2}; EpiPart E{R3};
            pg8::gemm_phase<EpiPart, SplitOrder, true, true>(C.lds, g, So, E, C.tid); }
        else for (int m = (C.bid - NSPLIT) * 8 + C.wave; m < MP; m += (C.G - NSPLIT) * 8)
            row_update((const bf16*)MIX + (size_t)m * DM, INP(I_NMPOST) + l * DM, X + (size_t)m * DM, INP(I_NFPRE) + l * DM, HN + (size_t)m * DM, C.lane); }
    if constexpr (PH == PH_E4S)
        for (int m = MP + C.gw; m < M; m += C.NGW)
            row_update_parts(R3 + (size_t)(m - MP) * DM, R3 + (size_t)(MS + m - MP) * DM, INP(I_BOUT) + (size_t)l * DM, INP(I_NMPOST) + l * DM, X + (size_t)m * DM, INP(I_NFPRE) + l * DM, HN + (size_t)m * DM, C.lane);
    if constexpr (PH == PH_G4) {
        pg8::Gemm g{HN, (const bf16*)(wl + O_WGU), M, 2 * DFF, DM}; pg8::StaticOrder So; So.init(M, 2 * DFF, C.G, C.bid);
        EpiSwiglu E{(bf16*)(ws + WS_R2)};
        pg8::gemm_phase<EpiSwiglu, pg8::StaticOrder, true, true>(C.lds, g, So, E, C.tid); }
    if constexpr (PH == PH_G5) {
        pg8::Gemm g{(const bf16*)(ws + WS_R2), (const bf16*)(wl + O_WD), MP, DM, DFF}; pg8::StaticOrder So; So.init(MP, DM, C.G, C.bid);
        pg8::EpiBf16<0> E{(bf16*)MIX, DM, nullptr, 0, 0, 1.f};
        pg8::gemm_phase<pg8::EpiBf16<0>, pg8::StaticOrder, true, true>(C.lds, g, So, E, C.tid); }
    if constexpr (PH == PH_G5B) {
        if (C.bid < NSPLIT) { pg8::Gemm g{(const bf16*)(ws + WS_R2) + (size_t)MP * DFF, (const bf16*)(wl + O_WD), MS, DM, DFF / 2, DFF}; SplitOrder So{C.bid, NSPLIT, DFF / 2}; EpiPart E{R3};
            pg8::gemm_phase<EpiPart, SplitOrder, true, true>(C.lds, g, So, E, C.tid); }
        else for (int m = (C.bid - NSPLIT) * 8 + C.wave; m < MP; m += (C.G - NSPLIT) * 8)
            row_update((const bf16*)MIX + (size_t)m * DM, INP(I_NFPOST) + l * DM, X + (size_t)m * DM, nullptr, HN + (size_t)m * DM, C.lane); }
    if constexpr (PH == PH_E5S)
        for (int m = MP + C.gw; m < M; m += C.NGW)
            row_update_parts(R3 + (size_t)(m - MP) * DM, R3 + (size_t)(MS + m - MP) * DM, nullptr, INP(I_NFPOST) + l * DM, X + (size_t)m * DM, nullptr, HN + (size_t)m * DM, C.lane);
    if constexpr (PH == PH_G6) {
        pg8::StaticOrder So; So.init(M, DM, C.G, C.bid);
        pg8::Gemm g{HN, (const bf16*)(wl + O_WPG), M, DM, DM}; EpiPle E{X, (const bf16*)(ws + WS_PP), l == NL - 1 ? C.out : nullptr};
        pg8::gemm_phase<EpiPle, pg8::StaticOrder, true, true>(C.lds, g, So, E, C.tid); }
    if constexpr (PH == PH_E0)
        for (int m = C.gw; m < M; m += C.NGW) row_norm(X + (size_t)m * DM, INP(I_NMPRE) + (l + 1) * DM, HN + (size_t)m * DM, C.lane);
}

#if MK_MULTI
template <int PH> __global__ void __launch_bounds__(512, 2) mk_one(Args A, int l) {
    extern __shared__ __attribute__((aligned(16))) unsigned char lds_raw[];
    const int wave0 = __builtin_amdgcn_readfirstlane((int)threadIdx.x >> 6);
    run_phase<PH>(A, wave0, (LAS unsigned char*)lds_raw, l);
}
#else
__global__ void __launch_bounds__(512, 2) mk_fwd(Args A) {
    extern __shared__ __attribute__((aligned(16))) unsigned char lds_raw[];
    cg::grid_group grid = cg::this_grid();
    const int wave0 = __builtin_amdgcn_readfirstlane((int)threadIdx.x >> 6);
    LAS unsigned char* lds = (LAS unsigned char*)lds_raw;
    if (threadIdx.x < 16) ((LAS unsigned*)lds)[131072 / 4 + threadIdx.x] = 0u;
    __syncthreads();
    const unsigned xbar_x = __builtin_amdgcn_readfirstlane(xcd_barrier_post((unsigned*)inp_ld(N_IN + 1), (volatile LAS unsigned*)(lds + 131072), (int)threadIdx.x).x);
#define GRID_BAR() do { int z_ = 0; asm volatile("" : "+v"(z_)); int ln_ = __builtin_amdgcn_mbcnt_hi(-1, __builtin_amdgcn_mbcnt_lo(-1, z_)); XcdBarrier xb_; xb_.bar = (unsigned*)inp_ld(N_IN + 1); xb_.x = xbar_x; \
        xb_.st = (volatile LAS unsigned*)(lds + 131072); xcd_barrier(xb_, wave0 * 64 + ln_); } while (0)
    run_phase<PH_P0>(A, wave0, lds, 0);
    if (MK_DUP & 1) { GRID_BAR(); run_phase<PH_P0>(A, wave0, lds, 0); }
    grid.sync();
#pragma unroll 1
    for (int l = 0; l < NL; ++l) {
#define RP(PH) do { run_phase<PH>(A, wave0, lds, l); GRID_BAR(); if (MK_DUP & (1 << 20)) GRID_BAR(); if (MK_DUP & (1 << PH)) { run_phase<PH>(A, wave0, lds, l); GRID_BAR(); } } while (0)
        RP(PH_G1); RP(PH_E1); RP(PH_G2); RP(PH_S); RP(PH_E3); RP(PH_G3); RP(PH_G3B); RP(PH_E4S); RP(PH_G4); RP(PH_G5); RP(PH_G5B); RP(PH_E5S);
        run_phase<PH_G6>(A, wave0, lds, l);
        if (l + 1 < NL) { GRID_BAR(); RP(PH_E0); }
    }
}
#endif
}

#if MK_MULTI
template <int PH> static void launch_one(const mk::Args& a, int l, int grid, hipStream_t stream) {
    static bool attr = false;
    if (!attr) { (void)hipFuncSetAttribute((const void*)mk::mk_one<PH>, hipFuncAttributeMaxDynamicSharedMemorySize, mk::LDS_BYTES); attr = true; }
    hipLaunchKernelGGL(mk::mk_one<PH>, dim3(grid), dim3(512), mk::LDS_BYTES, stream, a, l);
}
#endif
extern "C" void kernel_launch(void* const* d_in, const int* in_sizes, int n_in, void* d_out, int out_size, void* d_ws, size_t ws_size, hipStream_t stream) {
    using namespace mk;
    static int grid = 0;
    if (grid == 0) {
        if (n_in != N_IN || (size_t)out_size != OUT_END || ws_size < WS_END) {
            fprintf(stderr, "kernel_launch: shape mismatch: n_in %d (want %d), out %d (want %zu), ws %zu (want >= %zu); nothing launched\n", n_in, (int)N_IN, out_size, (size_t)OUT_END, ws_size, (size_t)WS_END);
            grid = -1; return; }
        int dev = 0, cus = 0;
        (void)hipGetDevice(&dev); (void)hipDeviceGetAttribute(&cus, hipDeviceAttributeMultiprocessorCount, dev);
#if !MK_MULTI
        int per_cu = 0;
        if (hipFuncSetAttribute((const void*)mk_fwd, hipFuncAttributeMaxDynamicSharedMemorySize, LDS_BYTES) != hipSuccess) { fprintf(stderr, "kernel_launch: hipFuncSetAttribute failed\n"); grid = -1; return; }
        if (hipOccupancyMaxActiveBlocksPerMultiprocessor(&per_cu, (const void*)mk_fwd, 512, LDS_BYTES) != hipSuccess || per_cu < 1) fprintf(stderr, "kernel_launch: note: occupancy query gave %d\n", per_cu);
        (void)hipGetLastError();
#endif
        grid = cus;
        if (grid < 128) { fprintf(stderr, "kernel_launch: %d CUs: too few for this kernel\n", grid); grid = -1; return; }
    }
    if (grid < 0) return;
    Args a{};
    for (int i = 0; i < N_IN; ++i) a.in[i] = (const float*)d_in[i];
    a.out = (float*)d_out; a.ws = (unsigned char*)d_ws;
#if MK_MULTI
    launch_one<PH_P0>(a, 0, grid, stream);
    for (int l = 0; l < NL; ++l) {
        launch_one<PH_G1>(a, l, grid, stream); launch_one<PH_E1>(a, l, grid, stream); launch_one<PH_G2>(a, l, grid, stream); launch_one<PH_S>(a, l, grid, stream);
        launch_one<PH_E3>(a, l, grid, stream); launch_one<PH_G3>(a, l, grid, stream); launch_one<PH_E4>(a, l, grid, stream); launch_one<PH_G4>(a, l, grid, stream);
        launch_one<PH_G5>(a, l, grid, stream); launch_one<PH_E5>(a, l, grid, stream); launch_one<PH_G6>(a, l, grid, stream);
        if (l + 1 < NL) launch_one<PH_E0>(a, l, grid, stream);
    }
#else
    if (hipMemsetAsync(d_ws, 0, 65536, stream) != hipSuccess) { fprintf(stderr, "kernel_launch: hipMemsetAsync failed\n"); return; }
    void* args[] = {&a};
    const hipError_t e = hipLaunchCooperativeKernel((const void*)mk_fwd, dim3(grid), dim3(512), args, LDS_BYTES, stream);
    if (e != hipSuccess) fprintf(stderr, "kernel_launch: cooperative launch failed: %s (grid %d)\n", hipGetErrorString(e), grid);
#endif
}
```

```cpp
#include <hip/hip_runtime.h>
#include <hip/hip_cooperative_groups.h>
#include <cstdio>
#include <cstdint>
#include <cstddef>
#include <cmath>
namespace cg = cooperative_groups;
namespace pg8 {
#define PG8_LAS __attribute__((address_space(3)))
typedef unsigned short bf16_t;
typedef short bf16x8 __attribute__((ext_vector_type(8)));
typedef float f32x4 __attribute__((ext_vector_type(4)));
typedef unsigned u32x4 __attribute__((ext_vector_type(4)));
constexpr int BM = 256, BK = 64, HALF = 128, HTB = HALF * BK * 2  , STAGE_BYTES = 8 * HTB, NXCD = 8, WGM = 8;

__host__ __device__ __forceinline__ int lds_byte(int r, int c) { const int st = (r >> 4) * 2 + (c >> 5), rr = r & 15, cc = c & 31, ob = rr * 64 + cc * 2; return st * 1024 + (ob ^ (((ob >> 9) & 1) << 5)); }
__host__ __device__ __forceinline__ void stage_rc(int b, int& R, int& C) { const int st = b / 1024, sb = b % 1024, swz = sb ^ (((sb >> 9) & 1) << 5); R = (st >> 1) * 16 + swz / 64; C = (st & 1) * 32 + (swz % 64) / 2; }
__host__ __device__ __forceinline__ int perm32(int rho) { const int n = rho >> 4, i = rho & 15; return 8 * (i >> 2) + 4 * n + (i & 3); }

struct Unit { int pm, pn, ko = 0; };
struct Gemm { const bf16_t* A; const bf16_t* Bt; int M, N, K; int ld = 0; };

struct StaticOrder {
    int nM, nN, nwg, G, c;
    __host__ __device__ void init(int M, int N, int G_, int c_) { nM = M / BM; nN = N / BM; nwg = nM * nN; G = G_; c = c_; }
    __host__ __device__ bool next(int i, Unit& u) const {
        const long L = (long)i * G + c; if (L >= nwg) return false;
        int wgid = (int)L; { const int q = nwg / NXCD, r = nwg % NXCD, xcd = wgid % NXCD, off = wgid / NXCD; wgid = (xcd < r ? xcd * (q + 1) : r * (q + 1) + (xcd - r) * q) + off; }
        const int nig = WGM * nN, gid = wgid / nig, fm = gid * WGM, gsz = (nM - fm) < WGM ? (nM - fm) : WGM;
        u.pm = fm + ((wgid % nig) % gsz); u.pn = (wgid % nig) / gsz; return true;
    }
    __device__ __forceinline__ void a_ready(const Unit&) const {}
    __device__ __forceinline__ void done(const Unit&) const {}
};

__device__ __forceinline__ unsigned cvt_pk_bf16(float lo, float hi) { unsigned r; asm volatile("v_cvt_pk_bf16_f32 %0, %1, %2" : "=v"(r) : "v"(lo), "v"(hi)); return r; }
typedef float f32x2 __attribute__((ext_vector_type(2)));
__device__ __forceinline__ f32x2 gelu_pk(f32x2 v) {
    const f32x2 av = __builtin_elementwise_abs(v), d = av * 0.2316418882f + 1.0f;
    f32x2 t; t.x = __builtin_amdgcn_rcpf(d.x); t.y = __builtin_amdgcn_rcpf(d.y);
    f32x2 q = t * 0.5307027145f + (-0.7265760135f); q = q * t + 0.7107068705f; q = q * t + (-0.142248368f); q = q * t + 0.127414796f; q = q * t;
    const f32x2 s = (v * v) * (-0.72134752044f);
    f32x2 e; e.x = __builtin_amdgcn_exp2f(s.x); e.y = __builtin_amdgcn_exp2f(s.y);
    const f32x2 m = v * (q * e), r = v - m;
    f32x2 o; o.x = v.x < 0.f ? m.x : r.x; o.y = v.y < 0.f ? m.y : r.y; return o;
}

template <int ACT  > struct EpiBf16 {
    static constexpr bool PERM = true, AFTER_DRAIN = false; static_assert(ACT == 0 || ACT == 1, "EpiBf16: ACT is 0 (none) or 1 (gelu_pk)");
    bf16_t* O; int ldc; const float* bias; int split_cols; size_t split_stride; float scale0;
    __device__ __forceinline__ void operator()(const f32x4 (&acc)[2][2][4][2], const Unit& u, int wr, int wc, int fr, int fq) const {
        const int row0 = u.pm * BM + wr * 64 + fr; int colt = u.pn * BM; bf16_t* base = O;
        float sc = 1.f; if (split_cols) { const int t = colt / split_cols; base += (size_t)t * split_stride; colt -= t * split_cols; if (t == 0) sc = scale0; }
        const int col0 = colt + wc * 32 + 8 * fq, bcol0 = u.pn * BM + wc * 32 + 8 * fq;
        f32x4 bv[2][2];
#pragma unroll
        for (int bj = 0; bj < 2; ++bj)
#pragma unroll
            for (int n = 0; n < 2; ++n) bv[bj][n] = bias ? *(const f32x4*)(bias + bcol0 + bj * HALF + 4 * n) : (f32x4){0.f, 0.f, 0.f, 0.f};
#pragma unroll
        for (int ai = 0; ai < 2; ++ai)
#pragma unroll
            for (int m = 0; m < 4; ++m) { bf16_t* rowp = base + (size_t)(row0 + ai * HALF + m * 16) * ldc + col0;
#pragma unroll
                for (int bj = 0; bj < 2; ++bj) { f32x4 v0 = acc[ai][bj][m][0] + bv[bj][0], v1 = acc[ai][bj][m][1] + bv[bj][1];
                    if (ACT == 1) { f32x2 a = gelu_pk((f32x2){v0[0], v0[1]}), b = gelu_pk((f32x2){v0[2], v0[3]}), c = gelu_pk((f32x2){v1[0], v1[1]}), d = gelu_pk((f32x2){v1[2], v1[3]});
                        v0 = (f32x4){a.x, a.y, b.x, b.y}; v1 = (f32x4){c.x, c.y, d.x, d.y}; }
                    v0 = v0 * sc; v1 = v1 * sc; u32x4 w; w.x = cvt_pk_bf16(v0[0], v0[1]); w.y = cvt_pk_bf16(v0[2], v0[3]); w.z = cvt_pk_bf16(v1[0], v1[1]); w.w = cvt_pk_bf16(v1[2], v1[3]);
                    *(u32x4*)(rowp + bj * HALF) = w; } }
    }
};
template <class Epi, class Sched, bool ALIGN_EPI = false, bool SP2 = false>
__device__ __forceinline__ void gemm_phase(PG8_LAS unsigned char* lds, const Gemm g, const Sched& S, const Epi& E, int tid_in) {
    int tid_ = tid_in; asm volatile("" : "+v"(tid_));
    const int tid = tid_, wid = __builtin_amdgcn_readfirstlane(tid >> 6), lane = tid & 63, wr = wid >> 2, wc = wid & 3, fr = lane & 15, fq = lane >> 4;
    const int K = g.K, nt = K / BK, LD = g.ld ? g.ld : g.K;
    unsigned voffA[2], voffB[2];
#pragma unroll
    for (int i = 0; i < 2; ++i) { int R, C; stage_rc(tid * 16 + i * 8192, R, C); const int Rb = Epi::PERM ? ((R & ~31) + perm32(R & 31)) : R;
        voffA[i] = (unsigned)(R * LD + C) * 2u; voffB[i] = (unsigned)(Rb * LD + C) * 2u; }
    const size_t kstep = (size_t)(BK * 2);
    const size_t hstep = (size_t)HALF * LD * 2;
    const size_t tstep = 2 * hstep;
    const unsigned ldsw = (unsigned)wid * 1024u;
    const int aoff = lds_byte(wr * 64 + fr, fq * 8), boff = lds_byte(wc * 32 + fr, fq * 8);
#define PG8_SA(b, h) (((b) * 2 + (h)) * HTB)
#define PG8_SB(b, h) ((4 + (b) * 2 + (h)) * HTB)
#define PG8_STAGE(bufoff, gbase, voff) do { _Pragma("unroll") for (int _i = 0; _i < 2; ++_i) \
        __builtin_amdgcn_global_load_lds((const unsigned*)((const char*)(gbase) + (voff)[_i]), (PG8_LAS unsigned*)(lds + (bufoff) + ldsw + _i * 8192), 16, 0, 0); } while (0)
#define PG8_LDA(dst, b, h) do { _Pragma("unroll") for (int m = 0; m < 4; ++m) _Pragma("unroll") for (int k = 0; k < 2; ++k) dst[m][k] = *(const PG8_LAS bf16x8*)(lds + PG8_SA(b, h) + aoff + m * 2048 + k * 1024); } while (0)
#define PG8_LDB(dst, b, h) do { _Pragma("unroll") for (int n = 0; n < 2; ++n) _Pragma("unroll") for (int k = 0; k < 2; ++k) dst[n][k] = *(const PG8_LAS bf16x8*)(lds + PG8_SB(b, h) + boff + n * 2048 + k * 1024); } while (0)
#define PG8_MMA(ai, bj, At, Bt) do { __builtin_amdgcn_s_setprio(1); _Pragma("unroll") for (int m = 0; m < 4; ++m) _Pragma("unroll") for (int n = 0; n < 2; ++n) _Pragma("unroll") for (int k = 0; k < 2; ++k) \
        acc[ai][bj][m][n] = __builtin_amdgcn_mfma_f32_16x16x32_bf16(Bt[n][k], At[m][k], acc[ai][bj][m][n], 0, 0, 0); __builtin_amdgcn_s_setprio(0); } while (0)
#define PG8_WAIT_V(n) asm volatile("s_waitcnt vmcnt(" #n ")" ::: "memory")
#define PG8_WAIT_L(n) asm volatile("s_waitcnt lgkmcnt(" #n ")" ::: "memory")
#define PG8_BAR __builtin_amdgcn_s_barrier()
#define PG8_SCHED __builtin_amdgcn_sched_barrier(0)
    Unit cur, nxt; int ui = 0;
    if (!S.next(0, cur)) return;
    f32x4 acc[2][2][4][2];
#pragma unroll
    for (int a = 0; a < 2; ++a)
#pragma unroll
        for (int b = 0; b < 2; ++b)
#pragma unroll
            for (int m = 0; m < 4; ++m)
#pragma unroll
                for (int n = 0; n < 2; ++n) acc[a][b][m][n] = (f32x4){0.f, 0.f, 0.f, 0.f};
    bf16x8 At[4][2], B0[2][2], B1[2][2];
    const char* cA = (const char*)g.A + (size_t)cur.pm * tstep + (size_t)cur.ko * 2; const char* cB = (const char*)g.Bt + (size_t)cur.pn * tstep + (size_t)cur.ko * 2;
    S.a_ready(cur);
    if constexpr (SP2) {
        PG8_STAGE(PG8_SB(0, 0), cB, voffB); PG8_STAGE(PG8_SB(0, 1), cB + hstep, voffB); PG8_STAGE(PG8_SA(0, 0), cA, voffA); PG8_STAGE(PG8_SA(0, 1), cA + hstep, voffA);
        if (wr == 1) PG8_BAR;
        PG8_WAIT_V(2); PG8_BAR;
        PG8_STAGE(PG8_SB(1, 0), cB + kstep, voffB); PG8_STAGE(PG8_SA(1, 0), cA + kstep, voffA); PG8_STAGE(PG8_SB(1, 1), cB + hstep + kstep, voffB);
        PG8_WAIT_V(6); PG8_BAR;
    } else {
        PG8_STAGE(PG8_SB(0, 0), cB, voffB); PG8_STAGE(PG8_SA(0, 0), cA, voffA); PG8_STAGE(PG8_SB(0, 1), cB + hstep, voffB); PG8_STAGE(PG8_SA(0, 1), cA + hstep, voffA);
        if (wr == 1) PG8_BAR;
        PG8_WAIT_V(4); PG8_BAR;
        PG8_STAGE(PG8_SB(1, 0), cB + kstep, voffB); PG8_STAGE(PG8_SA(1, 0), cA + kstep, voffA); PG8_STAGE(PG8_SB(1, 1), cB + hstep + kstep, voffB);
        PG8_WAIT_V(6); PG8_BAR;
    }
    for (;;) {
        const bool has_next = S.next(ui + 1, nxt);
        const char* nA = has_next ? (const char*)g.A + (size_t)nxt.pm * tstep + (size_t)nxt.ko * 2 : cA; const char* nB = has_next ? (const char*)g.Bt + (size_t)nxt.pn * tstep + (size_t)nxt.ko * 2 : cB;
        for (int t = 0; t < nt; t += 2) {
            const bool last = (t == nt - 2);
            const char* a1 = cA + (size_t)(t + 1) * kstep;
            const char* a2 = last ? nA : cA + (size_t)(t + 2) * kstep; const char* b2 = last ? nB : cB + (size_t)(t + 2) * kstep;
            const char* a3 = a2 + kstep; const char* b3 = b2 + kstep;
            if (last && has_next) S.a_ready(nxt);
            if constexpr (SP2) {
            PG8_LDB(B0, 0, 0); PG8_LDB(B1, 0, 1); PG8_SCHED; PG8_LDA(At, 0, 0); PG8_STAGE(PG8_SA(1, 1), a1 + hstep, voffA);
            PG8_WAIT_V(8); PG8_WAIT_L(0); PG8_BAR; PG8_MMA(0, 0, At, B0); PG8_MMA(0, 1, At, B1); PG8_BAR; PG8_SCHED;
            PG8_LDA(At, 0, 1); PG8_STAGE(PG8_SB(0, 0), b2, voffB); PG8_STAGE(PG8_SB(0, 1), b2 + hstep, voffB); PG8_STAGE(PG8_SA(0, 0), a2, voffA);
            PG8_WAIT_V(8); PG8_WAIT_L(0); PG8_BAR; PG8_MMA(1, 0, At, B0); PG8_MMA(1, 1, At, B1); PG8_BAR; PG8_SCHED;
            PG8_LDB(B0, 1, 0); PG8_LDB(B1, 1, 1); PG8_SCHED; PG8_LDA(At, 1, 0); PG8_STAGE(PG8_SA(0, 1), a2 + hstep, voffA);
            PG8_WAIT_V(8); PG8_WAIT_L(0); PG8_BAR; PG8_MMA(0, 0, At, B0); PG8_MMA(0, 1, At, B1); PG8_BAR; PG8_SCHED;
            PG8_LDA(At, 1, 1); PG8_STAGE(PG8_SB(1, 0), b3, voffB); PG8_STAGE(PG8_SB(1, 1), b3 + hstep, voffB); PG8_STAGE(PG8_SA(1, 0), a3, voffA);
            PG8_WAIT_V(8); PG8_WAIT_L(0); PG8_BAR; PG8_MMA(1, 0, At, B0); PG8_MMA(1, 1, At, B1); PG8_BAR; PG8_SCHED;
            } else {
            PG8_LDB(B0, 0, 0); PG8_SCHED; PG8_LDA(At, 0, 0); PG8_STAGE(PG8_SA(1, 1), a1 + hstep, voffA);
            PG8_WAIT_L(8); PG8_BAR; PG8_WAIT_L(0); PG8_MMA(0, 0, At, B0); PG8_BAR; PG8_SCHED;
            PG8_LDB(B1, 0, 1); PG8_STAGE(PG8_SB(0, 0), b2, voffB);
            PG8_BAR; PG8_WAIT_L(0); PG8_MMA(0, 1, At, B1); PG8_BAR;
            PG8_LDA(At, 0, 1); PG8_STAGE(PG8_SA(0, 0), a2, voffA);
            PG8_BAR; PG8_WAIT_L(0); PG8_MMA(1, 0, At, B0); PG8_BAR; PG8_SCHED;
            PG8_STAGE(PG8_SB(0, 1), b2 + hstep, voffB);
            PG8_WAIT_V(6); PG8_BAR; PG8_MMA(1, 1, At, B1); PG8_BAR;
            PG8_LDB(B0, 1, 0); PG8_SCHED; PG8_LDA(At, 1, 0); PG8_STAGE(PG8_SA(0, 1), a2 + hstep, voffA);
            PG8_WAIT_L(8); PG8_BAR; PG8_WAIT_L(0); PG8_MMA(0, 0, At, B0); PG8_BAR; PG8_SCHED;
            PG8_LDB(B1, 1, 1); PG8_STAGE(PG8_SB(1, 0), b3, voffB);
            PG8_BAR; PG8_WAIT_L(0); PG8_MMA(0, 1, At, B1); PG8_BAR;
            PG8_LDA(At, 1, 1); PG8_STAGE(PG8_SA(1, 0), a3, voffA);
            PG8_BAR; PG8_WAIT_L(0); PG8_MMA(1, 0, At, B0); PG8_BAR; PG8_SCHED;
            PG8_STAGE(PG8_SB(1, 1), b3 + hstep, voffB);
            PG8_WAIT_V(6); PG8_BAR; PG8_MMA(1, 1, At, B1); PG8_BAR;
            }
        }
        if constexpr (ALIGN_EPI) { if (wr == 0) PG8_BAR; }
        if constexpr (!Epi::AFTER_DRAIN) { int z_ = 0; asm volatile("" : "+v"(z_)); const int ln_ = __builtin_amdgcn_mbcnt_hi(-1, __builtin_amdgcn_mbcnt_lo(-1, z_)); E(acc, cur, wr, wc, ln_ & 15, ln_ >> 4); S.done(cur); }
        if (!has_next) break;
#pragma unroll
        for (int a = 0; a < 2; ++a)
#pragma unroll
            for (int b = 0; b < 2; ++b)
#pragma unroll
                for (int m = 0; m < 4; ++m)
#pragma unroll
                    for (int n = 0; n < 2; ++n) acc[a][b][m][n] = (f32x4){0.f, 0.f, 0.f, 0.f};
        cur = nxt; cA = nA; cB = nB; ++ui;
        if constexpr (ALIGN_EPI) { if (wr == 1) PG8_BAR; }
    }
    PG8_WAIT_V(0);
    if constexpr (!ALIGN_EPI) { if (wr == 0) PG8_BAR; }
    PG8_BAR;
    if constexpr (Epi::AFTER_DRAIN) { E.fused(acc, cur, wr, wc, fr, fq, lds, wid, lane); S.done(cur); }
#undef PG8_SA
#undef PG8_SB
#undef PG8_STAGE
#undef PG8_LDA
#undef PG8_LDB
#undef PG8_MMA
#undef PG8_WAIT_V
#undef PG8_WAIT_L
#undef PG8_BAR
#undef PG8_SCHED
}
}
namespace mk {
typedef pg8::bf16_t bf16;
typedef pg8::f32x4 f32x4;
typedef pg8::u32x4 u32x4;
typedef pg8::bf16x8 bf16x8;
typedef pg8::Unit Unit;
typedef float f32x16 __attribute__((ext_vector_type(16)));
typedef unsigned u32x2 __attribute__((ext_vector_type(2)));
typedef float f32x2 __attribute__((ext_vector_type(2)));
#define LAS __attribute__((address_space(3)))
#define LDS_WAIT() asm volatile("s_waitcnt lgkmcnt(0)" ::: "memory")

constexpr int DM = 1024, T = 4096, NBP = 4, MP = NBP * T, DB = 128, DS = 4, MS = DB * DS, M = MP + MS, NL = 4;
constexpr int INC = 2304, DFF = 2816, K2 = 512, N2 = 1280, PLE = 256;
constexpr int C_K = 512, C_V = 640, C_RW = 768, C_XB = 1792, C_GB = 2048;

constexpr size_t SZ_WIN = (size_t)INC * DM * 2, SZ_W2 = (size_t)N2 * K2 * 2, SZ_WOUT = (size_t)DM * DM * 2, SZ_WGU = (size_t)2 * DFF * DM * 2,
                 SZ_WD = (size_t)DM * DFF * 2, SZ_WPG = (size_t)DM * DM * 2, SZ_WP = (size_t)DM * PLE * 2;
constexpr size_t O_WIN = 0, O_W2 = O_WIN + SZ_WIN, O_WOUT = O_W2 + SZ_W2, O_WGU = O_WOUT + SZ_WOUT, O_WD = O_WGU + SZ_WGU, O_WPG = O_WD + SZ_WD,
                 O_WP = O_WPG + SZ_WPG, WL = O_WP + SZ_WP;
constexpr size_t WS_W = 1u << 20  , SZ_PBL = (size_t)M * PLE * 2, WS_X16 = WS_W + 2 * WL  , WS_PB = WS_X16 + (size_t)M * DM * 2  , SZ_ACT = (size_t)M * DM * 2, WS_PP = WS_PB + 2 * SZ_PBL  , WS_HN = WS_PP + SZ_ACT,
                 WS_R1 = WS_HN + SZ_ACT, SZ_R1 = (size_t)M * INC * 2, WS_R2 = WS_R1 + SZ_R1, SZ_F256 = (size_t)M * 256 * 4, WS_R3 = WS_R2 + 7 * SZ_F256,
                 WS_END = WS_R3 + 3 * SZ_F256;
static_assert(WL % 256 == 0 && SZ_R1 >= (size_t)M * DM * 4 && 7 * SZ_F256 >= (size_t)M * DFF * 2, "ws map");

constexpr size_t OUT_Y = 0, OUT_KP = (size_t)M * DM, OUT_VP = OUT_KP + (size_t)NL * NBP * 128 * 128, OUT_SHP = OUT_VP + (size_t)NL * NBP * 128 * 128,
                 OUT_WKVP = OUT_SHP + (size_t)NL * NBP * 1024, OUT_CVP = OUT_WKVP + (size_t)NL * NBP * 4 * 4096, OUT_LRP = OUT_CVP + (size_t)NL * NBP * 768,
                 OUT_KS = OUT_LRP + (size_t)NL * NBP * 256, OUT_VS = OUT_KS + (size_t)NL * DB * 128 * 128, OUT_SHS = OUT_VS + (size_t)NL * DB * 128 * 128,
                 OUT_WKVS = OUT_SHS + (size_t)NL * DB * 1024, OUT_CVS = OUT_WKVS + (size_t)NL * DB * 4 * 4096, OUT_LRS = OUT_CVS + (size_t)NL * DB * 768,
                 OUT_END = OUT_LRS + (size_t)NL * DB * 256;

enum { I_XP = 0, I_XS, I_CK, I_CV, I_SSH, I_SWKV, I_SCV, I_SLRU, I_PP, I_PS, I_NMPRE, I_NMPOST, I_NFPRE, I_NFPOST, I_WIN, I_BIN, I_SINK, I_MU, I_W0, I_WUP,
       I_A0, I_AUP, I_GUP, I_KK, I_KA, I_RK, I_LNW, I_LNB, I_CW, I_CB, I_WA, I_BA, I_WI, I_BI, I_L, I_WOUT, I_BOUT, I_WG, I_WU, I_WDN, I_PW, I_PGW, N_IN };

__device__ __forceinline__ unsigned f2bf(float f) { unsigned u = __float_as_uint(f); return (u + 0x7fffu + ((u >> 16) & 1u)) >> 16; }
__device__ __forceinline__ unsigned pk2(float lo, float hi) { return f2bf(lo) | (f2bf(hi) << 16); }
__device__ __forceinline__ float bflo(unsigned w) { return __uint_as_float(w << 16); }
__device__ __forceinline__ float bfhi(unsigned w) { return __uint_as_float(w & 0xffff0000u); }
__device__ __forceinline__ float bf1(bf16 b) { return __uint_as_float((unsigned)b << 16); }
__device__ __forceinline__ f32x4 ld_bf4(const bf16* p) { const u32x2 w = *(const u32x2*)p; return (f32x4){bflo(w.x), bfhi(w.x), bflo(w.y), bfhi(w.y)}; }
__device__ __forceinline__ void st_bf4(bf16* p, f32x4 v) { u32x2 w; w.x = pk2(v.x, v.y); w.y = pk2(v.z, v.w); *(u32x2*)p = w; }
__device__ __forceinline__ float sigm(float x) { return __builtin_amdgcn_rcpf(1.f + __expf(-x)); }
__device__ __forceinline__ float tanh_(float x) { return 1.f - 2.f * __builtin_amdgcn_rcpf(__expf(2.f * x) + 1.f); }
__device__ __forceinline__ float gelu_t(float x) { return 0.5f * x * (1.f + tanh_(0.7978845608f * (x + 0.044715f * x * x * x))); }
template <int CTRL> __device__ __forceinline__ float dppf(float x) { return __builtin_bit_cast(float, __builtin_amdgcn_mov_dpp(__builtin_bit_cast(int, x), CTRL, 0xf, 0xf, true)); }
__device__ __forceinline__ float red16(float x) { x += dppf<0xB1>(x); x += dppf<0x4E>(x); x += dppf<0x141>(x); x += dppf<0x128>(x); return x; }
__device__ __forceinline__ float wave_sum(float v) {
    v = red16(v);
    v += __builtin_bit_cast(float, __builtin_amdgcn_update_dpp(0, __builtin_bit_cast(int, v), 0x142, 0xa, 0xf, false));
    v += __builtin_bit_cast(float, __builtin_amdgcn_update_dpp(0, __builtin_bit_cast(int, v), 0x143, 0xc, 0xf, false));
    return __builtin_bit_cast(float, __builtin_amdgcn_readlane(__builtin_bit_cast(int, v), 63));
}
__device__ __forceinline__ float vmul(float a, float b) { float d; asm("v_mul_f32 %0, %1, %2" : "=v"(d) : "v"(a), "v"(b)); return d; }
__device__ __forceinline__ float vfma(float a, float b, float c) { float d; asm("v_fma_f32 %0, %1, %2, %3" : "=v"(d) : "v"(a), "v"(b), "v"(c)); return d; }
__device__ __forceinline__ float vfnma(float a, float b, float c) { float d; asm("v_fma_f32 %0, -%1, %2, %3" : "=v"(d) : "v"(a), "v"(b), "v"(c)); return d; }
__device__ __forceinline__ void red16x2(float& p, float& q) {
    asm volatile("v_add_f32_dpp %0, %0, %0 quad_perm:[1,0,3,2] row_mask:0xf bank_mask:0xf bound_ctrl:1\n\t"
                 "v_add_f32_dpp %1, %1, %1 quad_perm:[1,0,3,2] row_mask:0xf bank_mask:0xf bound_ctrl:1\n\ts_nop 0\n\t"
                 "v_add_f32_dpp %0, %0, %0 quad_perm:[2,3,0,1] row_mask:0xf bank_mask:0xf bound_ctrl:1\n\t"
                 "v_add_f32_dpp %1, %1, %1 quad_perm:[2,3,0,1] row_mask:0xf bank_mask:0xf bound_ctrl:1\n\ts_nop 0\n\t"
                 "v_add_f32_dpp %0, %0, %0 row_half_mirror row_mask:0xf bank_mask:0xf bound_ctrl:1\n\t"
                 "v_add_f32_dpp %1, %1, %1 row_half_mirror row_mask:0xf bank_mask:0xf bound_ctrl:1\n\ts_nop 0\n\t"
                 "v_add_f32_dpp %0, %0, %0 row_ror:8 row_mask:0xf bank_mask:0xf bound_ctrl:1\n\t"
                 "v_add_f32_dpp %1, %1, %1 row_ror:8 row_mask:0xf bank_mask:0xf bound_ctrl:1\n\ts_nop 1"
                 : "+v"(p), "+v"(q));
}
__device__ __forceinline__ float shx(float v, int mask, int lane) { return __builtin_bit_cast(float, __builtin_amdgcn_ds_bpermute((lane ^ mask) << 2, __builtin_bit_cast(int, v))); }
__device__ __forceinline__ float dot4(f32x4 a, f32x4 b) { return (a.x * b.x + a.y * b.y) + (a.z * b.z + a.w * b.w); }

struct EpiF32 {
    static constexpr bool PERM = false, AFTER_DRAIN = false;
    float* O; int ldc; const float* bias;
    __device__ __forceinline__ void operator()(const f32x4 (&acc)[2][2][4][2], const Unit& u, int wr, int wc, int fr, int fq) const {
        asm volatile("" : "+v"(fr), "+v"(fq));
        const int row0 = u.pm * 256 + wr * 64 + fr, col0 = u.pn * 256 + wc * 32 + 4 * fq;
        f32x4 bv[2][2];
#pragma unroll
        for (int bj = 0; bj < 2; ++bj)
#pragma unroll
            for (int n = 0; n < 2; ++n) bv[bj][n] = bias ? *(const f32x4*)(bias + col0 + bj * 128 + n * 16) : (f32x4){0.f, 0.f, 0.f, 0.f};
#pragma unroll
        for (int ai = 0; ai < 2; ++ai)
#pragma unroll
            for (int m = 0; m < 4; ++m) { float* rowp = O + (size_t)(row0 + ai * 128 + m * 16) * ldc + col0;
#pragma unroll
                for (int bj = 0; bj < 2; ++bj)
#pragma unroll
                    for (int n = 0; n < 2; ++n) *(f32x4*)(rowp + bj * 128 + n * 16) = acc[ai][bj][m][n] + bv[bj][n]; }
    }
};
struct EpiPle {
    static constexpr bool PERM = false, AFTER_DRAIN = false;
    bf16* X; const bf16* PP; float* Y;
    __device__ __forceinline__ void operator()(const f32x4 (&acc)[2][2][4][2], const Unit& u, int wr, int wc, int fr, int fq) const {
        asm volatile("" : "+v"(fr), "+v"(fq));
        const int row0 = u.pm * 256 + wr * 64 + fr, col0 = u.pn * 256 + wc * 32 + 4 * fq;
#pragma unroll
        for (int ai = 0; ai < 2; ++ai)
#pragma unroll
            for (int m = 0; m < 4; ++m) { const size_t off = (size_t)(row0 + ai * 128 + m * 16) * DM + col0;
#pragma unroll
                for (int bj = 0; bj < 2; ++bj)
#pragma unroll
                    for (int n = 0; n < 2; ++n) { const size_t o = off + bj * 128 + n * 16; const f32x4 x = ld_bf4(X + o), p = ld_bf4(PP + o), a = acc[ai][bj][m][n];
                        const f32x4 r = (f32x4){x.x + sigm(a.x) * p.x, x.y + sigm(a.y) * p.y, x.z + sigm(a.z) * p.z, x.w + sigm(a.w) * p.w};
                        if (Y) *(f32x4*)(Y + o) = r; else st_bf4(X + o, r); }
                asm volatile("" ::: "memory"); }
    }
};
struct EpiSwiglu {
    static constexpr bool PERM = true, AFTER_DRAIN = false;
    bf16* O;
    __device__ __forceinline__ void operator()(const f32x4 (&acc)[2][2][4][2], const Unit& u, int wr, int wc, int fr, int fq) const {
        asm volatile("" : "+v"(fr), "+v"(fq));
        const int row0 = u.pm * 256 + wr * 64 + fr, col0 = u.pn * 128 + wc * 32 + 8 * fq;
#pragma unroll
        for (int ai = 0; ai < 2; ++ai)
#pragma unroll
            for (int m = 0; m < 4; ++m) { bf16* p = O + (size_t)(row0 + ai * 128 + m * 16) * DFF + col0;
                const f32x4 g0 = acc[ai][0][m][0], g1 = acc[ai][0][m][1], u0 = acc[ai][1][m][0], u1 = acc[ai][1][m][1];
                u32x4 w; w.x = pk2(g0.x * sigm(g0.x) * u0.x, g0.y * sigm(g0.y) * u0.y); w.y = pk2(g0.z * sigm(g0.z) * u0.z, g0.w * sigm(g0.w) * u0.w);
                w.z = pk2(g1.x * sigm(g1.x) * u1.x, g1.y * sigm(g1.y) * u1.y); w.w = pk2(g1.z * sigm(g1.z) * u1.z, g1.w * sigm(g1.w) * u1.w);
                *(u32x4*)p = w; }
    }
};
struct G2Order {
    pg8::StaticOrder b;
    __device__ bool next(int i, Unit& u) const { if (!b.next(i, u)) return false; u.ko = u.pn < 3 ? 0 : 256; return true; }
    __device__ __forceinline__ void a_ready(const Unit&) const {}
    __device__ __forceinline__ void done(const Unit&) const {}
};
struct SplitOrder {
    int c, G, kh;
    __device__ bool next(int i, Unit& u) const { const long L = (long)i * G + c; if (L >= 16) return false; u.pm = (int)L >> 3; u.pn = ((int)L >> 1) & 3; u.ko = ((int)L & 1) * kh; return true; }
    __device__ __forceinline__ void a_ready(const Unit&) const {}
    __device__ __forceinline__ void done(const Unit&) const {}
};
struct EpiPart {
    static constexpr bool PERM = false, AFTER_DRAIN = false;
    float* P;
    __device__ __forceinline__ void operator()(const f32x4 (&acc)[2][2][4][2], const Unit& u, int wr, int wc, int fr, int fq) const {
        asm volatile("" : "+v"(fr), "+v"(fq));
        const int row0 = u.pm * 256 + wr * 64 + fr, col0 = u.pn * 256 + wc * 32 + 4 * fq; float* O = P + (u.ko ? (size_t)MS * DM : 0);
#pragma unroll
        for (int ai = 0; ai < 2; ++ai)
#pragma unroll
            for (int m = 0; m < 4; ++m) { float* rowp = O + (size_t)(row0 + ai * 128 + m * 16) * DM + col0;
#pragma unroll
                for (int bj = 0; bj < 2; ++bj)
#pragma unroll
                    for (int n = 0; n < 2; ++n) *(f32x4*)(rowp + bj * 128 + n * 16) = acc[ai][bj][m][n]; }
    }
};
struct EpiMix {
    static constexpr bool PERM = false, AFTER_DRAIN = false;
    const float *w0, *a0, *k_a, *b_a, *b_i, *Lp; float* Wd; bf16 *Ks, *KK, *BV, *G; float *AL, *U; const bf16* A2;
    __device__ __forceinline__ void operator()(const f32x4 (&acc)[2][2][4][2], const Unit& u, int wr, int wc, int fr, int fq) const {
        asm volatile("" : "+v"(fr), "+v"(fq));
        const int row0 = u.pm * 256 + wr * 64 + fr;
        if (u.pn < 3) {
#pragma unroll
            for (int ai = 0; ai < 2; ++ai)
#pragma unroll
                for (int m = 0; m < 4; ++m) { const size_t ro = (size_t)(row0 + ai * 128 + m * 16) * 256;
#pragma unroll
                    for (int bj = 0; bj < 2; ++bj)
#pragma unroll
                        for (int n = 0; n < 2; ++n) { const int c = bj * 128 + wc * 32 + n * 16 + 4 * fq; const f32x4 z = acc[ai][bj][m][n];
                            if (u.pn == 0) { const f32x4 b = *(const f32x4*)(w0 + c); f32x4 d;
                                d.x = __expf(-0.60653066f * sigm(z.x + b.x)); d.y = __expf(-0.60653066f * sigm(z.y + b.y)); d.z = __expf(-0.60653066f * sigm(z.z + b.z)); d.w = __expf(-0.60653066f * sigm(z.w + b.w));
                                *(f32x4*)(Wd + ro + c) = d; }
                            else if (u.pn == 1) { const f32x4 b = *(const f32x4*)(a0 + c), ka = *(const f32x4*)(k_a + c), ks = ld_bf4(Ks + ro + c), kk = ld_bf4(KK + ro + c);
                                f32x4 a; a.x = sigm(z.x + b.x); a.y = sigm(z.y + b.y); a.z = sigm(z.z + b.z); a.w = sigm(z.w + b.w);
                                st_bf4(Ks + ro + c, ks * (1.f + (a - 1.f) * ka)); st_bf4(BV + ro + c, kk * a); }
                            else { st_bf4(G + ro + c, z); }
                            asm volatile("" ::: "memory"); } }
        } else {
            const int t = u.pn - 3;
#pragma unroll
            for (int ai = 0; ai < 2; ++ai)
#pragma unroll
                for (int m = 0; m < 4; ++m) { const size_t r = (size_t)(row0 + ai * 128 + m * 16);
#pragma unroll
                    for (int n = 0; n < 2; ++n) { const int cc = 128 * t + wc * 32 + n * 16 + 4 * fq;
                        const f32x4 zr = acc[ai][0][m][n] + *(const f32x4*)(b_a + cc), zi = acc[ai][1][m][n] + *(const f32x4*)(b_i + cc), Lv = *(const f32x4*)(Lp + cc), xc = ld_bf4(A2 + r * K2 + 256 + cc);
                        f32x4 al, uu;
#define LRU1(e) { const float xe = __expf(-Lv.e); const float ls = -xe * (1.f + xe * (-0.5f + xe * 0.33333334f)); const float la = 8.f * sigm(zr.e) * ls; al.e = __expf(la); const float z2 = 2.f * la; \
    const float om = -z2 * (1.f + z2 * (0.5f + z2 * (0.16666667f + z2 * (0.041666668f + z2 * 0.0083333338f)))); uu.e = __builtin_amdgcn_sqrtf(om) * sigm(zi.e) * xc.e; }
                        LRU1(x) LRU1(y) LRU1(z) LRU1(w)
#undef LRU1
                        *(f32x4*)(AL + r * 256 + cc) = al; *(f32x4*)(U + r * 256 + cc) = uu; asm volatile("" ::: "memory"); } }
        }
    }
};
#define RLX_AGENT __ATOMIC_RELAXED, __HIP_MEMORY_SCOPE_AGENT
#define XB_TMO      128
#define XB_XCNT(j)  (256  + 64 * (j))
#define XB_XSUB(j)  (1280 + 64 * (j))
#define XB_XGEN(j)  (2304 + 64 * (j))
#define XB_TOP      3328
#define XB_TOPGEN   3392
#define XCD_BAR_WORDS 3456
#define XB_SPIN_CAP (1u << 18)

__device__ __forceinline__ unsigned xb_ld(unsigned* p)              { return __hip_atomic_load(p, __ATOMIC_RELAXED, __HIP_MEMORY_SCOPE_AGENT); }
__device__ __forceinline__ unsigned xb_add(unsigned* p, unsigned v) { return __hip_atomic_fetch_add(p, v, __ATOMIC_RELAXED, __HIP_MEMORY_SCOPE_AGENT); }
__device__ __forceinline__ unsigned xb_xcc_id() { return (unsigned)__builtin_amdgcn_s_getreg((3 << 11) | 20) & 0xFu; }
#define XB_SPIN(cond, bar) do { unsigned _sp = 0; while (cond) { __builtin_amdgcn_s_sleep(1); \
    if ((++_sp & 255u) == 0u) { if (xb_ld(&(bar)[XB_TMO])) break; if (_sp > XB_SPIN_CAP) { atomicAdd(&(bar)[XB_TMO], 1u); break; } } } } while (0)

struct XcdBarrier {
    unsigned* bar; unsigned x;
    volatile LAS unsigned* st;
};

__device__ __forceinline__ XcdBarrier xcd_barrier_post(unsigned* bar, volatile LAS unsigned* st, int tid) {
    XcdBarrier b; b.bar = bar; b.x = xb_xcc_id(); b.st = st;
    if (tid == 0) (void)xb_add(&bar[XB_XCNT(b.x)], 1u);
    return b;
}
__device__ __forceinline__ void xcd_barrier_complete(unsigned* bar, unsigned x, unsigned& nloc, unsigned& nx) {
    const unsigned G = gridDim.x * gridDim.y * gridDim.z;
    unsigned sum, cnt, mine, sp = 0u;
    for (;;) {
        sum = 0u; cnt = 0u; mine = 0u;
#pragma unroll
        for (unsigned j = 0; j < 16; ++j) { const unsigned c = xb_ld(&bar[XB_XCNT(j)]); sum += c; cnt += (c > 0u) ? 1u : 0u; mine = (j == x) ? c : mine; }
        if (sum == G) break;
        __builtin_amdgcn_s_sleep(1);
        if ((++sp & 255u) == 0u) { if (xb_ld(&bar[XB_TMO])) break; if (sp > XB_SPIN_CAP) { atomicAdd(&bar[XB_TMO], 1u); break; } }
    }
    nloc = mine > 0u ? mine : 1u; nx = cnt > 0u ? cnt : 1u;
}

__device__ __forceinline__ void xcd_barrier(const XcdBarrier& b, int tid) {
    asm volatile("s_waitcnt vmcnt(0)" ::: "memory");
    __syncthreads();
    if (tid == 0) {
        unsigned* bar = b.bar;
        __builtin_amdgcn_s_waitcnt(0);
        unsigned nloc = b.st[0], nx = b.st[1];
        if (nloc == 0u) { xcd_barrier_complete(bar, b.x, nloc, nx); b.st[0] = nloc; b.st[1] = nx; }
        const unsigned old = xb_add(&bar[XB_XSUB(b.x)], 1u);
        const unsigned gen = old / nloc;
        if (old + 1u == (gen + 1u) * nloc) {
            __builtin_amdgcn_fence(__ATOMIC_RELEASE, "agent");
            asm volatile("s_waitcnt vmcnt(0)" ::: "memory");
            const unsigned og = xb_add(&bar[XB_TOP], 1u);
            const unsigned tg = og / nx;
            if (og + 1u == (tg + 1u) * nx) xb_add(&bar[XB_TOPGEN], 1u);
            else XB_SPIN(xb_ld(&bar[XB_TOPGEN]) == tg, bar);
            __builtin_amdgcn_fence(__ATOMIC_ACQUIRE, "agent");
            xb_add(&bar[XB_XGEN(b.x)], 1u);
            asm volatile("s_waitcnt vmcnt(0)" ::: "memory");
        } else {
            XB_SPIN(xb_ld(&bar[XB_XGEN(b.x)]) == gen, bar);
            __builtin_amdgcn_fence(__ATOMIC_ACQUIRE, "agent");
            asm volatile("s_waitcnt vmcnt(0)" ::: "memory");
        }
    }
    __syncthreads();
}
struct Args { const float* in[N_IN]; float* out; unsigned char* ws; };
struct Ctx {
    LAS unsigned char* lds; unsigned char* ws; float* out;
    int tid, lane, wave, bid, G, gw, NGW;
};
__device__ __forceinline__ const float* inp_ld(int k) {
    asm volatile("" : "+s"(k));
    const __attribute__((address_space(4))) unsigned long long* tab = (const __attribute__((address_space(4))) unsigned long long*)__builtin_amdgcn_kernarg_segment_ptr();
    return (const float*)tab[k];
}
#define INP(k) inp_ld(k)
__device__ __forceinline__ int opq(int v) { asm volatile("" : "+v"(v)); return v; }

__device__ __forceinline__ void tr_item(const float* W, int ldw, bf16* WT, int ldt, int k0, int n0, int drow, int dcol, LAS float* scr, int lane) {
#pragma unroll 8
    for (int i = 0; i < 32; ++i) { const int kk = 2 * i + (lane >> 5); scr[kk * 33 + (lane & 31)] = W[(size_t)(k0 + kk) * ldw + n0 + (lane & 31)]; }
    LDS_WAIT(); asm volatile("" ::: "memory");
    const int c = lane & 7;
#pragma unroll
    for (int j = 0; j < 4; ++j) { const int n = (lane >> 3) + 8 * j; const LAS float* s = scr + (8 * c) * 33 + n;
        u32x4 o; o.x = pk2(s[0 * 33], s[1 * 33]); o.y = pk2(s[2 * 33], s[3 * 33]); o.z = pk2(s[4 * 33], s[5 * 33]); o.w = pk2(s[6 * 33], s[7 * 33]);
        *(u32x4*)(WT + (size_t)(drow + n) * ldt + dcol + 8 * c) = o; }
    LDS_WAIT(); asm volatile("" ::: "memory");
}
__device__ __forceinline__ void row_norm_in(const float* xrow, const float* g, bf16* orow, bf16* xcopy, int lane) {
    f32x4 v[4]; float ss = 0.f;
#pragma unroll
    for (int j = 0; j < 4; ++j) { v[j] = *(const f32x4*)(xrow + 4 * lane + 256 * j); ss += dot4(v[j], v[j]); }
    const float rs = rsqrtf(wave_sum(ss) * (1.f / DM) + 1e-6f);
#pragma unroll
    for (int j = 0; j < 4; ++j) { const f32x4 gg = *(const f32x4*)(g + 4 * lane + 256 * j); if (xcopy) st_bf4(xcopy + 4 * lane + 256 * j, v[j]); st_bf4(orow + 4 * lane + 256 * j, v[j] * rs * gg); }
}
__device__ __forceinline__ void row_norm(const bf16* xrow, const float* g, bf16* orow, int lane) {
    f32x4 v[4]; float ss = 0.f;
#pragma unroll
    for (int j = 0; j < 4; ++j) { v[j] = ld_bf4(xrow + 4 * lane + 256 * j); ss += dot4(v[j], v[j]); }
    const float rs = rsqrtf(wave_sum(ss) * (1.f / DM) + 1e-6f);
#pragma unroll
    for (int j = 0; j < 4; ++j) st_bf4(orow + 4 * lane + 256 * j, v[j] * rs * *(const f32x4*)(g + 4 * lane + 256 * j));
}
__device__ __forceinline__ void row_update_parts(const float* p0, const float* p1, const float* bias, const float* gA, bf16* X, const float* gB, bf16* outB, int lane) {
    f32x4 a[4], x[4]; float ss = 0.f;
#pragma unroll
    for (int j = 0; j < 4; ++j) { a[j] = *(const f32x4*)(p0 + 4 * lane + 256 * j) + *(const f32x4*)(p1 + 4 * lane + 256 * j); if (bias) a[j] = a[j] + *(const f32x4*)(bias + 4 * lane + 256 * j);
        x[j] = ld_bf4(X + 4 * lane + 256 * j); ss += dot4(a[j], a[j]); }
    const float rs = rsqrtf(wave_sum(ss) * (1.f / DM) + 1e-6f); float s2 = 0.f;
#pragma unroll
    for (int j = 0; j < 4; ++j) { const f32x4 gg = *(const f32x4*)(gA + 4 * lane + 256 * j); x[j] = x[j] + a[j] * rs * gg; st_bf4(X + 4 * lane + 256 * j, x[j]); s2 += dot4(x[j], x[j]); }
    float r2 = 1.f;
    if (gB) r2 = rsqrtf(wave_sum(s2) * (1.f / DM) + 1e-6f);
#pragma unroll
    for (int j = 0; j < 4; ++j) { f32x4 o = x[j]; if (gB) o = o * r2 * *(const f32x4*)(gB + 4 * lane + 256 * j); st_bf4(outB + 4 * lane + 256 * j, o); }
}
__device__ __forceinline__ void row_update(const bf16* add, const float* gA, bf16* X, const float* gB, bf16* outB, int lane) {
    f32x4 a[4], x[4]; float ss = 0.f;
#pragma unroll
    for (int j = 0; j < 4; ++j) { a[j] = ld_bf4(add + 4 * lane + 256 * j); x[j] = ld_bf4(X + 4 * lane + 256 * j); ss += dot4(a[j], a[j]); }
    const float rs = rsqrtf(wave_sum(ss) * (1.f / DM) + 1e-6f); float s2 = 0.f;
#pragma unroll
    for (int j = 0; j < 4; ++j) { const f32x4 gg = *(const f32x4*)(gA + 4 * lane + 256 * j); x[j] = x[j] + a[j] * rs * gg; st_bf4(X + 4 * lane + 256 * j, x[j]); s2 += dot4(x[j], x[j]); }
    float r2 = 1.f;
    if (gB) r2 = rsqrtf(wave_sum(s2) * (1.f / DM) + 1e-6f);
#pragma unroll
    for (int j = 0; j < 4; ++j) { f32x4 o = x[j]; if (gB) o = o * r2 * *(const f32x4*)(gB + 4 * lane + 256 * j); st_bf4(outB + 4 * lane + 256 * j, o); }
}

__device__ __forceinline__ void convert_layer(const Ctx& C, const Args& A, int l, int gw0, int ngw, int gt, int NT) {
    LAS float* scr = (LAS float*)(C.lds + C.wave * 16384);
    constexpr int J0 = 16 * 72, J1 = 16 * 32, J2 = 16 * 88, J4 = 44 * 32, J5 = 16 * 32, J6 = 4 * 32, JL = J0 + J1 + 2 * J2 + J4 + J5 + J6;
    unsigned char* wl = C.ws + WS_W + (size_t)(l & 1) * WL;
    for (int it = gw0; it < JL; it += ngw) {
        int r = it;
        const float* W; int ldw, ldt, kb, nb, drow; bf16* WT;
        if (r < J0) { W = INP(I_WIN) + (size_t)l * DM * INC; ldw = INC; WT = (bf16*)(wl + O_WIN); ldt = DM; kb = r / 72; nb = r % 72; drow = 32 * nb; }
        else if ((r -= J0) < J1) { W = INP(I_WOUT) + (size_t)l * DM * DM; ldw = DM; WT = (bf16*)(wl + O_WOUT); ldt = DM; kb = r / 32; nb = r % 32; drow = 32 * nb; }
        else if ((r -= J1) < J2) { W = INP(I_WG) + (size_t)l * DM * DFF; ldw = DFF; WT = (bf16*)(wl + O_WGU); ldt = DM; kb = r / 88; nb = r % 88; drow = (nb >> 2) * 256 + (nb & 3) * 32; }
        else if ((r -= J2) < J2) { W = INP(I_WU) + (size_t)l * DM * DFF; ldw = DFF; WT = (bf16*)(wl + O_WGU); ldt = DM; kb = r / 88; nb = r % 88; drow = (nb >> 2) * 256 + 128 + (nb & 3) * 32; }
        else if ((r -= J2) < J4) { W = INP(I_WDN) + (size_t)l * DFF * DM; ldw = DM; WT = (bf16*)(wl + O_WD); ldt = DFF; kb = r / 32; nb = r % 32; drow = 32 * nb; }
        else if ((r -= J4) < J5) { W = INP(I_PGW) + (size_t)l * DM * DM; ldw = DM; WT = (bf16*)(wl + O_WPG); ldt = DM; kb = r / 32; nb = r % 32; drow = 32 * nb; }
        else { r -= J5; W = INP(I_PW) + (size_t)l * PLE * DM; ldw = DM; WT = (bf16*)(wl + O_WP); ldt = PLE; kb = r / 32; nb = r % 32; drow = 32 * nb; }
        tr_item(W, ldw, WT, ldt, 64 * kb, 32 * nb, drow, 64 * kb, scr, C.lane);
    }
#pragma unroll 1
    for (int r = gt; r < N2 * K2; r = opq(r + NT)) {
        const int n = r / K2, k = r % K2; float v = 0.f;
        if (n < 256) { if (k < 64) v = INP(I_WUP)[((size_t)l * 64 + k) * 256 + n]; }
        else if (n < 512) { if (k >= 64 && k < 128) v = INP(I_AUP)[((size_t)l * 64 + (k - 64)) * 256 + (n - 256)]; }
        else if (n < 768) { if (k >= 128 && k < 256) v = INP(I_GUP)[((size_t)l * 128 + (k - 128)) * 256 + (n - 512)]; }
        else { const int tt = (n - 768) >> 8, rr = (n - 768) & 255, cc = 128 * tt + (rr & 127), h = cc >> 6, j = cc & 63;
            if (k >= 256 && ((k - 256) >> 6) == h) v = ((rr >> 7) ? INP(I_WI) : INP(I_WA))[(((size_t)l * 4 + h) * 64 + ((k - 256) & 63)) * 64 + j]; }
        ((bf16*)(wl + O_W2))[r] = (bf16)f2bf(v);
    }
#pragma unroll 1
    for (int r = gt; r < M * (PLE / 4); r = opq(r + NT)) {
        const int m = r >> 6, c4 = (r & 63) * 4;
        const float* src = m < MP ? INP(I_PP) + ((size_t)l * MP + m) * PLE + c4 : INP(I_PS) + ((size_t)l * MS + (m - MP)) * PLE + c4;
        st_bf4((bf16*)(C.ws + WS_PB + (size_t)(l & 1) * SZ_PBL) + (size_t)m * PLE + c4, *(const f32x4*)src);
    }
}
__device__ __forceinline__ void p0_prologue(const Ctx& C, const Args& A) {
    convert_layer(C, A, 0, C.gw, C.NGW, C.bid * 512 + C.tid, C.G * 512);
    for (int m = C.gw; m < M; m += C.NGW) {
        const float* src = m < MP ? INP(I_XP) + (size_t)m * DM : INP(I_XS) + (size_t)(m - MP) * DM;
        row_norm_in(src, INP(I_NMPRE), (bf16*)(C.ws + WS_HN) + (size_t)m * DM, (bf16*)(C.ws + WS_X16) + (size_t)m * DM, C.lane);
    }
}

__device__ __forceinline__ void e1_prep(const Ctx& C, const Args& A, int l) {
    const bf16* PROJ = (const bf16*)(C.ws + WS_R1);
    bf16* R = (bf16*)(C.ws + WS_R2); bf16* Ks = (bf16*)(C.ws + WS_R2 + SZ_F256); bf16* V = (bf16*)(C.ws + WS_R2 + 2 * SZ_F256); bf16* KK = (bf16*)(C.ws + WS_R2 + 3 * SZ_F256);
    bf16* A2 = (bf16*)(C.ws + WS_R3);
    const int lane = C.lane, c4 = 4 * lane;
    for (int m = C.gw; m < M; m += C.NGW) {
        const bool samp = m >= MP; int b, t;
        if (!samp) { b = m >> 12; t = m & 4095; } else { b = (m - MP) >> 2; t = (m - MP) & 3; }
        const bf16* pr = PROJ + (size_t)m * INC;
#pragma unroll
        for (int cg = 0; cg < 4; ++cg) {
            const int col = 256 * cg + c4;
            const f32x4 cur = ld_bf4(pr + C_RW + col); f32x4 prv = (f32x4){0.f, 0.f, 0.f, 0.f};
            if (t > 0) prv = ld_bf4(pr - INC + C_RW + col);
            else if (samp) prv = *(const f32x4*)(INP(I_SSH) + ((size_t)l * DB + b) * 1024 + col);
            const f32x4 mu = *(const f32x4*)(INP(I_MU) + l * 1024 + col);
            const f32x4 xs = cur + (prv - cur) * mu;
            if (cg == 0) st_bf4(R + (size_t)m * 256 + c4, xs);
            else if (cg == 1) { st_bf4(Ks + (size_t)m * 256 + c4, xs); f32x4 kk = xs * *(const f32x4*)(INP(I_KK) + l * 256 + c4);
                const float ss = red16(dot4(kk, kk)); kk = kk * rsqrtf(fmaxf(ss, 1e-24f)); st_bf4(KK + (size_t)m * 256 + c4, kk); }
            else if (cg == 2) st_bf4(V + (size_t)m * 256 + c4, xs);
            else { f32x4 o;
                if (lane < 16) o = (f32x4){tanh_(xs.x), tanh_(xs.y), tanh_(xs.z), tanh_(xs.w)};
                else if (lane < 32) o = xs;
                else o = (f32x4){sigm(xs.x), sigm(xs.y), sigm(xs.z), sigm(xs.w)};
                st_bf4(A2 + (size_t)m * K2 + c4, o); }
        }
        f32x4 xc = *(const f32x4*)(INP(I_CB) + l * 256 + c4);
#pragma unroll
        for (int j = 0; j < 4; ++j) { const int tt = t - 3 + j; f32x4 val = (f32x4){0.f, 0.f, 0.f, 0.f};
            if (tt >= 0) val = ld_bf4(pr + (ptrdiff_t)(j - 3) * INC + C_XB + c4);
            else if (samp) val = *(const f32x4*)(INP(I_SCV) + (((size_t)l * DB + b) * 3 + (tt + 3)) * 256 + c4);
            xc = xc + val * *(const f32x4*)(INP(I_CW) + ((size_t)l * 4 + j) * 256 + c4); }
        st_bf4(A2 + (size_t)m * K2 + 256 + c4, xc);
    }
    const int gt = C.bid * 512 + C.tid, NT = C.G * 512;
    float* out = C.out;
#pragma unroll 1
    for (int e = gt; e < 2 * NBP * 128 * 128; e = opq(e + NT)) {
        const int kv = e / (NBP * 16384), r = e % (NBP * 16384), b = r >> 14, rr = (r >> 7) & 127, c = r & 127;
        out[(kv ? OUT_VP : OUT_KP) + (size_t)l * NBP * 16384 + r] = bf1(PROJ[(size_t)(b * T + T - 128 + rr) * INC + (kv ? C_V : C_K) + c]);
    }
#pragma unroll 1
    for (int e = gt; e < NBP * 1024; e = opq(e + NT)) { const int b = e >> 10, c = e & 1023; out[OUT_SHP + (size_t)l * NBP * 1024 + e] = bf1(PROJ[(size_t)(b * T + T - 1) * INC + C_RW + c]); }
#pragma unroll 1
    for (int e = gt; e < DB * 1024; e = opq(e + NT)) { const int b = e >> 10, c = e & 1023; out[OUT_SHS + (size_t)l * DB * 1024 + e] = bf1(PROJ[(size_t)(MP + 4 * b + 3) * INC + C_RW + c]); }
#pragma unroll 1
    for (int e = gt; e < NBP * 768; e = opq(e + NT)) { const int b = e / 768, j = (e % 768) >> 8, c = e & 255; out[OUT_CVP + (size_t)l * NBP * 768 + e] = bf1(PROJ[(size_t)(b * T + T - 3 + j) * INC + C_XB + c]); }
#pragma unroll 1
    for (int e = gt; e < DB * 768; e = opq(e + NT)) { const int b = e / 768, j = (e % 768) >> 8, c = e & 255; out[OUT_CVS + (size_t)l * DB * 768 + e] = bf1(PROJ[(size_t)(MP + 4 * b + 1 + j) * INC + C_XB + c]); }
}

struct RwkvPtrs { const bf16 *R, *K, *V, *KK, *BV; const float* W; float* YR; };
__device__ __forceinline__ void rwkv_step(f32x4& s, const f32x4 w, const f32x4 kk, const f32x4 bv, const f32x4 k2, const f32x4 r, const float v, float& y) {
    const float sa = red16(dot4(s, kk));
    s = s * w + (k2 * v - bv * sa);
    y = red16(dot4(s, r));
}
__device__ __forceinline__ void rwkv_prompt(const Ctx& C, const RwkvPtrs& P, int wg, float* wkv_out  ) {
    constexpr int TC = 32, VEC = TC * 64 * 4, O_V = 5 * VEC, BUF = O_V + TC * 16 * 4, O_Q = 2 * BUF;
    static_assert(O_Q + TC * 1024 <= 131072, "LDS");
    const int chain = wg >> 2, b = chain >> 2, h = chain & 3, qr = wg & 3, tid = C.tid, lane = C.lane, wave = C.wave;
    const size_t m0 = (size_t)b * T;
    const int ltid = tid - 256, lstep = ltid >> 4, lq = tid & 15;
    const int vstep = ltid >> 2, vq = ltid & 3;
    f32x4 st[2][5], stv;
    f32x4 s = (f32x4){0.f, 0.f, 0.f, 0.f};
    const int row = 16 * qr + 4 * wave + (lane >> 4), cq = lane & 15;
#define RW_LOAD(c) do { if (wave >= 4) { _Pragma("unroll") for (int u = 0; u < 2; ++u) { const size_t o_ = (m0 + (size_t)(c) * TC + lstep + 16 * u) * 256 + h * 64 + 4 * lq; \
        st[u][0] = *(const f32x4*)(P.W + o_); st[u][1] = ld_bf4(P.KK + o_); st[u][2] = ld_bf4(P.BV + o_); st[u][3] = ld_bf4(P.K + o_); st[u][4] = ld_bf4(P.R + o_); } \
        if (ltid < 128) stv = ld_bf4(P.V + (m0 + (size_t)(c) * TC + vstep) * 256 + h * 64 + 16 * qr + 4 * vq); } } while (0)
#define RW_STORE(bufi) do { if (wave >= 4) { LAS unsigned char* bb = C.lds + (bufi) * BUF; _Pragma("unroll") for (int u = 0; u < 2; ++u) { const int ls = lstep + 16 * u; \
        _Pragma("unroll") for (int i = 0; i < 5; ++i) *(LAS f32x4*)(bb + i * VEC + (ls * 64 + 4 * lq) * 4) = st[u][i]; } \
        if (ltid < 128) *(LAS f32x4*)(bb + O_V + (vstep * 16 + 4 * vq) * 4) = stv; } } while (0)
#define RW_FLUSH(cc, half) do { if (wave >= 4) { const int stp = lstep + 16 * (half); const LAS f32x4* qp = (const LAS f32x4*)(C.lds + O_Q + stp * 1024 + (lq >> 2) * 256 + (lq & 3) * 64); \
        const f32x4 a0 = qp[0], a1_ = qp[1], a2_ = qp[2], a3 = qp[3]; const f32x4 t_ = (a0 + a1_) + (a2_ + a3); \
        P.YR[(m0 + (size_t)(cc) * TC + stp) * 256 + h * 64 + 16 * qr + lq] = (t_.x + t_.y) + (t_.z + t_.w); } } while (0)
    RW_LOAD(0); RW_STORE(0); __syncthreads();
    for (int c = 0; c < T / TC; ++c) {
        if (c > 0) RW_FLUSH(c - 1, 1);
        if (c + 1 < T / TC) RW_LOAD(c + 1);
        if (wave < 4) {
            const LAS unsigned char* bb = C.lds + (c & 1) * BUF;
            const int vo = O_V + (4 * wave + (lane >> 4)) * 4, lo = 16 * cq;
            LAS float* ring = (LAS float*)(C.lds + O_Q) + wave * 64 + lane;
            f32x4 w = *(const LAS f32x4*)(bb + 0 * VEC + lo), kk = *(const LAS f32x4*)(bb + 1 * VEC + lo), bv = *(const LAS f32x4*)(bb + 2 * VEC + lo),
                  k2 = *(const LAS f32x4*)(bb + 3 * VEC + lo), r = *(const LAS f32x4*)(bb + 4 * VEC + lo), rp = r;
            float v = *(const LAS float*)(bb + vo), qpend = 0.f;
            const unsigned b1 = (unsigned)(unsigned long long)(bb + lo), b2 = (unsigned)(unsigned long long)(bb + vo), qa = (unsigned)(unsigned long long)ring;
            f32x4 nw, nkk, nbv, nk2, nr; float nv;
#define RW_A_DOT "v_mul_f32 %6, %10, %14\n\tv_fma_f32 %6, %11, %15, %6\n\tv_fma_f32 %6, %12, %16, %6\n\tv_fma_f32 %6, %13, %17, %6"
#define RW_A_RD "ds_read_b128 %0, %7 offset:%c19\n\tds_read_b128 %1, %7 offset:%c20\n\tds_read_b128 %2, %7 offset:%c21\n\tds_read_b128 %3, %7 offset:%c22\n\tds_read_b128 %4, %7 offset:%c23\n\tds_read_b32 %5, %8 offset:%c24\n\t"
#define RW_A_OPS(IN, WO) : "=&v"(nw), "=&v"(nkk), "=&v"(nbv), "=&v"(nk2), "=&v"(nr), "=&v"(nv), "=&v"(sa) \
                 : "v"(b1), "v"(b2), "v"(qa), "v"(s.x), "v"(s.y), "v"(s.z), "v"(s.w), "v"(kk.x), "v"(kk.y), "v"(kk.z), "v"(kk.w), "v"(qpend), \
                   "n"(0 * VEC + (IN) * 256), "n"(1 * VEC + (IN) * 256), "n"(2 * VEC + (IN) * 256), "n"(3 * VEC + (IN) * 256), "n"(4 * VEC + (IN) * 256), "n"((IN) * 64), "n"(WO) : "memory"
#define RW_STEP(I, IN) { float sa, q, t0, t1, t2, t3; \
                if ((I) < 2 || (I) == 16 || (I) == 17) asm volatile(RW_A_RD "s_waitcnt lgkmcnt(6)\n\t" RW_A_DOT RW_A_OPS(IN, 0)); \
                else asm volatile("ds_write_b32 %9, %18 offset:%c25\n\t" RW_A_RD "s_waitcnt lgkmcnt(7)\n\t" RW_A_DOT RW_A_OPS(IN, ((I) >= 2 ? (I) - 2 : 0) * 1024)); \
                asm volatile("v_mul_f32 %2, %6, %10\n\tv_mul_f32 %3, %7, %10\n\t" \
                             "v_add_f32_dpp %0, %0, %0 quad_perm:[1,0,3,2] row_mask:0xf bank_mask:0xf bound_ctrl:1\n\t" \
                             "v_mul_f32 %1, %11, %15\n\tv_fma_f32 %1, %12, %16, %1\n\t" \
                             "v_add_f32_dpp %0, %0, %0 quad_perm:[2,3,0,1] row_mask:0xf bank_mask:0xf bound_ctrl:1\n\t" \
                             "v_fma_f32 %1, %13, %17, %1\n\tv_fma_f32 %1, %14, %18, %1\n\t" \
                             "v_add_f32_dpp %0, %0, %0 row_half_mirror row_mask:0xf bank_mask:0xf bound_ctrl:1\n\t" \
                             "v_mul_f32 %4, %8, %10\n\tv_mul_f32 %5, %9, %10\n\t" \
                             "v_add_f32_dpp %0, %0, %0 row_ror:8 row_mask:0xf bank_mask:0xf bound_ctrl:1" \
                             : "+v"(sa), "=&v"(q), "=&v"(t0), "=&v"(t1), "=&v"(t2), "=&v"(t3) \
                             : "v"(k2.x), "v"(k2.y), "v"(k2.z), "v"(k2.w), "v"(v), "v"(s.x), "v"(s.y), "v"(s.z), "v"(s.w), "v"(rp.x), "v"(rp.y), "v"(rp.z), "v"(rp.w)); \
                asm volatile("v_fma_f32 %4, -%8, %9, %4\n\tv_fma_f32 %5, -%8, %10, %5\n\tv_fma_f32 %6, -%8, %11, %6\n\tv_fma_f32 %7, -%8, %12, %7\n\t" \
                             "v_fma_f32 %0, %0, %13, %4\n\tv_fma_f32 %1, %1, %14, %5\n\tv_fma_f32 %2, %2, %15, %6\n\tv_fma_f32 %3, %3, %16, %7" \
                             : "+v"(s.x), "+v"(s.y), "+v"(s.z), "+v"(s.w), "+v"(t0), "+v"(t1), "+v"(t2), "+v"(t3) \
                             : "v"(sa), "v"(bv.x), "v"(bv.y), "v"(bv.z), "v"(bv.w), "v"(w.x), "v"(w.y), "v"(w.z), "v"(w.w)); \
                qpend = q; rp = r; w = nw; kk = nkk; bv = nbv; k2 = nk2; r = nr; v = nv; }
#define RW_STEP4(I) RW_STEP(I, (I) + 1) RW_STEP((I) + 1, (I) + 2) RW_STEP((I) + 2, (I) + 3) RW_STEP((I) + 3, ((I) + 4 < TC ? (I) + 4 : TC - 1))
#define RW_HALF_END(h0) do { asm volatile("s_waitcnt lgkmcnt(0)" :: "v"(w), "v"(kk), "v"(bv), "v"(k2), "v"(r), "v"(v) : "memory"); \
                ring[((h0) + 14) * 256] = qpend; ring[((h0) + 15) * 256] = dot4(s, rp); } while (0)
            RW_STEP4(0) RW_STEP4(4) RW_STEP4(8) RW_STEP4(12)
            RW_HALF_END(0);
            __syncthreads();
            RW_STEP4(16) RW_STEP4(20) RW_STEP4(24) RW_STEP4(28)
            RW_HALF_END(16);
#undef RW_HALF_END
#undef RW_STEP4
#undef RW_STEP
#undef RW_A_OPS
#undef RW_A_RD
#undef RW_A_DOT
        } else {
            __syncthreads();
            RW_FLUSH(c, 0);
        }
        if (c + 1 < T / TC) RW_STORE((c + 1) & 1);
        __syncthreads();
    }
    RW_FLUSH(T / TC - 1, 1);
#undef RW_LOAD
#undef RW_STORE
#undef RW_FLUSH
    if (wave < 4) *(f32x4*)(wkv_out + (((size_t)b * 4 + h) * 64 + row) * 64 + 4 * cq) = s;
    __syncthreads();
}
__device__ __forceinline__ void rwkv_sample_item(const RwkvPtrs& P, int item, const float* wkv_in, float* wkv_out, int lane) {
    const int rg = item & 15, h = (item >> 4) & 3, b = item >> 6, row = 4 * rg + (lane >> 4), cq = lane & 15;
    const size_t so = (((size_t)b * 4 + h) * 64 + row) * 64 + 4 * cq;
    f32x4 s = *(const f32x4*)(wkv_in + so);
#pragma unroll
    for (int i = 0; i < DS; ++i) { const size_t m = (size_t)MP + 4 * b + i, o = m * 256 + h * 64 + 4 * cq;
        float y; rwkv_step(s, *(const f32x4*)(P.W + o), ld_bf4(P.KK + o), ld_bf4(P.BV + o), ld_bf4(P.K + o), ld_bf4(P.R + o), bf1(P.V[m * 256 + h * 64 + row]), y);
        if (cq == 0) P.YR[m * 256 + h * 64 + row] = y; }
    *(f32x4*)(wkv_out + so) = s;
}
__device__ __forceinline__ void lru_prompt_item(const Ctx& C, int item, const float* AL, const float* U, const bf16* PROJ, bf16* MIXCAT, float* lru_out  ) {
    const int b = item >> 4, c = (item & 15) * 16 + (C.tid & 15), seg = C.tid >> 4; constexpr int SL = T / 32;
    const size_t m0 = (size_t)b * T + (size_t)seg * SL;
    LAS float* sA = (LAS float*)C.lds; LAS float* sH = sA + 512;
    float Ap = 1.f, H = 0.f;
#pragma unroll 8
    for (int i = 0; i < SL; ++i) { const float a = AL[(m0 + i) * 256 + c], u = U[(m0 + i) * 256 + c]; H = a * H + u; Ap *= a; }
    sA[C.tid] = Ap; sH[C.tid] = H;
    __syncthreads();
    float h = 0.f;
    for (int sp = 0; sp < seg; ++sp) h = sA[sp * 16 + (C.tid & 15)] * h + sH[sp * 16 + (C.tid & 15)];
#pragma unroll 8
    for (int i = 0; i < SL; ++i) { const float a = AL[(m0 + i) * 256 + c], u = U[(m0 + i) * 256 + c]; h = a * h + u;
        const float gb = bf1(PROJ[(m0 + i) * INC + C_GB + c]); MIXCAT[(m0 + i) * DM + 768 + c] = (bf16)f2bf(h * gelu_t(gb)); }
    if (seg == 31) lru_out[b * 256 + c] = h;
    __syncthreads();
}
__device__ __forceinline__ void swa_prompt_item(const Ctx& C, int item, const bf16* PROJ, bf16* MIXCAT, const float* sinks  ) {
    constexpr int KP = 72, VP = 264;
    const int kvh = item & 1, n = (item >> 1) & 31, b = item >> 6, tid = C.tid, lane = C.lane, wave = C.wave;
    LAS bf16* Ks = (LAS bf16*)C.lds; LAS bf16* Vt = Ks + 256 * KP;
    const size_t rowq0 = (size_t)b * T + (size_t)n * 128;
    { const int key = tid >> 1, hf = tid & 1; size_t kr = rowq0 + key; kr = (kr >= 128 + (size_t)b * T) ? kr - 128 : kr;
        const bf16* kp = PROJ + kr * INC + C_K + kvh * 64 + hf * 32;
#pragma unroll
        for (int i = 0; i < 4; ++i) *(LAS u32x4*)(Ks + key * KP + hf * 32 + 8 * i) = *(const u32x4*)(kp + 8 * i);
#pragma unroll
        for (int i = 0; i < 4; ++i) { const int ch = tid + 512 * i, vk = ch >> 3, d0 = (ch & 7) * 8; size_t vr = rowq0 + vk; vr = (vr >= 128 + (size_t)b * T) ? vr - 128 : vr;
            const u32x4 w = *(const u32x4*)(PROJ + vr * INC + C_V + kvh * 64 + d0);
            Vt[(d0 + 0) * VP + vk] = (bf16)(w.x & 0xffff); Vt[(d0 + 1) * VP + vk] = (bf16)(w.x >> 16); Vt[(d0 + 2) * VP + vk] = (bf16)(w.y & 0xffff); Vt[(d0 + 3) * VP + vk] = (bf16)(w.y >> 16);
            Vt[(d0 + 4) * VP + vk] = (bf16)(w.z & 0xffff); Vt[(d0 + 5) * VP + vk] = (bf16)(w.z >> 16); Vt[(d0 + 6) * VP + vk] = (bf16)(w.w & 0xffff); Vt[(d0 + 7) * VP + vk] = (bf16)(w.w >> 16); } }
    __syncthreads();
    const int q = lane & 31, hi = lane >> 5;
#pragma unroll 1
    for (int qi = 0; qi < 2; ++qi) {
        const int qt = wave * 2 + qi, g = qt >> 2, j = qt & 3, hh = kvh * 4 + g;
        const size_t qrow = rowq0 + 32 * j + q;
        bf16x8 qf[4];
#pragma unroll
        for (int dk = 0; dk < 4; ++dk) qf[dk] = *(const bf16x8*)(PROJ + qrow * INC + hh * 64 + 16 * dk + 8 * hi);
        f32x16 sc[5];
#pragma unroll
        for (int kt = 0; kt < 5; ++kt) {
            f32x16 acc;
#pragma unroll
            for (int i = 0; i < 16; ++i) acc[i] = 0.f;
#pragma unroll
            for (int dk = 0; dk < 4; ++dk) { const bf16x8 kf = *(const LAS bf16x8*)(Ks + (32 * (j + kt) + q) * KP + 16 * dk + 8 * hi); acc = __builtin_amdgcn_mfma_f32_32x32x16_bf16(kf, qf[dk], acc, 0, 0, 0); }
            sc[kt] = acc;
        }
        const int qpos = 128 + 32 * j + q; float mx = -INFINITY;
#pragma unroll
        for (int kt = 0; kt < 5; ++kt)
#pragma unroll
            for (int i = 0; i < 16; ++i) { const int kj = 32 * (j + kt) + (i & 3) + 8 * (i >> 2) + 4 * hi, d = qpos - kj; const bool ok = d >= 0 && d <= 128 && (n > 0 || kj >= 128);
                const float sv = ok ? sc[kt][i] * 0.125f : -INFINITY; sc[kt][i] = sv; mx = fmaxf(mx, sv); }
        mx = fmaxf(mx, shx(mx, 32, lane)); const float sink = sinks[hh]; mx = fmaxf(mx, sink);
        float sum = 0.f;
#pragma unroll
        for (int kt = 0; kt < 5; ++kt)
#pragma unroll
            for (int i = 0; i < 16; ++i) { const float e = __expf(sc[kt][i] - mx); sc[kt][i] = e; sum += e; }
        sum += shx(sum, 32, lane);
        const float inv = 1.f / (sum + __expf(sink - mx));
#pragma unroll
        for (int dt = 0; dt < 2; ++dt) {
            f32x16 o;
#pragma unroll
            for (int i = 0; i < 16; ++i) o[i] = 0.f;
#pragma unroll
            for (int kt = 0; kt < 5; ++kt)
#pragma unroll
                for (int s2 = 0; s2 < 2; ++s2) {
                    u32x4 pw; pw.x = pk2(sc[kt][8 * s2 + 0], sc[kt][8 * s2 + 1]); pw.y = pk2(sc[kt][8 * s2 + 2], sc[kt][8 * s2 + 3]); pw.z = pk2(sc[kt][8 * s2 + 4], sc[kt][8 * s2 + 5]); pw.w = pk2(sc[kt][8 * s2 + 6], sc[kt][8 * s2 + 7]);
                    const LAS bf16* vp = Vt + (32 * dt + q) * VP + 32 * (j + kt) + 16 * s2 + 4 * hi;
                    const u32x2 v0 = *(const LAS u32x2*)vp, v1 = *(const LAS u32x2*)(vp + 8);
                    u32x4 vw; vw.x = v0.x; vw.y = v0.y; vw.z = v1.x; vw.w = v1.y;
                    o = __builtin_amdgcn_mfma_f32_32x32x16_bf16(__builtin_bit_cast(bf16x8, vw), __builtin_bit_cast(bf16x8, pw), o, 0, 0, 0);
                }
#pragma unroll
            for (int g4 = 0; g4 < 4; ++g4) st_bf4(MIXCAT + qrow * DM + hh * 64 + 32 * dt + 8 * g4 + 4 * hi, (f32x4){o[4 * g4] * inv, o[4 * g4 + 1] * inv, o[4 * g4 + 2] * inv, o[4 * g4 + 3] * inv});
        }
    }
    __syncthreads();
}
__device__ __forceinline__ void swa_sample_item(const Ctx& C, int item, const bf16* PROJ, bf16* MIXCAT, const float* sinks, const float* ck, const float* cv, float* ko, float* vo) {
    const int kvh = item & 1, b = item >> 1, tid = C.tid;
    LAS float* Kf = (LAS float*)C.lds; LAS float* Vf = Kf + 132 * 65; LAS float* Qf = Vf + 132 * 64; LAS float* Pf = Qf + 16 * 64;
    for (int e = tid; e < 132 * 64; e += 512) { const int key = e >> 6, d = e & 63; float kx, vx;
        if (key < 128) { const size_t o = (((size_t)b * 128 + key) * 2 + kvh) * 64 + d; kx = ck[o]; vx = cv[o]; }
        else { const size_t r = (size_t)MP + 4 * b + (key - 128); kx = bf1(PROJ[r * INC + C_K + kvh * 64 + d]); vx = bf1(PROJ[r * INC + C_V + kvh * 64 + d]); }
        Kf[key * 65 + d] = kx; Vf[key * 64 + d] = vx;
        if (key >= 4) { const size_t o = (((size_t)b * 128 + (key - 4)) * 2 + kvh) * 64 + d; ko[o] = kx; vo[o] = vx; } }
    for (int e = tid; e < 16 * 64; e += 512) { const int qr = e >> 6, d = e & 63, i = qr >> 2, g = qr & 3; Qf[e] = bf1(PROJ[((size_t)MP + 4 * b + i) * INC + (kvh * 4 + g) * 64 + d]); }
    __syncthreads();
    { const int qr = tid >> 5, kl = tid & 31, i = qr >> 2, g = qr & 3; float sc[5]; float mx = -INFINITY;
#pragma unroll
        for (int k5 = 0; k5 < 5; ++k5) { const int key = kl + 32 * k5; float sv = -INFINITY;
            if (key < 132 && key >= i && key <= i + 128) { float a = 0.f;
#pragma unroll 16
                for (int d = 0; d < 64; ++d) a += Qf[qr * 64 + d] * Kf[key * 65 + d];
                sv = a * 0.125f; }
            sc[k5] = sv; mx = fmaxf(mx, sv); }
#pragma unroll
        for (int o = 1; o < 32; o <<= 1) mx = fmaxf(mx, shx(mx, o, C.lane));
        const float sink = sinks[kvh * 4 + g]; mx = fmaxf(mx, sink); float sum = 0.f;
#pragma unroll
        for (int k5 = 0; k5 < 5; ++k5) { sc[k5] = __expf(sc[k5] - mx); sum += sc[k5]; }
#pragma unroll
        for (int o = 1; o < 32; o <<= 1) sum += shx(sum, o, C.lane);
        const float inv = 1.f / (sum + __expf(sink - mx));
#pragma unroll
        for (int k5 = 0; k5 < 5; ++k5) { const int key = kl + 32 * k5; if (key < 136) Pf[qr * 136 + key] = sc[k5] * inv; } }
    __syncthreads();
    { const int qr = tid >> 5, d = (tid & 31) * 2, i = qr >> 2, g = qr & 3; float o0 = 0.f, o1 = 0.f;
#pragma unroll 4
        for (int key = 0; key < 132; ++key) { const float p = Pf[qr * 136 + key]; o0 += p * Vf[key * 64 + d]; o1 += p * Vf[key * 64 + d + 1]; }
        *(unsigned*)(MIXCAT + ((size_t)MP + 4 * b + i) * DM + (kvh * 4 + g) * 64 + d) = pk2(o0, o1); }
    __syncthreads();
}

__device__ __forceinline__ void s_phase(const Ctx& C, const Args& A, int l) {
    const bf16* PROJ = (const bf16*)(C.ws + WS_R1); bf16* MIXCAT = (bf16*)(C.ws + WS_HN);
    float* R = (float*)(C.ws + WS_R2); const size_t S = (size_t)M * 256;
    RwkvPtrs P{(const bf16*)R, (const bf16*)(R + S), (const bf16*)(R + 2 * S), (const bf16*)(R + 3 * S), (const bf16*)(R + 4 * S), R + 5 * S, (float*)(C.ws + WS_R3)};
    const float* AL = (const float*)(C.ws + WS_R3) + S; const float* U = AL + S;
    float* out = C.out;
    constexpr int NSCAN = 64;
    if (C.bid < NSCAN) { rwkv_prompt(C, P, C.bid, out + OUT_WKVP + (size_t)l * NBP * 4 * 4096); return; }
    constexpr int N0 = 256, N1 = N0 + 64, N2_ = N1 + 256, N3 = N2_ + 1024, N4 = N3 + 64;
    for (int it = C.bid - NSCAN; it < N4; it += C.G - NSCAN) {
        if (it < N0) swa_prompt_item(C, it, PROJ, MIXCAT, INP(I_SINK) + l * 8);
        else if (it < N1) lru_prompt_item(C, it - N0, AL, U, PROJ, MIXCAT, out + OUT_LRP + (size_t)l * NBP * 256);
        else if (it < N2_) swa_sample_item(C, it - N1, PROJ, MIXCAT, INP(I_SINK) + l * 8, INP(I_CK) + (size_t)l * DB * 16384, INP(I_CV) + (size_t)l * DB * 16384,
                                          out + OUT_KS + (size_t)l * DB * 16384, out + OUT_VS + (size_t)l * DB * 16384);
        else if (it < N3) rwkv_sample_item(P, (it - N2_) * 8 + C.wave, INP(I_SWKV) + (size_t)l * DB * 4 * 4096, out + OUT_WKVS + (size_t)l * DB * 4 * 4096, C.lane);
        else { const int e = (it - N3) * 512 + C.tid, b = e >> 8, c = e & 255; float h = INP(I_SLRU)[((size_t)l * DB + b) * 256 + c];
#pragma unroll
            for (int i = 0; i < DS; ++i) { const size_t m = (size_t)MP + 4 * b + i; h = AL[m * 256 + c] * h + U[m * 256 + c];
                MIXCAT[m * DM + 768 + c] = (bf16)f2bf(h * gelu_t(bf1(PROJ[m * INC + C_GB + c]))); }
            out[OUT_LRS + ((size_t)l * DB + b) * 256 + c] = h; }
    }
    if (l + 1 < NL) convert_layer(C, A, l + 1, (C.bid - NSCAN) * 8 + C.wave, (C.G - NSCAN) * 8, (C.bid - NSCAN) * 512 + C.tid, (C.G - NSCAN) * 512);
    __syncthreads();
    { pg8::Gemm g{(const bf16*)(C.ws + WS_PB + (size_t)(l & 1) * SZ_PBL), (const bf16*)(C.ws + WS_W + (size_t)(l & 1) * WL + O_WP), M, DM, PLE}; pg8::StaticOrder So; So.init(M, DM, C.G - NSCAN, C.bid - NSCAN);
      pg8::EpiBf16<0> E{(bf16*)(C.ws + WS_PP), DM, nullptr, 0, 0, 1.f};
      pg8::gemm_phase<pg8::EpiBf16<0>, pg8::StaticOrder, true, true>(C.lds, g, So, E, C.tid); }
}

__device__ __forceinline__ void e3_post(const Ctx& C, const Args& A, int l) {
    const float* R = (const float*)(C.ws + WS_R2); const size_t S = (size_t)M * 256;
    const bf16 *Rb = (const bf16*)R, *K = (const bf16*)(R + S), *V = (const bf16*)(R + 2 * S), *G = (const bf16*)(R + 6 * S); const float* YR = (const float*)(C.ws + WS_R3);
    bf16* MIXCAT = (bf16*)(C.ws + WS_HN); const int c4 = 4 * C.lane;
    const f32x4 lw = *(const f32x4*)(INP(I_LNW) + l * 256 + c4), lb = *(const f32x4*)(INP(I_LNB) + l * 256 + c4), rk = *(const f32x4*)(INP(I_RK) + l * 256 + c4);
    for (int m = C.gw; m < M; m += C.NGW) {
        const size_t o = (size_t)m * 256 + c4;
        const f32x4 y = *(const f32x4*)(YR + o), r = ld_bf4(Rb + o), k = ld_bf4(K + o), v = ld_bf4(V + o), g = ld_bf4(G + o);
        const float mean = red16((y.x + y.y) + (y.z + y.w)) * (1.f / 64.f); const f32x4 d = y - mean;
        const float var = red16(dot4(d, d)) * (1.f / 64.f); const float rs = rsqrtf(var + 64e-5f);
        const float bonus = red16(dot4(r * k, rk));
        st_bf4(MIXCAT + (size_t)m * DM + 512 + c4, (d * rs * lw + lb + v * bonus) * g);
    }
}
constexpr int LDS_BYTES = 131072 + 64;
#ifndef MK_MULTI
#define MK_MULTI 0
#endif
#ifndef MK_DUP
#define MK_DUP 0
#endif
enum { PH_P0 = 0, PH_G1, PH_E1, PH_G2, PH_S, PH_E3, PH_G3, PH_E4, PH_G4, PH_G5, PH_E5, PH_G6, PH_E0, PH_G3B, PH_E4S, PH_G5B, PH_E5S, PH_N };
constexpr int NSPLIT = 16;

__device__ __forceinline__ Ctx make_ctx(int wave0, LAS unsigned char* lds) {
    Ctx D; int z_ = 0; asm volatile("" : "+v"(z_)); int ln_ = __builtin_amdgcn_mbcnt_hi(-1, __builtin_amdgcn_mbcnt_lo(-1, z_));
    D.lane = ln_; D.wave = wave0; D.tid = wave0 * 64 + ln_;
    int b_ = blockIdx.x; asm volatile("" : "+s"(b_)); D.bid = b_; D.gw = b_ * 8 + wave0; D.G = gridDim.x; D.NGW = D.G * 8;
    D.lds = lds; D.out = (float*)inp_ld(N_IN); D.ws = (unsigned char*)inp_ld(N_IN + 1);
    return D;
}
template <int PH> __device__ __forceinline__ void run_phase(const Args& A, int wave0, LAS unsigned char* lds, int l_in) {
    const Ctx C = make_ctx(wave0, lds);
    int l = l_in; asm volatile("" : "+s"(l));
    unsigned char* ws = C.ws; unsigned char* wl = ws + WS_W + (size_t)(l & 1) * WL; (void)wl;
    bf16* HN = (bf16*)(ws + WS_HN); float* MIX = (float*)(ws + WS_R1); float* R2 = (float*)(ws + WS_R2); float* R3 = (float*)(ws + WS_R3); bf16* X = (bf16*)(ws + WS_X16);
    const size_t S = (size_t)M * 256; (void)HN; (void)MIX; (void)R2; (void)R3; (void)X; (void)S;
    if constexpr (PH == PH_P0) p0_prologue(C, A);
    if constexpr (PH == PH_G1) {
        pg8::Gemm g{HN, (const bf16*)(wl + O_WIN), M, INC, DM}; pg8::StaticOrder So; So.init(M, INC, C.G, C.bid);
        pg8::EpiBf16<0> E{(bf16*)(ws + WS_R1), INC, INP(I_BIN) + (size_t)l * INC, 0, 0, 1.f};
        pg8::gemm_phase<pg8::EpiBf16<0>, pg8::StaticOrder, true, true>(C.lds, g, So, E, C.tid); }
    if constexpr (PH == PH_E1) e1_prep(C, A, l);
    if constexpr (PH == PH_G2) {
        pg8::Gemm g{(const bf16*)(ws + WS_R3), (const bf16*)(wl + O_W2), M, N2, K2 / 2, K2}; G2Order So; So.b.init(M, N2, C.G, C.bid);
        EpiMix E{INP(I_W0) + l * 256, INP(I_A0) + l * 256, INP(I_KA) + l * 256, INP(I_BA) + l * 256, INP(I_BI) + l * 256, INP(I_L) + l * 256,
                 R2 + 5 * S, (bf16*)(R2 + 1 * S), (bf16*)(R2 + 3 * S), (bf16*)(R2 + 4 * S), (bf16*)(R2 + 6 * S), R3 + S, R3 + 2 * S, (const bf16*)(ws + WS_R3)};
        pg8::gemm_phase<EpiMix, G2Order, true, true>(C.lds, g, So, E, C.tid); }
    if constexpr (PH == PH_S) s_phase(C, A, l);
    if constexpr (PH == PH_E3) e3_post(C, A, l);
    if constexpr (PH == PH_G3) {
        pg8::Gemm g{HN, (const bf16*)(wl + O_WOUT), MP, DM, DM}; pg8::StaticOrder So; So.init(MP, DM, C.G, C.bid);
        pg8::EpiBf16<0> E{(bf16*)MIX, DM, INP(I_BOUT) + (size_t)l * DM, 0, 0, 1.f};
        pg8::gemm_phase<pg8::EpiBf16<0>, pg8::StaticOrder, true, true>(C.lds, g, So, E, C.tid); }
    if constexpr (PH == PH_G3B) {
        if (C.bid < NSPLIT) { pg8::Gemm g{HN + (size_t)MP * DM, (const bf16*)(wl + O_WOUT), MS, DM, DM / 2, DM}; SplitOrder So{C.bid, NSPLIT, DM / 2}; EpiPart E{R3};
            pg8::gemm_phase<EpiPart, SplitOrder, true, true>(C.lds, g, So, E, C.tid); }
        else for (int m = (C.bid - NSPLIT) * 8 + C.wave; m < MP; m += (C.G - NSPLIT) * 8)
            row_update((const bf16*)MIX + (size_t)m * DM, INP(I_NMPOST) + l * DM, X + (size_t)m * DM, INP(I_NFPRE) + l * DM, HN + (size_t)m * DM, C.lane); }
    if constexpr (PH == PH_E4S)
        for (int m = MP + C.gw; m < M; m += C.NGW)
            row_update_parts(R3 + (size_t)(m - MP) * DM, R3 + (size_t)(MS + m - MP) * DM, INP(I_BOUT) + (size_t)l * DM, INP(I_NMPOST) + l * DM, X + (size_t)m * DM, INP(I_NFPRE) + l * DM, HN + (size_t)m * DM, C.lane);
    if constexpr (PH == PH_G4) {
        pg8::Gemm g{HN, (const bf16*)(wl + O_WGU), M, 2 * DFF, DM}; pg8::StaticOrder So; So.init(M, 2 * DFF, C.G, C.bid);
        EpiSwiglu E{(bf16*)(ws + WS_R2)};
        pg8::gemm_phase<EpiSwiglu, pg8::StaticOrder, true, true>(C.lds, g, So, E, C.tid); }
    if constexpr (PH == PH_G5) {
        pg8::Gemm g{(const bf16*)(ws + WS_R2), (const bf16*)(wl + O_WD), MP, DM, DFF}; pg8::StaticOrder So; So.init(MP, DM, C.G, C.bid);
        pg8::EpiBf16<0> E{(bf16*)MIX, DM, nullptr, 0, 0, 1.f};
        pg8::gemm_phase<pg8::EpiBf16<0>, pg8::StaticOrder, true, true>(C.lds, g, So, E, C.tid); }
    if constexpr (PH == PH_G5B) {
        if (C.bid < NSPLIT) { pg8::Gemm g{(const bf16*)(ws + WS_R2) + (size_t)MP * DFF, (const bf16*)(wl + O_WD), MS, DM, DFF / 2, DFF}; SplitOrder So{C.bid, NSPLIT, DFF / 2}; EpiPart E{R3};
            pg8::gemm_phase<EpiPart, SplitOrder, true, true>(C.lds, g, So, E, C.tid); }
        else for (int m = (C.bid - NSPLIT) * 8 + C.wave; m < MP; m += (C.G - NSPLIT) * 8)
            row_update((const bf16*)MIX + (size_t)m * DM, INP(I_NFPOST) + l * DM, X + (size_t)m * DM, nullptr, HN + (size_t)m * DM, C.lane); }
    if constexpr (PH == PH_E5S)
        for (int m = MP + C.gw; m < M; m += C.NGW)
            row_update_parts(R3 + (size_t)(m - MP) * DM, R3 + (size_t)(MS + m - MP) * DM, nullptr, INP(I_NFPOST) + l * DM, X + (size_t)m * DM, nullptr, HN + (size_t)m * DM, C.lane);
    if constexpr (PH == PH_G6) {
        pg8::StaticOrder So; So.init(M, DM, C.G, C.bid);
        pg8::Gemm g{HN, (const bf16*)(wl + O_WPG), M, DM, DM}; EpiPle E{X, (const bf16*)(ws + WS_PP), l == NL - 1 ? C.out : nullptr};
        pg8::gemm_phase<EpiPle, pg8::StaticOrder, true, true>(C.lds, g, So, E, C.tid); }
    if constexpr (PH == PH_E0)
        for (int m = C.gw; m < M; m += C.NGW) row_norm(X + (size_t)m * DM, INP(I_NMPRE) + (l + 1) * DM, HN + (size_t)m * DM, C.lane);
}

#if MK_MULTI
template <int PH> __global__ void __launch_bounds__(512, 2) mk_one(Args A, int l) {
    extern __shared__ __attribute__((aligned(16))) unsigned char lds_raw[];
    const int wave0 = __builtin_amdgcn_readfirstlane((int)threadIdx.x >> 6);
    run_phase<PH>(A, wave0, (LAS unsigned char*)lds_raw, l);
}
#else
__global__ void __launch_bounds__(512, 2) mk_fwd(Args A) {
    extern __shared__ __attribute__((aligned(16))) unsigned char lds_raw[];
    cg::grid_group grid = cg::this_grid();
    const int wave0 = __builtin_amdgcn_readfirstlane((int)threadIdx.x >> 6);
    LAS unsigned char* lds = (LAS unsigned char*)lds_raw;
    if (threadIdx.x < 16) ((LAS unsigned*)lds)[131072 / 4 + threadIdx.x] = 0u;
    __syncthreads();
    const unsigned xbar_x = __builtin_amdgcn_readfirstlane(xcd_barrier_post((unsigned*)inp_ld(N_IN + 1), (volatile LAS unsigned*)(lds + 131072), (int)threadIdx.x).x);
#define GRID_BAR() do { int z_ = 0; asm volatile("" : "+v"(z_)); int ln_ = __builtin_amdgcn_mbcnt_hi(-1, __builtin_amdgcn_mbcnt_lo(-1, z_)); XcdBarrier xb_; xb_.bar = (unsigned*)inp_ld(N_IN + 1); xb_.x = xbar_x; \
        xb_.st = (volatile LAS unsigned*)(lds + 131072); xcd_barrier(xb_, wave0 * 64 + ln_); } while (0)
    run_phase<PH_P0>(A, wave0, lds, 0);
    if (MK_DUP & 1) { GRID_BAR(); run_phase<PH_P0>(A, wave0, lds, 0); }
    grid.sync();
#pragma unroll 1
    for (int l = 0; l < NL; ++l) {
#define RP(PH) do { run_phase<PH>(A, wave0, lds, l); GRID_BAR(); if (MK_DUP & (1 << 20)) GRID_BAR(); if (MK_DUP & (1 << PH)) { run_phase<PH>(A, wave0, lds, l); GRID_BAR(); } } while (0)
        RP(PH_G1); RP(PH_E1); RP(PH_G2); RP(PH_S); RP(PH_E3); RP(PH_G3); RP(PH_G3B); RP(PH_E4S); RP(PH_G4); RP(PH_G5); RP(PH_G5B); RP(PH_E5S);
        run_phase<PH_G6>(A, wave0, lds, l);
        if (l + 1 < NL) { GRID_BAR(); RP(PH_E0); }
    }
}
#endif
}

#if MK_MULTI
template <int PH> static void launch_one(const mk::Args& a, int l, int grid, hipStream_t stream) {
    static bool attr = false;
    if (!attr) { (void)hipFuncSetAttribute((const void*)mk::mk_one<PH>, hipFuncAttributeMaxDynamicSharedMemorySize, mk::LDS_BYTES); attr = true; }
    hipLaunchKernelGGL(mk::mk_one<PH>, dim3(grid), dim3(512), mk::LDS_BYTES, stream, a, l);
}
#endif
extern "C" void kernel_launch(void* const* d_in, const int* in_sizes, int n_in, void* d_out, int out_size, void* d_ws, size_t ws_size, hipStream_t stream) {
    using namespace mk;
    static int grid = 0;
    if (grid == 0) {
        if (n_in != N_IN || (size_t)out_size != OUT_END || ws_size < WS_END) {
            fprintf(stderr, "kernel_launch: shape mismatch: n_in %d (want %d), out %d (want %zu), ws %zu (want >= %zu); nothing launched\n", n_in, (int)N_IN, out_size, (size_t)OUT_END, ws_size, (size_t)WS_END);
            grid = -1; return; }
        int dev = 0, cus = 0;
        (void)hipGetDevice(&dev); (void)hipDeviceGetAttribute(&cus, hipDeviceAttributeMultiprocessorCount, dev);
#if !MK_MULTI
        int per_cu = 0;
        if (hipFuncSetAttribute((const void*)mk_fwd, hipFuncAttributeMaxDynamicSharedMemorySize, LDS_BYTES) != hipSuccess) { fprintf(stderr, "kernel_launch: hipFuncSetAttribute failed\n"); grid = -1; return; }
        if (hipOccupancyMaxActiveBlocksPerMultiprocessor(&per_cu, (const void*)mk_fwd, 512, LDS_BYTES) != hipSuccess || per_cu < 1) fprintf(stderr, "kernel_launch: note: occupancy query gave %d\n", per_cu);
        (void)hipGetLastError();
#endif
        grid = cus;
        if (grid < 128) { fprintf(stderr, "kernel_launch: %d CUs: too few for this kernel\n", grid); grid = -1; return; }
    }
    if (grid < 0) return;
    Args a{};
    for (int i = 0; i < N_IN; ++i) a.in[i] = (const float*)d_in[i];
    a.out = (float*)d_out; a.ws = (unsigned char*)d_ws;
#if MK_MULTI
    launch_one<PH_P0>(a, 0, grid, stream);
    for (int l = 0; l < NL; ++l) {
        launch_one<PH_G1>(a, l, grid, stream); launch_one<PH_E1>(a, l, grid, stream); launch_one<PH_G2>(a, l, grid, stream); launch_one<PH_S>(a, l, grid, stream);
        launch_one<PH_E3>(a, l, grid, stream); launch_one<PH_G3>(a, l, grid, stream); launch_one<PH_E4>(a, l, grid, stream); launch_one<PH_G4>(a, l, grid, stream);
        launch_one<PH_G5>(a, l, grid, stream); launch_one<PH_E5>(a, l, grid, stream); launch_one<PH_G6>(a, l, grid, stream);
        if (l + 1 < NL) launch_one<PH_E0>(a, l, grid, stream);
    }
#else
    if (hipMemsetAsync(d_ws, 0, 65536, stream) != hipSuccess) { fprintf(stderr, "kernel_launch: hipMemsetAsync failed\n"); return; }
    void* args[] = {&a};
    const hipError_t e = hipLaunchCooperativeKernel((const void*)mk_fwd, dim3(grid), dim3(512), args, LDS_BYTES, stream);
    if (e != hipSuccess) fprintf(stderr, "kernel_launch: cooperative launch failed: %s (grid %d)\n", hipGetErrorString(e), grid);
#endif
}
```

```cpp
#include <hip/hip_runtime.h>
#include <hip/hip_cooperative_groups.h>
#include <cstdio>
#include <cstdint>
#include <cstddef>
#include <cmath>
namespace cg = cooperative_groups;
namespace pg8 {
#define PG8_LAS __attribute__((address_space(3)))
typedef unsigned short bf16_t;
typedef short bf16x8 __attribute__((ext_vector_type(8)));
typedef float f32x4 __attribute__((ext_vector_type(4)));
typedef unsigned u32x4 __attribute__((ext_vector_type(4)));
constexpr int BM = 256, BK = 64, HALF = 128, HTB = HALF * BK * 2  , STAGE_BYTES = 8 * HTB, NXCD = 8, WGM = 8;

__host__ __device__ __forceinline__ int lds_byte(int r, int c) { const int st = (r >> 4) * 2 + (c >> 5), rr = r & 15, cc = c & 31, ob = rr * 64 + cc * 2; return st * 1024 + (ob ^ (((ob >> 9) & 1) << 5)); }
__host__ __device__ __forceinline__ void stage_rc(int b, int& R, int& C) { const int st = b / 1024, sb = b % 1024, swz = sb ^ (((sb >> 9) & 1) << 5); R = (st >> 1) * 16 + swz / 64; C = (st & 1) * 32 + (swz % 64) / 2; }
__host__ __device__ __forceinline__ int perm32(int rho) { const int n = rho >> 4, i = rho & 15; return 8 * (i >> 2) + 4 * n + (i & 3); }

struct Unit { int pm, pn, ko = 0; };
struct Gemm { const bf16_t* A; const bf16_t* Bt; int M, N, K; int ld = 0; };

struct StaticOrder {
    int nM, nN, nwg, G, c;
    __host__ __device__ void init(int M, int N, int G_, int c_) { nM = M / BM; nN = N / BM; nwg = nM * nN; G = G_; c = c_; }
    __host__ __device__ bool next(int i, Unit& u) const {
        const long L = (long)i * G + c; if (L >= nwg) return false;
        int wgid = (int)L; { const int q = nwg / NXCD, r = nwg % NXCD, xcd = wgid % NXCD, off = wgid / NXCD; wgid = (xcd < r ? xcd * (q + 1) : r * (q + 1) + (xcd - r) * q) + off; }
        const int nig = WGM * nN, gid = wgid / nig, fm = gid * WGM, gsz = (nM - fm) < WGM ? (nM - fm) : WGM;
        u.pm = fm + ((wgid % nig) % gsz); u.pn = (wgid % nig) / gsz; return true;
    }
    __device__ __forceinline__ void a_ready(const Unit&) const {}
    __device__ __forceinline__ void done(const Unit&) const {}
};

__device__ __forceinline__ unsigned cvt_pk_bf16(float lo, float hi) { unsigned r; asm volatile("v_cvt_pk_bf16_f32 %0, %1, %2" : "=v"(r) : "v"(lo), "v"(hi)); return r; }
typedef float f32x2 __attribute__((ext_vector_type(2)));
__device__ __forceinline__ f32x2 gelu_pk(f32x2 v) {
    const f32x2 av = __builtin_elementwise_abs(v), d = av * 0.2316418882f + 1.0f;
    f32x2 t; t.x = __builtin_amdgcn_rcpf(d.x); t.y = __builtin_amdgcn_rcpf(d.y);
    f32x2 q = t * 0.5307027145f + (-0.7265760135f); q = q * t + 0.7107068705f; q = q * t + (-0.142248368f); q = q * t + 0.127414796f; q = q * t;
    const f32x2 s = (v * v) * (-0.72134752044f);
    f32x2 e; e.x = __builtin_amdgcn_exp2f(s.x); e.y = __builtin_amdgcn_exp2f(s.y);
    const f32x2 m = v * (q * e), r = v - m;
    f32x2 o; o.x = v.x < 0.f ? m.x : r.x; o.y = v.y < 0.f ? m.y : r.y; return o;
}

template <int ACT  > struct EpiBf16 {
    static constexpr bool PERM = true, AFTER_DRAIN = false; static_assert(ACT == 0 || ACT == 1, "EpiBf16: ACT is 0 (none) or 1 (gelu_pk)");
    bf16_t* O; int ldc; const float* bias; int split_cols; size_t split_stride; float scale0;
    __device__ __forceinline__ void operator()(const f32x4 (&acc)[2][2][4][2], const Unit& u, int wr, int wc, int fr, int fq) const {
        const int row0 = u.pm * BM + wr * 64 + fr; int colt = u.pn * BM; bf16_t* base = O;
        float sc = 1.f; if (split_cols) { const int t = colt / split_cols; base += (size_t)t * split_stride; colt -= t * split_cols; if (t == 0) sc = scale0; }
        const int col0 = colt + wc * 32 + 8 * fq, bcol0 = u.pn * BM + wc * 32 + 8 * fq;
        f32x4 bv[2][2];
#pragma unroll
        for (int bj = 0; bj < 2; ++bj)
#pragma unroll
            for (int n = 0; n < 2; ++n) bv[bj][n] = bias ? *(const f32x4*)(bias + bcol0 + bj * HALF + 4 * n) : (f32x4){0.f, 0.f, 0.f, 0.f};
#pragma unroll
        for (int ai = 0; ai < 2; ++ai)
#pragma unroll
            for (int m = 0; m < 4; ++m) { bf16_t* rowp = base + (size_t)(row0 + ai * HALF + m * 16) * ldc + col0;
#pragma unroll
                for (int bj = 0; bj < 2; ++bj) { f32x4 v0 = acc[ai][bj][m][0] + bv[bj][0], v1 = acc[ai][bj][m][1] + bv[bj][1];
                    if (ACT == 1) { f32x2 a = gelu_pk((f32x2){v0[0], v0[1]}), b = gelu_pk((f32x2){v0[2], v0[3]}), c = gelu_pk((f32x2){v1[0], v1[1]}), d = gelu_pk((f32x2){v1[2], v1[3]});
                        v0 = (f32x4){a.x, a.y, b.x, b.y}; v1 = (f32x4){c.x, c.y, d.x, d.y}; }
                    v0 = v0 * sc; v1 = v1 * sc; u32x4 w; w.x = cvt_pk_bf16(v0[0], v0[1]); w.y = cvt_pk_bf16(v0[2], v0[3]); w.z = cvt_pk_bf16(v1[0], v1[1]); w.w = cvt_pk_bf16(v1[2], v1[3]);
                    *(u32x4*)(rowp + bj * HALF) = w; } }
    }
};
template <class Epi, class Sched, bool ALIGN_EPI = false, bool SP2 = false>
__device__ __forceinline__ void gemm_phase(PG8_LAS unsigned char* lds, const Gemm g, const Sched& S, const Epi& E, int tid_in) {
    int tid_ = tid_in; asm volatile("" : "+v"(tid_));
    const int tid = tid_, wid = __builtin_amdgcn_readfirstlane(tid >> 6), lane = tid & 63, wr = wid >> 2, wc = wid & 3, fr = lane & 15, fq = lane >> 4;
    const int K = g.K, nt = K / BK, LD = g.ld ? g.ld : g.K;
    unsigned voffA[2], voffB[2];
#pragma unroll
    for (int i = 0; i < 2; ++i) { int R, C; stage_rc(tid * 16 + i * 8192, R, C); const int Rb = Epi::PERM ? ((R & ~31) + perm32(R & 31)) : R;
        voffA[i] = (unsigned)(R * LD + C) * 2u; voffB[i] = (unsigned)(Rb * LD + C) * 2u; }
    const size_t kstep = (size_t)(BK * 2);
    const size_t hstep = (size_t)HALF * LD * 2;
    const size_t tstep = 2 * hstep;
    const unsigned ldsw = (unsigned)wid * 1024u;
    const int aoff = lds_byte(wr * 64 + fr, fq * 8), boff = lds_byte(wc * 32 + fr, fq * 8);
#define PG8_SA(b, h) (((b) * 2 + (h)) * HTB)
#define PG8_SB(b, h) ((4 + (b) * 2 + (h)) * HTB)
#define PG8_STAGE(bufoff, gbase, voff) do { _Pragma("unroll") for (int _i = 0; _i < 2; ++_i) \
        __builtin_amdgcn_global_load_lds((const unsigned*)((const char*)(gbase) + (voff)[_i]), (PG8_LAS unsigned*)(lds + (bufoff) + ldsw + _i * 8192), 16, 0, 0); } while (0)
#define PG8_LDA(dst, b, h) do { _Pragma("unroll") for (int m = 0; m < 4; ++m) _Pragma("unroll") for (int k = 0; k < 2; ++k) dst[m][k] = *(const PG8_LAS bf16x8*)(lds + PG8_SA(b, h) + aoff + m * 2048 + k * 1024); } while (0)
#define PG8_LDB(dst, b, h) do { _Pragma("unroll") for (int n = 0; n < 2; ++n) _Pragma("unroll") for (int k = 0; k < 2; ++k) dst[n][k] = *(const PG8_LAS bf16x8*)(lds + PG8_SB(b, h) + boff + n * 2048 + k * 1024); } while (0)
#define PG8_MMA(ai, bj, At, Bt) do { __builtin_amdgcn_s_setprio(1); _Pragma("unroll") for (int m = 0; m < 4; ++m) _Pragma("unroll") for (int n = 0; n < 2; ++n) _Pragma("unroll") for (int k = 0; k < 2; ++k) \
        acc[ai][bj][m][n] = __builtin_amdgcn_mfma_f32_16x16x32_bf16(Bt[n][k], At[m][k], acc[ai][bj][m][n], 0, 0, 0); __builtin_amdgcn_s_setprio(0); } while (0)
#define PG8_WAIT_V(n) asm volatile("s_waitcnt vmcnt(" #n ")" ::: "memory")
#define PG8_WAIT_L(n) asm volatile("s_waitcnt lgkmcnt(" #n ")" ::: "memory")
#define PG8_BAR __builtin_amdgcn_s_barrier()
#define PG8_SCHED __builtin_amdgcn_sched_barrier(0)
    Unit cur, nxt; int ui = 0;
    if (!S.next(0, cur)) return;
    f32x4 acc[2][2][4][2];
#pragma unroll
    for (int a = 0; a < 2; ++a)
#pragma unroll
        for (int b = 0; b < 2; ++b)
#pragma unroll
            for (int m = 0; m < 4; ++m)
#pragma unroll
                for (int n = 0; n < 2; ++n) acc[a][b][m][n] = (f32x4){0.f, 0.f, 0.f, 0.f};
    bf16x8 At[4][2], B0[2][2], B1[2][2];
    const char* cA = (const char*)g.A + (size_t)cur.pm * tstep + (size_t)cur.ko * 2; const char* cB = (const char*)g.Bt + (size_t)cur.pn * tstep + (size_t)cur.ko * 2;
    S.a_ready(cur);
    if constexpr (SP2) {
        PG8_STAGE(PG8_SB(0, 0), cB, voffB); PG8_STAGE(PG8_SB(0, 1), cB + hstep, voffB); PG8_STAGE(PG8_SA(0, 0), cA, voffA); PG8_STAGE(PG8_SA(0, 1), cA + hstep, voffA);
        if (wr == 1) PG8_BAR;
        PG8_WAIT_V(2); PG8_BAR;
        PG8_STAGE(PG8_SB(1, 0), cB + kstep, voffB); PG8_STAGE(PG8_SA(1, 0), cA + kstep, voffA); PG8_STAGE(PG8_SB(1, 1), cB + hstep + kstep, voffB);
        PG8_WAIT_V(6); PG8_BAR;
    } else {
        PG8_STAGE(PG8_SB(0, 0), cB, voffB); PG8_STAGE(PG8_SA(0, 0), cA, voffA); PG8_STAGE(PG8_SB(0, 1), cB + hstep, voffB); PG8_STAGE(PG8_SA(0, 1), cA + hstep, voffA);
        if (wr == 1) PG8_BAR;
        PG8_WAIT_V(4); PG8_BAR;
        PG8_STAGE(PG8_SB(1, 0), cB + kstep, voffB); PG8_STAGE(PG8_SA(1, 0), cA + kstep, voffA); PG8_STAGE(PG8_SB(1, 1), cB + hstep + kstep, voffB);
        PG8_WAIT_V(6); PG8_BAR;
    }
    for (;;) {
        const bool has_next = S.next(ui + 1, nxt);
        const char* nA = has_next ? (const char*)g.A + (size_t)nxt.pm * tstep + (size_t)nxt.ko * 2 : cA; const char* nB = has_next ? (const char*)g.Bt + (size_t)nxt.pn * tstep + (size_t)nxt.ko * 2 : cB;
        for (int t = 0; t < nt; t += 2) {
            const bool last = (t == nt - 2);
            const char* a1 = cA + (size_t)(t + 1) * kstep;
            const char* a2 = last ? nA : cA + (size_t)(t + 2) * kstep; const char* b2 = last ? nB : cB + (size_t)(t + 2) * kstep;
            const char* a3 = a2 + kstep; const char* b3 = b2 + kstep;
            if (last && has_next) S.a_ready(nxt);
            if constexpr (SP2) {
            PG8_LDB(B0, 0, 0); PG8_LDB(B1, 0, 1); PG8_SCHED; PG8_LDA(At, 0, 0); PG8_STAGE(PG8_SA(1, 1), a1 + hstep, voffA);
            PG8_WAIT_V(8); PG8_WAIT_L(0); PG8_BAR; PG8_MMA(0, 0, At, B0); PG8_MMA(0, 1, At, B1); PG8_BAR; PG8_SCHED;
            PG8_LDA(At, 0, 1); PG8_STAGE(PG8_SB(0, 0), b2, voffB); PG8_STAGE(PG8_SB(0, 1), b2 + hstep, voffB); PG8_STAGE(PG8_SA(0, 0), a2, voffA);
            PG8_WAIT_V(8); PG8_WAIT_L(0); PG8_BAR; PG8_MMA(1, 0, At, B0); PG8_MMA(1, 1, At, B1); PG8_BAR; PG8_SCHED;
            PG8_LDB(B0, 1, 0); PG8_LDB(B1, 1, 1); PG8_SCHED; PG8_LDA(At, 1, 0); PG8_STAGE(PG8_SA(0, 1), a2 + hstep, voffA);
            PG8_WAIT_V(8); PG8_WAIT_L(0); PG8_BAR; PG8_MMA(0, 0, At, B0); PG8_MMA(0, 1, At, B1); PG8_BAR; PG8_SCHED;
            PG8_LDA(At, 1, 1); PG8_STAGE(PG8_SB(1, 0), b3, voffB); PG8_STAGE(PG8_SB(1, 1), b3 + hstep, voffB); PG8_STAGE(PG8_SA(1, 0), a3, voffA);
            PG8_WAIT_V(8); PG8_WAIT_L(0); PG8_BAR; PG8_MMA(1, 0, At, B0); PG8_MMA(1, 1, At, B1); PG8_BAR; PG8_SCHED;
            } else {
            PG8_LDB(B0, 0, 0); PG8_SCHED; PG8_LDA(At, 0, 0); PG8_STAGE(PG8_SA(1, 1), a1 + hstep, voffA);
            PG8_WAIT_L(8); PG8_BAR; PG8_WAIT_L(0); PG8_MMA(0, 0, At, B0); PG8_BAR; PG8_SCHED;
            PG8_LDB(B1, 0, 1); PG8_STAGE(PG8_SB(0, 0), b2, voffB);
            PG8_BAR; PG8_WAIT_L(0); PG8_MMA(0, 1, At, B1); PG8_BAR;
            PG8_LDA(At, 0, 1); PG8_STAGE(PG8_SA(0, 0), a2, voffA);
            PG8_BAR; PG8_WAIT_L(0); PG8_MMA(1, 0, At, B0); PG8_BAR; PG8_SCHED;
            PG8_STAGE(PG8_SB(0, 1), b2 + hstep, voffB);
            PG8_WAIT_V(6); PG8_BAR; PG8_MMA(1, 1, At, B1); PG8_BAR;
            PG8_LDB(B0, 1, 0); PG8_SCHED; PG8_LDA(At, 1, 0); PG8_STAGE(PG8_SA(0, 1), a2 + hstep, voffA);
            PG8_WAIT_L(8); PG8_BAR; PG8_WAIT_L(0); PG8_MMA(0, 0, At, B0); PG8_BAR; PG8_SCHED;
            PG8_LDB(B1, 1, 1); PG8_STAGE(PG8_SB(1, 0), b3, voffB);
            PG8_BAR; PG8_WAIT_L(0); PG8_MMA(0, 1, At, B1); PG8_BAR;
            PG8_LDA(At, 1, 1); PG8_STAGE(PG8_SA(1, 0), a3, voffA);
            PG8_BAR; PG8_WAIT_L(0); PG8_MMA(1, 0, At, B0); PG8_BAR; PG8_SCHED;
            PG8_STAGE(PG8_SB(1, 1), b3 + hstep, voffB);
            PG8_WAIT_V(6); PG8_BAR; PG8_MMA(1, 1, At, B1); PG8_BAR;
            }
        }
        if constexpr (ALIGN_EPI) { if (wr == 0) PG8_BAR; }
        if constexpr (!Epi::AFTER_DRAIN) { int z_ = 0; asm volatile("" : "+v"(z_)); const int ln_ = __builtin_amdgcn_mbcnt_hi(-1, __builtin_amdgcn_mbcnt_lo(-1, z_)); E(acc, cur, wr, wc, ln_ & 15, ln_ >> 4); S.done(cur); }
        if (!has_next) break;
#pragma unroll
        for (int a = 0; a < 2; ++a)
#pragma unroll
            for (int b = 0; b < 2; ++b)
#pragma unroll
                for (int m = 0; m < 4; ++m)
#pragma unroll
                    for (int n = 0; n < 2; ++n) acc[a][b][m][n] = (f32x4){0.f, 0.f, 0.f, 0.f};
        cur = nxt; cA = nA; cB = nB; ++ui;
        if constexpr (ALIGN_EPI) { if (wr == 1) PG8_BAR; }
    }
    PG8_WAIT_V(0);
    if constexpr (!ALIGN_EPI) { if (wr == 0) PG8_BAR; }
    PG8_BAR;
    if constexpr (Epi::AFTER_DRAIN) { E.fused(acc, cur, wr, wc, fr, fq, lds, wid, lane); S.done(cur); }
#undef PG8_SA
#undef PG8_SB
#undef PG8_STAGE
#undef PG8_LDA
#undef PG8_LDB
#undef PG8_MMA
#undef PG8_WAIT_V
#undef PG8_WAIT_L
#undef PG8_BAR
#undef PG8_SCHED
}
}
namespace mk {
typedef pg8::bf16_t bf16;
typedef pg8::f32x4 f32x4;
typedef pg8::u32x4 u32x4;
typedef pg8::bf16x8 bf16x8;
typedef pg8::Unit Unit;
typedef float f32x16 __attribute__((ext_vector_type(16)));
typedef unsigned u32x2 __attribute__((ext_vector_type(2)));
typedef float f32x2 __attribute__((ext_vector_type(2)));
#define LAS __attribute__((address_space(3)))
#define LDS_WAIT() asm volatile("s_waitcnt lgkmcnt(0)" ::: "memory")

constexpr int DM = 1024, T = 4096, NBP = 4, MP = NBP * T, DB = 128, DS = 4, MS = DB * DS, M = MP + MS, NL = 4;
constexpr int INC = 2304, DFF = 2816, K2 = 512, N2 = 1280, PLE = 256;
constexpr int C_K = 512, C_V = 640, C_RW = 768, C_XB = 1792, C_GB = 2048;

constexpr size_t SZ_WIN = (size_t)INC * DM * 2, SZ_W2 = (size_t)N2 * K2 * 2, SZ_WOUT = (size_t)DM * DM * 2, SZ_WGU = (size_t)2 * DFF * DM * 2,
                 SZ_WD = (size_t)DM * DFF * 2, SZ_WPG = (size_t)DM * DM * 2, SZ_WP = (size_t)DM * PLE * 2;
constexpr size_t O_WIN = 0, O_W2 = O_WIN + SZ_WIN, O_WOUT = O_W2 + SZ_W2, O_WGU = O_WOUT + SZ_WOUT, O_WD = O_WGU + SZ_WGU, O_WPG = O_WD + SZ_WD,
                 O_WP = O_WPG + SZ_WPG, WL = O_WP + SZ_WP;
constexpr size_t WS_W = 1u << 20  , SZ_PBL = (size_t)M * PLE * 2, WS_X16 = WS_W + 2 * WL  , WS_PB = WS_X16 + (size_t)M * DM * 2  , SZ_ACT = (size_t)M * DM * 2, WS_PP = WS_PB + 2 * SZ_PBL  , WS_HN = WS_PP + SZ_ACT,
                 WS_R1 = WS_HN + SZ_ACT, SZ_R1 = (size_t)M * INC * 2, WS_R2 = WS_R1 + SZ_R1, SZ_F256 = (size_t)M * 256 * 4, WS_R3 = WS_R2 + 7 * SZ_F256,
                 WS_END = WS_R3 + 3 * SZ_F256;
static_assert(WL % 256 == 0 && SZ_R1 >= (size_t)M * DM * 4 && 7 * SZ_F256 >= (size_t)M * DFF * 2, "ws map");

constexpr size_t OUT_Y = 0, OUT_KP = (size_t)M * DM, OUT_VP = OUT_KP + (size_t)NL * NBP * 128 * 128, OUT_SHP = OUT_VP + (size_t)NL * NBP * 128 * 128,
                 OUT_WKVP = OUT_SHP + (size_t)NL * NBP * 1024, OUT_CVP = OUT_WKVP + (size_t)NL * NBP * 4 * 4096, OUT_LRP = OUT_CVP + (size_t)NL * NBP * 768,
                 OUT_KS = OUT_LRP + (size_t)NL * NBP * 256, OUT_VS = OUT_KS + (size_t)NL * DB * 128 * 128, OUT_SHS = OUT_VS + (size_t)NL * DB * 128 * 128,
                 OUT_WKVS = OUT_SHS + (size_t)NL * DB * 1024, OUT_CVS = OUT_WKVS + (size_t)NL * DB * 4 * 4096, OUT_LRS = OUT_CVS + (size_t)NL * DB * 768,
                 OUT_END = OUT_LRS + (size_t)NL * DB * 256;

enum { I_XP = 0, I_XS, I_CK, I_CV, I_SSH, I_SWKV, I_SCV, I_SLRU, I_PP, I_PS, I_NMPRE, I_NMPOST, I_NFPRE, I_NFPOST, I_WIN, I_BIN, I_SINK, I_MU, I_W0, I_WUP,
       I_A0, I_AUP, I_GUP, I_KK, I_KA, I_RK, I_LNW, I_LNB, I_CW, I_CB, I_WA, I_BA, I_WI, I_BI, I_L, I_WOUT, I_BOUT, I_WG, I_WU, I_WDN, I_PW, I_PGW, N_IN };

__device__ __forceinline__ unsigned f2bf(float f) { unsigned u = __float_as_uint(f); return (u + 0x7fffu + ((u >> 16) & 1u)) >> 16; }
__device__ __forceinline__ unsigned pk2(float lo, float hi) { return f2bf(lo) | (f2bf(hi) << 16); }
__device__ __forceinline__ float bflo(unsigned w) { return __uint_as_float(w << 16); }
__device__ __forceinline__ float bfhi(unsigned w) { return __uint_as_float(w & 0xffff0000u); }
__device__ __forceinline__ float bf1(bf16 b) { return __uint_as_float((unsigned)b << 16); }
__device__ __forceinline__ f32x4 ld_bf4(const bf16* p) { const u32x2 w = *(const u32x2*)p; return (f32x4){bflo(w.x), bfhi(w.x), bflo(w.y), bfhi(w.y)}; }
__device__ __forceinline__ void st_bf4(bf16* p, f32x4 v) { u32x2 w; w.x = pk2(v.x, v.y); w.y = pk2(v.z, v.w); *(u32x2*)p = w; }
__device__ __forceinline__ void ld_bf8(const bf16* p, f32x4& lo, f32x4& hi) { const u32x4 w = *(const u32x4*)p; lo = (f32x4){bflo(w.x), bfhi(w.x), bflo(w.y), bfhi(w.y)}; hi = (f32x4){bflo(w.z), bfhi(w.z), bflo(w.w), bfhi(w.w)}; }
__device__ __forceinline__ void st_bf8(bf16* p, f32x4 lo, f32x4 hi) { u32x4 w; w.x = pk2(lo.x, lo.y); w.y = pk2(lo.z, lo.w); w.z = pk2(hi.x, hi.y); w.w = pk2(hi.z, hi.w); *(u32x4*)p = w; }
__device__ __forceinline__ float sigm(float x) { return __builtin_amdgcn_rcpf(1.f + __expf(-x)); }
__device__ __forceinline__ float tanh_(float x) { return 1.f - 2.f * __builtin_amdgcn_rcpf(__expf(2.f * x) + 1.f); }
__device__ __forceinline__ float gelu_t(float x) { return 0.5f * x * (1.f + tanh_(0.7978845608f * (x + 0.044715f * x * x * x))); }
template <int CTRL> __device__ __forceinline__ float dppf(float x) { return __builtin_bit_cast(float, __builtin_amdgcn_mov_dpp(__builtin_bit_cast(int, x), CTRL, 0xf, 0xf, true)); }
__device__ __forceinline__ float red16(float x) { x += dppf<0xB1>(x); x += dppf<0x4E>(x); x += dppf<0x141>(x); x += dppf<0x128>(x); return x; }
__device__ __forceinline__ float wave_sum(float v) {
    v = red16(v);
    v += __builtin_bit_cast(float, __builtin_amdgcn_update_dpp(0, __builtin_bit_cast(int, v), 0x142, 0xa, 0xf, false));
    v += __builtin_bit_cast(float, __builtin_amdgcn_update_dpp(0, __builtin_bit_cast(int, v), 0x143, 0xc, 0xf, false));
    return __builtin_bit_cast(float, __builtin_amdgcn_readlane(__builtin_bit_cast(int, v), 63));
}
__device__ __forceinline__ float vmul(float a, float b) { float d; asm("v_mul_f32 %0, %1, %2" : "=v"(d) : "v"(a), "v"(b)); return d; }
__device__ __forceinline__ float vfma(float a, float b, float c) { float d; asm("v_fma_f32 %0, %1, %2, %3" : "=v"(d) : "v"(a), "v"(b), "v"(c)); return d; }
__device__ __forceinline__ float vfnma(float a, float b, float c) { float d; asm("v_fma_f32 %0, -%1, %2, %3" : "=v"(d) : "v"(a), "v"(b), "v"(c)); return d; }
__device__ __forceinline__ void red16x2(float& p, float& q) {
    asm volatile("v_add_f32_dpp %0, %0, %0 quad_perm:[1,0,3,2] row_mask:0xf bank_mask:0xf bound_ctrl:1\n\t"
                 "v_add_f32_dpp %1, %1, %1 quad_perm:[1,0,3,2] row_mask:0xf bank_mask:0xf bound_ctrl:1\n\ts_nop 0\n\t"
                 "v_add_f32_dpp %0, %0, %0 quad_perm:[2,3,0,1] row_mask:0xf bank_mask:0xf bound_ctrl:1\n\t"
                 "v_add_f32_dpp %1, %1, %1 quad_perm:[2,3,0,1] row_mask:0xf bank_mask:0xf bound_ctrl:1\n\ts_nop 0\n\t"
                 "v_add_f32_dpp %0, %0, %0 row_half_mirror row_mask:0xf bank_mask:0xf bound_ctrl:1\n\t"
                 "v_add_f32_dpp %1, %1, %1 row_half_mirror row_mask:0xf bank_mask:0xf bound_ctrl:1\n\ts_nop 0\n\t"
                 "v_add_f32_dpp %0, %0, %0 row_ror:8 row_mask:0xf bank_mask:0xf bound_ctrl:1\n\t"
                 "v_add_f32_dpp %1, %1, %1 row_ror:8 row_mask:0xf bank_mask:0xf bound_ctrl:1\n\ts_nop 1"
                 : "+v"(p), "+v"(q));
}
__device__ __forceinline__ float shx(float v, int mask, int lane) { return __builtin_bit_cast(float, __builtin_amdgcn_ds_bpermute((lane ^ mask) << 2, __builtin_bit_cast(int, v))); }
__device__ __forceinline__ float dot4(f32x4 a, f32x4 b) { return (a.x * b.x + a.y * b.y) + (a.z * b.z + a.w * b.w); }

struct EpiF32 {
    static constexpr bool PERM = false, AFTER_DRAIN = false;
    float* O; int ldc; const float* bias;
    __device__ __forceinline__ void operator()(const f32x4 (&acc)[2][2][4][2], const Unit& u, int wr, int wc, int fr, int fq) const {
        asm volatile("" : "+v"(fr), "+v"(fq));
        const int row0 = u.pm * 256 + wr * 64 + fr, col0 = u.pn * 256 + wc * 32 + 4 * fq;
        f32x4 bv[2][2];
#pragma unroll
        for (int bj = 0; bj < 2; ++bj)
#pragma unroll
            for (int n = 0; n < 2; ++n) bv[bj][n] = bias ? *(const f32x4*)(bias + col0 + bj * 128 + n * 16) : (f32x4){0.f, 0.f, 0.f, 0.f};
#pragma unroll
        for (int ai = 0; ai < 2; ++ai)
#pragma unroll
            for (int m = 0; m < 4; ++m) { float* rowp = O + (size_t)(row0 + ai * 128 + m * 16) * ldc + col0;
#pragma unroll
                for (int bj = 0; bj < 2; ++bj)
#pragma unroll
                    for (int n = 0; n < 2; ++n) *(f32x4*)(rowp + bj * 128 + n * 16) = acc[ai][bj][m][n] + bv[bj][n]; }
    }
};
struct EpiPle {
    static constexpr bool PERM = false, AFTER_DRAIN = false;
    bf16* X; const bf16* PP; float* Y;
    __device__ __forceinline__ void operator()(const f32x4 (&acc)[2][2][4][2], const Unit& u, int wr, int wc, int fr, int fq) const {
        asm volatile("" : "+v"(fr), "+v"(fq));
        const int row0 = u.pm * 256 + wr * 64 + fr, col0 = u.pn * 256 + wc * 32 + 4 * fq;
#pragma unroll
        for (int ai = 0; ai < 2; ++ai)
#pragma unroll
            for (int m = 0; m < 4; ++m) { const size_t off = (size_t)(row0 + ai * 128 + m * 16) * DM + col0;
#pragma unroll
                for (int bj = 0; bj < 2; ++bj)
#pragma unroll
                    for (int n = 0; n < 2; ++n) { const size_t o = off + bj * 128 + n * 16; const f32x4 x = ld_bf4(X + o), p = ld_bf4(PP + o), a = acc[ai][bj][m][n];
                        const f32x4 r = (f32x4){x.x + sigm(a.x) * p.x, x.y + sigm(a.y) * p.y, x.z + sigm(a.z) * p.z, x.w + sigm(a.w) * p.w};
                        if (Y) *(f32x4*)(Y + o) = r; else st_bf4(X + o, r); }
                asm volatile("" ::: "memory"); }
    }
};
struct EpiSwiglu {
    static constexpr bool PERM = true, AFTER_DRAIN = false;
    bf16* O;
    __device__ __forceinline__ void operator()(const f32x4 (&acc)[2][2][4][2], const Unit& u, int wr, int wc, int fr, int fq) const {
        asm volatile("" : "+v"(fr), "+v"(fq));
        const int row0 = u.pm * 256 + wr * 64 + fr, col0 = u.pn * 128 + wc * 32 + 8 * fq;
#pragma unroll
        for (int ai = 0; ai < 2; ++ai)
#pragma unroll
            for (int m = 0; m < 4; ++m) { bf16* p = O + (size_t)(row0 + ai * 128 + m * 16) * DFF + col0;
                const f32x4 g0 = acc[ai][0][m][0], g1 = acc[ai][0][m][1], u0 = acc[ai][1][m][0], u1 = acc[ai][1][m][1];
                u32x4 w; w.x = pk2(g0.x * sigm(g0.x) * u0.x, g0.y * sigm(g0.y) * u0.y); w.y = pk2(g0.z * sigm(g0.z) * u0.z, g0.w * sigm(g0.w) * u0.w);
                w.z = pk2(g1.x * sigm(g1.x) * u1.x, g1.y * sigm(g1.y) * u1.y); w.w = pk2(g1.z * sigm(g1.z) * u1.z, g1.w * sigm(g1.w) * u1.w);
                *(u32x4*)p = w; }
    }
};
struct G2Order {
    pg8::StaticOrder b;
    __device__ bool next(int i, Unit& u) const { if (!b.next(i, u)) return false; u.ko = u.pn < 3 ? 0 : 256; return true; }
    __device__ __forceinline__ void a_ready(const Unit&) const {}
    __device__ __forceinline__ void done(const Unit&) const {}
};
struct SplitOrder {
    int c, G, kh;
    __device__ bool next(int i, Unit& u) const { const long L = (long)i * G + c; if (L >= 16) return false; u.pm = (int)L >> 3; u.pn = ((int)L >> 1) & 3; u.ko = ((int)L & 1) * kh; return true; }
    __device__ __forceinline__ void a_ready(const Unit&) const {}
    __device__ __forceinline__ void done(const Unit&) const {}
};
struct EpiPart {
    static constexpr bool PERM = false, AFTER_DRAIN = false;
    float* P;
    __device__ __forceinline__ void operator()(const f32x4 (&acc)[2][2][4][2], const Unit& u, int wr, int wc, int fr, int fq) const {
        asm volatile("" : "+v"(fr), "+v"(fq));
        const int row0 = u.pm * 256 + wr * 64 + fr, col0 = u.pn * 256 + wc * 32 + 4 * fq; float* O = P + (u.ko ? (size_t)MS * DM : 0);
#pragma unroll
        for (int ai = 0; ai < 2; ++ai)
#pragma unroll
            for (int m = 0; m < 4; ++m) { float* rowp = O + (size_t)(row0 + ai * 128 + m * 16) * DM + col0;
#pragma unroll
                for (int bj = 0; bj < 2; ++bj)
#pragma unroll
                    for (int n = 0; n < 2; ++n) *(f32x4*)(rowp + bj * 128 + n * 16) = acc[ai][bj][m][n]; }
    }
};
struct EpiMix {
    static constexpr bool PERM = false, AFTER_DRAIN = false;
    const float *w0, *a0, *k_a, *b_a, *b_i, *Lp; float* Wd; bf16 *Ks, *KK, *BV, *G; float *AL, *U; const bf16* A2;
    __device__ __forceinline__ void operator()(const f32x4 (&acc)[2][2][4][2], const Unit& u, int wr, int wc, int fr, int fq) const {
        asm volatile("" : "+v"(fr), "+v"(fq));
        const int row0 = u.pm * 256 + wr * 64 + fr;
        if (u.pn < 3) {
#pragma unroll
            for (int ai = 0; ai < 2; ++ai)
#pragma unroll
                for (int m = 0; m < 4; ++m) { const size_t ro = (size_t)(row0 + ai * 128 + m * 16) * 256;
#pragma unroll
                    for (int bj = 0; bj < 2; ++bj)
#pragma unroll
                        for (int n = 0; n < 2; ++n) { const int c = bj * 128 + wc * 32 + n * 16 + 4 * fq; const f32x4 z = acc[ai][bj][m][n];
                            if (u.pn == 0) { const f32x4 b = *(const f32x4*)(w0 + c); f32x4 d;
                                d.x = __expf(-0.60653066f * sigm(z.x + b.x)); d.y = __expf(-0.60653066f * sigm(z.y + b.y)); d.z = __expf(-0.60653066f * sigm(z.z + b.z)); d.w = __expf(-0.60653066f * sigm(z.w + b.w));
                                *(f32x4*)(Wd + ro + c) = d; }
                            else if (u.pn == 1) { const f32x4 b = *(const f32x4*)(a0 + c), ka = *(const f32x4*)(k_a + c), ks = ld_bf4(Ks + ro + c), kk = ld_bf4(KK + ro + c);
                                f32x4 a; a.x = sigm(z.x + b.x); a.y = sigm(z.y + b.y); a.z = sigm(z.z + b.z); a.w = sigm(z.w + b.w);
                                st_bf4(Ks + ro + c, ks * (1.f + (a - 1.f) * ka)); st_bf4(BV + ro + c, kk * a); }
                            else { st_bf4(G + ro + c, z); }
                            asm volatile("" ::: "memory"); } }
        } else {
            const int t = u.pn - 3;
#pragma unroll
            for (int ai = 0; ai < 2; ++ai)
#pragma unroll
                for (int m = 0; m < 4; ++m) { const size_t r = (size_t)(row0 + ai * 128 + m * 16);
#pragma unroll
                    for (int n = 0; n < 2; ++n) { const int cc = 128 * t + wc * 32 + n * 16 + 4 * fq;
                        const f32x4 zr = acc[ai][0][m][n] + *(const f32x4*)(b_a + cc), zi = acc[ai][1][m][n] + *(const f32x4*)(b_i + cc), Lv = *(const f32x4*)(Lp + cc), xc = ld_bf4(A2 + r * K2 + 256 + cc);
                        f32x4 al, uu;
#define LRU1(e) { const float xe = __expf(-Lv.e); const float ls = -xe * (1.f + xe * (-0.5f + xe * 0.33333334f)); const float la = 8.f * sigm(zr.e) * ls; al.e = __expf(la); const float z2 = 2.f * la; \
    const float om = -z2 * (1.f + z2 * (0.5f + z2 * (0.16666667f + z2 * (0.041666668f + z2 * 0.0083333338f)))); uu.e = __builtin_amdgcn_sqrtf(om) * sigm(zi.e) * xc.e; }
                        LRU1(x) LRU1(y) LRU1(z) LRU1(w)
#undef LRU1
                        *(f32x4*)(AL + r * 256 + cc) = al; *(f32x4*)(U + r * 256 + cc) = uu; asm volatile("" ::: "memory"); } }
        }
    }
};
#define RLX_AGENT __ATOMIC_RELAXED, __HIP_MEMORY_SCOPE_AGENT
#define XB_TMO      128
#define XB_XCNT(j)  (256  + 64 * (j))
#define XB_XSUB(j)  (1280 + 64 * (j))
#define XB_XGEN(j)  (2304 + 64 * (j))
#define XB_TOP      3328
#define XB_TOPGEN   3392
#define XCD_BAR_WORDS 3456
#define XB_SPIN_CAP (1u << 18)

__device__ __forceinline__ unsigned xb_ld(unsigned* p)              { return __hip_atomic_load(p, __ATOMIC_RELAXED, __HIP_MEMORY_SCOPE_AGENT); }
__device__ __forceinline__ unsigned xb_add(unsigned* p, unsigned v) { return __hip_atomic_fetch_add(p, v, __ATOMIC_RELAXED, __HIP_MEMORY_SCOPE_AGENT); }
__device__ __forceinline__ unsigned xb_xcc_id() { return (unsigned)__builtin_amdgcn_s_getreg((3 << 11) | 20) & 0xFu; }
#define XB_SPIN(cond, bar) do { unsigned _sp = 0; while (cond) { __builtin_amdgcn_s_sleep(1); \
    if ((++_sp & 255u) == 0u) { if (xb_ld(&(bar)[XB_TMO])) break; if (_sp > XB_SPIN_CAP) { atomicAdd(&(bar)[XB_TMO], 1u); break; } } } } while (0)

struct XcdBarrier {
    unsigned* bar; unsigned x;
    volatile LAS unsigned* st;
};

__device__ __forceinline__ XcdBarrier xcd_barrier_post(unsigned* bar, volatile LAS unsigned* st, int tid) {
    XcdBarrier b; b.bar = bar; b.x = xb_xcc_id(); b.st = st;
    if (tid == 0) (void)xb_add(&bar[XB_XCNT(b.x)], 1u);
    return b;
}
__device__ __forceinline__ void xcd_barrier_complete(unsigned* bar, unsigned x, unsigned& nloc, unsigned& nx) {
    const unsigned G = gridDim.x * gridDim.y * gridDim.z;
    unsigned sum, cnt, mine, sp = 0u;
    for (;;) {
        sum = 0u; cnt = 0u; mine = 0u;
#pragma unroll
        for (unsigned j = 0; j < 16; ++j) { const unsigned c = xb_ld(&bar[XB_XCNT(j)]); sum += c; cnt += (c > 0u) ? 1u : 0u; mine = (j == x) ? c : mine; }
        if (sum == G) break;
        __builtin_amdgcn_s_sleep(1);
        if ((++sp & 255u) == 0u) { if (xb_ld(&bar[XB_TMO])) break; if (sp > XB_SPIN_CAP) { atomicAdd(&bar[XB_TMO], 1u); break; } }
    }
    nloc = mine > 0u ? mine : 1u; nx = cnt > 0u ? cnt : 1u;
}

__device__ __forceinline__ void xcd_barrier(const XcdBarrier& b, int tid) {
    asm volatile("s_waitcnt vmcnt(0)" ::: "memory");
    __syncthreads();
    if (tid == 0) {
        unsigned* bar = b.bar;
        __builtin_amdgcn_s_waitcnt(0);
        unsigned nloc = b.st[0], nx = b.st[1];
        if (nloc == 0u) { xcd_barrier_complete(bar, b.x, nloc, nx); b.st[0] = nloc; b.st[1] = nx; }
        const unsigned old = xb_add(&bar[XB_XSUB(b.x)], 1u);
        const unsigned gen = old / nloc;
        if (old + 1u == (gen + 1u) * nloc) {
            __builtin_amdgcn_fence(__ATOMIC_RELEASE, "agent");
            asm volatile("s_waitcnt vmcnt(0)" ::: "memory");
            const unsigned og = xb_add(&bar[XB_TOP], 1u);
            const unsigned tg = og / nx;
            if (og + 1u == (tg + 1u) * nx) xb_add(&bar[XB_TOPGEN], 1u);
            else XB_SPIN(xb_ld(&bar[XB_TOPGEN]) == tg, bar);
            __builtin_amdgcn_fence(__ATOMIC_ACQUIRE, "agent");
            xb_add(&bar[XB_XGEN(b.x)], 1u);
            asm volatile("s_waitcnt vmcnt(0)" ::: "memory");
        } else {
            XB_SPIN(xb_ld(&bar[XB_XGEN(b.x)]) == gen, bar);
            __builtin_amdgcn_fence(__ATOMIC_ACQUIRE, "agent");
            asm volatile("s_waitcnt vmcnt(0)" ::: "memory");
        }
    }
    __syncthreads();
}
struct Args { const float* in[N_IN]; float* out; unsigned char* ws; };
struct Ctx {
    LAS unsigned char* lds; unsigned char* ws; float* out;
    int tid, lane, wave, bid, G, gw, NGW;
};
__device__ __forceinline__ const float* inp_ld(int k) {
    asm volatile("" : "+s"(k));
    const __attribute__((address_space(4))) unsigned long long* tab = (const __attribute__((address_space(4))) unsigned long long*)__builtin_amdgcn_kernarg_segment_ptr();
    return (const float*)tab[k];
}
#define INP(k) inp_ld(k)
__device__ __forceinline__ int opq(int v) { asm volatile("" : "+v"(v)); return v; }

__device__ __forceinline__ void tr_item(const float* W, int ldw, bf16* WT, int ldt, int k0, int n0, int drow, int dcol, LAS float* scr, int lane) {
#pragma unroll 8
    for (int i = 0; i < 32; ++i) { const int kk = 2 * i + (lane >> 5); scr[kk * 33 + (lane & 31)] = W[(size_t)(k0 + kk) * ldw + n0 + (lane & 31)]; }
    LDS_WAIT(); asm volatile("" ::: "memory");
    const int c = lane & 7;
#pragma unroll
    for (int j = 0; j < 4; ++j) { const int n = (lane >> 3) + 8 * j; const LAS float* s = scr + (8 * c) * 33 + n;
        u32x4 o; o.x = pk2(s[0 * 33], s[1 * 33]); o.y = pk2(s[2 * 33], s[3 * 33]); o.z = pk2(s[4 * 33], s[5 * 33]); o.w = pk2(s[6 * 33], s[7 * 33]);
        *(u32x4*)(WT + (size_t)(drow + n) * ldt + dcol + 8 * c) = o; }
    LDS_WAIT(); asm volatile("" ::: "memory");
}
__device__ __forceinline__ void row_norm_in(const float* xrow, const float* g, bf16* orow, bf16* xcopy, int lane) {
    f32x4 v[4]; float ss = 0.f;
#pragma unroll
    for (int j = 0; j < 4; ++j) { v[j] = *(const f32x4*)(xrow + 4 * lane + 256 * j); ss += dot4(v[j], v[j]); }
    const float rs = rsqrtf(wave_sum(ss) * (1.f / DM) + 1e-6f);
#pragma unroll
    for (int j = 0; j < 4; ++j) { const f32x4 gg = *(const f32x4*)(g + 4 * lane + 256 * j); if (xcopy) st_bf4(xcopy + 4 * lane + 256 * j, v[j]); st_bf4(orow + 4 * lane + 256 * j, v[j] * rs * gg); }
}
__device__ __forceinline__ void row_norm(const bf16* xrow, const float* g, bf16* orow, int lane) {
    f32x4 v[4]; float ss = 0.f;
#pragma unroll
    for (int j = 0; j < 2; ++j) { ld_bf8(xrow + 8 * lane + 512 * j, v[2 * j], v[2 * j + 1]); ss += dot4(v[2 * j], v[2 * j]) + dot4(v[2 * j + 1], v[2 * j + 1]); }
    const float rs = rsqrtf(wave_sum(ss) * (1.f / DM) + 1e-6f);
#pragma unroll
    for (int j = 0; j < 2; ++j) { const float* gp = g + 8 * lane + 512 * j; st_bf8(orow + 8 * lane + 512 * j, v[2 * j] * rs * *(const f32x4*)gp, v[2 * j + 1] * rs * *(const f32x4*)(gp + 4)); }
}
__device__ __forceinline__ void row_update_parts(const float* p0, const float* p1, const float* bias, const float* gA, bf16* X, const float* gB, bf16* outB, int lane) {
    f32x4 a[4], x[4]; float ss = 0.f;
#pragma unroll
    for (int j = 0; j < 4; ++j) { a[j] = *(const f32x4*)(p0 + 4 * lane + 256 * j) + *(const f32x4*)(p1 + 4 * lane + 256 * j); if (bias) a[j] = a[j] + *(const f32x4*)(bias + 4 * lane + 256 * j);
        x[j] = ld_bf4(X + 4 * lane + 256 * j); ss += dot4(a[j], a[j]); }
    const float rs = rsqrtf(wave_sum(ss) * (1.f / DM) + 1e-6f); float s2 = 0.f;
#pragma unroll
    for (int j = 0; j < 4; ++j) { const f32x4 gg = *(const f32x4*)(gA + 4 * lane + 256 * j); x[j] = x[j] + a[j] * rs * gg; st_bf4(X + 4 * lane + 256 * j, x[j]); s2 += dot4(x[j], x[j]); }
    float r2 = 1.f;
    if (gB) r2 = rsqrtf(wave_sum(s2) * (1.f / DM) + 1e-6f);
#pragma unroll
    for (int j = 0; j < 4; ++j) { f32x4 o = x[j]; if (gB) o = o * r2 * *(const f32x4*)(gB + 4 * lane + 256 * j); st_bf4(outB + 4 * lane + 256 * j, o); }
}
__device__ __forceinline__ void row_update(const bf16* add, const float* gA, bf16* X, const float* gB, bf16* outB, int lane) {
    f32x4 a[4], x[4]; float ss = 0.f;
#pragma unroll
    for (int j = 0; j < 2; ++j) { ld_bf8(add + 8 * lane + 512 * j, a[2 * j], a[2 * j + 1]); ld_bf8(X + 8 * lane + 512 * j, x[2 * j], x[2 * j + 1]); ss += dot4(a[2 * j], a[2 * j]) + dot4(a[2 * j + 1], a[2 * j + 1]); }
    const float rs = rsqrtf(wave_sum(ss) * (1.f / DM) + 1e-6f); float s2 = 0.f;
#pragma unroll
    for (int j = 0; j < 2; ++j) { const float* gp = gA + 8 * lane + 512 * j; x[2 * j] = x[2 * j] + a[2 * j] * rs * *(const f32x4*)gp; x[2 * j + 1] = x[2 * j + 1] + a[2 * j + 1] * rs * *(const f32x4*)(gp + 4);
        st_bf8(X + 8 * lane + 512 * j, x[2 * j], x[2 * j + 1]); s2 += dot4(x[2 * j], x[2 * j]) + dot4(x[2 * j + 1], x[2 * j + 1]); }
    float r2 = 1.f;
    if (gB) r2 = rsqrtf(wave_sum(s2) * (1.f / DM) + 1e-6f);
#pragma unroll
    for (int j = 0; j < 2; ++j) { f32x4 o0 = x[2 * j], o1 = x[2 * j + 1]; if (gB) { const float* gp = gB + 8 * lane + 512 * j; o0 = o0 * r2 * *(const f32x4*)gp; o1 = o1 * r2 * *(const f32x4*)(gp + 4); } st_bf8(outB + 8 * lane + 512 * j, o0, o1); }
}

__device__ __forceinline__ void convert_layer(const Ctx& C, const Args& A, int l, int gw0, int ngw, int gt, int NT) {
    LAS float* scr = (LAS float*)(C.lds + C.wave * 16384);
    constexpr int J0 = 16 * 72, J1 = 16 * 32, J2 = 16 * 88, J4 = 44 * 32, J5 = 16 * 32, J6 = 4 * 32, JL = J0 + J1 + 2 * J2 + J4 + J5 + J6;
    unsigned char* wl = C.ws + WS_W + (size_t)(l & 1) * WL;
    for (int it = gw0; it < JL; it += ngw) {
        int r = it;
        const float* W; int ldw, ldt, kb, nb, drow; bf16* WT;
        if (r < J0) { W = INP(I_WIN) + (size_t)l * DM * INC; ldw = INC; WT = (bf16*)(wl + O_WIN); ldt = DM; kb = r / 72; nb = r % 72; drow = 32 * nb; }
        else if ((r -= J0) < J1) { W = INP(I_WOUT) + (size_t)l * DM * DM; ldw = DM; WT = (bf16*)(wl + O_WOUT); ldt = DM; kb = r / 32; nb = r % 32; drow = 32 * nb; }
        else if ((r -= J1) < J2) { W = INP(I_WG) + (size_t)l * DM * DFF; ldw = DFF; WT = (bf16*)(wl + O_WGU); ldt = DM; kb = r / 88; nb = r % 88; drow = (nb >> 2) * 256 + (nb & 3) * 32; }
        else if ((r -= J2) < J2) { W = INP(I_WU) + (size_t)l * DM * DFF; ldw = DFF; WT = (bf16*)(wl + O_WGU); ldt = DM; kb = r / 88; nb = r % 88; drow = (nb >> 2) * 256 + 128 + (nb & 3) * 32; }
        else if ((r -= J2) < J4) { W = INP(I_WDN) + (size_t)l * DFF * DM; ldw = DM; WT = (bf16*)(wl + O_WD); ldt = DFF; kb = r / 32; nb = r % 32; drow = 32 * nb; }
        else if ((r -= J4) < J5) { W = INP(I_PGW) + (size_t)l * DM * DM; ldw = DM; WT = (bf16*)(wl + O_WPG); ldt = DM; kb = r / 32; nb = r % 32; drow = 32 * nb; }
        else { r -= J5; W = INP(I_PW) + (size_t)l * PLE * DM; ldw = DM; WT = (bf16*)(wl + O_WP); ldt = PLE; kb = r / 32; nb = r % 32; drow = 32 * nb; }
        tr_item(W, ldw, WT, ldt, 64 * kb, 32 * nb, drow, 64 * kb, scr, C.lane);
    }
#pragma unroll 1
    for (int r = gt; r < N2 * K2; r = opq(r + NT)) {
        const int n = r / K2, k = r % K2; float v = 0.f;
        if (n < 256) { if (k < 64) v = INP(I_WUP)[((size_t)l * 64 + k) * 256 + n]; }
        else if (n < 512) { if (k >= 64 && k < 128) v = INP(I_AUP)[((size_t)l * 64 + (k - 64)) * 256 + (n - 256)]; }
        else if (n < 768) { if (k >= 128 && k < 256) v = INP(I_GUP)[((size_t)l * 128 + (k - 128)) * 256 + (n - 512)]; }
        else { const int tt = (n - 768) >> 8, rr = (n - 768) & 255, cc = 128 * tt + (rr & 127), h = cc >> 6, j = cc & 63;
            if (k >= 256 && ((k - 256) >> 6) == h) v = ((rr >> 7) ? INP(I_WI) : INP(I_WA))[(((size_t)l * 4 + h) * 64 + ((k - 256) & 63)) * 64 + j]; }
        ((bf16*)(wl + O_W2))[r] = (bf16)f2bf(v);
    }
#pragma unroll 1
    for (int r = gt; r < M * (PLE / 4); r = opq(r + NT)) {
        const int m = r >> 6, c4 = (r & 63) * 4;
        const float* src = m < MP ? INP(I_PP) + ((size_t)l * MP + m) * PLE + c4 : INP(I_PS) + ((size_t)l * MS + (m - MP)) * PLE + c4;
        st_bf4((bf16*)(C.ws + WS_PB + (size_t)(l & 1) * SZ_PBL) + (size_t)m * PLE + c4, *(const f32x4*)src);
    }
}
__device__ __forceinline__ void p0_prologue(const Ctx& C, const Args& A) {
    convert_layer(C, A, 0, C.gw, C.NGW, C.bid * 512 + C.tid, C.G * 512);
    for (int m = C.gw; m < M; m += C.NGW) {
        const float* src = m < MP ? INP(I_XP) + (size_t)m * DM : INP(I_XS) + (size_t)(m - MP) * DM;
        row_norm_in(src, INP(I_NMPRE), (bf16*)(C.ws + WS_HN) + (size_t)m * DM, (bf16*)(C.ws + WS_X16) + (size_t)m * DM, C.lane);
    }
}

__device__ __forceinline__ void e1_prep(const Ctx& C, const Args& A, int l) {
    const bf16* PROJ = (const bf16*)(C.ws + WS_R1);
    bf16* R = (bf16*)(C.ws + WS_R2); bf16* Ks = (bf16*)(C.ws + WS_R2 + SZ_F256); bf16* V = (bf16*)(C.ws + WS_R2 + 2 * SZ_F256); bf16* KK = (bf16*)(C.ws + WS_R2 + 3 * SZ_F256);
    bf16* A2 = (bf16*)(C.ws + WS_R3);
    const int lane = C.lane, c4 = 4 * lane;
    for (int m = C.gw; m < M; m += C.NGW) {
        const bool samp = m >= MP; int b, t;
        if (!samp) { b = m >> 12; t = m & 4095; } else { b = (m - MP) >> 2; t = (m - MP) & 3; }
        const bf16* pr = PROJ + (size_t)m * INC;
#pragma unroll
        for (int cg = 0; cg < 4; ++cg) {
            const int col = 256 * cg + c4;
            const f32x4 cur = ld_bf4(pr + C_RW + col); f32x4 prv = (f32x4){0.f, 0.f, 0.f, 0.f};
            if (t > 0) prv = ld_bf4(pr - INC + C_RW + col);
            else if (samp) prv = *(const f32x4*)(INP(I_SSH) + ((size_t)l * DB + b) * 1024 + col);
            const f32x4 mu = *(const f32x4*)(INP(I_MU) + l * 1024 + col);
            const f32x4 xs = cur + (prv - cur) * mu;
            if (cg == 0) st_bf4(R + (size_t)m * 256 + c4, xs);
            else if (cg == 1) { st_bf4(Ks + (size_t)m * 256 + c4, xs); f32x4 kk = xs * *(const f32x4*)(INP(I_KK) + l * 256 + c4);
                const float ss = red16(dot4(kk, kk)); kk = kk * rsqrtf(fmaxf(ss, 1e-24f)); st_bf4(KK + (size_t)m * 256 + c4, kk); }
            else if (cg == 2) st_bf4(V + (size_t)m * 256 + c4, xs);
            else { f32x4 o;
                if (lane < 16) o = (f32x4){tanh_(xs.x), tanh_(xs.y), tanh_(xs.z), tanh_(xs.w)};
                else if (lane < 32) o = xs;
                else o = (f32x4){sigm(xs.x), sigm(xs.y), sigm(xs.z), sigm(xs.w)};
                st_bf4(A2 + (size_t)m * K2 + c4, o); }
        }
        f32x4 xc = *(const f32x4*)(INP(I_CB) + l * 256 + c4);
#pragma unroll
        for (int j = 0; j < 4; ++j) { const int tt = t - 3 + j; f32x4 val = (f32x4){0.f, 0.f, 0.f, 0.f};
            if (tt >= 0) val = ld_bf4(pr + (ptrdiff_t)(j - 3) * INC + C_XB + c4);
            else if (samp) val = *(const f32x4*)(INP(I_SCV) + (((size_t)l * DB + b) * 3 + (tt + 3)) * 256 + c4);
            xc = xc + val * *(const f32x4*)(INP(I_CW) + ((size_t)l * 4 + j) * 256 + c4); }
        st_bf4(A2 + (size_t)m * K2 + 256 + c4, xc);
    }
    const int gt = C.bid * 512 + C.tid, NT = C.G * 512;
    float* out = C.out;
#pragma unroll 1
    for (int e = gt; e < 2 * NBP * 128 * 128; e = opq(e + NT)) {
        const int kv = e / (NBP * 16384), r = e % (NBP * 16384), b = r >> 14, rr = (r >> 7) & 127, c = r & 127;
        out[(kv ? OUT_VP : OUT_KP) + (size_t)l * NBP * 16384 + r] = bf1(PROJ[(size_t)(b * T + T - 128 + rr) * INC + (kv ? C_V : C_K) + c]);
    }
#pragma unroll 1
    for (int e = gt; e < NBP * 1024; e = opq(e + NT)) { const int b = e >> 10, c = e & 1023; out[OUT_SHP + (size_t)l * NBP * 1024 + e] = bf1(PROJ[(size_t)(b * T + T - 1) * INC + C_RW + c]); }
#pragma unroll 1
    for (int e = gt; e < DB * 1024; e = opq(e + NT)) { const int b = e >> 10, c = e & 1023; out[OUT_SHS + (size_t)l * DB * 1024 + e] = bf1(PROJ[(size_t)(MP + 4 * b + 3) * INC + C_RW + c]); }
#pragma unroll 1
    for (int e = gt; e < NBP * 768; e = opq(e + NT)) { const int b = e / 768, j = (e % 768) >> 8, c = e & 255; out[OUT_CVP + (size_t)l * NBP * 768 + e] = bf1(PROJ[(size_t)(b * T + T - 3 + j) * INC + C_XB + c]); }
#pragma unroll 1
    for (int e = gt; e < DB * 768; e = opq(e + NT)) { const int b = e / 768, j = (e % 768) >> 8, c = e & 255; out[OUT_CVS + (size_t)l * DB * 768 + e] = bf1(PROJ[(size_t)(MP + 4 * b + 1 + j) * INC + C_XB + c]); }
}

struct RwkvPtrs { const bf16 *R, *K, *V, *KK, *BV; const float* W; float* YR; };
__device__ __forceinline__ void rwkv_step(f32x4& s, const f32x4 w, const f32x4 kk, const f32x4 bv, const f32x4 k2, const f32x4 r, const float v, float& y) {
    const float sa = red16(dot4(s, kk));
    s = s * w + (k2 * v - bv * sa);
    y = red16(dot4(s, r));
}
__device__ __forceinline__ void rwkv_prompt(const Ctx& C, const RwkvPtrs& P, int wg, float* wkv_out  ) {
    constexpr int TC = 32, VEC = TC * 64 * 4, O_V = 5 * VEC, BUF = O_V + TC * 16 * 4, O_Q = 2 * BUF;
    static_assert(O_Q + TC * 1024 <= 131072, "LDS");
    const int chain = wg >> 2, b = chain >> 2, h = chain & 3, qr = wg & 3, tid = C.tid, lane = C.lane, wave = C.wave;
    const size_t m0 = (size_t)b * T;
    const int ltid = tid - 256, lstep = ltid >> 4, lq = tid & 15;
    const int vstep = ltid >> 2, vq = ltid & 3;
    f32x4 st[2][5], stv;
    f32x4 s = (f32x4){0.f, 0.f, 0.f, 0.f};
    const int row = 16 * qr + 4 * wave + (lane >> 4), cq = lane & 15;
#define RW_LOAD(c) do { if (wave >= 4) { _Pragma("unroll") for (int u = 0; u < 2; ++u) { const size_t o_ = (m0 + (size_t)(c) * TC + lstep + 16 * u) * 256 + h * 64 + 4 * lq; \
        st[u][0] = *(const f32x4*)(P.W + o_); st[u][1] = ld_bf4(P.KK + o_); st[u][2] = ld_bf4(P.BV + o_); st[u][3] = ld_bf4(P.K + o_); st[u][4] = ld_bf4(P.R + o_); } \
        if (ltid < 128) stv = ld_bf4(P.V + (m0 + (size_t)(c) * TC + vstep) * 256 + h * 64 + 16 * qr + 4 * vq); } } while (0)
#define RW_STORE(bufi) do { if (wave >= 4) { LAS unsigned char* bb = C.lds + (bufi) * BUF; _Pragma("unroll") for (int u = 0; u < 2; ++u) { const int ls = lstep + 16 * u; \
        _Pragma("unroll") for (int i = 0; i < 5; ++i) *(LAS f32x4*)(bb + i * VEC + (ls * 64 + 4 * lq) * 4) = st[u][i]; } \
        if (ltid < 128) *(LAS f32x4*)(bb + O_V + (vstep * 16 + 4 * vq) * 4) = stv; } } while (0)
#define RW_FLUSH(cc, half) do { if (wave >= 4) { const int stp = lstep + 16 * (half); const LAS f32x4* qp = (const LAS f32x4*)(C.lds + O_Q + stp * 1024 + (lq >> 2) * 256 + (lq & 3) * 64); \
        const f32x4 a0 = qp[0], a1_ = qp[1], a2_ = qp[2], a3 = qp[3]; const f32x4 t_ = (a0 + a1_) + (a2_ + a3); \
        P.YR[(m0 + (size_t)(cc) * TC + stp) * 256 + h * 64 + 16 * qr + lq] = (t_.x + t_.y) + (t_.z + t_.w); } } while (0)
    RW_LOAD(0); RW_STORE(0); __syncthreads();
    for (int c = 0; c < T / TC; ++c) {
        if (c > 0) RW_FLUSH(c - 1, 1);
        if (c + 1 < T / TC) RW_LOAD(c + 1);
        if (wave < 4) {
            const LAS unsigned char* bb = C.lds + (c & 1) * BUF;
            const int vo = O_V + (4 * wave + (lane >> 4)) * 4, lo = 16 * cq;
            LAS float* ring = (LAS float*)(C.lds + O_Q) + wave * 64 + lane;
            f32x4 w = *(const LAS f32x4*)(bb + 0 * VEC + lo), kk = *(const LAS f32x4*)(bb + 1 * VEC + lo), bv = *(const LAS f32x4*)(bb + 2 * VEC + lo),
                  k2 = *(const LAS f32x4*)(bb + 3 * VEC + lo), r = *(const LAS f32x4*)(bb + 4 * VEC + lo), rp = r;
            float v = *(const LAS float*)(bb + vo), qpend = 0.f;
            const unsigned b1 = (unsigned)(unsigned long long)(bb + lo), b2 = (unsigned)(unsigned long long)(bb + vo), qa = (unsigned)(unsigned long long)ring;
            f32x4 nw, nkk, nbv, nk2, nr; float nv;
#define RW_A_DOT "v_mul_f32 %6, %10, %14\n\tv_fma_f32 %6, %11, %15, %6\n\tv_fma_f32 %6, %12, %16, %6\n\tv_fma_f32 %6, %13, %17, %6"
#define RW_A_RD "ds_read_b128 %0, %7 offset:%c19\n\tds_read_b128 %1, %7 offset:%c20\n\tds_read_b128 %2, %7 offset:%c21\n\tds_read_b128 %3, %7 offset:%c22\n\tds_read_b128 %4, %7 offset:%c23\n\tds_read_b32 %5, %8 offset:%c24\n\t"
#define RW_A_OPS(IN, WO) : "=&v"(nw), "=&v"(nkk), "=&v"(nbv), "=&v"(nk2), "=&v"(nr), "=&v"(nv), "=&v"(sa) \
                 : "v"(b1), "v"(b2), "v"(qa), "v"(s.x), "v"(s.y), "v"(s.z), "v"(s.w), "v"(kk.x), "v"(kk.y), "v"(kk.z), "v"(kk.w), "v"(qpend), \
                   "n"(0 * VEC + (IN) * 256), "n"(1 * VEC + (IN) * 256), "n"(2 * VEC + (IN) * 256), "n"(3 * VEC + (IN) * 256), "n"(4 * VEC + (IN) * 256), "n"((IN) * 64), "n"(WO) : "memory"
#define RW_STEP(I, IN) { float sa, q, t0, t1, t2, t3; \
                if ((I) < 2 || (I) == 16 || (I) == 17) asm volatile(RW_A_RD "s_waitcnt lgkmcnt(6)\n\t" RW_A_DOT RW_A_OPS(IN, 0)); \
                else asm volatile("ds_write_b32 %9, %18 offset:%c25\n\t" RW_A_RD "s_waitcnt lgkmcnt(7)\n\t" RW_A_DOT RW_A_OPS(IN, ((I) >= 2 ? (I) - 2 : 0) * 1024)); \
                asm volatile("v_mul_f32 %2, %6, %10\n\tv_mul_f32 %3, %7, %10\n\t" \
                             "v_add_f32_dpp %0, %0, %0 quad_perm:[1,0,3,2] row_mask:0xf bank_mask:0xf bound_ctrl:1\n\t" \
                             "v_mul_f32 %1, %11, %15\n\tv_fma_f32 %1, %12, %16, %1\n\t" \
                             "v_add_f32_dpp %0, %0, %0 quad_perm:[2,3,0,1] row_mask:0xf bank_mask:0xf bound_ctrl:1\n\t" \
                             "v_fma_f32 %1, %13, %17, %1\n\tv_fma_f32 %1, %14, %18, %1\n\t" \
                             "v_add_f32_dpp %0, %0, %0 row_half_mirror row_mask:0xf bank_mask:0xf bound_ctrl:1\n\t" \
                             "v_mul_f32 %4, %8, %10\n\tv_mul_f32 %5, %9, %10\n\t" \
                             "v_add_f32_dpp %0, %0, %0 row_ror:8 row_mask:0xf bank_mask:0xf bound_ctrl:1" \
                             : "+v"(sa), "=&v"(q), "=&v"(t0), "=&v"(t1), "=&v"(t2), "=&v"(t3) \
                             : "v"(k2.x), "v"(k2.y), "v"(k2.z), "v"(k2.w), "v"(v), "v"(s.x), "v"(s.y), "v"(s.z), "v"(s.w), "v"(rp.x), "v"(rp.y), "v"(rp.z), "v"(rp.w)); \
                asm volatile("v_fma_f32 %4, -%8, %9, %4\n\tv_fma_f32 %5, -%8, %10, %5\n\tv_fma_f32 %6, -%8, %11, %6\n\tv_fma_f32 %7, -%8, %12, %7\n\t" \
                             "v_fma_f32 %0, %0, %13, %4\n\tv_fma_f32 %1, %1, %14, %5\n\tv_fma_f32 %2, %2, %15, %6\n\tv_fma_f32 %3, %3, %16, %7" \
                             : "+v"(s.x), "+v"(s.y), "+v"(s.z), "+v"(s.w), "+v"(t0), "+v"(t1), "+v"(t2), "+v"(t3) \
                             : "v"(sa), "v"(bv.x), "v"(bv.y), "v"(bv.z), "v"(bv.w), "v"(w.x), "v"(w.y), "v"(w.z), "v"(w.w)); \
                qpend = q; rp = r; w = nw; kk = nkk; bv = nbv; k2 = nk2; r = nr; v = nv; }
#define RW_STEP4(I) RW_STEP(I, (I) + 1) RW_STEP((I) + 1, (I) + 2) RW_STEP((I) + 2, (I) + 3) RW_STEP((I) + 3, ((I) + 4 < TC ? (I) + 4 : TC - 1))
#define RW_HALF_END(h0) do { asm volatile("s_waitcnt lgkmcnt(0)" :: "v"(w), "v"(kk), "v"(bv), "v"(k2), "v"(r), "v"(v) : "memory"); \
                ring[((h0) + 14) * 256] = qpend; ring[((h0) + 15) * 256] = dot4(s, rp); } while (0)
            RW_STEP4(0) RW_STEP4(4) RW_STEP4(8) RW_STEP4(12)
            RW_HALF_END(0);
            __syncthreads();
            RW_STEP4(16) RW_STEP4(20) RW_STEP4(24) RW_STEP4(28)
            RW_HALF_END(16);
#undef RW_HALF_END
#undef RW_STEP4
#undef RW_STEP
#undef RW_A_OPS
#undef RW_A_RD
#undef RW_A_DOT
        } else {
            __syncthreads();
            RW_FLUSH(c, 0);
        }
        if (c + 1 < T / TC) RW_STORE((c + 1) & 1);
        __syncthreads();
    }
    RW_FLUSH(T / TC - 1, 1);
#undef RW_LOAD
#undef RW_STORE
#undef RW_FLUSH
    if (wave < 4) *(f32x4*)(wkv_out + (((size_t)b * 4 + h) * 64 + row) * 64 + 4 * cq) = s;
    __syncthreads();
}
__device__ __forceinline__ void rwkv_sample_item(const RwkvPtrs& P, int item, const float* wkv_in, float* wkv_out, int lane) {
    const int rg = item & 15, h = (item >> 4) & 3, b = item >> 6, row = 4 * rg + (lane >> 4), cq = lane & 15;
    const size_t so = (((size_t)b * 4 + h) * 64 + row) * 64 + 4 * cq;
    f32x4 s = *(const f32x4*)(wkv_in + so);
#pragma unroll
    for (int i = 0; i < DS; ++i) { const size_t m = (size_t)MP + 4 * b + i, o = m * 256 + h * 64 + 4 * cq;
        float y; rwkv_step(s, *(const f32x4*)(P.W + o), ld_bf4(P.KK + o), ld_bf4(P.BV + o), ld_bf4(P.K + o), ld_bf4(P.R + o), bf1(P.V[m * 256 + h * 64 + row]), y);
        if (cq == 0) P.YR[m * 256 + h * 64 + row] = y; }
    *(f32x4*)(wkv_out + so) = s;
}
__device__ __forceinline__ void lru_prompt_item(const Ctx& C, int item, const float* AL, const float* U, const bf16* PROJ, bf16* MIXCAT, float* lru_out  ) {
    const int b = item >> 4, c = (item & 15) * 16 + (C.tid & 15), seg = C.tid >> 4; constexpr int SL = T / 32;
    const size_t m0 = (size_t)b * T + (size_t)seg * SL;
    LAS float* sA = (LAS float*)C.lds; LAS float* sH = sA + 512;
    float Ap = 1.f, H = 0.f;
#pragma unroll 8
    for (int i = 0; i < SL; ++i) { const float a = AL[(m0 + i) * 256 + c], u = U[(m0 + i) * 256 + c]; H = a * H + u; Ap *= a; }
    sA[C.tid] = Ap; sH[C.tid] = H;
    __syncthreads();
    float h = 0.f;
    for (int sp = 0; sp < seg; ++sp) h = sA[sp * 16 + (C.tid & 15)] * h + sH[sp * 16 + (C.tid & 15)];
#pragma unroll 8
    for (int i = 0; i < SL; ++i) { const float a = AL[(m0 + i) * 256 + c], u = U[(m0 + i) * 256 + c]; h = a * h + u;
        const float gb = bf1(PROJ[(m0 + i) * INC + C_GB + c]); MIXCAT[(m0 + i) * DM + 768 + c] = (bf16)f2bf(h * gelu_t(gb)); }
    if (seg == 31) lru_out[b * 256 + c] = h;
    __syncthreads();
}
__device__ __forceinline__ void swa_prompt_item(const Ctx& C, int item, const bf16* PROJ, bf16* MIXCAT, const float* sinks  ) {
    constexpr int KP = 72, VP = 264;
    const int kvh = item & 1, n = (item >> 1) & 31, b = item >> 6, tid = C.tid, lane = C.lane, wave = C.wave;
    LAS bf16* Ks = (LAS bf16*)C.lds; LAS bf16* Vt = Ks + 256 * KP;
    const size_t rowq0 = (size_t)b * T + (size_t)n * 128;
    { const int key = tid >> 1, hf = tid & 1; size_t kr = rowq0 + key; kr = (kr >= 128 + (size_t)b * T) ? kr - 128 : kr;
        const bf16* kp = PROJ + kr * INC + C_K + kvh * 64 + hf * 32;
#pragma unroll
        for (int i = 0; i < 4; ++i) *(LAS u32x4*)(Ks + key * KP + hf * 32 + 8 * i) = *(const u32x4*)(kp + 8 * i);
#pragma unroll
        for (int i = 0; i < 4; ++i) { const int ch = tid + 512 * i, vk = ch >> 3, d0 = (ch & 7) * 8; size_t vr = rowq0 + vk; vr = (vr >= 128 + (size_t)b * T) ? vr - 128 : vr;
            const u32x4 w = *(const u32x4*)(PROJ + vr * INC + C_V + kvh * 64 + d0);
            Vt[(d0 + 0) * VP + vk] = (bf16)(w.x & 0xffff); Vt[(d0 + 1) * VP + vk] = (bf16)(w.x >> 16); Vt[(d0 + 2) * VP + vk] = (bf16)(w.y & 0xffff); Vt[(d0 + 3) * VP + vk] = (bf16)(w.y >> 16);
            Vt[(d0 + 4) * VP + vk] = (bf16)(w.z & 0xffff); Vt[(d0 + 5) * VP + vk] = (bf16)(w.z >> 16); Vt[(d0 + 6) * VP + vk] = (bf16)(w.w & 0xffff); Vt[(d0 + 7) * VP + vk] = (bf16)(w.w >> 16); } }
    __syncthreads();
    const int q = lane & 31, hi = lane >> 5;
#pragma unroll 1
    for (int qi = 0; qi < 2; ++qi) {
        const int qt = wave * 2 + qi, g = qt >> 2, j = qt & 3, hh = kvh * 4 + g;
        const size_t qrow = rowq0 + 32 * j + q;
        bf16x8 qf[4];
#pragma unroll
        for (int dk = 0; dk < 4; ++dk) qf[dk] = *(const bf16x8*)(PROJ + qrow * INC + hh * 64 + 16 * dk + 8 * hi);
        f32x16 sc[5];
#pragma unroll
        for (int kt = 0; kt < 5; ++kt) {
            f32x16 acc;
#pragma unroll
            for (int i = 0; i < 16; ++i) acc[i] = 0.f;
#pragma unroll
            for (int dk = 0; dk < 4; ++dk) { const bf16x8 kf = *(const LAS bf16x8*)(Ks + (32 * (j + kt) + q) * KP + 16 * dk + 8 * hi); acc = __builtin_amdgcn_mfma_f32_32x32x16_bf16(kf, qf[dk], acc, 0, 0, 0); }
            sc[kt] = acc;
        }
        const int qpos = 128 + 32 * j + q; float mx = -INFINITY;
#pragma unroll
        for (int kt = 0; kt < 5; ++kt)
#pragma unroll
            for (int i = 0; i < 16; ++i) { const int kj = 32 * (j + kt) + (i & 3) + 8 * (i >> 2) + 4 * hi, d = qpos - kj; const bool ok = d >= 0 && d <= 128 && (n > 0 || kj >= 128);
                const float sv = ok ? sc[kt][i] * 0.125f : -INFINITY; sc[kt][i] = sv; mx = fmaxf(mx, sv); }
        mx = fmaxf(mx, shx(mx, 32, lane)); const float sink = sinks[hh]; mx = fmaxf(mx, sink);
        float sum = 0.f;
#pragma unroll
        for (int kt = 0; kt < 5; ++kt)
#pragma unroll
            for (int i = 0; i < 16; ++i) { const float e = __expf(sc[kt][i] - mx); sc[kt][i] = e; sum += e; }
        sum += shx(sum, 32, lane);
        const float inv = 1.f / (sum + __expf(sink - mx));
#pragma unroll
        for (int dt = 0; dt < 2; ++dt) {
            f32x16 o;
#pragma unroll
            for (int i = 0; i < 16; ++i) o[i] = 0.f;
#pragma unroll
            for (int kt = 0; kt < 5; ++kt)
#pragma unroll
                for (int s2 = 0; s2 < 2; ++s2) {
                    u32x4 pw; pw.x = pk2(sc[kt][8 * s2 + 0], sc[kt][8 * s2 + 1]); pw.y = pk2(sc[kt][8 * s2 + 2], sc[kt][8 * s2 + 3]); pw.z = pk2(sc[kt][8 * s2 + 4], sc[kt][8 * s2 + 5]); pw.w = pk2(sc[kt][8 * s2 + 6], sc[kt][8 * s2 + 7]);
                    const LAS bf16* vp = Vt + (32 * dt + q) * VP + 32 * (j + kt) + 16 * s2 + 4 * hi;
                    const u32x2 v0 = *(const LAS u32x2*)vp, v1 = *(const LAS u32x2*)(vp + 8);
                    u32x4 vw; vw.x = v0.x; vw.y = v0.y; vw.z = v1.x; vw.w = v1.y;
                    o = __builtin_amdgcn_mfma_f32_32x32x16_bf16(__builtin_bit_cast(bf16x8, vw), __builtin_bit_cast(bf16x8, pw), o, 0, 0, 0);
                }
#pragma unroll
            for (int g4 = 0; g4 < 4; ++g4) st_bf4(MIXCAT + qrow * DM + hh * 64 + 32 * dt + 8 * g4 + 4 * hi, (f32x4){o[4 * g4] * inv, o[4 * g4 + 1] * inv, o[4 * g4 + 2] * inv, o[4 * g4 + 3] * inv});
        }
    }
    __syncthreads();
}
__device__ __forceinline__ void swa_sample_item(const Ctx& C, int item, const bf16* PROJ, bf16* MIXCAT, const float* sinks, const float* ck, const float* cv, float* ko, float* vo) {
    const int kvh = item & 1, b = item >> 1, tid = C.tid;
    LAS float* Kf = (LAS float*)C.lds; LAS float* Vf = Kf + 132 * 65; LAS float* Qf = Vf + 132 * 64; LAS float* Pf = Qf + 16 * 64;
    for (int e = tid; e < 132 * 64; e += 512) { const int key = e >> 6, d = e & 63; float kx, vx;
        if (key < 128) { const size_t o = (((size_t)b * 128 + key) * 2 + kvh) * 64 + d; kx = ck[o]; vx = cv[o]; }
        else { const size_t r = (size_t)MP + 4 * b + (key - 128); kx = bf1(PROJ[r * INC + C_K + kvh * 64 + d]); vx = bf1(PROJ[r * INC + C_V + kvh * 64 + d]); }
        Kf[key * 65 + d] = kx; Vf[key * 64 + d] = vx;
        if (key >= 4) { const size_t o = (((size_t)b * 128 + (key - 4)) * 2 + kvh) * 64 + d; ko[o] = kx; vo[o] = vx; } }
    for (int e = tid; e < 16 * 64; e += 512) { const int qr = e >> 6, d = e & 63, i = qr >> 2, g = qr & 3; Qf[e] = bf1(PROJ[((size_t)MP + 4 * b + i) * INC + (kvh * 4 + g) * 64 + d]); }
    __syncthreads();
    { const int qr = tid >> 5, kl = tid & 31, i = qr >> 2, g = qr & 3; float sc[5]; float mx = -INFINITY;
#pragma unroll
        for (int k5 = 0; k5 < 5; ++k5) { const int key = kl + 32 * k5; float sv = -INFINITY;
            if (key < 132 && key >= i && key <= i + 128) { float a = 0.f;
#pragma unroll 16
                for (int d = 0; d < 64; ++d) a += Qf[qr * 64 + d] * Kf[key * 65 + d];
                sv = a * 0.125f; }
            sc[k5] = sv; mx = fmaxf(mx, sv); }
#pragma unroll
        for (int o = 1; o < 32; o <<= 1) mx = fmaxf(mx, shx(mx, o, C.lane));
        const float sink = sinks[kvh * 4 + g]; mx = fmaxf(mx, sink); float sum = 0.f;
#pragma unroll
        for (int k5 = 0; k5 < 5; ++k5) { sc[k5] = __expf(sc[k5] - mx); sum += sc[k5]; }
#pragma unroll
        for (int o = 1; o < 32; o <<= 1) sum += shx(sum, o, C.lane);
        const float inv = 1.f / (sum + __expf(sink - mx));
#pragma unroll
        for (int k5 = 0; k5 < 5; ++k5) { const int key = kl + 32 * k5; if (key < 136) Pf[qr * 136 + key] = sc[k5] * inv; } }
    __syncthreads();
    { const int qr = tid >> 5, d = (tid & 31) * 2, i = qr >> 2, g = qr & 3; float o0 = 0.f, o1 = 0.f;
#pragma unroll 4
        for (int key = 0; key < 132; ++key) { const float p = Pf[qr * 136 + key]; o0 += p * Vf[key * 64 + d]; o1 += p * Vf[key * 64 + d + 1]; }
        *(unsigned*)(MIXCAT + ((size_t)MP + 4 * b + i) * DM + (kvh * 4 + g) * 64 + d) = pk2(o0, o1); }
    __syncthreads();
}

__device__ __forceinline__ void s_phase(const Ctx& C, const Args& A, int l) {
    const bf16* PROJ = (const bf16*)(C.ws + WS_R1); bf16* MIXCAT = (bf16*)(C.ws + WS_HN);
    float* R = (float*)(C.ws + WS_R2); const size_t S = (size_t)M * 256;
    RwkvPtrs P{(const bf16*)R, (const bf16*)(R + S), (const bf16*)(R + 2 * S), (const bf16*)(R + 3 * S), (const bf16*)(R + 4 * S), R + 5 * S, (float*)(C.ws + WS_R3)};
    const float* AL = (const float*)(C.ws + WS_R3) + S; const float* U = AL + S;
    float* out = C.out;
    constexpr int NSCAN = 64;
    if (C.bid < NSCAN) { rwkv_prompt(C, P, C.bid, out + OUT_WKVP + (size_t)l * NBP * 4 * 4096); return; }
    constexpr int N0 = 256, N1 = N0 + 64, N2_ = N1 + 256, N3 = N2_ + 1024, N4 = N3 + 64;
    for (int it = C.bid - NSCAN; it < N4; it += C.G - NSCAN) {
        if (it < N0) swa_prompt_item(C, it, PROJ, MIXCAT, INP(I_SINK) + l * 8);
        else if (it < N1) lru_prompt_item(C, it - N0, AL, U, PROJ, MIXCAT, out + OUT_LRP + (size_t)l * NBP * 256);
        else if (it < N2_) swa_sample_item(C, it - N1, PROJ, MIXCAT, INP(I_SINK) + l * 8, INP(I_CK) + (size_t)l * DB * 16384, INP(I_CV) + (size_t)l * DB * 16384,
                                          out + OUT_KS + (size_t)l * DB * 16384, out + OUT_VS + (size_t)l * DB * 16384);
        else if (it < N3) rwkv_sample_item(P, (it - N2_) * 8 + C.wave, INP(I_SWKV) + (size_t)l * DB * 4 * 4096, out + OUT_WKVS + (size_t)l * DB * 4 * 4096, C.lane);
        else { const int e = (it - N3) * 512 + C.tid, b = e >> 8, c = e & 255; float h = INP(I_SLRU)[((size_t)l * DB + b) * 256 + c];
#pragma unroll
            for (int i = 0; i < DS; ++i) { const size_t m = (size_t)MP + 4 * b + i; h = AL[m * 256 + c] * h + U[m * 256 + c];
                MIXCAT[m * DM + 768 + c] = (bf16)f2bf(h * gelu_t(bf1(PROJ[m * INC + C_GB + c]))); }
            out[OUT_LRS + ((size_t)l * DB + b) * 256 + c] = h; }
    }
    if (l + 1 < NL) convert_layer(C, A, l + 1, (C.bid - NSCAN) * 8 + C.wave, (C.G - NSCAN) * 8, (C.bid - NSCAN) * 512 + C.tid, (C.G - NSCAN) * 512);
    __syncthreads();
    { pg8::Gemm g{(const bf16*)(C.ws + WS_PB + (size_t)(l & 1) * SZ_PBL), (const bf16*)(C.ws + WS_W + (size_t)(l & 1) * WL + O_WP), M, DM, PLE}; pg8::StaticOrder So; So.init(M, DM, C.G - NSCAN, C.bid - NSCAN);
      pg8::EpiBf16<0> E{(bf16*)(C.ws + WS_PP), DM, nullptr, 0, 0, 1.f};
      pg8::gemm_phase<pg8::EpiBf16<0>, pg8::StaticOrder, true, true>(C.lds, g, So, E, C.tid); }
}

__device__ __forceinline__ void e3_post(const Ctx& C, const Args& A, int l) {
    const float* R = (const float*)(C.ws + WS_R2); const size_t S = (size_t)M * 256;
    const bf16 *Rb = (const bf16*)R, *K = (const bf16*)(R + S), *V = (const bf16*)(R + 2 * S), *G = (const bf16*)(R + 6 * S); const float* YR = (const float*)(C.ws + WS_R3);
    bf16* MIXCAT = (bf16*)(C.ws + WS_HN); const int c4 = 4 * C.lane;
    const f32x4 lw = *(const f32x4*)(INP(I_LNW) + l * 256 + c4), lb = *(const f32x4*)(INP(I_LNB) + l * 256 + c4), rk = *(const f32x4*)(INP(I_RK) + l * 256 + c4);
    for (int m = C.gw; m < M; m += C.NGW) {
        const size_t o = (size_t)m * 256 + c4;
        const f32x4 y = *(const f32x4*)(YR + o), r = ld_bf4(Rb + o), k = ld_bf4(K + o), v = ld_bf4(V + o), g = ld_bf4(G + o);
        const float mean = red16((y.x + y.y) + (y.z + y.w)) * (1.f / 64.f); const f32x4 d = y - mean;
        const float var = red16(dot4(d, d)) * (1.f / 64.f); const float rs = rsqrtf(var + 64e-5f);
        const float bonus = red16(dot4(r * k, rk));
        st_bf4(MIXCAT + (size_t)m * DM + 512 + c4, (d * rs * lw + lb + v * bonus) * g);
    }
}
constexpr int LDS_BYTES = 131072 + 64;
#ifndef MK_MULTI
#define MK_MULTI 0
#endif
#ifndef MK_DUP
#define MK_DUP 0
#endif
enum { PH_P0 = 0, PH_G1, PH_E1, PH_G2, PH_S, PH_E3, PH_G3, PH_E4, PH_G4, PH_G5, PH_E5, PH_G6, PH_E0, PH_G3B, PH_E4S, PH_G5B, PH_E5S, PH_N };
constexpr int NSPLIT = 16;

__device__ __forceinline__ Ctx make_ctx(int wave0, LAS unsigned char* lds) {
    Ctx D; int z_ = 0; asm volatile("" : "+v"(z_)); int ln_ = __builtin_amdgcn_mbcnt_hi(-1, __builtin_amdgcn_mbcnt_lo(-1, z_));
    D.lane = ln_; D.wave = wave0; D.tid = wave0 * 64 + ln_;
    int b_ = blockIdx.x; asm volatile("" : "+s"(b_)); D.bid = b_; D.gw = b_ * 8 + wave0; D.G = gridDim.x; D.NGW = D.G * 8;
    D.lds = lds; D.out = (float*)inp_ld(N_IN); D.ws = (unsigned char*)inp_ld(N_IN + 1);
    return D;
}
template <int PH> __device__ __forceinline__ void run_phase(const Args& A, int wave0, LAS unsigned char* lds, int l_in) {
    const Ctx C = make_ctx(wave0, lds);
    int l = l_in; asm volatile("" : "+s"(l));
    unsigned char* ws = C.ws; unsigned char* wl = ws + WS_W + (size_t)(l & 1) * WL; (void)wl;
    bf16* HN = (bf16*)(ws + WS_HN); float* MIX = (float*)(ws + WS_R1); float* R2 = (float*)(ws + WS_R2); float* R3 = (float*)(ws + WS_R3); bf16* X = (bf16*)(ws + WS_X16);
    const size_t S = (size_t)M * 256; (void)HN; (void)MIX; (void)R2; (void)R3; (void)X; (void)S;
    if constexpr (PH == PH_P0) p0_prologue(C, A);
    if constexpr (PH == PH_G1) {
        pg8::Gemm g{HN, (const bf16*)(wl + O_WIN), M, INC, DM}; pg8::StaticOrder So; So.init(M, INC, C.G, C.bid);
        pg8::EpiBf16<0> E{(bf16*)(ws + WS_R1), INC, INP(I_BIN) + (size_t)l * INC, 0, 0, 1.f};
        pg8::gemm_phase<pg8::EpiBf16<0>, pg8::StaticOrder, true, true>(C.lds, g, So, E, C.tid); }
    if constexpr (PH == PH_E1) e1_prep(C, A, l);
    if constexpr (PH == PH_G2) {
        pg8::Gemm g{(const bf16*)(ws + WS_R3), (const bf16*)(wl + O_W2), M, N2, K2 / 2, K2}; G2Order So; So.b.init(M, N2, C.G, C.bid);
        EpiMix E{INP(I_W0) + l * 256, INP(I_A0) + l * 256, INP(I_KA) + l * 256, INP(I_BA) + l * 256, INP(I_BI) + l * 256, INP(I_L) + l * 256,
                 R2 + 5 * S, (bf16*)(R2 + 1 * S), (bf16*)(R2 + 3 * S), (bf16*)(R2 + 4 * S), (bf16*)(R2 + 6 * S), R3 + S, R3 + 2 * S, (const bf16*)(ws + WS_R3)};
        pg8::gemm_phase<EpiMix, G2Order, true, true>(C.lds, g, So, E, C.tid); }
    if constexpr (PH == PH_S) s_phase(C, A, l);
    if constexpr (PH == PH_E3) e3_post(C, A, l);
    if constexpr (PH == PH_G3) {
        pg8::Gemm g{HN, (const bf16*)(wl + O_WOUT), MP, DM, DM}; pg8::StaticOrder So; So.init(MP, DM, C.G, C.bid);
        pg8::EpiBf16<0> E{(bf16*)MIX, DM, INP(I_BOUT) + (size_t)l * DM, 0, 0, 1.f};
        pg8::gemm_phase<pg8::EpiBf16<0>, pg8::StaticOrder, true, true>(C.lds, g, So, E, C.tid); }
    if constexpr (PH == PH_G3B) {
        if (C.bid < NSPLIT) { pg8::Gemm g{HN + (size_t)MP * DM, (const bf16*)(wl + O_WOUT), MS, DM, DM / 2, DM}; SplitOrder So{C.bid, NSPLIT, DM / 2}; EpiPart E{R3};
            pg8::gemm_phase<EpiPart, SplitOrder, true, true>(C.lds, g, So, E, C.tid); }
        else for (int m = (C.bid - NSPLIT) * 8 + C.wave; m < MP; m += (C.G - NSPLIT) * 8)
            row_update((const bf16*)MIX + (size_t)m * DM, INP(I_NMPOST) + l * DM, X + (size_t)m * DM, INP(I_NFPRE) + l * DM, HN + (size_t)m * DM, C.lane); }
    if constexpr (PH == PH_E4S)
        for (int m = MP + C.gw; m < M; m += C.NGW)
            row_update_parts(R3 + (size_t)(m - MP) * DM, R3 + (size_t)(MS + m - MP) * DM, INP(I_BOUT) + (size_t)l * DM, INP(I_NMPOST) + l * DM, X + (size_t)m * DM, INP(I_NFPRE) + l * DM, HN + (size_t)m * DM, C.lane);
    if constexpr (PH == PH_G4) {
        pg8::Gemm g{HN, (const bf16*)(wl + O_WGU), M, 2 * DFF, DM}; pg8::StaticOrder So; So.init(M, 2 * DFF, C.G, C.bid);
        EpiSwiglu E{(bf16*)(ws + WS_R2)};
        pg8::gemm_phase<EpiSwiglu, pg8::StaticOrder, true, true>(C.lds, g, So, E, C.tid); }
    if constexpr (PH == PH_G5) {
        pg8::Gemm g{(const bf16*)(ws + WS_R2), (const bf16*)(wl + O_WD), MP, DM, DFF}; pg8::StaticOrder So; So.init(MP, DM, C.G, C.bid);
        pg8::EpiBf16<0> E{(bf16*)MIX, DM, nullptr, 0, 0, 1.f};
        pg8::gemm_phase<pg8::EpiBf16<0>, pg8::StaticOrder, true, true>(C.lds, g, So, E, C.tid); }
    if constexpr (PH == PH_G5B) {
        if (C.bid < NSPLIT) { pg8::Gemm g{(const bf16*)(ws + WS_R2) + (size_t)MP * DFF, (const bf16*)(wl + O_WD), MS, DM, DFF / 2, DFF}; SplitOrder So{C.bid, NSPLIT, DFF / 2}; EpiPart E{R3};
            pg8::gemm_phase<EpiPart, SplitOrder, true, true>(C.lds, g, So, E, C.tid); }
        else for (int m = (C.bid - NSPLIT) * 8 + C.wave; m < MP; m += (C.G - NSPLIT) * 8)
            row_update((const bf16*)MIX + (size_t)m * DM, INP(I_NFPOST) + l * DM, X + (size_t)m * DM, nullptr, HN + (size_t)m * DM, C.lane); }
    if constexpr (PH == PH_E5S)
        for (int m = MP + C.gw; m < M; m += C.NGW)
            row_update_parts(R3 + (size_t)(m - MP) * DM, R3 + (size_t)(MS + m - MP) * DM, nullptr, INP(I_NFPOST) + l * DM, X + (size_t)m * DM, nullptr, HN + (size_t)m * DM, C.lane);
    if constexpr (PH == PH_G6) {
        pg8::StaticOrder So; So.init(M, DM, C.G, C.bid);
        pg8::Gemm g{HN, (const bf16*)(wl + O_WPG), M, DM, DM}; EpiPle E{X, (const bf16*)(ws + WS_PP), l == NL - 1 ? C.out : nullptr};
        pg8::gemm_phase<EpiPle, pg8::StaticOrder, true, true>(C.lds, g, So, E, C.tid); }
    if constexpr (PH == PH_E0)
        for (int m = C.gw; m < M; m += C.NGW) row_norm(X + (size_t)m * DM, INP(I_NMPRE) + (l + 1) * DM, HN + (size_t)m * DM, C.lane);
}

#if MK_MULTI
template <int PH> __global__ void __launch_bounds__(512, 2) mk_one(Args A, int l) {
    extern __shared__ __attribute__((aligned(16))) unsigned char lds_raw[];
    const int wave0 = __builtin_amdgcn_readfirstlane((int)threadIdx.x >> 6);
    run_phase<PH>(A, wave0, (LAS unsigned char*)lds_raw, l);
}
#else
__global__ void __launch_bounds__(512, 2) mk_fwd(Args A) {
    extern __shared__ __attribute__((aligned(16))) unsigned char lds_raw[];
    cg::grid_group grid = cg::this_grid();
    const int wave0 = __builtin_amdgcn_readfirstlane((int)threadIdx.x >> 6);
    LAS unsigned char* lds = (LAS unsigned char*)lds_raw;
    if (threadIdx.x < 16) ((LAS unsigned*)lds)[131072 / 4 + threadIdx.x] = 0u;
    __syncthreads();
    const unsigned xbar_x = __builtin_amdgcn_readfirstlane(xcd_barrier_post((unsigned*)inp_ld(N_IN + 1), (volatile LAS unsigned*)(lds + 131072), (int)threadIdx.x).x);
#define GRID_BAR() do { int z_ = 0; asm volatile("" : "+v"(z_)); int ln_ = __builtin_amdgcn_mbcnt_hi(-1, __builtin_amdgcn_mbcnt_lo(-1, z_)); XcdBarrier xb_; xb_.bar = (unsigned*)inp_ld(N_IN + 1); xb_.x = xbar_x; \
        xb_.st = (volatile LAS unsigned*)(lds + 131072); xcd_barrier(xb_, wave0 * 64 + ln_); } while (0)
    run_phase<PH_P0>(A, wave0, lds, 0);
    if (MK_DUP & 1) { GRID_BAR(); run_phase<PH_P0>(A, wave0, lds, 0); }
    grid.sync();
#pragma unroll 1
    for (int l = 0; l < NL; ++l) {
#define RP(PH) do { run_phase<PH>(A, wave0, lds, l); GRID_BAR(); if (MK_DUP & (1 << 20)) GRID_BAR(); if (MK_DUP & (1 << PH)) { run_phase<PH>(A, wave0, lds, l); GRID_BAR(); } } while (0)
        RP(PH_G1); RP(PH_E1); RP(PH_G2); RP(PH_S); RP(PH_E3); RP(PH_G3); RP(PH_G3B); RP(PH_E4S); RP(PH_G4); RP(PH_G5); RP(PH_G5B); RP(PH_E5S);
        run_phase<PH_G6>(A, wave0, lds, l);
        if (l + 1 < NL) { GRID_BAR(); RP(PH_E0); }
    }
}
#endif
}

#if MK_MULTI
template <int PH> static void launch_one(const mk::Args& a, int l, int grid, hipStream_t stream) {
    static bool attr = false;
    if (!attr) { (void)hipFuncSetAttribute((const void*)mk::mk_one<PH>, hipFuncAttributeMaxDynamicSharedMemorySize, mk::LDS_BYTES); attr = true; }
    hipLaunchKernelGGL(mk::mk_one<PH>, dim3(grid), dim3(512), mk::LDS_BYTES, stream, a, l);
}
#endif
extern "C" void kernel_launch(void* const* d_in, const int* in_sizes, int n_in, void* d_out, int out_size, void* d_ws, size_t ws_size, hipStream_t stream) {
    using namespace mk;
    static int grid = 0;
    if (grid == 0) {
        if (n_in != N_IN || (size_t)out_size != OUT_END || ws_size < WS_END) {
            fprintf(stderr, "kernel_launch: shape mismatch: n_in %d (want %d), out %d (want %zu), ws %zu (want >= %zu); nothing launched\n", n_in, (int)N_IN, out_size, (size_t)OUT_END, ws_size, (size_t)WS_END);
            grid = -1; return; }
        int dev = 0, cus = 0;
        (void)hipGetDevice(&dev); (void)hipDeviceGetAttribute(&cus, hipDeviceAttributeMultiprocessorCount, dev);
#if !MK_MULTI
        int per_cu = 0;
        if (hipFuncSetAttribute((const void*)mk_fwd, hipFuncAttributeMaxDynamicSharedMemorySize, LDS_BYTES) != hipSuccess) { fprintf(stderr, "kernel_launch: hipFuncSetAttribute failed\n"); grid = -1; return; }
        if (hipOccupancyMaxActiveBlocksPerMultiprocessor(&per_cu, (const void*)mk_fwd, 512, LDS_BYTES) != hipSuccess || per_cu < 1) fprintf(stderr, "kernel_launch: note: occupancy query gave %d\n", per_cu);
        (void)hipGetLastError();
#endif
        grid = cus;
        if (grid < 128) { fprintf(stderr, "kernel_launch: %d CUs: too few for this kernel\n", grid); grid = -1; return; }
    }
    if (grid < 0) return;
    Args a{};
    for (int i = 0; i < N_IN; ++i) a.in[i] = (const float*)d_in[i];
    a.out = (float*)d_out; a.ws = (unsigned char*)d_ws;
#if MK_MULTI
    launch_one<PH_P0>(a, 0, grid, stream);
    for (int l = 0; l < NL; ++l) {
        launch_one<PH_G1>(a, l, grid, stream); launch_one<PH_E1>(a, l, grid, stream); launch_one<PH_G2>(a, l, grid, stream); launch_one<PH_S>(a, l, grid, stream);
        launch_one<PH_E3>(a, l, grid, stream); launch_one<PH_G3>(a, l, grid, stream); launch_one<PH_E4>(a, l, grid, stream); launch_one<PH_G4>(a, l, grid, stream);
        launch_one<PH_G5>(a, l, grid, stream); launch_one<PH_E5>(a, l, grid, stream); launch_one<PH_G6>(a, l, grid, stream);
        if (l + 1 < NL) launch_one<PH_E0>(a, l, grid, stream);
    }
#else
    if (hipMemsetAsync(d_ws, 0, 65536, stream) != hipSuccess) { fprintf(stderr, "kernel_launch: hipMemsetAsync failed\n"); return; }
    void* args[] = {&a};
    const hipError_t e = hipLaunchCooperativeKernel((const void*)mk_fwd, dim3(grid), dim3(512), args, LDS_BYTES, stream);
    if (e != hipSuccess) fprintf(stderr, "kernel_launch: cooperative launch failed: %s (grid %d)\n", hipGetErrorString(e), grid);
#endif
}
```

```cpp
#include <hip/hip_runtime.h>
#include <hip/hip_cooperative_groups.h>
#include <cstdio>
#include <cstdint>
#include <cstddef>
#include <cmath>
namespace cg = cooperative_groups;
namespace pg8 {
#define PG8_LAS __attribute__((address_space(3)))
typedef unsigned short bf16_t;
typedef short bf16x8 __attribute__((ext_vector_type(8)));
typedef float f32x4 __attribute__((ext_vector_type(4)));
typedef unsigned u32x4 __attribute__((ext_vector_type(4)));
constexpr int BM = 256, BK = 64, HALF = 128, HTB = HALF * BK * 2  , STAGE_BYTES = 8 * HTB, NXCD = 8, WGM = 8;

__host__ __device__ __forceinline__ int lds_byte(int r, int c) { const int st = (r >> 4) * 2 + (c >> 5), rr = r & 15, cc = c & 31, ob = rr * 64 + cc * 2; return st * 1024 + (ob ^ (((ob >> 9) & 1) << 5)); }
__host__ __device__ __forceinline__ void stage_rc(int b, int& R, int& C) { const int st = b / 1024, sb = b % 1024, swz = sb ^ (((sb >> 9) & 1) << 5); R = (st >> 1) * 16 + swz / 64; C = (st & 1) * 32 + (swz % 64) / 2; }
__host__ __device__ __forceinline__ int perm32(int rho) { const int n = rho >> 4, i = rho & 15; return 8 * (i >> 2) + 4 * n + (i & 3); }

struct Unit { int pm, pn, ko = 0; };
struct Gemm { const bf16_t* A; const bf16_t* Bt; int M, N, K; int ld = 0; };

struct StaticOrder {
    int nM, nN, nwg, G, c;
    __host__ __device__ void init(int M, int N, int G_, int c_) { nM = M / BM; nN = N / BM; nwg = nM * nN; G = G_; c = c_; }
    __host__ __device__ bool next(int i, Unit& u) const {
        const long L = (long)i * G + c; if (L >= nwg) return false;
        int wgid = (int)L; { const int q = nwg / NXCD, r = nwg % NXCD, xcd = wgid % NXCD, off = wgid / NXCD; wgid = (xcd < r ? xcd * (q + 1) : r * (q + 1) + (xcd - r) * q) + off; }
        const int nig = WGM * nN, gid = wgid / nig, fm = gid * WGM, gsz = (nM - fm) < WGM ? (nM - fm) : WGM;
        u.pm = fm + ((wgid % nig) % gsz); u.pn = (wgid % nig) / gsz; return true;
    }
    __device__ __forceinline__ void a_ready(const Unit&) const {}
    __device__ __forceinline__ void done(const Unit&) const {}
};

__device__ __forceinline__ unsigned cvt_pk_bf16(float lo, float hi) { unsigned r; asm volatile("v_cvt_pk_bf16_f32 %0, %1, %2" : "=v"(r) : "v"(lo), "v"(hi)); return r; }
typedef float f32x2 __attribute__((ext_vector_type(2)));
__device__ __forceinline__ f32x2 gelu_pk(f32x2 v) {
    const f32x2 av = __builtin_elementwise_abs(v), d = av * 0.2316418882f + 1.0f;
    f32x2 t; t.x = __builtin_amdgcn_rcpf(d.x); t.y = __builtin_amdgcn_rcpf(d.y);
    f32x2 q = t * 0.5307027145f + (-0.7265760135f); q = q * t + 0.7107068705f; q = q * t + (-0.142248368f); q = q * t + 0.127414796f; q = q * t;
    const f32x2 s = (v * v) * (-0.72134752044f);
    f32x2 e; e.x = __builtin_amdgcn_exp2f(s.x); e.y = __builtin_amdgcn_exp2f(s.y);
    const f32x2 m = v * (q * e), r = v - m;
    f32x2 o; o.x = v.x < 0.f ? m.x : r.x; o.y = v.y < 0.f ? m.y : r.y; return o;
}

template <int ACT  > struct EpiBf16 {
    static constexpr bool PERM = true, AFTER_DRAIN = false; static_assert(ACT == 0 || ACT == 1, "EpiBf16: ACT is 0 (none) or 1 (gelu_pk)");
    bf16_t* O; int ldc; const float* bias; int split_cols; size_t split_stride; float scale0;
    __device__ __forceinline__ void operator()(const f32x4 (&acc)[2][2][4][2], const Unit& u, int wr, int wc, int fr, int fq) const {
        const int row0 = u.pm * BM + wr * 64 + fr; int colt = u.pn * BM; bf16_t* base = O;
        float sc = 1.f; if (split_cols) { const int t = colt / split_cols; base += (size_t)t * split_stride; colt -= t * split_cols; if (t == 0) sc = scale0; }
        const int col0 = colt + wc * 32 + 8 * fq, bcol0 = u.pn * BM + wc * 32 + 8 * fq;
        f32x4 bv[2][2];
#pragma unroll
        for (int bj = 0; bj < 2; ++bj)
#pragma unroll
            for (int n = 0; n < 2; ++n) bv[bj][n] = bias ? *(const f32x4*)(bias + bcol0 + bj * HALF + 4 * n) : (f32x4){0.f, 0.f, 0.f, 0.f};
#pragma unroll
        for (int ai = 0; ai < 2; ++ai)
#pragma unroll
            for (int m = 0; m < 4; ++m) { bf16_t* rowp = base + (size_t)(row0 + ai * HALF + m * 16) * ldc + col0;
#pragma unroll
                for (int bj = 0; bj < 2; ++bj) { f32x4 v0 = acc[ai][bj][m][0] + bv[bj][0], v1 = acc[ai][bj][m][1] + bv[bj][1];
                    if (ACT == 1) { f32x2 a = gelu_pk((f32x2){v0[0], v0[1]}), b = gelu_pk((f32x2){v0[2], v0[3]}), c = gelu_pk((f32x2){v1[0], v1[1]}), d = gelu_pk((f32x2){v1[2], v1[3]});
                        v0 = (f32x4){a.x, a.y, b.x, b.y}; v1 = (f32x4){c.x, c.y, d.x, d.y}; }
                    v0 = v0 * sc; v1 = v1 * sc; u32x4 w; w.x = cvt_pk_bf16(v0[0], v0[1]); w.y = cvt_pk_bf16(v0[2], v0[3]); w.z = cvt_pk_bf16(v1[0], v1[1]); w.w = cvt_pk_bf16(v1[2], v1[3]);
                    *(u32x4*)(rowp + bj * HALF) = w; } }
    }
};
template <class Epi, class Sched, bool ALIGN_EPI = false, bool SP2 = false>
__device__ __forceinline__ void gemm_phase(PG8_LAS unsigned char* lds, const Gemm g, const Sched& S, const Epi& E, int tid_in) {
    int tid_ = tid_in; asm volatile("" : "+v"(tid_));
    const int tid = tid_, wid = __builtin_amdgcn_readfirstlane(tid >> 6), lane = tid & 63, wr = wid >> 2, wc = wid & 3, fr = lane & 15, fq = lane >> 4;
    const int K = g.K, nt = K / BK, LD = g.ld ? g.ld : g.K;
    unsigned voffA[2], voffB[2];
#pragma unroll
    for (int i = 0; i < 2; ++i) { int R, C; stage_rc(tid * 16 + i * 8192, R, C); const int Rb = Epi::PERM ? ((R & ~31) + perm32(R & 31)) : R;
        voffA[i] = (unsigned)(R * LD + C) * 2u; voffB[i] = (unsigned)(Rb * LD + C) * 2u; }
    const size_t kstep = (size_t)(BK * 2);
    const size_t hstep = (size_t)HALF * LD * 2;
    const size_t tstep = 2 * hstep;
    const unsigned ldsw = (unsigned)wid * 1024u;
    const int aoff = lds_byte(wr * 64 + fr, fq * 8), boff = lds_byte(wc * 32 + fr, fq * 8);
#define PG8_SA(b, h) (((b) * 2 + (h)) * HTB)
#define PG8_SB(b, h) ((4 + (b) * 2 + (h)) * HTB)
#define PG8_STAGE(bufoff, gbase, voff) do { _Pragma("unroll") for (int _i = 0; _i < 2; ++_i) \
        __builtin_amdgcn_global_load_lds((const unsigned*)((const char*)(gbase) + (voff)[_i]), (PG8_LAS unsigned*)(lds + (bufoff) + ldsw + _i * 8192), 16, 0, 0); } while (0)
#define PG8_LDA(dst, b, h) do { _Pragma("unroll") for (int m = 0; m < 4; ++m) _Pragma("unroll") for (int k = 0; k < 2; ++k) dst[m][k] = *(const PG8_LAS bf16x8*)(lds + PG8_SA(b, h) + aoff + m * 2048 + k * 1024); } while (0)
#define PG8_LDB(dst, b, h) do { _Pragma("unroll") for (int n = 0; n < 2; ++n) _Pragma("unroll") for (int k = 0; k < 2; ++k) dst[n][k] = *(const PG8_LAS bf16x8*)(lds + PG8_SB(b, h) + boff + n * 2048 + k * 1024); } while (0)
#define PG8_MMA(ai, bj, At, Bt) do { __builtin_amdgcn_s_setprio(1); _Pragma("unroll") for (int m = 0; m < 4; ++m) _Pragma("unroll") for (int n = 0; n < 2; ++n) _Pragma("unroll") for (int k = 0; k < 2; ++k) \
        acc[ai][bj][m][n] = __builtin_amdgcn_mfma_f32_16x16x32_bf16(Bt[n][k], At[m][k], acc[ai][bj][m][n], 0, 0, 0); __builtin_amdgcn_s_setprio(0); } while (0)
#define PG8_WAIT_V(n) asm volatile("s_waitcnt vmcnt(" #n ")" ::: "memory")
#define PG8_WAIT_L(n) asm volatile("s_waitcnt lgkmcnt(" #n ")" ::: "memory")
#define PG8_BAR __builtin_amdgcn_s_barrier()
#define PG8_SCHED __builtin_amdgcn_sched_barrier(0)
    Unit cur, nxt; int ui = 0;
    if (!S.next(0, cur)) return;
    f32x4 acc[2][2][4][2];
#pragma unroll
    for (int a = 0; a < 2; ++a)
#pragma unroll
        for (int b = 0; b < 2; ++b)
#pragma unroll
            for (int m = 0; m < 4; ++m)
#pragma unroll
                for (int n = 0; n < 2; ++n) acc[a][b][m][n] = (f32x4){0.f, 0.f, 0.f, 0.f};
    bf16x8 At[4][2], B0[2][2], B1[2][2];
    const char* cA = (const char*)g.A + (size_t)cur.pm * tstep + (size_t)cur.ko * 2; const char* cB = (const char*)g.Bt + (size_t)cur.pn * tstep + (size_t)cur.ko * 2;
    S.a_ready(cur);
    if constexpr (SP2) {
        PG8_STAGE(PG8_SB(0, 0), cB, voffB); PG8_STAGE(PG8_SB(0, 1), cB + hstep, voffB); PG8_STAGE(PG8_SA(0, 0), cA, voffA); PG8_STAGE(PG8_SA(0, 1), cA + hstep, voffA);
        if (wr == 1) PG8_BAR;
        PG8_WAIT_V(2); PG8_BAR;
        PG8_STAGE(PG8_SB(1, 0), cB + kstep, voffB); PG8_STAGE(PG8_SA(1, 0), cA + kstep, voffA); PG8_STAGE(PG8_SB(1, 1), cB + hstep + kstep, voffB);
        PG8_WAIT_V(6); PG8_BAR;
    } else {
        PG8_STAGE(PG8_SB(0, 0), cB, voffB); PG8_STAGE(PG8_SA(0, 0), cA, voffA); PG8_STAGE(PG8_SB(0, 1), cB + hstep, voffB); PG8_STAGE(PG8_SA(0, 1), cA + hstep, voffA);
        if (wr == 1) PG8_BAR;
        PG8_WAIT_V(4); PG8_BAR;
        PG8_STAGE(PG8_SB(1, 0), cB + kstep, voffB); PG8_STAGE(PG8_SA(1, 0), cA + kstep, voffA); PG8_STAGE(PG8_SB(1, 1), cB + hstep + kstep, voffB);
        PG8_WAIT_V(6); PG8_BAR;
    }
    for (;;) {
        const bool has_next = S.next(ui + 1, nxt);
        const char* nA = has_next ? (const char*)g.A + (size_t)nxt.pm * tstep + (size_t)nxt.ko * 2 : cA; const char* nB = has_next ? (const char*)g.Bt + (size_t)nxt.pn * tstep + (size_t)nxt.ko * 2 : cB;
        for (int t = 0; t < nt; t += 2) {
            const bool last = (t == nt - 2);
            const char* a1 = cA + (size_t)(t + 1) * kstep;
            const char* a2 = last ? nA : cA + (size_t)(t + 2) * kstep; const char* b2 = last ? nB : cB + (size_t)(t + 2) * kstep;
            const char* a3 = a2 + kstep; const char* b3 = b2 + kstep;
            if (last && has_next) S.a_ready(nxt);
            if constexpr (SP2) {
            PG8_LDB(B0, 0, 0); PG8_LDB(B1, 0, 1); PG8_SCHED; PG8_LDA(At, 0, 0); PG8_STAGE(PG8_SA(1, 1), a1 + hstep, voffA);
            PG8_WAIT_V(8); PG8_WAIT_L(0); PG8_BAR; PG8_MMA(0, 0, At, B0); PG8_MMA(0, 1, At, B1); PG8_BAR; PG8_SCHED;
            PG8_LDA(At, 0, 1); PG8_STAGE(PG8_SB(0, 0), b2, voffB); PG8_STAGE(PG8_SB(0, 1), b2 + hstep, voffB); PG8_STAGE(PG8_SA(0, 0), a2, voffA);
            PG8_WAIT_V(8); PG8_WAIT_L(0); PG8_BAR; PG8_MMA(1, 0, At, B0); PG8_MMA(1, 1, At, B1); PG8_BAR; PG8_SCHED;
            PG8_LDB(B0, 1, 0); PG8_LDB(B1, 1, 1); PG8_SCHED; PG8_LDA(At, 1, 0); PG8_STAGE(PG8_SA(0, 1), a2 + hstep, voffA);
            PG8_WAIT_V(8); PG8_WAIT_L(0); PG8_BAR; PG8_MMA(0, 0, At, B0); PG8_MMA(0, 1, At, B1); PG8_BAR; PG8_SCHED;
            PG8_LDA(At, 1, 1); PG8_STAGE(PG8_SB(1, 0), b3, voffB); PG8_STAGE(PG8_SB(1, 1), b3 + hstep, voffB); PG8_STAGE(PG8_SA(1, 0), a3, voffA);
            PG8_WAIT_V(8); PG8_WAIT_L(0); PG8_BAR; PG8_MMA(1, 0, At, B0); PG8_MMA(1, 1, At, B1); PG8_BAR; PG8_SCHED;
            } else {
            PG8_LDB(B0, 0, 0); PG8_SCHED; PG8_LDA(At, 0, 0); PG8_STAGE(PG8_SA(1, 1), a1 + hstep, voffA);
            PG8_WAIT_L(8); PG8_BAR; PG8_WAIT_L(0); PG8_MMA(0, 0, At, B0); PG8_BAR; PG8_SCHED;
            PG8_LDB(B1, 0, 1); PG8_STAGE(PG8_SB(0, 0), b2, voffB);
            PG8_BAR; PG8_WAIT_L(0); PG8_MMA(0, 1, At, B1); PG8_BAR;
            PG8_LDA(At, 0, 1); PG8_STAGE(PG8_SA(0, 0), a2, voffA);
            PG8_BAR; PG8_WAIT_L(0); PG8_MMA(1, 0, At, B0); PG8_BAR; PG8_SCHED;
            PG8_STAGE(PG8_SB(0, 1), b2 + hstep, voffB);
            PG8_WAIT_V(6); PG8_BAR; PG8_MMA(1, 1, At, B1); PG8_BAR;
            PG8_LDB(B0, 1, 0); PG8_SCHED; PG8_LDA(At, 1, 0); PG8_STAGE(PG8_SA(0, 1), a2 + hstep, voffA);
            PG8_WAIT_L(8); PG8_BAR; PG8_WAIT_L(0); PG8_MMA(0, 0, At, B0); PG8_BAR; PG8_SCHED;
            PG8_LDB(B1, 1, 1); PG8_STAGE(PG8_SB(1, 0), b3, voffB);
            PG8_BAR; PG8_WAIT_L(0); PG8_MMA(0, 1, At, B1); PG8_BAR;
            PG8_LDA(At, 1, 1); PG8_STAGE(PG8_SA(1, 0), a3, voffA);
            PG8_BAR; PG8_WAIT_L(0); PG8_MMA(1, 0, At, B0); PG8_BAR; PG8_SCHED;
            PG8_STAGE(PG8_SB(1, 1), b3 + hstep, voffB);
            PG8_WAIT_V(6); PG8_BAR; PG8_MMA(1, 1, At, B1); PG8_BAR;
            }
        }
        if constexpr (ALIGN_EPI) { if (wr == 0) PG8_BAR; }
        if constexpr (!Epi::AFTER_DRAIN) { int z_ = 0; asm volatile("" : "+v"(z_)); const int ln_ = __builtin_amdgcn_mbcnt_hi(-1, __builtin_amdgcn_mbcnt_lo(-1, z_)); E(acc, cur, wr, wc, ln_ & 15, ln_ >> 4); S.done(cur); }
        if (!has_next) break;
#pragma unroll
        for (int a = 0; a < 2; ++a)
#pragma unroll
            for (int b = 0; b < 2; ++b)
#pragma unroll
                for (int m = 0; m < 4; ++m)
#pragma unroll
                    for (int n = 0; n < 2; ++n) acc[a][b][m][n] = (f32x4){0.f, 0.f, 0.f, 0.f};
        cur = nxt; cA = nA; cB = nB; ++ui;
        if constexpr (ALIGN_EPI) { if (wr == 1) PG8_BAR; }
    }
    PG8_WAIT_V(0);
    if constexpr (!ALIGN_EPI) { if (wr == 0) PG8_BAR; }
    PG8_BAR;
    if constexpr (Epi::AFTER_DRAIN) { E.fused(acc, cur, wr, wc, fr, fq, lds, wid, lane); S.done(cur); }
#undef PG8_SA
#undef PG8_SB
#undef PG8_STAGE
#undef PG8_LDA
#undef PG8_LDB
#undef PG8_MMA
#undef PG8_WAIT_V
#undef PG8_WAIT_L
#undef PG8_BAR
#undef PG8_SCHED
}
}
namespace mk {
typedef pg8::bf16_t bf16;
typedef pg8::f32x4 f32x4;
typedef pg8::u32x4 u32x4;
typedef pg8::bf16x8 bf16x8;
typedef pg8::Unit Unit;
typedef float f32x16 __attribute__((ext_vector_type(16)));
typedef unsigned u32x2 __attribute__((ext_vector_type(2)));
typedef float f32x2 __attribute__((ext_vector_type(2)));
#define LAS __attribute__((address_space(3)))
#define LDS_WAIT() asm volatile("s_waitcnt lgkmcnt(0)" ::: "memory")

constexpr int DM = 1024, T = 4096, NBP = 4, MP = NBP * T, DB = 128, DS = 4, MS = DB * DS, M = MP + MS, NL = 4;
constexpr int INC = 2304, DFF = 2816, K2 = 512, N2 = 1280, PLE = 256;
constexpr int C_K = 512, C_V = 640, C_RW = 768, C_XB = 1792, C_GB = 2048;

constexpr size_t SZ_WIN = (size_t)INC * DM * 2, SZ_W2 = (size_t)N2 * K2 * 2, SZ_WOUT = (size_t)DM * DM * 2, SZ_WGU = (size_t)2 * DFF * DM * 2,
                 SZ_WD = (size_t)DM * DFF * 2, SZ_WPG = (size_t)DM * DM * 2, SZ_WP = (size_t)DM * PLE * 2;
constexpr size_t O_WIN = 0, O_W2 = O_WIN + SZ_WIN, O_WOUT = O_W2 + SZ_W2, O_WGU = O_WOUT + SZ_WOUT, O_WD = O_WGU + SZ_WGU, O_WPG = O_WD + SZ_WD,
                 O_WP = O_WPG + SZ_WPG, WL = O_WP + SZ_WP;
constexpr size_t WS_W = 1u << 20  , SZ_PBL = (size_t)M * PLE * 2, WS_X16 = WS_W + 2 * WL  , WS_PB = WS_X16 + (size_t)M * DM * 2  , SZ_ACT = (size_t)M * DM * 2, WS_PP = WS_PB + 2 * SZ_PBL  , WS_HN = WS_PP + SZ_ACT,
                 WS_R1 = WS_HN + SZ_ACT, SZ_R1 = (size_t)M * INC * 2, WS_R2 = WS_R1 + SZ_R1, SZ_F256 = (size_t)M * 256 * 4, WS_R3 = WS_R2 + 7 * SZ_F256,
                 WS_END = WS_R3 + 3 * SZ_F256;
static_assert(WL % 256 == 0 && SZ_R1 >= (size_t)M * DM * 4 && 7 * SZ_F256 >= (size_t)M * DFF * 2, "ws map");

constexpr size_t OUT_Y = 0, OUT_KP = (size_t)M * DM, OUT_VP = OUT_KP + (size_t)NL * NBP * 128 * 128, OUT_SHP = OUT_VP + (size_t)NL * NBP * 128 * 128,
                 OUT_WKVP = OUT_SHP + (size_t)NL * NBP * 1024, OUT_CVP = OUT_WKVP + (size_t)NL * NBP * 4 * 4096, OUT_LRP = OUT_CVP + (size_t)NL * NBP * 768,
                 OUT_KS = OUT_LRP + (size_t)NL * NBP * 256, OUT_VS = OUT_KS + (size_t)NL * DB * 128 * 128, OUT_SHS = OUT_VS + (size_t)NL * DB * 128 * 128,
                 OUT_WKVS = OUT_SHS + (size_t)NL * DB * 1024, OUT_CVS = OUT_WKVS + (size_t)NL * DB * 4 * 4096, OUT_LRS = OUT_CVS + (size_t)NL * DB * 768,
                 OUT_END = OUT_LRS + (size_t)NL * DB * 256;

enum { I_XP = 0, I_XS, I_CK, I_CV, I_SSH, I_SWKV, I_SCV, I_SLRU, I_PP, I_PS, I_NMPRE, I_NMPOST, I_NFPRE, I_NFPOST, I_WIN, I_BIN, I_SINK, I_MU, I_W0, I_WUP,
       I_A0, I_AUP, I_GUP, I_KK, I_KA, I_RK, I_LNW, I_LNB, I_CW, I_CB, I_WA, I_BA, I_WI, I_BI, I_L, I_WOUT, I_BOUT, I_WG, I_WU, I_WDN, I_PW, I_PGW, N_IN };

__device__ __forceinline__ unsigned f2bf(float f) { unsigned u = __float_as_uint(f); return (u + 0x7fffu + ((u >> 16) & 1u)) >> 16; }
__device__ __forceinline__ unsigned pk2(float lo, float hi) { return f2bf(lo) | (f2bf(hi) << 16); }
__device__ __forceinline__ float bflo(unsigned w) { return __uint_as_float(w << 16); }
__device__ __forceinline__ float bfhi(unsigned w) { return __uint_as_float(w & 0xffff0000u); }
__device__ __forceinline__ float bf1(bf16 b) { return __uint_as_float((unsigned)b << 16); }
__device__ __forceinline__ f32x4 ld_bf4(const bf16* p) { const u32x2 w = *(const u32x2*)p; return (f32x4){bflo(w.x), bfhi(w.x), bflo(w.y), bfhi(w.y)}; }
__device__ __forceinline__ void st_bf4(bf16* p, f32x4 v) { u32x2 w; w.x = pk2(v.x, v.y); w.y = pk2(v.z, v.w); *(u32x2*)p = w; }
__device__ __forceinline__ void ld_bf8(const bf16* p, f32x4& lo, f32x4& hi) { const u32x4 w = *(const u32x4*)p; lo = (f32x4){bflo(w.x), bfhi(w.x), bflo(w.y), bfhi(w.y)}; hi = (f32x4){bflo(w.z), bfhi(w.z), bflo(w.w), bfhi(w.w)}; }
__device__ __forceinline__ void st_bf8(bf16* p, f32x4 lo, f32x4 hi) { u32x4 w; w.x = pk2(lo.x, lo.y); w.y = pk2(lo.z, lo.w); w.z = pk2(hi.x, hi.y); w.w = pk2(hi.z, hi.w); *(u32x4*)p = w; }
__device__ __forceinline__ float sigm(float x) { return __builtin_amdgcn_rcpf(1.f + __expf(-x)); }
__device__ __forceinline__ float tanh_(float x) { return 1.f - 2.f * __builtin_amdgcn_rcpf(__expf(2.f * x) + 1.f); }
__device__ __forceinline__ float gelu_t(float x) { return 0.5f * x * (1.f + tanh_(0.7978845608f * (x + 0.044715f * x * x * x))); }
template <int CTRL> __device__ __forceinline__ float dppf(float x) { return __builtin_bit_cast(float, __builtin_amdgcn_mov_dpp(__builtin_bit_cast(int, x), CTRL, 0xf, 0xf, true)); }
__device__ __forceinline__ float red16(float x) { x += dppf<0xB1>(x); x += dppf<0x4E>(x); x += dppf<0x141>(x); x += dppf<0x128>(x); return x; }
__device__ __forceinline__ float wave_sum(float v) {
    v = red16(v);
    v += __builtin_bit_cast(float, __builtin_amdgcn_update_dpp(0, __builtin_bit_cast(int, v), 0x142, 0xa, 0xf, false));
    v += __builtin_bit_cast(float, __builtin_amdgcn_update_dpp(0, __builtin_bit_cast(int, v), 0x143, 0xc, 0xf, false));
    return __builtin_bit_cast(float, __builtin_amdgcn_readlane(__builtin_bit_cast(int, v), 63));
}
__device__ __forceinline__ float vmul(float a, float b) { float d; asm("v_mul_f32 %0, %1, %2" : "=v"(d) : "v"(a), "v"(b)); return d; }
__device__ __forceinline__ float vfma(float a, float b, float c) { float d; asm("v_fma_f32 %0, %1, %2, %3" : "=v"(d) : "v"(a), "v"(b), "v"(c)); return d; }
__device__ __forceinline__ float vfnma(float a, float b, float c) { float d; asm("v_fma_f32 %0, -%1, %2, %3" : "=v"(d) : "v"(a), "v"(b), "v"(c)); return d; }
__device__ __forceinline__ void red16x2(float& p, float& q) {
    asm volatile("v_add_f32_dpp %0, %0, %0 quad_perm:[1,0,3,2] row_mask:0xf bank_mask:0xf bound_ctrl:1\n\t"
                 "v_add_f32_dpp %1, %1, %1 quad_perm:[1,0,3,2] row_mask:0xf bank_mask:0xf bound_ctrl:1\n\ts_nop 0\n\t"
                 "v_add_f32_dpp %0, %0, %0 quad_perm:[2,3,0,1] row_mask:0xf bank_mask:0xf bound_ctrl:1\n\t"
                 "v_add_f32_dpp %1, %1, %1 quad_perm:[2,3,0,1] row_mask:0xf bank_mask:0xf bound_ctrl:1\n\ts_nop 0\n\t"
                 "v_add_f32_dpp %0, %0, %0 row_half_mirror row_mask:0xf bank_mask:0xf bound_ctrl:1\n\t"
                 "v_add_f32_dpp %1, %1, %1 row_half_mirror row_mask:0xf bank_mask:0xf bound_ctrl:1\n\ts_nop 0\n\t"
                 "v_add_f32_dpp %0, %0, %0 row_ror:8 row_mask:0xf bank_mask:0xf bound_ctrl:1\n\t"
                 "v_add_f32_dpp %1, %1, %1 row_ror:8 row_mask:0xf bank_mask:0xf bound_ctrl:1\n\ts_nop 1"
                 : "+v"(p), "+v"(q));
}
__device__ __forceinline__ float shx(float v, int mask, int lane) { return __builtin_bit_cast(float, __builtin_amdgcn_ds_bpermute((lane ^ mask) << 2, __builtin_bit_cast(int, v))); }
__device__ __forceinline__ float dot4(f32x4 a, f32x4 b) { return (a.x * b.x + a.y * b.y) + (a.z * b.z + a.w * b.w); }

struct EpiF32 {
    static constexpr bool PERM = false, AFTER_DRAIN = false;
    float* O; int ldc; const float* bias;
    __device__ __forceinline__ void operator()(const f32x4 (&acc)[2][2][4][2], const Unit& u, int wr, int wc, int fr, int fq) const {
        asm volatile("" : "+v"(fr), "+v"(fq));
        const int row0 = u.pm * 256 + wr * 64 + fr, col0 = u.pn * 256 + wc * 32 + 4 * fq;
        f32x4 bv[2][2];
#pragma unroll
        for (int bj = 0; bj < 2; ++bj)
#pragma unroll
            for (int n = 0; n < 2; ++n) bv[bj][n] = bias ? *(const f32x4*)(bias + col0 + bj * 128 + n * 16) : (f32x4){0.f, 0.f, 0.f, 0.f};
#pragma unroll
        for (int ai = 0; ai < 2; ++ai)
#pragma unroll
            for (int m = 0; m < 4; ++m) { float* rowp = O + (size_t)(row0 + ai * 128 + m * 16) * ldc + col0;
#pragma unroll
                for (int bj = 0; bj < 2; ++bj)
#pragma unroll
                    for (int n = 0; n < 2; ++n) *(f32x4*)(rowp + bj * 128 + n * 16) = acc[ai][bj][m][n] + bv[bj][n]; }
    }
};
struct EpiPle {
    static constexpr bool PERM = true, AFTER_DRAIN = false;
    bf16* X; const bf16* PP; float* Y;
    __device__ __forceinline__ void operator()(const f32x4 (&acc)[2][2][4][2], const Unit& u, int wr, int wc, int fr, int fq) const {
        asm volatile("" : "+v"(fr), "+v"(fq));
        const int row0 = u.pm * 256 + wr * 64 + fr, col0 = u.pn * 256 + wc * 32 + 8 * fq;
#pragma unroll
        for (int ai = 0; ai < 2; ++ai)
#pragma unroll
            for (int m = 0; m < 4; ++m) { const size_t off = (size_t)(row0 + ai * 128 + m * 16) * DM + col0;
#pragma unroll
                for (int bj = 0; bj < 2; ++bj) { const size_t o = off + bj * 128; f32x4 x0, x1, p0, p1; ld_bf8(X + o, x0, x1); ld_bf8(PP + o, p0, p1); const f32x4 a0 = acc[ai][bj][m][0], a1 = acc[ai][bj][m][1];
                    const f32x4 r0 = (f32x4){x0.x + sigm(a0.x) * p0.x, x0.y + sigm(a0.y) * p0.y, x0.z + sigm(a0.z) * p0.z, x0.w + sigm(a0.w) * p0.w},
                                r1 = (f32x4){x1.x + sigm(a1.x) * p1.x, x1.y + sigm(a1.y) * p1.y, x1.z + sigm(a1.z) * p1.z, x1.w + sigm(a1.w) * p1.w};
                    if (Y) { *(f32x4*)(Y + o) = r0; *(f32x4*)(Y + o + 4) = r1; } else st_bf8(X + o, r0, r1); }
                asm volatile("" ::: "memory"); }
    }
};
struct EpiSwiglu {
    static constexpr bool PERM = true, AFTER_DRAIN = false;
    bf16* O;
    __device__ __forceinline__ void operator()(const f32x4 (&acc)[2][2][4][2], const Unit& u, int wr, int wc, int fr, int fq) const {
        asm volatile("" : "+v"(fr), "+v"(fq));
        const int row0 = u.pm * 256 + wr * 64 + fr, col0 = u.pn * 128 + wc * 32 + 8 * fq;
#pragma unroll
        for (int ai = 0; ai < 2; ++ai)
#pragma unroll
            for (int m = 0; m < 4; ++m) { bf16* p = O + (size_t)(row0 + ai * 128 + m * 16) * DFF + col0;
                const f32x4 g0 = acc[ai][0][m][0], g1 = acc[ai][0][m][1], u0 = acc[ai][1][m][0], u1 = acc[ai][1][m][1];
                u32x4 w; w.x = pk2(g0.x * sigm(g0.x) * u0.x, g0.y * sigm(g0.y) * u0.y); w.y = pk2(g0.z * sigm(g0.z) * u0.z, g0.w * sigm(g0.w) * u0.w);
                w.z = pk2(g1.x * sigm(g1.x) * u1.x, g1.y * sigm(g1.y) * u1.y); w.w = pk2(g1.z * sigm(g1.z) * u1.z, g1.w * sigm(g1.w) * u1.w);
                *(u32x4*)p = w; }
    }
};
struct G2Order {
    pg8::StaticOrder b;
    __device__ bool next(int i, Unit& u) const { if (!b.next(i, u)) return false; u.ko = u.pn < 3 ? 0 : 256; return true; }
    __device__ __forceinline__ void a_ready(const Unit&) const {}
    __device__ __forceinline__ void done(const Unit&) const {}
};
struct SplitOrder {
    int c, G, kh;
    __device__ bool next(int i, Unit& u) const { const long L = (long)i * G + c; if (L >= 16) return false; u.pm = (int)L >> 3; u.pn = ((int)L >> 1) & 3; u.ko = ((int)L & 1) * kh; return true; }
    __device__ __forceinline__ void a_ready(const Unit&) const {}
    __device__ __forceinline__ void done(const Unit&) const {}
};
struct EpiPart {
    static constexpr bool PERM = false, AFTER_DRAIN = false;
    float* P;
    __device__ __forceinline__ void operator()(const f32x4 (&acc)[2][2][4][2], const Unit& u, int wr, int wc, int fr, int fq) const {
        asm volatile("" : "+v"(fr), "+v"(fq));
        const int row0 = u.pm * 256 + wr * 64 + fr, col0 = u.pn * 256 + wc * 32 + 4 * fq; float* O = P + (u.ko ? (size_t)MS * DM : 0);
#pragma unroll
        for (int ai = 0; ai < 2; ++ai)
#pragma unroll
            for (int m = 0; m < 4; ++m) { float* rowp = O + (size_t)(row0 + ai * 128 + m * 16) * DM + col0;
#pragma unroll
                for (int bj = 0; bj < 2; ++bj)
#pragma unroll
                    for (int n = 0; n < 2; ++n) *(f32x4*)(rowp + bj * 128 + n * 16) = acc[ai][bj][m][n]; }
    }
};
struct EpiMix {
    static constexpr bool PERM = false, AFTER_DRAIN = false;
    const float *w0, *a0, *k_a, *b_a, *b_i, *Lp; float* Wd; bf16 *Ks, *KK, *BV, *G; float *AL, *U; const bf16* A2;
    __device__ __forceinline__ void operator()(const f32x4 (&acc)[2][2][4][2], const Unit& u, int wr, int wc, int fr, int fq) const {
        asm volatile("" : "+v"(fr), "+v"(fq));
        const int row0 = u.pm * 256 + wr * 64 + fr;
        if (u.pn < 3) {
#pragma unroll
            for (int ai = 0; ai < 2; ++ai)
#pragma unroll
                for (int m = 0; m < 4; ++m) { const size_t ro = (size_t)(row0 + ai * 128 + m * 16) * 256;
#pragma unroll
                    for (int bj = 0; bj < 2; ++bj)
#pragma unroll
                        for (int n = 0; n < 2; ++n) { const int c = bj * 128 + wc * 32 + n * 16 + 4 * fq; const f32x4 z = acc[ai][bj][m][n];
                            if (u.pn == 0) { const f32x4 b = *(const f32x4*)(w0 + c); f32x4 d;
                                d.x = __expf(-0.60653066f * sigm(z.x + b.x)); d.y = __expf(-0.60653066f * sigm(z.y + b.y)); d.z = __expf(-0.60653066f * sigm(z.z + b.z)); d.w = __expf(-0.60653066f * sigm(z.w + b.w));
                                *(f32x4*)(Wd + ro + c) = d; }
                            else if (u.pn == 1) { const f32x4 b = *(const f32x4*)(a0 + c), ka = *(const f32x4*)(k_a + c), ks = ld_bf4(Ks + ro + c), kk = ld_bf4(KK + ro + c);
                                f32x4 a; a.x = sigm(z.x + b.x); a.y = sigm(z.y + b.y); a.z = sigm(z.z + b.z); a.w = sigm(z.w + b.w);
                                st_bf4(Ks + ro + c, ks * (1.f + (a - 1.f) * ka)); st_bf4(BV + ro + c, kk * a); }
                            else { st_bf4(G + ro + c, z); }
                            asm volatile("" ::: "memory"); } }
        } else {
            const int t = u.pn - 3;
#pragma unroll
            for (int ai = 0; ai < 2; ++ai)
#pragma unroll
                for (int m = 0; m < 4; ++m) { const size_t r = (size_t)(row0 + ai * 128 + m * 16);
#pragma unroll
                    for (int n = 0; n < 2; ++n) { const int cc = 128 * t + wc * 32 + n * 16 + 4 * fq;
                        const f32x4 zr = acc[ai][0][m][n] + *(const f32x4*)(b_a + cc), zi = acc[ai][1][m][n] + *(const f32x4*)(b_i + cc), Lv = *(const f32x4*)(Lp + cc), xc = ld_bf4(A2 + r * K2 + 256 + cc);
                        f32x4 al, uu;
#define LRU1(e) { const float xe = __expf(-Lv.e); const float ls = -xe * (1.f + xe * (-0.5f + xe * 0.33333334f)); const float la = 8.f * sigm(zr.e) * ls; al.e = __expf(la); const float z2 = 2.f * la; \
    const float om = -z2 * (1.f + z2 * (0.5f + z2 * (0.16666667f + z2 * (0.041666668f + z2 * 0.0083333338f)))); uu.e = __builtin_amdgcn_sqrtf(om) * sigm(zi.e) * xc.e; }
                        LRU1(x) LRU1(y) LRU1(z) LRU1(w)
#undef LRU1
                        *(f32x4*)(AL + r * 256 + cc) = al; *(f32x4*)(U + r * 256 + cc) = uu; asm volatile("" ::: "memory"); } }
        }
    }
};
#define RLX_AGENT __ATOMIC_RELAXED, __HIP_MEMORY_SCOPE_AGENT
#define XB_TMO      128
#define XB_XCNT(j)  (256  + 64 * (j))
#define XB_XSUB(j)  (1280 + 64 * (j))
#define XB_XGEN(j)  (2304 + 64 * (j))
#define XB_TOP      3328
#define XB_TOPGEN   3392
#define XCD_BAR_WORDS 3456
#define XB_SPIN_CAP (1u << 18)

__device__ __forceinline__ unsigned xb_ld(unsigned* p)              { return __hip_atomic_load(p, __ATOMIC_RELAXED, __HIP_MEMORY_SCOPE_AGENT); }
__device__ __forceinline__ unsigned xb_add(unsigned* p, unsigned v) { return __hip_atomic_fetch_add(p, v, __ATOMIC_RELAXED, __HIP_MEMORY_SCOPE_AGENT); }
__device__ __forceinline__ unsigned xb_xcc_id() { return (unsigned)__builtin_amdgcn_s_getreg((3 << 11) | 20) & 0xFu; }
#define XB_SPIN(cond, bar) do { unsigned _sp = 0; while (cond) { __builtin_amdgcn_s_sleep(1); \
    if ((++_sp & 255u) == 0u) { if (xb_ld(&(bar)[XB_TMO])) break; if (_sp > XB_SPIN_CAP) { atomicAdd(&(bar)[XB_TMO], 1u); break; } } } } while (0)

struct XcdBarrier {
    unsigned* bar; unsigned x;
    volatile LAS unsigned* st;
};

__device__ __forceinline__ XcdBarrier xcd_barrier_post(unsigned* bar, volatile LAS unsigned* st, int tid) {
    XcdBarrier b; b.bar = bar; b.x = xb_xcc_id(); b.st = st;
    if (tid == 0) (void)xb_add(&bar[XB_XCNT(b.x)], 1u);
    return b;
}
__device__ __forceinline__ void xcd_barrier_complete(unsigned* bar, unsigned x, unsigned& nloc, unsigned& nx) {
    const unsigned G = gridDim.x * gridDim.y * gridDim.z;
    unsigned sum, cnt, mine, sp = 0u;
    for (;;) {
        sum = 0u; cnt = 0u; mine = 0u;
#pragma unroll
        for (unsigned j = 0; j < 16; ++j) { const unsigned c = xb_ld(&bar[XB_XCNT(j)]); sum += c; cnt += (c > 0u) ? 1u : 0u; mine = (j == x) ? c : mine; }
        if (sum == G) break;
        __builtin_amdgcn_s_sleep(1);
        if ((++sp & 255u) == 0u) { if (xb_ld(&bar[XB_TMO])) break; if (sp > XB_SPIN_CAP) { atomicAdd(&bar[XB_TMO], 1u); break; } }
    }
    nloc = mine > 0u ? mine : 1u; nx = cnt > 0u ? cnt : 1u;
}

__device__ __forceinline__ void xcd_barrier(const XcdBarrier& b, int tid) {
    asm volatile("s_waitcnt vmcnt(0)" ::: "memory");
    __syncthreads();
    if (tid == 0) {
        unsigned* bar = b.bar;
        __builtin_amdgcn_s_waitcnt(0);
        unsigned nloc = b.st[0], nx = b.st[1];
        if (nloc == 0u) { xcd_barrier_complete(bar, b.x, nloc, nx); b.st[0] = nloc; b.st[1] = nx; }
        const unsigned old = xb_add(&bar[XB_XSUB(b.x)], 1u);
        const unsigned gen = old / nloc;
        if (old + 1u == (gen + 1u) * nloc) {
            __builtin_amdgcn_fence(__ATOMIC_RELEASE, "agent");
            asm volatile("s_waitcnt vmcnt(0)" ::: "memory");
            const unsigned og = xb_add(&bar[XB_TOP], 1u);
            const unsigned tg = og / nx;
            if (og + 1u == (tg + 1u) * nx) xb_add(&bar[XB_TOPGEN], 1u);
            else XB_SPIN(xb_ld(&bar[XB_TOPGEN]) == tg, bar);
            __builtin_amdgcn_fence(__ATOMIC_ACQUIRE, "agent");
            xb_add(&bar[XB_XGEN(b.x)], 1u);
            asm volatile("s_waitcnt vmcnt(0)" ::: "memory");
        } else {
            XB_SPIN(xb_ld(&bar[XB_XGEN(b.x)]) == gen, bar);
            __builtin_amdgcn_fence(__ATOMIC_ACQUIRE, "agent");
            asm volatile("s_waitcnt vmcnt(0)" ::: "memory");
        }
    }
    __syncthreads();
}
struct Args { const float* in[N_IN]; float* out; unsigned char* ws; };
struct Ctx {
    LAS unsigned char* lds; unsigned char* ws; float* out;
    int tid, lane, wave, bid, G, gw, NGW;
};
__device__ __forceinline__ const float* inp_ld(int k) {
    asm volatile("" : "+s"(k));
    const __attribute__((address_space(4))) unsigned long long* tab = (const __attribute__((address_space(4))) unsigned long long*)__builtin_amdgcn_kernarg_segment_ptr();
    return (const float*)tab[k];
}
#define INP(k) inp_ld(k)
__device__ __forceinline__ int opq(int v) { asm volatile("" : "+v"(v)); return v; }

__device__ __forceinline__ void tr_item(const float* W, int ldw, bf16* WT, int ldt, int k0, int n0, int drow, int dcol, LAS float* scr, int lane) {
#pragma unroll 8
    for (int i = 0; i < 32; ++i) { const int kk = 2 * i + (lane >> 5); scr[kk * 33 + (lane & 31)] = W[(size_t)(k0 + kk) * ldw + n0 + (lane & 31)]; }
    LDS_WAIT(); asm volatile("" ::: "memory");
    const int c = lane & 7;
#pragma unroll
    for (int j = 0; j < 4; ++j) { const int n = (lane >> 3) + 8 * j; const LAS float* s = scr + (8 * c) * 33 + n;
        u32x4 o; o.x = pk2(s[0 * 33], s[1 * 33]); o.y = pk2(s[2 * 33], s[3 * 33]); o.z = pk2(s[4 * 33], s[5 * 33]); o.w = pk2(s[6 * 33], s[7 * 33]);
        *(u32x4*)(WT + (size_t)(drow + n) * ldt + dcol + 8 * c) = o; }
    LDS_WAIT(); asm volatile("" ::: "memory");
}
__device__ __forceinline__ void row_norm_in(const float* xrow, const float* g, bf16* orow, bf16* xcopy, int lane) {
    f32x4 v[4]; float ss = 0.f;
#pragma unroll
    for (int j = 0; j < 4; ++j) { v[j] = *(const f32x4*)(xrow + 4 * lane + 256 * j); ss += dot4(v[j], v[j]); }
    const float rs = rsqrtf(wave_sum(ss) * (1.f / DM) + 1e-6f);
#pragma unroll
    for (int j = 0; j < 4; ++j) { const f32x4 gg = *(const f32x4*)(g + 4 * lane + 256 * j); if (xcopy) st_bf4(xcopy + 4 * lane + 256 * j, v[j]); st_bf4(orow + 4 * lane + 256 * j, v[j] * rs * gg); }
}
__device__ __forceinline__ void row_norm(const bf16* xrow, const float* g, bf16* orow, int lane) {
    f32x4 v[4]; float ss = 0.f;
#pragma unroll
    for (int j = 0; j < 2; ++j) { ld_bf8(xrow + 8 * lane + 512 * j, v[2 * j], v[2 * j + 1]); ss += dot4(v[2 * j], v[2 * j]) + dot4(v[2 * j + 1], v[2 * j + 1]); }
    const float rs = rsqrtf(wave_sum(ss) * (1.f / DM) + 1e-6f);
#pragma unroll
    for (int j = 0; j < 2; ++j) { const float* gp = g + 8 * lane + 512 * j; st_bf8(orow + 8 * lane + 512 * j, v[2 * j] * rs * *(const f32x4*)gp, v[2 * j + 1] * rs * *(const f32x4*)(gp + 4)); }
}
__device__ __forceinline__ void row_update_parts(const float* p0, const float* p1, const float* bias, const float* gA, bf16* X, const float* gB, bf16* outB, int lane) {
    f32x4 a[4], x[4]; float ss = 0.f;
#pragma unroll
    for (int j = 0; j < 4; ++j) { a[j] = *(const f32x4*)(p0 + 4 * lane + 256 * j) + *(const f32x4*)(p1 + 4 * lane + 256 * j); if (bias) a[j] = a[j] + *(const f32x4*)(bias + 4 * lane + 256 * j);
        x[j] = ld_bf4(X + 4 * lane + 256 * j); ss += dot4(a[j], a[j]); }
    const float rs = rsqrtf(wave_sum(ss) * (1.f / DM) + 1e-6f); float s2 = 0.f;
#pragma unroll
    for (int j = 0; j < 4; ++j) { const f32x4 gg = *(const f32x4*)(gA + 4 * lane + 256 * j); x[j] = x[j] + a[j] * rs * gg; st_bf4(X + 4 * lane + 256 * j, x[j]); s2 += dot4(x[j], x[j]); }
    float r2 = 1.f;
    if (gB) r2 = rsqrtf(wave_sum(s2) * (1.f / DM) + 1e-6f);
#pragma unroll
    for (int j = 0; j < 4; ++j) { f32x4 o = x[j]; if (gB) o = o * r2 * *(const f32x4*)(gB + 4 * lane + 256 * j); st_bf4(outB + 4 * lane + 256 * j, o); }
}
__device__ __forceinline__ void row_update(const bf16* add, const float* gA, bf16* X, const float* gB, bf16* outB, int lane) {
    f32x4 a[4], x[4]; float ss = 0.f;
#pragma unroll
    for (int j = 0; j < 2; ++j) { ld_bf8(add + 8 * lane + 512 * j, a[2 * j], a[2 * j + 1]); ld_bf8(X + 8 * lane + 512 * j, x[2 * j], x[2 * j + 1]); ss += dot4(a[2 * j], a[2 * j]) + dot4(a[2 * j + 1], a[2 * j + 1]); }
    const float rs = rsqrtf(wave_sum(ss) * (1.f / DM) + 1e-6f); float s2 = 0.f;
#pragma unroll
    for (int j = 0; j < 2; ++j) { const float* gp = gA + 8 * lane + 512 * j; x[2 * j] = x[2 * j] + a[2 * j] * rs * *(const f32x4*)gp; x[2 * j + 1] = x[2 * j + 1] + a[2 * j + 1] * rs * *(const f32x4*)(gp + 4);
        st_bf8(X + 8 * lane + 512 * j, x[2 * j], x[2 * j + 1]); s2 += dot4(x[2 * j], x[2 * j]) + dot4(x[2 * j + 1], x[2 * j + 1]); }
    float r2 = 1.f;
    if (gB) r2 = rsqrtf(wave_sum(s2) * (1.f / DM) + 1e-6f);
#pragma unroll
    for (int j = 0; j < 2; ++j) { f32x4 o0 = x[2 * j], o1 = x[2 * j + 1]; if (gB) { const float* gp = gB + 8 * lane + 512 * j; o0 = o0 * r2 * *(const f32x4*)gp; o1 = o1 * r2 * *(const f32x4*)(gp + 4); } st_bf8(outB + 8 * lane + 512 * j, o0, o1); }
}

__device__ __forceinline__ void convert_layer(const Ctx& C, const Args& A, int l, int gw0, int ngw, int gt, int NT) {
    LAS float* scr = (LAS float*)(C.lds + C.wave * 16384);
    constexpr int J0 = 16 * 72, J1 = 16 * 32, J2 = 16 * 88, J4 = 44 * 32, J5 = 16 * 32, J6 = 4 * 32, JL = J0 + J1 + 2 * J2 + J4 + J5 + J6;
    unsigned char* wl = C.ws + WS_W + (size_t)(l & 1) * WL;
    for (int it = gw0; it < JL; it += ngw) {
        int r = it;
        const float* W; int ldw, ldt, kb, nb, drow; bf16* WT;
        if (r < J0) { W = INP(I_WIN) + (size_t)l * DM * INC; ldw = INC; WT = (bf16*)(wl + O_WIN); ldt = DM; kb = r / 72; nb = r % 72; drow = 32 * nb; }
        else if ((r -= J0) < J1) { W = INP(I_WOUT) + (size_t)l * DM * DM; ldw = DM; WT = (bf16*)(wl + O_WOUT); ldt = DM; kb = r / 32; nb = r % 32; drow = 32 * nb; }
        else if ((r -= J1) < J2) { W = INP(I_WG) + (size_t)l * DM * DFF; ldw = DFF; WT = (bf16*)(wl + O_WGU); ldt = DM; kb = r / 88; nb = r % 88; drow = (nb >> 2) * 256 + (nb & 3) * 32; }
        else if ((r -= J2) < J2) { W = INP(I_WU) + (size_t)l * DM * DFF; ldw = DFF; WT = (bf16*)(wl + O_WGU); ldt = DM; kb = r / 88; nb = r % 88; drow = (nb >> 2) * 256 + 128 + (nb & 3) * 32; }
        else if ((r -= J2) < J4) { W = INP(I_WDN) + (size_t)l * DFF * DM; ldw = DM; WT = (bf16*)(wl + O_WD); ldt = DFF; kb = r / 32; nb = r % 32; drow = 32 * nb; }
        else if ((r -= J4) < J5) { W = INP(I_PGW) + (size_t)l * DM * DM; ldw = DM; WT = (bf16*)(wl + O_WPG); ldt = DM; kb = r / 32; nb = r % 32; drow = 32 * nb; }
        else { r -= J5; W = INP(I_PW) + (size_t)l * PLE * DM; ldw = DM; WT = (bf16*)(wl + O_WP); ldt = PLE; kb = r / 32; nb = r % 32; drow = 32 * nb; }
        tr_item(W, ldw, WT, ldt, 64 * kb, 32 * nb, drow, 64 * kb, scr, C.lane);
    }
#pragma unroll 1
    for (int r = gt; r < N2 * K2; r = opq(r + NT)) {
        const int n = r / K2, k = r % K2; float v = 0.f;
        if (n < 256) { if (k < 64) v = INP(I_WUP)[((size_t)l * 64 + k) * 256 + n]; }
        else if (n < 512) { if (k >= 64 && k < 128) v = INP(I_AUP)[((size_t)l * 64 + (k - 64)) * 256 + (n - 256)]; }
        else if (n < 768) { if (k >= 128 && k < 256) v = INP(I_GUP)[((size_t)l * 128 + (k - 128)) * 256 + (n - 512)]; }
        else { const int tt = (n - 768) >> 8, rr = (n - 768) & 255, cc = 128 * tt + (rr & 127), h = cc >> 6, j = cc & 63;
            if (k >= 256 && ((k - 256) >> 6) == h) v = ((rr >> 7) ? INP(I_WI) : INP(I_WA))[(((size_t)l * 4 + h) * 64 + ((k - 256) & 63)) * 64 + j]; }
        ((bf16*)(wl + O_W2))[r] = (bf16)f2bf(v);
    }
#pragma unroll 1
    for (int r = gt; r < M * (PLE / 4); r = opq(r + NT)) {
        const int m = r >> 6, c4 = (r & 63) * 4;
        const float* src = m < MP ? INP(I_PP) + ((size_t)l * MP + m) * PLE + c4 : INP(I_PS) + ((size_t)l * MS + (m - MP)) * PLE + c4;
        st_bf4((bf16*)(C.ws + WS_PB + (size_t)(l & 1) * SZ_PBL) + (size_t)m * PLE + c4, *(const f32x4*)src);
    }
}
__device__ __forceinline__ void p0_prologue(const Ctx& C, const Args& A) {
    convert_layer(C, A, 0, C.gw, C.NGW, C.bid * 512 + C.tid, C.G * 512);
    for (int m = C.gw; m < M; m += C.NGW) {
        const float* src = m < MP ? INP(I_XP) + (size_t)m * DM : INP(I_XS) + (size_t)(m - MP) * DM;
        row_norm_in(src, INP(I_NMPRE), (bf16*)(C.ws + WS_HN) + (size_t)m * DM, (bf16*)(C.ws + WS_X16) + (size_t)m * DM, C.lane);
    }
}

__device__ __forceinline__ void e1_prep(const Ctx& C, const Args& A, int l) {
    const bf16* PROJ = (const bf16*)(C.ws + WS_R1);
    bf16* R = (bf16*)(C.ws + WS_R2); bf16* Ks = (bf16*)(C.ws + WS_R2 + SZ_F256); bf16* V = (bf16*)(C.ws + WS_R2 + 2 * SZ_F256); bf16* KK = (bf16*)(C.ws + WS_R2 + 3 * SZ_F256);
    bf16* A2 = (bf16*)(C.ws + WS_R3);
    const int lane = C.lane, c4 = 4 * lane;
    for (int m = C.gw; m < M; m += C.NGW) {
        const bool samp = m >= MP; int b, t;
        if (!samp) { b = m >> 12; t = m & 4095; } else { b = (m - MP) >> 2; t = (m - MP) & 3; }
        const bf16* pr = PROJ + (size_t)m * INC;
#pragma unroll
        for (int cg = 0; cg < 4; ++cg) {
            const int col = 256 * cg + c4;
            const f32x4 cur = ld_bf4(pr + C_RW + col); f32x4 prv = (f32x4){0.f, 0.f, 0.f, 0.f};
            if (t > 0) prv = ld_bf4(pr - INC + C_RW + col);
            else if (samp) prv = *(const f32x4*)(INP(I_SSH) + ((size_t)l * DB + b) * 1024 + col);
            const f32x4 mu = *(const f32x4*)(INP(I_MU) + l * 1024 + col);
            const f32x4 xs = cur + (prv - cur) * mu;
            if (cg == 0) st_bf4(R + (size_t)m * 256 + c4, xs);
            else if (cg == 1) { st_bf4(Ks + (size_t)m * 256 + c4, xs); f32x4 kk = xs * *(const f32x4*)(INP(I_KK) + l * 256 + c4);
                const float ss = red16(dot4(kk, kk)); kk = kk * rsqrtf(fmaxf(ss, 1e-24f)); st_bf4(KK + (size_t)m * 256 + c4, kk); }
            else if (cg == 2) st_bf4(V + (size_t)m * 256 + c4, xs);
            else { f32x4 o;
                if (lane < 16) o = (f32x4){tanh_(xs.x), tanh_(xs.y), tanh_(xs.z), tanh_(xs.w)};
                else if (lane < 32) o = xs;
                else o = (f32x4){sigm(xs.x), sigm(xs.y), sigm(xs.z), sigm(xs.w)};
                st_bf4(A2 + (size_t)m * K2 + c4, o); }
        }
        f32x4 xc = *(const f32x4*)(INP(I_CB) + l * 256 + c4);
#pragma unroll
        for (int j = 0; j < 4; ++j) { const int tt = t - 3 + j; f32x4 val = (f32x4){0.f, 0.f, 0.f, 0.f};
            if (tt >= 0) val = ld_bf4(pr + (ptrdiff_t)(j - 3) * INC + C_XB + c4);
            else if (samp) val = *(const f32x4*)(INP(I_SCV) + (((size_t)l * DB + b) * 3 + (tt + 3)) * 256 + c4);
            xc = xc + val * *(const f32x4*)(INP(I_CW) + ((size_t)l * 4 + j) * 256 + c4); }
        st_bf4(A2 + (size_t)m * K2 + 256 + c4, xc);
    }
    const int gt = C.bid * 512 + C.tid, NT = C.G * 512;
    float* out = C.out;
#pragma unroll 1
    for (int e = gt; e < 2 * NBP * 128 * 128; e = opq(e + NT)) {
        const int kv = e / (NBP * 16384), r = e % (NBP * 16384), b = r >> 14, rr = (r >> 7) & 127, c = r & 127;
        out[(kv ? OUT_VP : OUT_KP) + (size_t)l * NBP * 16384 + r] = bf1(PROJ[(size_t)(b * T + T - 128 + rr) * INC + (kv ? C_V : C_K) + c]);
    }
#pragma unroll 1
    for (int e = gt; e < NBP * 1024; e = opq(e + NT)) { const int b = e >> 10, c = e & 1023; out[OUT_SHP + (size_t)l * NBP * 1024 + e] = bf1(PROJ[(size_t)(b * T + T - 1) * INC + C_RW + c]); }
#pragma unroll 1
    for (int e = gt; e < DB * 1024; e = opq(e + NT)) { const int b = e >> 10, c = e & 1023; out[OUT_SHS + (size_t)l * DB * 1024 + e] = bf1(PROJ[(size_t)(MP + 4 * b + 3) * INC + C_RW + c]); }
#pragma unroll 1
    for (int e = gt; e < NBP * 768; e = opq(e + NT)) { const int b = e / 768, j = (e % 768) >> 8, c = e & 255; out[OUT_CVP + (size_t)l * NBP * 768 + e] = bf1(PROJ[(size_t)(b * T + T - 3 + j) * INC + C_XB + c]); }
#pragma unroll 1
    for (int e = gt; e < DB * 768; e = opq(e + NT)) { const int b = e / 768, j = (e % 768) >> 8, c = e & 255; out[OUT_CVS + (size_t)l * DB * 768 + e] = bf1(PROJ[(size_t)(MP + 4 * b + 1 + j) * INC + C_XB + c]); }
}

struct RwkvPtrs { const bf16 *R, *K, *V, *KK, *BV; const float* W; float* YR; };
__device__ __forceinline__ void rwkv_step(f32x4& s, const f32x4 w, const f32x4 kk, const f32x4 bv, const f32x4 k2, const f32x4 r, const float v, float& y) {
    const float sa = red16(dot4(s, kk));
    s = s * w + (k2 * v - bv * sa);
    y = red16(dot4(s, r));
}
__device__ __forceinline__ void rwkv_prompt(const Ctx& C, const RwkvPtrs& P, int wg, float* wkv_out  ) {
    constexpr int TC = 32, VEC = TC * 64 * 4, O_V = 5 * VEC, BUF = O_V + TC * 16 * 4, O_Q = 2 * BUF;
    static_assert(O_Q + TC * 1024 <= 131072, "LDS");
    const int chain = wg >> 2, b = chain >> 2, h = chain & 3, qr = wg & 3, tid = C.tid, lane = C.lane, wave = C.wave;
    const size_t m0 = (size_t)b * T;
    const int ltid = tid - 256, lstep = ltid >> 4, lq = tid & 15;
    const int vstep = ltid >> 2, vq = ltid & 3;
    f32x4 st[2][5], stv;
    f32x4 s = (f32x4){0.f, 0.f, 0.f, 0.f};
    const int row = 16 * qr + 4 * wave + (lane >> 4), cq = lane & 15;
#define RW_LOAD(c) do { if (wave >= 4) { _Pragma("unroll") for (int u = 0; u < 2; ++u) { const size_t o_ = (m0 + (size_t)(c) * TC + lstep + 16 * u) * 256 + h * 64 + 4 * lq; \
        st[u][0] = *(const f32x4*)(P.W + o_); st[u][1] = ld_bf4(P.KK + o_); st[u][2] = ld_bf4(P.BV + o_); st[u][3] = ld_bf4(P.K + o_); st[u][4] = ld_bf4(P.R + o_); } \
        if (ltid < 128) stv = ld_bf4(P.V + (m0 + (size_t)(c) * TC + vstep) * 256 + h * 64 + 16 * qr + 4 * vq); } } while (0)
#define RW_STORE(bufi) do { if (wave >= 4) { LAS unsigned char* bb = C.lds + (bufi) * BUF; _Pragma("unroll") for (int u = 0; u < 2; ++u) { const int ls = lstep + 16 * u; \
        _Pragma("unroll") for (int i = 0; i < 5; ++i) *(LAS f32x4*)(bb + i * VEC + (ls * 64 + 4 * lq) * 4) = st[u][i]; } \
        if (ltid < 128) *(LAS f32x4*)(bb + O_V + (vstep * 16 + 4 * vq) * 4) = stv; } } while (0)
#define RW_FLUSH(cc, half) do { if (wave >= 4) { const int stp = lstep + 16 * (half); const LAS f32x4* qp = (const LAS f32x4*)(C.lds + O_Q + stp * 1024 + (lq >> 2) * 256 + (lq & 3) * 64); \
        const f32x4 a0 = qp[0], a1_ = qp[1], a2_ = qp[2], a3 = qp[3]; const f32x4 t_ = (a0 + a1_) + (a2_ + a3); \
        P.YR[(m0 + (size_t)(cc) * TC + stp) * 256 + h * 64 + 16 * qr + lq] = (t_.x + t_.y) + (t_.z + t_.w); } } while (0)
    RW_LOAD(0); RW_STORE(0); __syncthreads();
    for (int c = 0; c < T / TC; ++c) {
        if (c > 0) RW_FLUSH(c - 1, 1);
        if (c + 1 < T / TC) RW_LOAD(c + 1);
        if (wave < 4) {
            const LAS unsigned char* bb = C.lds + (c & 1) * BUF;
            const int vo = O_V + (4 * wave + (lane >> 4)) * 4, lo = 16 * cq;
            LAS float* ring = (LAS float*)(C.lds + O_Q) + wave * 64 + lane;
            f32x4 w = *(const LAS f32x4*)(bb + 0 * VEC + lo), kk = *(const LAS f32x4*)(bb + 1 * VEC + lo), bv = *(const LAS f32x4*)(bb + 2 * VEC + lo),
                  k2 = *(const LAS f32x4*)(bb + 3 * VEC + lo), r = *(const LAS f32x4*)(bb + 4 * VEC + lo), rp = r;
            float v = *(const LAS float*)(bb + vo), qpend = 0.f;
            const unsigned b1 = (unsigned)(unsigned long long)(bb + lo), b2 = (unsigned)(unsigned long long)(bb + vo), qa = (unsigned)(unsigned long long)ring;
            f32x4 nw, nkk, nbv, nk2, nr; float nv;
#define RW_A_DOT "v_mul_f32 %6, %10, %14\n\tv_fma_f32 %6, %11, %15, %6\n\tv_fma_f32 %6, %12, %16, %6\n\tv_fma_f32 %6, %13, %17, %6"
#define RW_A_RD "ds_read_b128 %0, %7 offset:%c19\n\tds_read_b128 %1, %7 offset:%c20\n\tds_read_b128 %2, %7 offset:%c21\n\tds_read_b128 %3, %7 offset:%c22\n\tds_read_b128 %4, %7 offset:%c23\n\tds_read_b32 %5, %8 offset:%c24\n\t"
#define RW_A_OPS(IN, WO) : "=&v"(nw), "=&v"(nkk), "=&v"(nbv), "=&v"(nk2), "=&v"(nr), "=&v"(nv), "=&v"(sa) \
                 : "v"(b1), "v"(b2), "v"(qa), "v"(s.x), "v"(s.y), "v"(s.z), "v"(s.w), "v"(kk.x), "v"(kk.y), "v"(kk.z), "v"(kk.w), "v"(qpend), \
                   "n"(0 * VEC + (IN) * 256), "n"(1 * VEC + (IN) * 256), "n"(2 * VEC + (IN) * 256), "n"(3 * VEC + (IN) * 256), "n"(4 * VEC + (IN) * 256), "n"((IN) * 64), "n"(WO) : "memory"
#define RW_STEP(I, IN) { float sa, q, t0, t1, t2, t3; \
                if ((I) < 2 || (I) == 16 || (I) == 17) asm volatile(RW_A_RD "s_waitcnt lgkmcnt(6)\n\t" RW_A_DOT RW_A_OPS(IN, 0)); \
                else asm volatile("ds_write_b32 %9, %18 offset:%c25\n\t" RW_A_RD "s_waitcnt lgkmcnt(7)\n\t" RW_A_DOT RW_A_OPS(IN, ((I) >= 2 ? (I) - 2 : 0) * 1024)); \
                asm volatile("v_mul_f32 %2, %6, %10\n\tv_mul_f32 %3, %7, %10\n\t" \
                             "v_add_f32_dpp %0, %0, %0 quad_perm:[1,0,3,2] row_mask:0xf bank_mask:0xf bound_ctrl:1\n\t" \
                             "v_mul_f32 %1, %11, %15\n\tv_fma_f32 %1, %12, %16, %1\n\t" \
                             "v_add_f32_dpp %0, %0, %0 quad_perm:[2,3,0,1] row_mask:0xf bank_mask:0xf bound_ctrl:1\n\t" \
                             "v_fma_f32 %1, %13, %17, %1\n\tv_fma_f32 %1, %14, %18, %1\n\t" \
                             "v_add_f32_dpp %0, %0, %0 row_half_mirror row_mask:0xf bank_mask:0xf bound_ctrl:1\n\t" \
                             "v_mul_f32 %4, %8, %10\n\tv_mul_f32 %5, %9, %10\n\t" \
                             "v_add_f32_dpp %0, %0, %0 row_ror:8 row_mask:0xf bank_mask:0xf bound_ctrl:1" \
                             : "+v"(sa), "=&v"(q), "=&v"(t0), "=&v"(t1), "=&v"(t2), "=&v"(t3) \
                             : "v"(k2.x), "v"(k2.y), "v"(k2.z), "v"(k2.w), "v"(v), "v"(s.x), "v"(s.y), "v"(s.z), "v"(s.w), "v"(rp.x), "v"(rp.y), "v"(rp.z), "v"(rp.w)); \
                asm volatile("v_fma_f32 %4, -%8, %9, %4\n\tv_fma_f32 %5, -%8, %10, %5\n\tv_fma_f32 %6, -%8, %11, %6\n\tv_fma_f32 %7, -%8, %12, %7\n\t" \
                             "v_fma_f32 %0, %0, %13, %4\n\tv_fma_f32 %1, %1, %14, %5\n\tv_fma_f32 %2, %2, %15, %6\n\tv_fma_f32 %3, %3, %16, %7" \
                             : "+v"(s.x), "+v"(s.y), "+v"(s.z), "+v"(s.w), "+v"(t0), "+v"(t1), "+v"(t2), "+v"(t3) \
                             : "v"(sa), "v"(bv.x), "v"(bv.y), "v"(bv.z), "v"(bv.w), "v"(w.x), "v"(w.y), "v"(w.z), "v"(w.w)); \
                qpend = q; rp = r; w = nw; kk = nkk; bv = nbv; k2 = nk2; r = nr; v = nv; }
#define RW_STEP4(I) RW_STEP(I, (I) + 1) RW_STEP((I) + 1, (I) + 2) RW_STEP((I) + 2, (I) + 3) RW_STEP((I) + 3, ((I) + 4 < TC ? (I) + 4 : TC - 1))
#define RW_HALF_END(h0) do { asm volatile("s_waitcnt lgkmcnt(0)" :: "v"(w), "v"(kk), "v"(bv), "v"(k2), "v"(r), "v"(v) : "memory"); \
                ring[((h0) + 14) * 256] = qpend; ring[((h0) + 15) * 256] = dot4(s, rp); } while (0)
            RW_STEP4(0) RW_STEP4(4) RW_STEP4(8) RW_STEP4(12)
            RW_HALF_END(0);
            __syncthreads();
            RW_STEP4(16) RW_STEP4(20) RW_STEP4(24) RW_STEP4(28)
            RW_HALF_END(16);
#undef RW_HALF_END
#undef RW_STEP4
#undef RW_STEP
#undef RW_A_OPS
#undef RW_A_RD
#undef RW_A_DOT
        } else {
            __syncthreads();
            RW_FLUSH(c, 0);
        }
        if (c + 1 < T / TC) RW_STORE((c + 1) & 1);
        __syncthreads();
    }
    RW_FLUSH(T / TC - 1, 1);
#undef RW_LOAD
#undef RW_STORE
#undef RW_FLUSH
    if (wave < 4) *(f32x4*)(wkv_out + (((size_t)b * 4 + h) * 64 + row) * 64 + 4 * cq) = s;
    __syncthreads();
}
__device__ __forceinline__ void rwkv_sample_item(const RwkvPtrs& P, int item, const float* wkv_in, float* wkv_out, int lane) {
    const int rg = item & 15, h = (item >> 4) & 3, b = item >> 6, row = 4 * rg + (lane >> 4), cq = lane & 15;
    const size_t so = (((size_t)b * 4 + h) * 64 + row) * 64 + 4 * cq;
    f32x4 s = *(const f32x4*)(wkv_in + so);
#pragma unroll
    for (int i = 0; i < DS; ++i) { const size_t m = (size_t)MP + 4 * b + i, o = m * 256 + h * 64 + 4 * cq;
        float y; rwkv_step(s, *(const f32x4*)(P.W + o), ld_bf4(P.KK + o), ld_bf4(P.BV + o), ld_bf4(P.K + o), ld_bf4(P.R + o), bf1(P.V[m * 256 + h * 64 + row]), y);
        if (cq == 0) P.YR[m * 256 + h * 64 + row] = y; }
    *(f32x4*)(wkv_out + so) = s;
}
__device__ __forceinline__ void lru_prompt_item(const Ctx& C, int item, const float* AL, const float* U, const bf16* PROJ, bf16* MIXCAT, float* lru_out  ) {
    const int b = item >> 4, c = (item & 15) * 16 + (C.tid & 15), seg = C.tid >> 4; constexpr int SL = T / 32;
    const size_t m0 = (size_t)b * T + (size_t)seg * SL;
    LAS float* sA = (LAS float*)C.lds; LAS float* sH = sA + 512;
    float Ap = 1.f, H = 0.f;
#pragma unroll 8
    for (int i = 0; i < SL; ++i) { const float a = AL[(m0 + i) * 256 + c], u = U[(m0 + i) * 256 + c]; H = a * H + u; Ap *= a; }
    sA[C.tid] = Ap; sH[C.tid] = H;
    __syncthreads();
    float h = 0.f;
    for (int sp = 0; sp < seg; ++sp) h = sA[sp * 16 + (C.tid & 15)] * h + sH[sp * 16 + (C.tid & 15)];
#pragma unroll 8
    for (int i = 0; i < SL; ++i) { const float a = AL[(m0 + i) * 256 + c], u = U[(m0 + i) * 256 + c]; h = a * h + u;
        const float gb = bf1(PROJ[(m0 + i) * INC + C_GB + c]); MIXCAT[(m0 + i) * DM + 768 + c] = (bf16)f2bf(h * gelu_t(gb)); }
    if (seg == 31) lru_out[b * 256 + c] = h;
    __syncthreads();
}
__device__ __forceinline__ void swa_prompt_item(const Ctx& C, int item, const bf16* PROJ, bf16* MIXCAT, const float* sinks  ) {
    constexpr int KP = 72, VP = 264;
    const int kvh = item & 1, n = (item >> 1) & 31, b = item >> 6, tid = C.tid, lane = C.lane, wave = C.wave;
    LAS bf16* Ks = (LAS bf16*)C.lds; LAS bf16* Vt = Ks + 256 * KP;
    const size_t rowq0 = (size_t)b * T + (size_t)n * 128;
    { const int key = tid >> 1, hf = tid & 1; size_t kr = rowq0 + key; kr = (kr >= 128 + (size_t)b * T) ? kr - 128 : kr;
        const bf16* kp = PROJ + kr * INC + C_K + kvh * 64 + hf * 32;
#pragma unroll
        for (int i = 0; i < 4; ++i) *(LAS u32x4*)(Ks + key * KP + hf * 32 + 8 * i) = *(const u32x4*)(kp + 8 * i);
#pragma unroll
        for (int i = 0; i < 4; ++i) { const int ch = tid + 512 * i, vk = ch >> 3, d0 = (ch & 7) * 8; size_t vr = rowq0 + vk; vr = (vr >= 128 + (size_t)b * T) ? vr - 128 : vr;
            const u32x4 w = *(const u32x4*)(PROJ + vr * INC + C_V + kvh * 64 + d0);
            Vt[(d0 + 0) * VP + vk] = (bf16)(w.x & 0xffff); Vt[(d0 + 1) * VP + vk] = (bf16)(w.x >> 16); Vt[(d0 + 2) * VP + vk] = (bf16)(w.y & 0xffff); Vt[(d0 + 3) * VP + vk] = (bf16)(w.y >> 16);
            Vt[(d0 + 4) * VP + vk] = (bf16)(w.z & 0xffff); Vt[(d0 + 5) * VP + vk] = (bf16)(w.z >> 16); Vt[(d0 + 6) * VP + vk] = (bf16)(w.w & 0xffff); Vt[(d0 + 7) * VP + vk] = (bf16)(w.w >> 16); } }
    __syncthreads();
    const int q = lane & 31, hi = lane >> 5;
#pragma unroll 1
    for (int qi = 0; qi < 2; ++qi) {
        const int qt = wave * 2 + qi, g = qt >> 2, j = qt & 3, hh = kvh * 4 + g;
        const size_t qrow = rowq0 + 32 * j + q;
        bf16x8 qf[4];
#pragma unroll
        for (int dk = 0; dk < 4; ++dk) qf[dk] = *(const bf16x8*)(PROJ + qrow * INC + hh * 64 + 16 * dk + 8 * hi);
        f32x16 sc[5];
#pragma unroll
        for (int kt = 0; kt < 5; ++kt) {
            f32x16 acc;
#pragma unroll
            for (int i = 0; i < 16; ++i) acc[i] = 0.f;
#pragma unroll
            for (int dk = 0; dk < 4; ++dk) { const bf16x8 kf = *(const LAS bf16x8*)(Ks + (32 * (j + kt) + q) * KP + 16 * dk + 8 * hi); acc = __builtin_amdgcn_mfma_f32_32x32x16_bf16(kf, qf[dk], acc, 0, 0, 0); }
            sc[kt] = acc;
        }
        const int qpos = 128 + 32 * j + q; float mx = -INFINITY;
#pragma unroll
        for (int kt = 0; kt < 5; ++kt)
#pragma unroll
            for (int i = 0; i < 16; ++i) { const int kj = 32 * (j + kt) + (i & 3) + 8 * (i >> 2) + 4 * hi, d = qpos - kj; const bool ok = d >= 0 && d <= 128 && (n > 0 || kj >= 128);
                const float sv = ok ? sc[kt][i] * 0.125f : -INFINITY; sc[kt][i] = sv; mx = fmaxf(mx, sv); }
        mx = fmaxf(mx, shx(mx, 32, lane)); const float sink = sinks[hh]; mx = fmaxf(mx, sink);
        float sum = 0.f;
#pragma unroll
        for (int kt = 0; kt < 5; ++kt)
#pragma unroll
            for (int i = 0; i < 16; ++i) { const float e = __expf(sc[kt][i] - mx); sc[kt][i] = e; sum += e; }
        sum += shx(sum, 32, lane);
        const float inv = 1.f / (sum + __expf(sink - mx));
#pragma unroll
        for (int dt = 0; dt < 2; ++dt) {
            f32x16 o;
#pragma unroll
            for (int i = 0; i < 16; ++i) o[i] = 0.f;
#pragma unroll
            for (int kt = 0; kt < 5; ++kt)
#pragma unroll
                for (int s2 = 0; s2 < 2; ++s2) {
                    u32x4 pw; pw.x = pk2(sc[kt][8 * s2 + 0], sc[kt][8 * s2 + 1]); pw.y = pk2(sc[kt][8 * s2 + 2], sc[kt][8 * s2 + 3]); pw.z = pk2(sc[kt][8 * s2 + 4], sc[kt][8 * s2 + 5]); pw.w = pk2(sc[kt][8 * s2 + 6], sc[kt][8 * s2 + 7]);
                    const LAS bf16* vp = Vt + (32 * dt + q) * VP + 32 * (j + kt) + 16 * s2 + 4 * hi;
                    const u32x2 v0 = *(const LAS u32x2*)vp, v1 = *(const LAS u32x2*)(vp + 8);
                    u32x4 vw; vw.x = v0.x; vw.y = v0.y; vw.z = v1.x; vw.w = v1.y;
                    o = __builtin_amdgcn_mfma_f32_32x32x16_bf16(__builtin_bit_cast(bf16x8, vw), __builtin_bit_cast(bf16x8, pw), o, 0, 0, 0);
                }
#pragma unroll
            for (int g4 = 0; g4 < 4; ++g4) st_bf4(MIXCAT + qrow * DM + hh * 64 + 32 * dt + 8 * g4 + 4 * hi, (f32x4){o[4 * g4] * inv, o[4 * g4 + 1] * inv, o[4 * g4 + 2] * inv, o[4 * g4 + 3] * inv});
        }
    }
    __syncthreads();
}
__device__ __forceinline__ void swa_sample_item(const Ctx& C, int item, const bf16* PROJ, bf16* MIXCAT, const float* sinks, const float* ck, const float* cv, float* ko, float* vo) {
    const int kvh = item & 1, b = item >> 1, tid = C.tid;
    LAS float* Kf = (LAS float*)C.lds; LAS float* Vf = Kf + 132 * 65; LAS float* Qf = Vf + 132 * 64; LAS float* Pf = Qf + 16 * 64;
    for (int e = tid; e < 132 * 64; e += 512) { const int key = e >> 6, d = e & 63; float kx, vx;
        if (key < 128) { const size_t o = (((size_t)b * 128 + key) * 2 + kvh) * 64 + d; kx = ck[o]; vx = cv[o]; }
        else { const size_t r = (size_t)MP + 4 * b + (key - 128); kx = bf1(PROJ[r * INC + C_K + kvh * 64 + d]); vx = bf1(PROJ[r * INC + C_V + kvh * 64 + d]); }
        Kf[key * 65 + d] = kx; Vf[key * 64 + d] = vx;
        if (key >= 4) { const size_t o = (((size_t)b * 128 + (key - 4)) * 2 + kvh) * 64 + d; ko[o] = kx; vo[o] = vx; } }
    for (int e = tid; e < 16 * 64; e += 512) { const int qr = e >> 6, d = e & 63, i = qr >> 2, g = qr & 3; Qf[e] = bf1(PROJ[((size_t)MP + 4 * b + i) * INC + (kvh * 4 + g) * 64 + d]); }
    __syncthreads();
    { const int qr = tid >> 5, kl = tid & 31, i = qr >> 2, g = qr & 3; float sc[5]; float mx = -INFINITY;
#pragma unroll
        for (int k5 = 0; k5 < 5; ++k5) { const int key = kl + 32 * k5; float sv = -INFINITY;
            if (key < 132 && key >= i && key <= i + 128) { float a = 0.f;
#pragma unroll 16
                for (int d = 0; d < 64; ++d) a += Qf[qr * 64 + d] * Kf[key * 65 + d];
                sv = a * 0.125f; }
            sc[k5] = sv; mx = fmaxf(mx, sv); }
#pragma unroll
        for (int o = 1; o < 32; o <<= 1) mx = fmaxf(mx, shx(mx, o, C.lane));
        const float sink = sinks[kvh * 4 + g]; mx = fmaxf(mx, sink); float sum = 0.f;
#pragma unroll
        for (int k5 = 0; k5 < 5; ++k5) { sc[k5] = __expf(sc[k5] - mx); sum += sc[k5]; }
#pragma unroll
        for (int o = 1; o < 32; o <<= 1) sum += shx(sum, o, C.lane);
        const float inv = 1.f / (sum + __expf(sink - mx));
#pragma unroll
        for (int k5 = 0; k5 < 5; ++k5) { const int key = kl + 32 * k5; if (key < 136) Pf[qr * 136 + key] = sc[k5] * inv; } }
    __syncthreads();
    { const int qr = tid >> 5, d = (tid & 31) * 2, i = qr >> 2, g = qr & 3; float o0 = 0.f, o1 = 0.f;
#pragma unroll 4
        for (int key = 0; key < 132; ++key) { const float p = Pf[qr * 136 + key]; o0 += p * Vf[key * 64 + d]; o1 += p * Vf[key * 64 + d + 1]; }
        *(unsigned*)(MIXCAT + ((size_t)MP + 4 * b + i) * DM + (kvh * 4 + g) * 64 + d) = pk2(o0, o1); }
    __syncthreads();
}

__device__ __forceinline__ void s_phase(const Ctx& C, const Args& A, int l) {
    const bf16* PROJ = (const bf16*)(C.ws + WS_R1); bf16* MIXCAT = (bf16*)(C.ws + WS_HN);
    float* R = (float*)(C.ws + WS_R2); const size_t S = (size_t)M * 256;
    RwkvPtrs P{(const bf16*)R, (const bf16*)(R + S), (const bf16*)(R + 2 * S), (const bf16*)(R + 3 * S), (const bf16*)(R + 4 * S), R + 5 * S, (float*)(C.ws + WS_R3)};
    const float* AL = (const float*)(C.ws + WS_R3) + S; const float* U = AL + S;
    float* out = C.out;
    constexpr int NSCAN = 64;
    if (C.bid < NSCAN) { rwkv_prompt(C, P, C.bid, out + OUT_WKVP + (size_t)l * NBP * 4 * 4096); return; }
    constexpr int N0 = 256, N1 = N0 + 64, N2_ = N1 + 256, N3 = N2_ + 1024, N4 = N3 + 64;
    for (int it = C.bid - NSCAN; it < N4; it += C.G - NSCAN) {
        if (it < N0) swa_prompt_item(C, it, PROJ, MIXCAT, INP(I_SINK) + l * 8);
        else if (it < N1) lru_prompt_item(C, it - N0, AL, U, PROJ, MIXCAT, out + OUT_LRP + (size_t)l * NBP * 256);
        else if (it < N2_) swa_sample_item(C, it - N1, PROJ, MIXCAT, INP(I_SINK) + l * 8, INP(I_CK) + (size_t)l * DB * 16384, INP(I_CV) + (size_t)l * DB * 16384,
                                          out + OUT_KS + (size_t)l * DB * 16384, out + OUT_VS + (size_t)l * DB * 16384);
        else if (it < N3) rwkv_sample_item(P, (it - N2_) * 8 + C.wave, INP(I_SWKV) + (size_t)l * DB * 4 * 4096, out + OUT_WKVS + (size_t)l * DB * 4 * 4096, C.lane);
        else { const int e = (it - N3) * 512 + C.tid, b = e >> 8, c = e & 255; float h = INP(I_SLRU)[((size_t)l * DB + b) * 256 + c];
#pragma unroll
            for (int i = 0; i < DS; ++i) { const size_t m = (size_t)MP + 4 * b + i; h = AL[m * 256 + c] * h + U[m * 256 + c];
                MIXCAT[m * DM + 768 + c] = (bf16)f2bf(h * gelu_t(bf1(PROJ[m * INC + C_GB + c]))); }
            out[OUT_LRS + ((size_t)l * DB + b) * 256 + c] = h; }
    }
    if (l + 1 < NL) convert_layer(C, A, l + 1, (C.bid - NSCAN) * 8 + C.wave, (C.G - NSCAN) * 8, (C.bid - NSCAN) * 512 + C.tid, (C.G - NSCAN) * 512);
    __syncthreads();
    { pg8::Gemm g{(const bf16*)(C.ws + WS_PB + (size_t)(l & 1) * SZ_PBL), (const bf16*)(C.ws + WS_W + (size_t)(l & 1) * WL + O_WP), M, DM, PLE}; pg8::StaticOrder So; So.init(M, DM, C.G - NSCAN, C.bid - NSCAN);
      pg8::EpiBf16<0> E{(bf16*)(C.ws + WS_PP), DM, nullptr, 0, 0, 1.f};
      pg8::gemm_phase<pg8::EpiBf16<0>, pg8::StaticOrder, true, true>(C.lds, g, So, E, C.tid); }
}

__device__ __forceinline__ void e3_post(const Ctx& C, const Args& A, int l) {
    const float* R = (const float*)(C.ws + WS_R2); const size_t S = (size_t)M * 256;
    const bf16 *Rb = (const bf16*)R, *K = (const bf16*)(R + S), *V = (const bf16*)(R + 2 * S), *G = (const bf16*)(R + 6 * S); const float* YR = (const float*)(C.ws + WS_R3);
    bf16* MIXCAT = (bf16*)(C.ws + WS_HN); const int c4 = 4 * C.lane;
    const f32x4 lw = *(const f32x4*)(INP(I_LNW) + l * 256 + c4), lb = *(const f32x4*)(INP(I_LNB) + l * 256 + c4), rk = *(const f32x4*)(INP(I_RK) + l * 256 + c4);
    for (int m = C.gw; m < M; m += C.NGW) {
        const size_t o = (size_t)m * 256 + c4;
        const f32x4 y = *(const f32x4*)(YR + o), r = ld_bf4(Rb + o), k = ld_bf4(K + o), v = ld_bf4(V + o), g = ld_bf4(G + o);
        const float mean = red16((y.x + y.y) + (y.z + y.w)) * (1.f / 64.f); const f32x4 d = y - mean;
        const float var = red16(dot4(d, d)) * (1.f / 64.f); const float rs = rsqrtf(var + 64e-5f);
        const float bonus = red16(dot4(r * k, rk));
        st_bf4(MIXCAT + (size_t)m * DM + 512 + c4, (d * rs * lw + lb + v * bonus) * g);
    }
}
constexpr int LDS_BYTES = 131072 + 64;
#ifndef MK_MULTI
#define MK_MULTI 0
#endif
#ifndef MK_DUP
#define MK_DUP 0
#endif
enum { PH_P0 = 0, PH_G1, PH_E1, PH_G2, PH_S, PH_E3, PH_G3, PH_E4, PH_G4, PH_G5, PH_E5, PH_G6, PH_E0, PH_G3B, PH_E4S, PH_G5B, PH_E5S, PH_N };
constexpr int NSPLIT = 16;

__device__ __forceinline__ Ctx make_ctx(int wave0, LAS unsigned char* lds) {
    Ctx D; int z_ = 0; asm volatile("" : "+v"(z_)); int ln_ = __builtin_amdgcn_mbcnt_hi(-1, __builtin_amdgcn_mbcnt_lo(-1, z_));
    D.lane = ln_; D.wave = wave0; D.tid = wave0 * 64 + ln_;
    int b_ = blockIdx.x; asm volatile("" : "+s"(b_)); D.bid = b_; D.gw = b_ * 8 + wave0; D.G = gridDim.x; D.NGW = D.G * 8;
    D.lds = lds; D.out = (float*)inp_ld(N_IN); D.ws = (unsigned char*)inp_ld(N_IN + 1);
    return D;
}
template <int PH> __device__ __forceinline__ void run_phase(const Args& A, int wave0, LAS unsigned char* lds, int l_in) {
    const Ctx C = make_ctx(wave0, lds);
    int l = l_in; asm volatile("" : "+s"(l));
    unsigned char* ws = C.ws; unsigned char* wl = ws + WS_W + (size_t)(l & 1) * WL; (void)wl;
    bf16* HN = (bf16*)(ws + WS_HN); float* MIX = (float*)(ws + WS_R1); float* R2 = (float*)(ws + WS_R2); float* R3 = (float*)(ws + WS_R3); bf16* X = (bf16*)(ws + WS_X16);
    const size_t S = (size_t)M * 256; (void)HN; (void)MIX; (void)R2; (void)R3; (void)X; (void)S;
    if constexpr (PH == PH_P0) p0_prologue(C, A);
    if constexpr (PH == PH_G1) {
        pg8::Gemm g{HN, (const bf16*)(wl + O_WIN), M, INC, DM}; pg8::StaticOrder So; So.init(M, INC, C.G, C.bid);
        pg8::EpiBf16<0> E{(bf16*)(ws + WS_R1), INC, INP(I_BIN) + (size_t)l * INC, 0, 0, 1.f};
        pg8::gemm_phase<pg8::EpiBf16<0>, pg8::StaticOrder, true, true>(C.lds, g, So, E, C.tid); }
    if constexpr (PH == PH_E1) e1_prep(C, A, l);
    if constexpr (PH == PH_G2) {
        pg8::Gemm g{(const bf16*)(ws + WS_R3), (const bf16*)(wl + O_W2), M, N2, K2 / 2, K2}; G2Order So; So.b.init(M, N2, C.G, C.bid);
        EpiMix E{INP(I_W0) + l * 256, INP(I_A0) + l * 256, INP(I_KA) + l * 256, INP(I_BA) + l * 256, INP(I_BI) + l * 256, INP(I_L) + l * 256,
                 R2 + 5 * S, (bf16*)(R2 + 1 * S), (bf16*)(R2 + 3 * S), (bf16*)(R2 + 4 * S), (bf16*)(R2 + 6 * S), R3 + S, R3 + 2 * S, (const bf16*)(ws + WS_R3)};
        pg8::gemm_phase<EpiMix, G2Order, true, true>(C.lds, g, So, E, C.tid); }
    if constexpr (PH == PH_S) s_phase(C, A, l);
    if constexpr (PH == PH_E3) e3_post(C, A, l);
    if constexpr (PH == PH_G3) {
        pg8::Gemm g{HN, (const bf16*)(wl + O_WOUT), MP, DM, DM}; pg8::StaticOrder So; So.init(MP, DM, C.G, C.bid);
        pg8::EpiBf16<0> E{(bf16*)MIX, DM, INP(I_BOUT) + (size_t)l * DM, 0, 0, 1.f};
        pg8::gemm_phase<pg8::EpiBf16<0>, pg8::StaticOrder, true, true>(C.lds, g, So, E, C.tid); }
    if constexpr (PH == PH_G3B) {
        if (C.bid < NSPLIT) { pg8::Gemm g{HN + (size_t)MP * DM, (const bf16*)(wl + O_WOUT), MS, DM, DM / 2, DM}; SplitOrder So{C.bid, NSPLIT, DM / 2}; EpiPart E{R3};
            pg8::gemm_phase<EpiPart, SplitOrder, true, true>(C.lds, g, So, E, C.tid); }
        else for (int m = (C.bid - NSPLIT) * 8 + C.wave; m < MP; m += (C.G - NSPLIT) * 8)
            row_update((const bf16*)MIX + (size_t)m * DM, INP(I_NMPOST) + l * DM, X + (size_t)m * DM, INP(I_NFPRE) + l * DM, HN + (size_t)m * DM, C.lane); }
    if constexpr (PH == PH_E4S)
        for (int m = MP + C.gw; m < M; m += C.NGW)
            row_update_parts(R3 + (size_t)(m - MP) * DM, R3 + (size_t)(MS + m - MP) * DM, INP(I_BOUT) + (size_t)l * DM, INP(I_NMPOST) + l * DM, X + (size_t)m * DM, INP(I_NFPRE) + l * DM, HN + (size_t)m * DM, C.lane);
    if constexpr (PH == PH_G4) {
        pg8::Gemm g{HN, (const bf16*)(wl + O_WGU), M, 2 * DFF, DM}; pg8::StaticOrder So; So.init(M, 2 * DFF, C.G, C.bid);
        EpiSwiglu E{(bf16*)(ws + WS_R2)};
        pg8::gemm_phase<EpiSwiglu, pg8::StaticOrder, true, true>(C.lds, g, So, E, C.tid); }
    if constexpr (PH == PH_G5) {
        pg8::Gemm g{(const bf16*)(ws + WS_R2), (const bf16*)(wl + O_WD), MP, DM, DFF}; pg8::StaticOrder So; So.init(MP, DM, C.G, C.bid);
        pg8::EpiBf16<0> E{(bf16*)MIX, DM, nullptr, 0, 0, 1.f};
        pg8::gemm_phase<pg8::EpiBf16<0>, pg8::StaticOrder, true, true>(C.lds, g, So, E, C.tid); }
    if constexpr (PH == PH_G5B) {
        if (C.bid < NSPLIT) { pg8::Gemm g{(const bf16*)(ws + WS_R2) + (size_t)MP * DFF, (const bf16*)(wl + O_WD), MS, DM, DFF / 2, DFF}; SplitOrder So{C.bid, NSPLIT, DFF / 2}; EpiPart E{R3};
            pg8::gemm_phase<EpiPart, SplitOrder, true, true>(C.lds, g, So, E, C.tid); }
        else for (int m = (C.bid - NSPLIT) * 8 + C.wave; m < MP; m += (C.G - NSPLIT) * 8)
            row_update((const bf16*)MIX + (size_t)m * DM, INP(I_NFPOST) + l * DM, X + (size_t)m * DM, nullptr, HN + (size_t)m * DM, C.lane); }
    if constexpr (PH == PH_E5S)
        for (int m = MP + C.gw; m < M; m += C.NGW)
            row_update_parts(R3 + (size_t)(m - MP) * DM, R3 + (size_t)(MS + m - MP) * DM, nullptr, INP(I_NFPOST) + l * DM, X + (size_t)m * DM, nullptr, HN + (size_t)m * DM, C.lane);
    if constexpr (PH == PH_G6) {
        pg8::StaticOrder So; So.init(M, DM, C.G, C.bid);
        pg8::Gemm g{HN, (const bf16*)(wl + O_WPG), M, DM, DM}; EpiPle E{X, (const bf16*)(ws + WS_PP), l == NL - 1 ? C.out : nullptr};
        pg8::gemm_phase<EpiPle, pg8::StaticOrder, true, true>(C.lds, g, So, E, C.tid); }
    if constexpr (PH == PH_E0)
        for (int m = C.gw; m < M; m += C.NGW) row_norm(X + (size_t)m * DM, INP(I_NMPRE) + (l + 1) * DM, HN + (size_t)m * DM, C.lane);
}

#if MK_MULTI
template <int PH> __global__ void __launch_bounds__(512, 2) mk_one(Args A, int l) {
    extern __shared__ __attribute__((aligned(16))) unsigned char lds_raw[];
    const int wave0 = __builtin_amdgcn_readfirstlane((int)threadIdx.x >> 6);
    run_phase<PH>(A, wave0, (LAS unsigned char*)lds_raw, l);
}
#else
__global__ void __launch_bounds__(512, 2) mk_fwd(Args A) {
    extern __shared__ __attribute__((aligned(16))) unsigned char lds_raw[];
    cg::grid_group grid = cg::this_grid();
    const int wave0 = __builtin_amdgcn_readfirstlane((int)threadIdx.x >> 6);
    LAS unsigned char* lds = (LAS unsigned char*)lds_raw;
    if (threadIdx.x < 16) ((LAS unsigned*)lds)[131072 / 4 + threadIdx.x] = 0u;
    __syncthreads();
    const unsigned xbar_x = __builtin_amdgcn_readfirstlane(xcd_barrier_post((unsigned*)inp_ld(N_IN + 1), (volatile LAS unsigned*)(lds + 131072), (int)threadIdx.x).x);
#define GRID_BAR() do { int z_ = 0; asm volatile("" : "+v"(z_)); int ln_ = __builtin_amdgcn_mbcnt_hi(-1, __builtin_amdgcn_mbcnt_lo(-1, z_)); XcdBarrier xb_; xb_.bar = (unsigned*)inp_ld(N_IN + 1); xb_.x = xbar_x; \
        xb_.st = (volatile LAS unsigned*)(lds + 131072); xcd_barrier(xb_, wave0 * 64 + ln_); } while (0)
    run_phase<PH_P0>(A, wave0, lds, 0);
    if (MK_DUP & 1) { GRID_BAR(); run_phase<PH_P0>(A, wave0, lds, 0); }
    grid.sync();
#pragma unroll 1
    for (int l = 0; l < NL; ++l) {
#define RP(PH) do { run_phase<PH>(A, wave0, lds, l); GRID_BAR(); if (MK_DUP & (1 << 20)) GRID_BAR(); if (MK_DUP & (1 << PH)) { run_phase<PH>(A, wave0, lds, l); GRID_BAR(); } } while (0)
        RP(PH_G1); RP(PH_E1); RP(PH_G2); RP(PH_S); RP(PH_E3); RP(PH_G3); RP(PH_G3B); RP(PH_E4S); RP(PH_G4); RP(PH_G5); RP(PH_G5B); RP(PH_E5S);
        run_phase<PH_G6>(A, wave0, lds, l);
        if (l + 1 < NL) { GRID_BAR(); RP(PH_E0); }
    }
}
#endif
}

#if MK_MULTI
template <int PH> static void launch_one(const mk::Args& a, int l, int grid, hipStream_t stream) {
    static bool attr = false;
    if (!attr) { (void)hipFuncSetAttribute((const void*)mk::mk_one<PH>, hipFuncAttributeMaxDynamicSharedMemorySize, mk::LDS_BYTES); attr = true; }
    hipLaunchKernelGGL(mk::mk_one<PH>, dim3(grid), dim3(512), mk::LDS_BYTES, stream, a, l);
}
#endif
extern "C" void kernel_launch(void* const* d_in, const int* in_sizes, int n_in, void* d_out, int out_size, void* d_ws, size_t ws_size, hipStream_t stream) {
    using namespace mk;
    static int grid = 0;
    if (grid == 0) {
        if (n_in != N_IN || (size_t)out_size != OUT_END || ws_size < WS_END) {
            fprintf(stderr, "kernel_launch: shape mismatch: n_in %d (want %d), out %d (want %zu), ws %zu (want >= %zu); nothing launched\n", n_in, (int)N_IN, out_size, (size_t)OUT_END, ws_size, (size_t)WS_END);
            grid = -1; return; }
        int dev = 0, cus = 0;
        (void)hipGetDevice(&dev); (void)hipDeviceGetAttribute(&cus, hipDeviceAttributeMultiprocessorCount, dev);
#if !MK_MULTI
        int per_cu = 0;
        if (hipFuncSetAttribute((const void*)mk_fwd, hipFuncAttributeMaxDynamicSharedMemorySize, LDS_BYTES) != hipSuccess) { fprintf(stderr, "kernel_launch: hipFuncSetAttribute failed\n"); grid = -1; return; }
        if (hipOccupancyMaxActiveBlocksPerMultiprocessor(&per_cu, (const void*)mk_fwd, 512, LDS_BYTES) != hipSuccess || per_cu < 1) fprintf(stderr, "kernel_launch: note: occupancy query gave %d\n", per_cu);
        (void)hipGetLastError();
#endif
        grid = cus;
        if (grid < 128) { fprintf(stderr, "kernel_launch: %d CUs: too few for this kernel\n", grid); grid = -1; return; }
    }
    if (grid < 0) return;
    Args a{};
    for (int i = 0; i < N_IN; ++i) a.in[i] = (const float*)d_in[i];
    a.out = (float*)d_out; a.ws = (unsigned char*)d_ws;
#if MK_MULTI
    launch_one<PH_P0>(a, 0, grid, stream);
    for (int l = 0; l < NL; ++l) {
        launch_one<PH_G1>(a, l, grid, stream); launch_one<PH_E1>(a, l, grid, stream); launch_one<PH_G2>(a, l, grid, stream); launch_one<PH_S>(a, l, grid, stream);
        launch_one<PH_E3>(a, l, grid, stream); launch_one<PH_G3>(a, l, grid, stream); launch_one<PH_E4>(a, l, grid, stream); launch_one<PH_G4>(a, l, grid, stream);
        launch_one<PH_G5>(a, l, grid, stream); launch_one<PH_E5>(a, l, grid, stream); launch_one<PH_G6>(a, l, grid, stream);
        if (l + 1 < NL) launch_one<PH_E0>(a, l, grid, stream);
    }
#else
    if (hipMemsetAsync(d_ws, 0, 65536, stream) != hipSuccess) { fprintf(stderr, "kernel_launch: hipMemsetAsync failed\n"); return; }
    void* args[] = {&a};
    const hipError_t e = hipLaunchCooperativeKernel((const void*)mk_fwd, dim3(grid), dim3(512), args, LDS_BYTES, stream);
    if (e != hipSuccess) fprintf(stderr, "kernel_launch: cooperative launch failed: %s (grid %d)\n", hipGetErrorString(e), grid);
#endif
}
```

```cpp
#include <hip/hip_runtime.h>
#include <hip/hip_cooperative_groups.h>
#include <cstdio>
#include <cstdint>
#include <cstddef>
#include <cmath>
namespace cg = cooperative_groups;
namespace pg8 {
#define PG8_LAS __attribute__((address_space(3)))
typedef unsigned short bf16_t;
typedef short bf16x8 __attribute__((ext_vector_type(8)));
typedef float f32x4 __attribute__((ext_vector_type(4)));
typedef unsigned u32x4 __attribute__((ext_vector_type(4)));
constexpr int BM = 256, BK = 64, HALF = 128, HTB = HALF * BK * 2  , STAGE_BYTES = 8 * HTB, NXCD = 8, WGM = 8;

__host__ __device__ __forceinline__ int lds_byte(int r, int c) { const int st = (r >> 4) * 2 + (c >> 5), rr = r & 15, cc = c & 31, ob = rr * 64 + cc * 2; return st * 1024 + (ob ^ (((ob >> 9) & 1) << 5)); }
__host__ __device__ __forceinline__ void stage_rc(int b, int& R, int& C) { const int st = b / 1024, sb = b % 1024, swz = sb ^ (((sb >> 9) & 1) << 5); R = (st >> 1) * 16 + swz / 64; C = (st & 1) * 32 + (swz % 64) / 2; }
__host__ __device__ __forceinline__ int perm32(int rho) { const int n = rho >> 4, i = rho & 15; return 8 * (i >> 2) + 4 * n + (i & 3); }

struct Unit { int pm, pn, ko = 0; };
struct Gemm { const bf16_t* A; const bf16_t* Bt; int M, N, K; int ld = 0; };

struct StaticOrder {
    int nM, nN, nwg, G, c;
    __host__ __device__ void init(int M, int N, int G_, int c_) { nM = M / BM; nN = N / BM; nwg = nM * nN; G = G_; c = c_; }
    __host__ __device__ bool next(int i, Unit& u) const {
        const long L = (long)i * G + c; if (L >= nwg) return false;
        int wgid = (int)L; { const int q = nwg / NXCD, r = nwg % NXCD, xcd = wgid % NXCD, off = wgid / NXCD; wgid = (xcd < r ? xcd * (q + 1) : r * (q + 1) + (xcd - r) * q) + off; }
        const int nig = WGM * nN, gid = wgid / nig, fm = gid * WGM, gsz = (nM - fm) < WGM ? (nM - fm) : WGM;
        u.pm = fm + ((wgid % nig) % gsz); u.pn = (wgid % nig) / gsz; return true;
    }
    __device__ __forceinline__ void a_ready(const Unit&) const {}
    __device__ __forceinline__ void done(const Unit&) const {}
};

__device__ __forceinline__ unsigned cvt_pk_bf16(float lo, float hi) { unsigned r; asm volatile("v_cvt_pk_bf16_f32 %0, %1, %2" : "=v"(r) : "v"(lo), "v"(hi)); return r; }
typedef float f32x2 __attribute__((ext_vector_type(2)));
__device__ __forceinline__ f32x2 gelu_pk(f32x2 v) {
    const f32x2 av = __builtin_elementwise_abs(v), d = av * 0.2316418882f + 1.0f;
    f32x2 t; t.x = __builtin_amdgcn_rcpf(d.x); t.y = __builtin_amdgcn_rcpf(d.y);
    f32x2 q = t * 0.5307027145f + (-0.7265760135f); q = q * t + 0.7107068705f; q = q * t + (-0.142248368f); q = q * t + 0.127414796f; q = q * t;
    const f32x2 s = (v * v) * (-0.72134752044f);
    f32x2 e; e.x = __builtin_amdgcn_exp2f(s.x); e.y = __builtin_amdgcn_exp2f(s.y);
    const f32x2 m = v * (q * e), r = v - m;
    f32x2 o; o.x = v.x < 0.f ? m.x : r.x; o.y = v.y < 0.f ? m.y : r.y; return o;
}

template <int ACT  > struct EpiBf16 {
    static constexpr bool PERM = true, AFTER_DRAIN = false; static_assert(ACT == 0 || ACT == 1, "EpiBf16: ACT is 0 (none) or 1 (gelu_pk)");
    bf16_t* O; int ldc; const float* bias; int split_cols; size_t split_stride; float scale0;
    __device__ __forceinline__ void operator()(const f32x4 (&acc)[2][2][4][2], const Unit& u, int wr, int wc, int fr, int fq) const {
        const int row0 = u.pm * BM + wr * 64 + fr; int colt = u.pn * BM; bf16_t* base = O;
        float sc = 1.f; if (split_cols) { const int t = colt / split_cols; base += (size_t)t * split_stride; colt -= t * split_cols; if (t == 0) sc = scale0; }
        const int col0 = colt + wc * 32 + 8 * fq, bcol0 = u.pn * BM + wc * 32 + 8 * fq;
        f32x4 bv[2][2];
#pragma unroll
        for (int bj = 0; bj < 2; ++bj)
#pragma unroll
            for (int n = 0; n < 2; ++n) bv[bj][n] = bias ? *(const f32x4*)(bias + bcol0 + bj * HALF + 4 * n) : (f32x4){0.f, 0.f, 0.f, 0.f};
#pragma unroll
        for (int ai = 0; ai < 2; ++ai)
#pragma unroll
            for (int m = 0; m < 4; ++m) { bf16_t* rowp = base + (size_t)(row0 + ai * HALF + m * 16) * ldc + col0;
#pragma unroll
                for (int bj = 0; bj < 2; ++bj) { f32x4 v0 = acc[ai][bj][m][0] + bv[bj][0], v1 = acc[ai][bj][m][1] + bv[bj][1];
                    if (ACT == 1) { f32x2 a = gelu_pk((f32x2){v0[0], v0[1]}), b = gelu_pk((f32x2){v0[2], v0[3]}), c = gelu_pk((f32x2){v1[0], v1[1]}), d = gelu_pk((f32x2){v1[2], v1[3]});
                        v0 = (f32x4){a.x, a.y, b.x, b.y}; v1 = (f32x4){c.x, c.y, d.x, d.y}; }
                    v0 = v0 * sc; v1 = v1 * sc; u32x4 w; w.x = cvt_pk_bf16(v0[0], v0[1]); w.y = cvt_pk_bf16(v0[2], v0[3]); w.z = cvt_pk_bf16(v1[0], v1[1]); w.w = cvt_pk_bf16(v1[2], v1[3]);
                    *(u32x4*)(rowp + bj * HALF) = w; } }
    }
};
template <class Epi, class Sched, bool ALIGN_EPI = false, bool SP2 = false>
__device__ __forceinline__ void gemm_phase(PG8_LAS unsigned char* lds, const Gemm g, const Sched& S, const Epi& E, int tid_in) {
    int tid_ = tid_in; asm volatile("" : "+v"(tid_));
    const int tid = tid_, wid = __builtin_amdgcn_readfirstlane(tid >> 6), lane = tid & 63, wr = wid >> 2, wc = wid & 3, fr = lane & 15, fq = lane >> 4;
    const int K = g.K, nt = K / BK, LD = g.ld ? g.ld : g.K;
    unsigned voffA[2], voffB[2];
#pragma unroll
    for (int i = 0; i < 2; ++i) { int R, C; stage_rc(tid * 16 + i * 8192, R, C); const int Rb = Epi::PERM ? ((R & ~31) + perm32(R & 31)) : R;
        voffA[i] = (unsigned)(R * LD + C) * 2u; voffB[i] = (unsigned)(Rb * LD + C) * 2u; }
    const size_t kstep = (size_t)(BK * 2);
    const size_t hstep = (size_t)HALF * LD * 2;
    const size_t tstep = 2 * hstep;
    const unsigned ldsw = (unsigned)wid * 1024u;
    const int aoff = lds_byte(wr * 64 + fr, fq * 8), boff = lds_byte(wc * 32 + fr, fq * 8);
#define PG8_SA(b, h) (((b) * 2 + (h)) * HTB)
#define PG8_SB(b, h) ((4 + (b) * 2 + (h)) * HTB)
#define PG8_STAGE(bufoff, gbase, voff) do { _Pragma("unroll") for (int _i = 0; _i < 2; ++_i) \
        __builtin_amdgcn_global_load_lds((const unsigned*)((const char*)(gbase) + (voff)[_i]), (PG8_LAS unsigned*)(lds + (bufoff) + ldsw + _i * 8192), 16, 0, 0); } while (0)
#define PG8_LDA(dst, b, h) do { _Pragma("unroll") for (int m = 0; m < 4; ++m) _Pragma("unroll") for (int k = 0; k < 2; ++k) dst[m][k] = *(const PG8_LAS bf16x8*)(lds + PG8_SA(b, h) + aoff + m * 2048 + k * 1024); } while (0)
#define PG8_LDB(dst, b, h) do { _Pragma("unroll") for (int n = 0; n < 2; ++n) _Pragma("unroll") for (int k = 0; k < 2; ++k) dst[n][k] = *(const PG8_LAS bf16x8*)(lds + PG8_SB(b, h) + boff + n * 2048 + k * 1024); } while (0)
#define PG8_MMA(ai, bj, At, Bt) do { __builtin_amdgcn_s_setprio(1); _Pragma("unroll") for (int m = 0; m < 4; ++m) _Pragma("unroll") for (int n = 0; n < 2; ++n) _Pragma("unroll") for (int k = 0; k < 2; ++k) \
        acc[ai][bj][m][n] = __builtin_amdgcn_mfma_f32_16x16x32_bf16(Bt[n][k], At[m][k], acc[ai][bj][m][n], 0, 0, 0); __builtin_amdgcn_s_setprio(0); } while (0)
#define PG8_WAIT_V(n) asm volatile("s_waitcnt vmcnt(" #n ")" ::: "memory")
#define PG8_WAIT_L(n) asm volatile("s_waitcnt lgkmcnt(" #n ")" ::: "memory")
#define PG8_BAR __builtin_amdgcn_s_barrier()
#define PG8_SCHED __builtin_amdgcn_sched_barrier(0)
    Unit cur, nxt; int ui = 0;
    if (!S.next(0, cur)) return;
    f32x4 acc[2][2][4][2];
#pragma unroll
    for (int a = 0; a < 2; ++a)
#pragma unroll
        for (int b = 0; b < 2; ++b)
#pragma unroll
            for (int m = 0; m < 4; ++m)
#pragma unroll
                for (int n = 0; n < 2; ++n) acc[a][b][m][n] = (f32x4){0.f, 0.f, 0.f, 0.f};
    bf16x8 At[4][2], B0[2][2], B1[2][2];
    const char* cA = (const char*)g.A + (size_t)cur.pm * tstep + (size_t)cur.ko * 2; const char* cB = (const char*)g.Bt + (size_t)cur.pn * tstep + (size_t)cur.ko * 2;
    S.a_ready(cur);
    if constexpr (SP2) {
        PG8_STAGE(PG8_SB(0, 0), cB, voffB); PG8_STAGE(PG8_SB(0, 1), cB + hstep, voffB); PG8_STAGE(PG8_SA(0, 0), cA, voffA); PG8_STAGE(PG8_SA(0, 1), cA + hstep, voffA);
        if (wr == 1) PG8_BAR;
        PG8_WAIT_V(2); PG8_BAR;
        PG8_STAGE(PG8_SB(1, 0), cB + kstep, voffB); PG8_STAGE(PG8_SA(1, 0), cA + kstep, voffA); PG8_STAGE(PG8_SB(1, 1), cB + hstep + kstep, voffB);
        PG8_WAIT_V(6); PG8_BAR;
    } else {
        PG8_STAGE(PG8_SB(0, 0), cB, voffB); PG8_STAGE(PG8_SA(0, 0), cA, voffA); PG8_STAGE(PG8_SB(0, 1), cB + hstep, voffB); PG8_STAGE(PG8_SA(0, 1), cA + hstep, voffA);
        if (wr == 1) PG8_BAR;
        PG8_WAIT_V(4); PG8_BAR;
        PG8_STAGE(PG8_SB(1, 0), cB + kstep, voffB); PG8_STAGE(PG8_SA(1, 0), cA + kstep, voffA); PG8_STAGE(PG8_SB(1, 1), cB + hstep + kstep, voffB);
        PG8_WAIT_V(6); PG8_BAR;
    }
    for (;;) {
        const bool has_next = S.next(ui + 1, nxt);
        const char* nA = has_next ? (const char*)g.A + (size_t)nxt.pm * tstep + (size_t)nxt.ko * 2 : cA; const char* nB = has_next ? (const char*)g.Bt + (size_t)nxt.pn * tstep + (size_t)nxt.ko * 2 : cB;
        for (int t = 0; t < nt; t += 2) {
            const bool last = (t == nt - 2);
            const char* a1 = cA + (size_t)(t + 1) * kstep;
            const char* a2 = last ? nA : cA + (size_t)(t + 2) * kstep; const char* b2 = last ? nB : cB + (size_t)(t + 2) * kstep;
            const char* a3 = a2 + kstep; const char* b3 = b2 + kstep;
            if (last && has_next) S.a_ready(nxt);
            if constexpr (SP2) {
            PG8_LDB(B0, 0, 0); PG8_LDB(B1, 0, 1); PG8_SCHED; PG8_LDA(At, 0, 0); PG8_STAGE(PG8_SA(1, 1), a1 + hstep, voffA);
            PG8_WAIT_V(8); PG8_WAIT_L(0); PG8_BAR; PG8_MMA(0, 0, At, B0); PG8_MMA(0, 1, At, B1); PG8_BAR; PG8_SCHED;
            PG8_LDA(At, 0, 1); PG8_STAGE(PG8_SB(0, 0), b2, voffB); PG8_STAGE(PG8_SB(0, 1), b2 + hstep, voffB); PG8_STAGE(PG8_SA(0, 0), a2, voffA);
            PG8_WAIT_V(8); PG8_WAIT_L(0); PG8_BAR; PG8_MMA(1, 0, At, B0); PG8_MMA(1, 1, At, B1); PG8_BAR; PG8_SCHED;
            PG8_LDB(B0, 1, 0); PG8_LDB(B1, 1, 1); PG8_SCHED; PG8_LDA(At, 1, 0); PG8_STAGE(PG8_SA(0, 1), a2 + hstep, voffA);
            PG8_WAIT_V(8); PG8_WAIT_L(0); PG8_BAR; PG8_MMA(0, 0, At, B0); PG8_MMA(0, 1, At, B1); PG8_BAR; PG8_SCHED;
            PG8_LDA(At, 1, 1); PG8_STAGE(PG8_SB(1, 0), b3, voffB); PG8_STAGE(PG8_SB(1, 1), b3 + hstep, voffB); PG8_STAGE(PG8_SA(1, 0), a3, voffA);
            PG8_WAIT_V(8); PG8_WAIT_L(0); PG8_BAR; PG8_MMA(1, 0, At, B0); PG8_MMA(1, 1, At, B1); PG8_BAR; PG8_SCHED;
            } else {
            PG8_LDB(B0, 0, 0); PG8_SCHED; PG8_LDA(At, 0, 0); PG8_STAGE(PG8_SA(1, 1), a1 + hstep, voffA);
            PG8_WAIT_L(8); PG8_BAR; PG8_WAIT_L(0); PG8_MMA(0, 0, At, B0); PG8_BAR; PG8_SCHED;
            PG8_LDB(B1, 0, 1); PG8_STAGE(PG8_SB(0, 0), b2, voffB);
            PG8_BAR; PG8_WAIT_L(0); PG8_MMA(0, 1, At, B1); PG8_BAR;
            PG8_LDA(At, 0, 1); PG8_STAGE(PG8_SA(0, 0), a2, voffA);
            PG8_BAR; PG8_WAIT_L(0); PG8_MMA(1, 0, At, B0); PG8_BAR; PG8_SCHED;
            PG8_STAGE(PG8_SB(0, 1), b2 + hstep, voffB);
            PG8_WAIT_V(6); PG8_BAR; PG8_MMA(1, 1, At, B1); PG8_BAR;
            PG8_LDB(B0, 1, 0); PG8_SCHED; PG8_LDA(At, 1, 0); PG8_STAGE(PG8_SA(0, 1), a2 + hstep, voffA);
            PG8_WAIT_L(8); PG8_BAR; PG8_WAIT_L(0); PG8_MMA(0, 0, At, B0); PG8_BAR; PG8_SCHED;
            PG8_LDB(B1, 1, 1); PG8_STAGE(PG8_SB(1, 0), b3, voffB);
            PG8_BAR; PG8_WAIT_L(0); PG8_MMA(0, 1, At, B1); PG8_BAR;
            PG8_LDA(At, 1, 1); PG8_STAGE(PG8_SA(1, 0), a3, voffA);
            PG8_BAR; PG8_WAIT_L(0); PG8_MMA(1, 0, At, B0); PG8_BAR; PG8_SCHED;
            PG8_STAGE(PG8_SB(1, 1), b3 + hstep, voffB);
            PG8_WAIT_V(6); PG8_BAR; PG8_MMA(1, 1, At, B1); PG8_BAR;
            }
        }
        if constexpr (ALIGN_EPI) { if (wr == 0) PG8_BAR; }
        if constexpr (!Epi::AFTER_DRAIN) { int z_ = 0; asm volatile("" : "+v"(z_)); const int ln_ = __builtin_amdgcn_mbcnt_hi(-1, __builtin_amdgcn_mbcnt_lo(-1, z_)); E(acc, cur, wr, wc, ln_ & 15, ln_ >> 4); S.done(cur); }
        if (!has_next) break;
#pragma unroll
        for (int a = 0; a < 2; ++a)
#pragma unroll
            for (int b = 0; b < 2; ++b)
#pragma unroll
                for (int m = 0; m < 4; ++m)
#pragma unroll
                    for (int n = 0; n < 2; ++n) acc[a][b][m][n] = (f32x4){0.f, 0.f, 0.f, 0.f};
        cur = nxt; cA = nA; cB = nB; ++ui;
        if constexpr (ALIGN_EPI) { if (wr == 1) PG8_BAR; }
    }
    PG8_WAIT_V(0);
    if constexpr (!ALIGN_EPI) { if (wr == 0) PG8_BAR; }
    PG8_BAR;
    if constexpr (Epi::AFTER_DRAIN) { E.fused(acc, cur, wr, wc, fr, fq, lds, wid, lane); S.done(cur); }
#undef PG8_SA
#undef PG8_SB
#undef PG8_STAGE
#undef PG8_LDA
#undef PG8_LDB
#undef PG8_MMA
#undef PG8_WAIT_V
#undef PG8_WAIT_L
#undef PG8_BAR
#undef PG8_SCHED
}
}
namespace mk {
typedef pg8::bf16_t bf16;
typedef pg8::f32x4 f32x4;
typedef pg8::u32x4 u32x4;
typedef pg8::bf16x8 bf16x8;
typedef pg8::Unit Unit;
typedef float f32x16 __attribute__((ext_vector_type(16)));
typedef unsigned u32x2 __attribute__((ext_vector_type(2)));
typedef float f32x2 __attribute__((ext_vector_type(2)));
#define LAS __attribute__((address_space(3)))
#define LDS_WAIT() asm volatile("s_waitcnt lgkmcnt(0)" ::: "memory")

constexpr int DM = 1024, T = 4096, NBP = 4, MP = NBP * T, DB = 128, DS = 4, MS = DB * DS, M = MP + MS, NL = 4;
constexpr int INC = 2304, DFF = 2816, K2 = 512, N2 = 1280, PLE = 256;
constexpr int C_K = 512, C_V = 640, C_RW = 768, C_XB = 1792, C_GB = 2048;

constexpr size_t SZ_WIN = (size_t)INC * DM * 2, SZ_W2 = (size_t)N2 * K2 * 2, SZ_WOUT = (size_t)DM * DM * 2, SZ_WGU = (size_t)2 * DFF * DM * 2,
                 SZ_WD = (size_t)DM * DFF * 2, SZ_WPG = (size_t)DM * DM * 2, SZ_WP = (size_t)DM * PLE * 2;
constexpr size_t O_WIN = 0, O_W2 = O_WIN + SZ_WIN, O_WOUT = O_W2 + SZ_W2, O_WGU = O_WOUT + SZ_WOUT, O_WD = O_WGU + SZ_WGU, O_WPG = O_WD + SZ_WD,
                 O_WP = O_WPG + SZ_WPG, WL = O_WP + SZ_WP;
constexpr size_t WS_W = 1u << 20  , SZ_PBL = (size_t)M * PLE * 2, WS_X16 = WS_W + 2 * WL  , WS_PB = WS_X16 + (size_t)M * DM * 2  , SZ_ACT = (size_t)M * DM * 2, WS_PP = WS_PB + 2 * SZ_PBL  , WS_HN = WS_PP + SZ_ACT,
                 WS_R1 = WS_HN + SZ_ACT, SZ_R1 = (size_t)M * INC * 2, WS_R2 = WS_R1 + SZ_R1, SZ_F256 = (size_t)M * 256 * 4, WS_R3 = WS_R2 + 7 * SZ_F256,
                 WS_END = WS_R3 + 3 * SZ_F256;
static_assert(WL % 256 == 0 && SZ_R1 >= (size_t)M * DM * 4 && 7 * SZ_F256 >= (size_t)M * DFF * 2, "ws map");

constexpr size_t OUT_Y = 0, OUT_KP = (size_t)M * DM, OUT_VP = OUT_KP + (size_t)NL * NBP * 128 * 128, OUT_SHP = OUT_VP + (size_t)NL * NBP * 128 * 128,
                 OUT_WKVP = OUT_SHP + (size_t)NL * NBP * 1024, OUT_CVP = OUT_WKVP + (size_t)NL * NBP * 4 * 4096, OUT_LRP = OUT_CVP + (size_t)NL * NBP * 768,
                 OUT_KS = OUT_LRP + (size_t)NL * NBP * 256, OUT_VS = OUT_KS + (size_t)NL * DB * 128 * 128, OUT_SHS = OUT_VS + (size_t)NL * DB * 128 * 128,
                 OUT_WKVS = OUT_SHS + (size_t)NL * DB * 1024, OUT_CVS = OUT_WKVS + (size_t)NL * DB * 4 * 4096, OUT_LRS = OUT_CVS + (size_t)NL * DB * 768,
                 OUT_END = OUT_LRS + (size_t)NL * DB * 256;

enum { I_XP = 0, I_XS, I_CK, I_CV, I_SSH, I_SWKV, I_SCV, I_SLRU, I_PP, I_PS, I_NMPRE, I_NMPOST, I_NFPRE, I_NFPOST, I_WIN, I_BIN, I_SINK, I_MU, I_W0, I_WUP,
       I_A0, I_AUP, I_GUP, I_KK, I_KA, I_RK, I_LNW, I_LNB, I_CW, I_CB, I_WA, I_BA, I_WI, I_BI, I_L, I_WOUT, I_BOUT, I_WG, I_WU, I_WDN, I_PW, I_PGW, N_IN };

__device__ __forceinline__ unsigned f2bf(float f) { unsigned u = __float_as_uint(f); return (u + 0x7fffu + ((u >> 16) & 1u)) >> 16; }
__device__ __forceinline__ unsigned pk2(float lo, float hi) { return f2bf(lo) | (f2bf(hi) << 16); }
__device__ __forceinline__ float bflo(unsigned w) { return __uint_as_float(w << 16); }
__device__ __forceinline__ float bfhi(unsigned w) { return __uint_as_float(w & 0xffff0000u); }
__device__ __forceinline__ float bf1(bf16 b) { return __uint_as_float((unsigned)b << 16); }
__device__ __forceinline__ f32x4 ld_bf4(const bf16* p) { const u32x2 w = *(const u32x2*)p; return (f32x4){bflo(w.x), bfhi(w.x), bflo(w.y), bfhi(w.y)}; }
__device__ __forceinline__ void st_bf4(bf16* p, f32x4 v) { u32x2 w; w.x = pk2(v.x, v.y); w.y = pk2(v.z, v.w); *(u32x2*)p = w; }
__device__ __forceinline__ void ld_bf8(const bf16* p, f32x4& lo, f32x4& hi) { const u32x4 w = *(const u32x4*)p; lo = (f32x4){bflo(w.x), bfhi(w.x), bflo(w.y), bfhi(w.y)}; hi = (f32x4){bflo(w.z), bfhi(w.z), bflo(w.w), bfhi(w.w)}; }
__device__ __forceinline__ void st_bf8(bf16* p, f32x4 lo, f32x4 hi) { u32x4 w; w.x = pk2(lo.x, lo.y); w.y = pk2(lo.z, lo.w); w.z = pk2(hi.x, hi.y); w.w = pk2(hi.z, hi.w); *(u32x4*)p = w; }
__device__ __forceinline__ float sigm(float x) { return __builtin_amdgcn_rcpf(1.f + __expf(-x)); }
__device__ __forceinline__ float tanh_(float x) { return 1.f - 2.f * __builtin_amdgcn_rcpf(__expf(2.f * x) + 1.f); }
__device__ __forceinline__ float gelu_t(float x) { return 0.5f * x * (1.f + tanh_(0.7978845608f * (x + 0.044715f * x * x * x))); }
template <int CTRL> __device__ __forceinline__ float dppf(float x) { return __builtin_bit_cast(float, __builtin_amdgcn_mov_dpp(__builtin_bit_cast(int, x), CTRL, 0xf, 0xf, true)); }
__device__ __forceinline__ float red16(float x) { x += dppf<0xB1>(x); x += dppf<0x4E>(x); x += dppf<0x141>(x); x += dppf<0x128>(x); return x; }
__device__ __forceinline__ float wave_sum(float v) {
    v = red16(v);
    v += __builtin_bit_cast(float, __builtin_amdgcn_update_dpp(0, __builtin_bit_cast(int, v), 0x142, 0xa, 0xf, false));
    v += __builtin_bit_cast(float, __builtin_amdgcn_update_dpp(0, __builtin_bit_cast(int, v), 0x143, 0xc, 0xf, false));
    return __builtin_bit_cast(float, __builtin_amdgcn_readlane(__builtin_bit_cast(int, v), 63));
}
__device__ __forceinline__ float vmul(float a, float b) { float d; asm("v_mul_f32 %0, %1, %2" : "=v"(d) : "v"(a), "v"(b)); return d; }
__device__ __forceinline__ float vfma(float a, float b, float c) { float d; asm("v_fma_f32 %0, %1, %2, %3" : "=v"(d) : "v"(a), "v"(b), "v"(c)); return d; }
__device__ __forceinline__ float vfnma(float a, float b, float c) { float d; asm("v_fma_f32 %0, -%1, %2, %3" : "=v"(d) : "v"(a), "v"(b), "v"(c)); return d; }
__device__ __forceinline__ void red16x2(float& p, float& q) {
    asm volatile("v_add_f32_dpp %0, %0, %0 quad_perm:[1,0,3,2] row_mask:0xf bank_mask:0xf bound_ctrl:1\n\t"
                 "v_add_f32_dpp %1, %1, %1 quad_perm:[1,0,3,2] row_mask:0xf bank_mask:0xf bound_ctrl:1\n\ts_nop 0\n\t"
                 "v_add_f32_dpp %0, %0, %0 quad_perm:[2,3,0,1] row_mask:0xf bank_mask:0xf bound_ctrl:1\n\t"
                 "v_add_f32_dpp %1, %1, %1 quad_perm:[2,3,0,1] row_mask:0xf bank_mask:0xf bound_ctrl:1\n\ts_nop 0\n\t"
                 "v_add_f32_dpp %0, %0, %0 row_half_mirror row_mask:0xf bank_mask:0xf bound_ctrl:1\n\t"
                 "v_add_f32_dpp %1, %1, %1 row_half_mirror row_mask:0xf bank_mask:0xf bound_ctrl:1\n\ts_nop 0\n\t"
                 "v_add_f32_dpp %0, %0, %0 row_ror:8 row_mask:0xf bank_mask:0xf bound_ctrl:1\n\t"
                 "v_add_f32_dpp %1, %1, %1 row_ror:8 row_mask:0xf bank_mask:0xf bound_ctrl:1\n\ts_nop 1"
                 : "+v"(p), "+v"(q));
}
__device__ __forceinline__ float shx(float v, int mask, int lane) { return __builtin_bit_cast(float, __builtin_amdgcn_ds_bpermute((lane ^ mask) << 2, __builtin_bit_cast(int, v))); }
__device__ __forceinline__ float dot4(f32x4 a, f32x4 b) { return (a.x * b.x + a.y * b.y) + (a.z * b.z + a.w * b.w); }

struct EpiF32 {
    static constexpr bool PERM = false, AFTER_DRAIN = false;
    float* O; int ldc; const float* bias;
    __device__ __forceinline__ void operator()(const f32x4 (&acc)[2][2][4][2], const Unit& u, int wr, int wc, int fr, int fq) const {
        asm volatile("" : "+v"(fr), "+v"(fq));
        const int row0 = u.pm * 256 + wr * 64 + fr, col0 = u.pn * 256 + wc * 32 + 4 * fq;
        f32x4 bv[2][2];
#pragma unroll
        for (int bj = 0; bj < 2; ++bj)
#pragma unroll
            for (int n = 0; n < 2; ++n) bv[bj][n] = bias ? *(const f32x4*)(bias + col0 + bj * 128 + n * 16) : (f32x4){0.f, 0.f, 0.f, 0.f};
#pragma unroll
        for (int ai = 0; ai < 2; ++ai)
#pragma unroll
            for (int m = 0; m < 4; ++m) { float* rowp = O + (size_t)(row0 + ai * 128 + m * 16) * ldc + col0;
#pragma unroll
                for (int bj = 0; bj < 2; ++bj)
#pragma unroll
                    for (int n = 0; n < 2; ++n) *(f32x4*)(rowp + bj * 128 + n * 16) = acc[ai][bj][m][n] + bv[bj][n]; }
    }
};
struct EpiPle {
    static constexpr bool PERM = true, AFTER_DRAIN = false;
    bf16* X; const bf16* PP; float* Y;
    __device__ __forceinline__ void operator()(const f32x4 (&acc)[2][2][4][2], const Unit& u, int wr, int wc, int fr, int fq) const {
        asm volatile("" : "+v"(fr), "+v"(fq));
        const int row0 = u.pm * 256 + wr * 64 + fr, col0 = u.pn * 256 + wc * 32 + 8 * fq;
#pragma unroll
        for (int ai = 0; ai < 2; ++ai)
#pragma unroll
            for (int m = 0; m < 4; ++m) { const size_t off = (size_t)(row0 + ai * 128 + m * 16) * DM + col0;
#pragma unroll
                for (int bj = 0; bj < 2; ++bj) { const size_t o = off + bj * 128; f32x4 x0, x1, p0, p1; ld_bf8(X + o, x0, x1); ld_bf8(PP + o, p0, p1); const f32x4 a0 = acc[ai][bj][m][0], a1 = acc[ai][bj][m][1];
                    const f32x4 r0 = (f32x4){x0.x + sigm(a0.x) * p0.x, x0.y + sigm(a0.y) * p0.y, x0.z + sigm(a0.z) * p0.z, x0.w + sigm(a0.w) * p0.w},
                                r1 = (f32x4){x1.x + sigm(a1.x) * p1.x, x1.y + sigm(a1.y) * p1.y, x1.z + sigm(a1.z) * p1.z, x1.w + sigm(a1.w) * p1.w};
                    if (Y) { *(f32x4*)(Y + o) = r0; *(f32x4*)(Y + o + 4) = r1; } else st_bf8(X + o, r0, r1); }
                asm volatile("" ::: "memory"); }
    }
};
struct EpiSwiglu {
    static constexpr bool PERM = true, AFTER_DRAIN = false;
    bf16* O;
    __device__ __forceinline__ void operator()(const f32x4 (&acc)[2][2][4][2], const Unit& u, int wr, int wc, int fr, int fq) const {
        asm volatile("" : "+v"(fr), "+v"(fq));
        const int row0 = u.pm * 256 + wr * 64 + fr, col0 = u.pn * 128 + wc * 32 + 8 * fq;
#pragma unroll
        for (int ai = 0; ai < 2; ++ai)
#pragma unroll
            for (int m = 0; m < 4; ++m) { bf16* p = O + (size_t)(row0 + ai * 128 + m * 16) * DFF + col0;
                const f32x4 g0 = acc[ai][0][m][0], g1 = acc[ai][0][m][1], u0 = acc[ai][1][m][0], u1 = acc[ai][1][m][1];
                u32x4 w; w.x = pk2(g0.x * sigm(g0.x) * u0.x, g0.y * sigm(g0.y) * u0.y); w.y = pk2(g0.z * sigm(g0.z) * u0.z, g0.w * sigm(g0.w) * u0.w);
                w.z = pk2(g1.x * sigm(g1.x) * u1.x, g1.y * sigm(g1.y) * u1.y); w.w = pk2(g1.z * sigm(g1.z) * u1.z, g1.w * sigm(g1.w) * u1.w);
                *(u32x4*)p = w; }
    }
};
struct G2Order {
    pg8::StaticOrder b;
    __device__ bool next(int i, Unit& u) const { if (!b.next(i, u)) return false; u.ko = u.pn < 3 ? 0 : 256; return true; }
    __device__ __forceinline__ void a_ready(const Unit&) const {}
    __device__ __forceinline__ void done(const Unit&) const {}
};
struct SplitOrder {
    int c, G, kh;
    __device__ bool next(int i, Unit& u) const { const long L = (long)i * G + c; if (L >= 16) return false; u.pm = (int)L >> 3; u.pn = ((int)L >> 1) & 3; u.ko = ((int)L & 1) * kh; return true; }
    __device__ __forceinline__ void a_ready(const Unit&) const {}
    __device__ __forceinline__ void done(const Unit&) const {}
};
struct EpiPart {
    static constexpr bool PERM = false, AFTER_DRAIN = false;
    float* P;
    __device__ __forceinline__ void operator()(const f32x4 (&acc)[2][2][4][2], const Unit& u, int wr, int wc, int fr, int fq) const {
        asm volatile("" : "+v"(fr), "+v"(fq));
        const int row0 = u.pm * 256 + wr * 64 + fr, col0 = u.pn * 256 + wc * 32 + 4 * fq; float* O = P + (u.ko ? (size_t)MS * DM : 0);
#pragma unroll
        for (int ai = 0; ai < 2; ++ai)
#pragma unroll
            for (int m = 0; m < 4; ++m) { float* rowp = O + (size_t)(row0 + ai * 128 + m * 16) * DM + col0;
#pragma unroll
                for (int bj = 0; bj < 2; ++bj)
#pragma unroll
                    for (int n = 0; n < 2; ++n) *(f32x4*)(rowp + bj * 128 + n * 16) = acc[ai][bj][m][n]; }
    }
};
struct EpiMix {
    static constexpr bool PERM = true, AFTER_DRAIN = false;
    const float *w0, *a0, *k_a, *b_a, *b_i, *Lp; float* Wd; bf16 *Ks, *KK, *BV, *G; float *AL, *U; const bf16* A2;
    __device__ __forceinline__ void operator()(const f32x4 (&acc)[2][2][4][2], const Unit& u, int wr, int wc, int fr, int fq) const {
        asm volatile("" : "+v"(fr), "+v"(fq));
        const int row0 = u.pm * 256 + wr * 64 + fr;
        if (u.pn < 3) {
#pragma unroll
            for (int ai = 0; ai < 2; ++ai)
#pragma unroll
                for (int m = 0; m < 4; ++m) { const size_t ro = (size_t)(row0 + ai * 128 + m * 16) * 256;
#pragma unroll
                    for (int bj = 0; bj < 2; ++bj) { const int c = bj * 128 + wc * 32 + 8 * fq; const f32x4 z0 = acc[ai][bj][m][0], z1 = acc[ai][bj][m][1];
                        if (u.pn == 0) { const f32x4 b0 = *(const f32x4*)(w0 + c), b1 = *(const f32x4*)(w0 + c + 4); f32x4 d0, d1;
                            d0.x = __expf(-0.60653066f * sigm(z0.x + b0.x)); d0.y = __expf(-0.60653066f * sigm(z0.y + b0.y)); d0.z = __expf(-0.60653066f * sigm(z0.z + b0.z)); d0.w = __expf(-0.60653066f * sigm(z0.w + b0.w));
                            d1.x = __expf(-0.60653066f * sigm(z1.x + b1.x)); d1.y = __expf(-0.60653066f * sigm(z1.y + b1.y)); d1.z = __expf(-0.60653066f * sigm(z1.z + b1.z)); d1.w = __expf(-0.60653066f * sigm(z1.w + b1.w));
                            *(f32x4*)(Wd + ro + c) = d0; *(f32x4*)(Wd + ro + c + 4) = d1; }
                        else if (u.pn == 1) { const f32x4 b0 = *(const f32x4*)(a0 + c), b1 = *(const f32x4*)(a0 + c + 4), ka0 = *(const f32x4*)(k_a + c), ka1 = *(const f32x4*)(k_a + c + 4);
                            f32x4 ks0, ks1, kk0, kk1; ld_bf8(Ks + ro + c, ks0, ks1); ld_bf8(KK + ro + c, kk0, kk1);
                            f32x4 av0, av1; av0.x = sigm(z0.x + b0.x); av0.y = sigm(z0.y + b0.y); av0.z = sigm(z0.z + b0.z); av0.w = sigm(z0.w + b0.w);
                            av1.x = sigm(z1.x + b1.x); av1.y = sigm(z1.y + b1.y); av1.z = sigm(z1.z + b1.z); av1.w = sigm(z1.w + b1.w);
                            st_bf8(Ks + ro + c, ks0 * (1.f + (av0 - 1.f) * ka0), ks1 * (1.f + (av1 - 1.f) * ka1)); st_bf8(BV + ro + c, kk0 * av0, kk1 * av1); }
                        else { st_bf8(G + ro + c, z0, z1); }
                        asm volatile("" ::: "memory"); } }
        } else {
            const int t = u.pn - 3;
#pragma unroll
            for (int ai = 0; ai < 2; ++ai)
#pragma unroll
                for (int m = 0; m < 4; ++m) { const size_t r = (size_t)(row0 + ai * 128 + m * 16); const int cc0 = 128 * t + wc * 32 + 8 * fq;
                    f32x4 xc0, xc1; ld_bf8(A2 + r * K2 + 256 + cc0, xc0, xc1);
#pragma unroll
                    for (int n = 0; n < 2; ++n) { const int cc = cc0 + 4 * n;
                        const f32x4 zr = acc[ai][0][m][n] + *(const f32x4*)(b_a + cc), zi = acc[ai][1][m][n] + *(const f32x4*)(b_i + cc), Lv = *(const f32x4*)(Lp + cc), xc = n ? xc1 : xc0;
                        f32x4 al, uu;
#define LRU1(e) { const float xe = __expf(-Lv.e); const float ls = -xe * (1.f + xe * (-0.5f + xe * 0.33333334f)); const float la = 8.f * sigm(zr.e) * ls; al.e = __expf(la); const float z2 = 2.f * la; \
    const float om = -z2 * (1.f + z2 * (0.5f + z2 * (0.16666667f + z2 * (0.041666668f + z2 * 0.0083333338f)))); uu.e = __builtin_amdgcn_sqrtf(om) * sigm(zi.e) * xc.e; }
                        LRU1(x) LRU1(y) LRU1(z) LRU1(w)
#undef LRU1
                        *(f32x4*)(AL + r * 256 + cc) = al; *(f32x4*)(U + r * 256 + cc) = uu; asm volatile("" ::: "memory"); } }
        }
    }
};

#define RLX_AGENT __ATOMIC_RELAXED, __HIP_MEMORY_SCOPE_AGENT
#define XB_TMO      128
#define XB_XCNT(j)  (256  + 64 * (j))
#define XB_XSUB(j)  (1280 + 64 * (j))
#define XB_XGEN(j)  (2304 + 64 * (j))
#define XB_TOP      3328
#define XB_TOPGEN   3392
#define XCD_BAR_WORDS 3456
#define XB_SPIN_CAP (1u << 18)

__device__ __forceinline__ unsigned xb_ld(unsigned* p)              { return __hip_atomic_load(p, __ATOMIC_RELAXED, __HIP_MEMORY_SCOPE_AGENT); }
__device__ __forceinline__ unsigned xb_add(unsigned* p, unsigned v) { return __hip_atomic_fetch_add(p, v, __ATOMIC_RELAXED, __HIP_MEMORY_SCOPE_AGENT); }
__device__ __forceinline__ unsigned xb_xcc_id() { return (unsigned)__builtin_amdgcn_s_getreg((3 << 11) | 20) & 0xFu; }
#define XB_SPIN(cond, bar) do { unsigned _sp = 0; while (cond) { __builtin_amdgcn_s_sleep(1); \
    if ((++_sp & 255u) == 0u) { if (xb_ld(&(bar)[XB_TMO])) break; if (_sp > XB_SPIN_CAP) { atomicAdd(&(bar)[XB_TMO], 1u); break; } } } } while (0)

struct XcdBarrier {
    unsigned* bar; unsigned x;
    volatile LAS unsigned* st;
};

__device__ __forceinline__ XcdBarrier xcd_barrier_post(unsigned* bar, volatile LAS unsigned* st, int tid) {
    XcdBarrier b; b.bar = bar; b.x = xb_xcc_id(); b.st = st;
    if (tid == 0) (void)xb_add(&bar[XB_XCNT(b.x)], 1u);
    return b;
}
__device__ __forceinline__ void xcd_barrier_complete(unsigned* bar, unsigned x, unsigned& nloc, unsigned& nx) {
    const unsigned G = gridDim.x * gridDim.y * gridDim.z;
    unsigned sum, cnt, mine, sp = 0u;
    for (;;) {
        sum = 0u; cnt = 0u; mine = 0u;
#pragma unroll
        for (unsigned j = 0; j < 16; ++j) { const unsigned c = xb_ld(&bar[XB_XCNT(j)]); sum += c; cnt += (c > 0u) ? 1u : 0u; mine = (j == x) ? c : mine; }
        if (sum == G) break;
        __builtin_amdgcn_s_sleep(1);
        if ((++sp & 255u) == 0u) { if (xb_ld(&bar[XB_TMO])) break; if (sp > XB_SPIN_CAP) { atomicAdd(&bar[XB_TMO], 1u); break; } }
    }
    nloc = mine > 0u ? mine : 1u; nx = cnt > 0u ? cnt : 1u;
}

__device__ __forceinline__ void xcd_barrier(const XcdBarrier& b, int tid) {
    asm volatile("s_waitcnt vmcnt(0)" ::: "memory");
    __syncthreads();
    if (tid == 0) {
        unsigned* bar = b.bar;
        __builtin_amdgcn_s_waitcnt(0);
        unsigned nloc = b.st[0], nx = b.st[1];
        if (nloc == 0u) { xcd_barrier_complete(bar, b.x, nloc, nx); b.st[0] = nloc; b.st[1] = nx; }
        const unsigned old = xb_add(&bar[XB_XSUB(b.x)], 1u);
        const unsigned gen = old / nloc;
        if (old + 1u == (gen + 1u) * nloc) {
            __builtin_amdgcn_fence(__ATOMIC_RELEASE, "agent");
            asm volatile("s_waitcnt vmcnt(0)" ::: "memory");
            const unsigned og = xb_add(&bar[XB_TOP], 1u);
            const unsigned tg = og / nx;
            if (og + 1u == (tg + 1u) * nx) xb_add(&bar[XB_TOPGEN], 1u);
            else XB_SPIN(xb_ld(&bar[XB_TOPGEN]) == tg, bar);
            __builtin_amdgcn_fence(__ATOMIC_ACQUIRE, "agent");
            xb_add(&bar[XB_XGEN(b.x)], 1u);
            asm volatile("s_waitcnt vmcnt(0)" ::: "memory");
        } else {
            XB_SPIN(xb_ld(&bar[XB_XGEN(b.x)]) == gen, bar);
            __builtin_amdgcn_fence(__ATOMIC_ACQUIRE, "agent");
            asm volatile("s_waitcnt vmcnt(0)" ::: "memory");
        }
    }
    __syncthreads();
}
struct Args { const float* in[N_IN]; float* out; unsigned char* ws; };
struct Ctx {
    LAS unsigned char* lds; unsigned char* ws; float* out;
    int tid, lane, wave, bid, G, gw, NGW;
};
__device__ __forceinline__ const float* inp_ld(int k) {
    asm volatile("" : "+s"(k));
    const __attribute__((address_space(4))) unsigned long long* tab = (const __attribute__((address_space(4))) unsigned long long*)__builtin_amdgcn_kernarg_segment_ptr();
    return (const float*)tab[k];
}
#define INP(k) inp_ld(k)
__device__ __forceinline__ int opq(int v) { asm volatile("" : "+v"(v)); return v; }

__device__ __forceinline__ void tr_item(const float* W, int ldw, bf16* WT, int ldt, int k0, int n0, int drow, int dcol, LAS float* scr, int lane) {
#pragma unroll 8
    for (int i = 0; i < 32; ++i) { const int kk = 2 * i + (lane >> 5); scr[kk * 33 + (lane & 31)] = W[(size_t)(k0 + kk) * ldw + n0 + (lane & 31)]; }
    LDS_WAIT(); asm volatile("" ::: "memory");
    const int c = lane & 7;
#pragma unroll
    for (int j = 0; j < 4; ++j) { const int n = (lane >> 3) + 8 * j; const LAS float* s = scr + (8 * c) * 33 + n;
        u32x4 o; o.x = pk2(s[0 * 33], s[1 * 33]); o.y = pk2(s[2 * 33], s[3 * 33]); o.z = pk2(s[4 * 33], s[5 * 33]); o.w = pk2(s[6 * 33], s[7 * 33]);
        *(u32x4*)(WT + (size_t)(drow + n) * ldt + dcol + 8 * c) = o; }
    LDS_WAIT(); asm volatile("" ::: "memory");
}
__device__ __forceinline__ void row_norm_in(const float* xrow, const float* g, bf16* orow, bf16* xcopy, int lane) {
    f32x4 v[4]; float ss = 0.f;
#pragma unroll
    for (int j = 0; j < 4; ++j) { v[j] = *(const f32x4*)(xrow + 4 * lane + 256 * j); ss += dot4(v[j], v[j]); }
    const float rs = rsqrtf(wave_sum(ss) * (1.f / DM) + 1e-6f);
#pragma unroll
    for (int j = 0; j < 4; ++j) { const f32x4 gg = *(const f32x4*)(g + 4 * lane + 256 * j); if (xcopy) st_bf4(xcopy + 4 * lane + 256 * j, v[j]); st_bf4(orow + 4 * lane + 256 * j, v[j] * rs * gg); }
}
__device__ __forceinline__ void row_norm(const bf16* xrow, const float* g, bf16* orow, int lane) {
    f32x4 v[4]; float ss = 0.f;
#pragma unroll
    for (int j = 0; j < 2; ++j) { ld_bf8(xrow + 8 * lane + 512 * j, v[2 * j], v[2 * j + 1]); ss += dot4(v[2 * j], v[2 * j]) + dot4(v[2 * j + 1], v[2 * j + 1]); }
    const float rs = rsqrtf(wave_sum(ss) * (1.f / DM) + 1e-6f);
#pragma unroll
    for (int j = 0; j < 2; ++j) { const float* gp = g + 8 * lane + 512 * j; st_bf8(orow + 8 * lane + 512 * j, v[2 * j] * rs * *(const f32x4*)gp, v[2 * j + 1] * rs * *(const f32x4*)(gp + 4)); }
}
__device__ __forceinline__ void row_update_parts(const float* p0, const float* p1, const float* bias, const float* gA, bf16* X, const float* gB, bf16* outB, int lane) {
    f32x4 a[4], x[4]; float ss = 0.f;
#pragma unroll
    for (int j = 0; j < 4; ++j) { a[j] = *(const f32x4*)(p0 + 4 * lane + 256 * j) + *(const f32x4*)(p1 + 4 * lane + 256 * j); if (bias) a[j] = a[j] + *(const f32x4*)(bias + 4 * lane + 256 * j);
        x[j] = ld_bf4(X + 4 * lane + 256 * j); ss += dot4(a[j], a[j]); }
    const float rs = rsqrtf(wave_sum(ss) * (1.f / DM) + 1e-6f); float s2 = 0.f;
#pragma unroll
    for (int j = 0; j < 4; ++j) { const f32x4 gg = *(const f32x4*)(gA + 4 * lane + 256 * j); x[j] = x[j] + a[j] * rs * gg; st_bf4(X + 4 * lane + 256 * j, x[j]); s2 += dot4(x[j], x[j]); }
    float r2 = 1.f;
    if (gB) r2 = rsqrtf(wave_sum(s2) * (1.f / DM) + 1e-6f);
#pragma unroll
    for (int j = 0; j < 4; ++j) { f32x4 o = x[j]; if (gB) o = o * r2 * *(const f32x4*)(gB + 4 * lane + 256 * j); st_bf4(outB + 4 * lane + 256 * j, o); }
}
__device__ __forceinline__ void row_update(const bf16* add, const float* gA, bf16* X, const float* gB, bf16* outB, int lane) {
    f32x4 a[4], x[4]; float ss = 0.f;
#pragma unroll
    for (int j = 0; j < 2; ++j) { ld_bf8(add + 8 * lane + 512 * j, a[2 * j], a[2 * j + 1]); ld_bf8(X + 8 * lane + 512 * j, x[2 * j], x[2 * j + 1]); ss += dot4(a[2 * j], a[2 * j]) + dot4(a[2 * j + 1], a[2 * j + 1]); }
    const float rs = rsqrtf(wave_sum(ss) * (1.f / DM) + 1e-6f); float s2 = 0.f;
#pragma unroll
    for (int j = 0; j < 2; ++j) { const float* gp = gA + 8 * lane + 512 * j; x[2 * j] = x[2 * j] + a[2 * j] * rs * *(const f32x4*)gp; x[2 * j + 1] = x[2 * j + 1] + a[2 * j + 1] * rs * *(const f32x4*)(gp + 4);
        st_bf8(X + 8 * lane + 512 * j, x[2 * j], x[2 * j + 1]); s2 += dot4(x[2 * j], x[2 * j]) + dot4(x[2 * j + 1], x[2 * j + 1]); }
    float r2 = 1.f;
    if (gB) r2 = rsqrtf(wave_sum(s2) * (1.f / DM) + 1e-6f);
#pragma unroll
    for (int j = 0; j < 2; ++j) { f32x4 o0 = x[2 * j], o1 = x[2 * j + 1]; if (gB) { const float* gp = gB + 8 * lane + 512 * j; o0 = o0 * r2 * *(const f32x4*)gp; o1 = o1 * r2 * *(const f32x4*)(gp + 4); } st_bf8(outB + 8 * lane + 512 * j, o0, o1); }
}

__device__ __forceinline__ void convert_layer(const Ctx& C, const Args& A, int l, int gw0, int ngw, int gt, int NT) {
    LAS float* scr = (LAS float*)(C.lds + C.wave * 16384);
    constexpr int J0 = 16 * 72, J1 = 16 * 32, J2 = 16 * 88, J4 = 44 * 32, J5 = 16 * 32, J6 = 4 * 32, JL = J0 + J1 + 2 * J2 + J4 + J5 + J6;
    unsigned char* wl = C.ws + WS_W + (size_t)(l & 1) * WL;
    for (int it = gw0; it < JL; it += ngw) {
        int r = it;
        const float* W; int ldw, ldt, kb, nb, drow; bf16* WT;
        if (r < J0) { W = INP(I_WIN) + (size_t)l * DM * INC; ldw = INC; WT = (bf16*)(wl + O_WIN); ldt = DM; kb = r / 72; nb = r % 72; drow = 32 * nb; }
        else if ((r -= J0) < J1) { W = INP(I_WOUT) + (size_t)l * DM * DM; ldw = DM; WT = (bf16*)(wl + O_WOUT); ldt = DM; kb = r / 32; nb = r % 32; drow = 32 * nb; }
        else if ((r -= J1) < J2) { W = INP(I_WG) + (size_t)l * DM * DFF; ldw = DFF; WT = (bf16*)(wl + O_WGU); ldt = DM; kb = r / 88; nb = r % 88; drow = (nb >> 2) * 256 + (nb & 3) * 32; }
        else if ((r -= J2) < J2) { W = INP(I_WU) + (size_t)l * DM * DFF; ldw = DFF; WT = (bf16*)(wl + O_WGU); ldt = DM; kb = r / 88; nb = r % 88; drow = (nb >> 2) * 256 + 128 + (nb & 3) * 32; }
        else if ((r -= J2) < J4) { W = INP(I_WDN) + (size_t)l * DFF * DM; ldw = DM; WT = (bf16*)(wl + O_WD); ldt = DFF; kb = r / 32; nb = r % 32; drow = 32 * nb; }
        else if ((r -= J4) < J5) { W = INP(I_PGW) + (size_t)l * DM * DM; ldw = DM; WT = (bf16*)(wl + O_WPG); ldt = DM; kb = r / 32; nb = r % 32; drow = 32 * nb; }
        else { r -= J5; W = INP(I_PW) + (size_t)l * PLE * DM; ldw = DM; WT = (bf16*)(wl + O_WP); ldt = PLE; kb = r / 32; nb = r % 32; drow = 32 * nb; }
        tr_item(W, ldw, WT, ldt, 64 * kb, 32 * nb, drow, 64 * kb, scr, C.lane);
    }
#pragma unroll 1
    for (int r = gt; r < N2 * K2; r = opq(r + NT)) {
        const int n = r / K2, k = r % K2; float v = 0.f;
        if (n < 256) { if (k < 64) v = INP(I_WUP)[((size_t)l * 64 + k) * 256 + n]; }
        else if (n < 512) { if (k >= 64 && k < 128) v = INP(I_AUP)[((size_t)l * 64 + (k - 64)) * 256 + (n - 256)]; }
        else if (n < 768) { if (k >= 128 && k < 256) v = INP(I_GUP)[((size_t)l * 128 + (k - 128)) * 256 + (n - 512)]; }
        else { const int tt = (n - 768) >> 8, rr = (n - 768) & 255, cc = 128 * tt + (rr & 127), h = cc >> 6, j = cc & 63;
            if (k >= 256 && ((k - 256) >> 6) == h) v = ((rr >> 7) ? INP(I_WI) : INP(I_WA))[(((size_t)l * 4 + h) * 64 + ((k - 256) & 63)) * 64 + j]; }
        ((bf16*)(wl + O_W2))[r] = (bf16)f2bf(v);
    }
#pragma unroll 1
    for (int r = gt; r < M * (PLE / 4); r = opq(r + NT)) {
        const int m = r >> 6, c4 = (r & 63) * 4;
        const float* src = m < MP ? INP(I_PP) + ((size_t)l * MP + m) * PLE + c4 : INP(I_PS) + ((size_t)l * MS + (m - MP)) * PLE + c4;
        st_bf4((bf16*)(C.ws + WS_PB + (size_t)(l & 1) * SZ_PBL) + (size_t)m * PLE + c4, *(const f32x4*)src);
    }
}
__device__ __forceinline__ void p0_prologue(const Ctx& C, const Args& A) {
    convert_layer(C, A, 0, C.gw, C.NGW, C.bid * 512 + C.tid, C.G * 512);
    for (int m = C.gw; m < M; m += C.NGW) {
        const float* src = m < MP ? INP(I_XP) + (size_t)m * DM : INP(I_XS) + (size_t)(m - MP) * DM;
        row_norm_in(src, INP(I_NMPRE), (bf16*)(C.ws + WS_HN) + (size_t)m * DM, (bf16*)(C.ws + WS_X16) + (size_t)m * DM, C.lane);
    }
}

__device__ __forceinline__ void e1_prep(const Ctx& C, const Args& A, int l) {
    const bf16* PROJ = (const bf16*)(C.ws + WS_R1);
    bf16* R = (bf16*)(C.ws + WS_R2); bf16* Ks = (bf16*)(C.ws + WS_R2 + SZ_F256); bf16* V = (bf16*)(C.ws + WS_R2 + 2 * SZ_F256); bf16* KK = (bf16*)(C.ws + WS_R2 + 3 * SZ_F256);
    bf16* A2 = (bf16*)(C.ws + WS_R3);
    const int lane = C.lane, c4 = 4 * lane;
    for (int m = C.gw; m < M; m += C.NGW) {
        const bool samp = m >= MP; int b, t;
        if (!samp) { b = m >> 12; t = m & 4095; } else { b = (m - MP) >> 2; t = (m - MP) & 3; }
        const bf16* pr = PROJ + (size_t)m * INC;
#pragma unroll
        for (int cg = 0; cg < 4; ++cg) {
            const int col = 256 * cg + c4;
            const f32x4 cur = ld_bf4(pr + C_RW + col); f32x4 prv = (f32x4){0.f, 0.f, 0.f, 0.f};
            if (t > 0) prv = ld_bf4(pr - INC + C_RW + col);
            else if (samp) prv = *(const f32x4*)(INP(I_SSH) + ((size_t)l * DB + b) * 1024 + col);
            const f32x4 mu = *(const f32x4*)(INP(I_MU) + l * 1024 + col);
            const f32x4 xs = cur + (prv - cur) * mu;
            if (cg == 0) st_bf4(R + (size_t)m * 256 + c4, xs);
            else if (cg == 1) { st_bf4(Ks + (size_t)m * 256 + c4, xs); f32x4 kk = xs * *(const f32x4*)(INP(I_KK) + l * 256 + c4);
                const float ss = red16(dot4(kk, kk)); kk = kk * rsqrtf(fmaxf(ss, 1e-24f)); st_bf4(KK + (size_t)m * 256 + c4, kk); }
            else if (cg == 2) st_bf4(V + (size_t)m * 256 + c4, xs);
            else { f32x4 o;
                if (lane < 16) o = (f32x4){tanh_(xs.x), tanh_(xs.y), tanh_(xs.z), tanh_(xs.w)};
                else if (lane < 32) o = xs;
                else o = (f32x4){sigm(xs.x), sigm(xs.y), sigm(xs.z), sigm(xs.w)};
                st_bf4(A2 + (size_t)m * K2 + c4, o); }
        }
        f32x4 xc = *(const f32x4*)(INP(I_CB) + l * 256 + c4);
#pragma unroll
        for (int j = 0; j < 4; ++j) { const int tt = t - 3 + j; f32x4 val = (f32x4){0.f, 0.f, 0.f, 0.f};
            if (tt >= 0) val = ld_bf4(pr + (ptrdiff_t)(j - 3) * INC + C_XB + c4);
            else if (samp) val = *(const f32x4*)(INP(I_SCV) + (((size_t)l * DB + b) * 3 + (tt + 3)) * 256 + c4);
            xc = xc + val * *(const f32x4*)(INP(I_CW) + ((size_t)l * 4 + j) * 256 + c4); }
        st_bf4(A2 + (size_t)m * K2 + 256 + c4, xc);
    }
    const int gt = C.bid * 512 + C.tid, NT = C.G * 512;
    float* out = C.out;
#pragma unroll 1
    for (int e = gt; e < 2 * NBP * 128 * 128; e = opq(e + NT)) {
        const int kv = e / (NBP * 16384), r = e % (NBP * 16384), b = r >> 14, rr = (r >> 7) & 127, c = r & 127;
        out[(kv ? OUT_VP : OUT_KP) + (size_t)l * NBP * 16384 + r] = bf1(PROJ[(size_t)(b * T + T - 128 + rr) * INC + (kv ? C_V : C_K) + c]);
    }
#pragma unroll 1
    for (int e = gt; e < NBP * 1024; e = opq(e + NT)) { const int b = e >> 10, c = e & 1023; out[OUT_SHP + (size_t)l * NBP * 1024 + e] = bf1(PROJ[(size_t)(b * T + T - 1) * INC + C_RW + c]); }
#pragma unroll 1
    for (int e = gt; e < DB * 1024; e = opq(e + NT)) { const int b = e >> 10, c = e & 1023; out[OUT_SHS + (size_t)l * DB * 1024 + e] = bf1(PROJ[(size_t)(MP + 4 * b + 3) * INC + C_RW + c]); }
#pragma unroll 1
    for (int e = gt; e < NBP * 768; e = opq(e + NT)) { const int b = e / 768, j = (e % 768) >> 8, c = e & 255; out[OUT_CVP + (size_t)l * NBP * 768 + e] = bf1(PROJ[(size_t)(b * T + T - 3 + j) * INC + C_XB + c]); }
#pragma unroll 1
    for (int e = gt; e < DB * 768; e = opq(e + NT)) { const int b = e / 768, j = (e % 768) >> 8, c = e & 255; out[OUT_CVS + (size_t)l * DB * 768 + e] = bf1(PROJ[(size_t)(MP + 4 * b + 1 + j) * INC + C_XB + c]); }
}

struct RwkvPtrs { const bf16 *R, *K, *V, *KK, *BV; const float* W; float* YR; };
__device__ __forceinline__ void rwkv_step(f32x4& s, const f32x4 w, const f32x4 kk, const f32x4 bv, const f32x4 k2, const f32x4 r, const float v, float& y) {
    const float sa = red16(dot4(s, kk));
    s = s * w + (k2 * v - bv * sa);
    y = red16(dot4(s, r));
}
__device__ __forceinline__ void rwkv_prompt(const Ctx& C, const RwkvPtrs& P, int wg, float* wkv_out  ) {
    constexpr int TC = 32, VEC = TC * 64 * 4, O_V = 5 * VEC, BUF = O_V + TC * 16 * 4, O_Q = 2 * BUF;
    static_assert(O_Q + TC * 1024 <= 131072, "LDS");
    const int chain = wg >> 2, b = chain >> 2, h = chain & 3, qr = wg & 3, tid = C.tid, lane = C.lane, wave = C.wave;
    const size_t m0 = (size_t)b * T;
    const int ltid = tid - 256, lstep = ltid >> 4, lq = tid & 15;
    const int vstep = ltid >> 2, vq = ltid & 3;
    f32x4 st[2][5], stv;
    f32x4 s = (f32x4){0.f, 0.f, 0.f, 0.f};
    const int row = 16 * qr + 4 * wave + (lane >> 4), cq = lane & 15;
#define RW_LOAD(c) do { if (wave >= 4) { _Pragma("unroll") for (int u = 0; u < 2; ++u) { const size_t o_ = (m0 + (size_t)(c) * TC + lstep + 16 * u) * 256 + h * 64 + 4 * lq; \
        st[u][0] = *(const f32x4*)(P.W + o_); st[u][1] = ld_bf4(P.KK + o_); st[u][2] = ld_bf4(P.BV + o_); st[u][3] = ld_bf4(P.K + o_); st[u][4] = ld_bf4(P.R + o_); } \
        if (ltid < 128) stv = ld_bf4(P.V + (m0 + (size_t)(c) * TC + vstep) * 256 + h * 64 + 16 * qr + 4 * vq); } } while (0)
#define RW_STORE(bufi) do { if (wave >= 4) { LAS unsigned char* bb = C.lds + (bufi) * BUF; _Pragma("unroll") for (int u = 0; u < 2; ++u) { const int ls = lstep + 16 * u; \
        _Pragma("unroll") for (int i = 0; i < 5; ++i) *(LAS f32x4*)(bb + i * VEC + (ls * 64 + 4 * lq) * 4) = st[u][i]; } \
        if (ltid < 128) *(LAS f32x4*)(bb + O_V + (vstep * 16 + 4 * vq) * 4) = stv; } } while (0)
#define RW_FLUSH(cc, half) do { if (wave >= 4) { const int stp = lstep + 16 * (half); const LAS f32x4* qp = (const LAS f32x4*)(C.lds + O_Q + stp * 1024 + (lq >> 2) * 256 + (lq & 3) * 64); \
        const f32x4 a0 = qp[0], a1_ = qp[1], a2_ = qp[2], a3 = qp[3]; const f32x4 t_ = (a0 + a1_) + (a2_ + a3); \
        P.YR[(m0 + (size_t)(cc) * TC + stp) * 256 + h * 64 + 16 * qr + lq] = (t_.x + t_.y) + (t_.z + t_.w); } } while (0)
    RW_LOAD(0); RW_STORE(0); __syncthreads();
    for (int c = 0; c < T / TC; ++c) {
        if (c > 0) RW_FLUSH(c - 1, 1);
        if (c + 1 < T / TC) RW_LOAD(c + 1);
        if (wave < 4) {
            const LAS unsigned char* bb = C.lds + (c & 1) * BUF;
            const int vo = O_V + (4 * wave + (lane >> 4)) * 4, lo = 16 * cq;
            LAS float* ring = (LAS float*)(C.lds + O_Q) + wave * 64 + lane;
            f32x4 w = *(const LAS f32x4*)(bb + 0 * VEC + lo), kk = *(const LAS f32x4*)(bb + 1 * VEC + lo), bv = *(const LAS f32x4*)(bb + 2 * VEC + lo),
                  k2 = *(const LAS f32x4*)(bb + 3 * VEC + lo), r = *(const LAS f32x4*)(bb + 4 * VEC + lo), rp = r;
            float v = *(const LAS float*)(bb + vo), qpend = 0.f;
            const unsigned b1 = (unsigned)(unsigned long long)(bb + lo), b2 = (unsigned)(unsigned long long)(bb + vo), qa = (unsigned)(unsigned long long)ring;
            f32x4 nw, nkk, nbv, nk2, nr; float nv;
#define RW_A_DOT "v_mul_f32 %6, %10, %14\n\tv_fma_f32 %6, %11, %15, %6\n\tv_fma_f32 %6, %12, %16, %6\n\tv_fma_f32 %6, %13, %17, %6"
#define RW_A_RD "ds_read_b128 %0, %7 offset:%c19\n\tds_read_b128 %1, %7 offset:%c20\n\tds_read_b128 %2, %7 offset:%c21\n\tds_read_b128 %3, %7 offset:%c22\n\tds_read_b128 %4, %7 offset:%c23\n\tds_read_b32 %5, %8 offset:%c24\n\t"
#define RW_A_OPS(IN, WO) : "=&v"(nw), "=&v"(nkk), "=&v"(nbv), "=&v"(nk2), "=&v"(nr), "=&v"(nv), "=&v"(sa) \
                 : "v"(b1), "v"(b2), "v"(qa), "v"(s.x), "v"(s.y), "v"(s.z), "v"(s.w), "v"(kk.x), "v"(kk.y), "v"(kk.z), "v"(kk.w), "v"(qpend), \
                   "n"(0 * VEC + (IN) * 256), "n"(1 * VEC + (IN) * 256), "n"(2 * VEC + (IN) * 256), "n"(3 * VEC + (IN) * 256), "n"(4 * VEC + (IN) * 256), "n"((IN) * 64), "n"(WO) : "memory"
#define RW_STEP(I, IN) { float sa, q, t0, t1, t2, t3; \
                if ((I) < 2 || (I) == 16 || (I) == 17) asm volatile(RW_A_RD "s_waitcnt lgkmcnt(6)\n\t" RW_A_DOT RW_A_OPS(IN, 0)); \
                else asm volatile("ds_write_b32 %9, %18 offset:%c25\n\t" RW_A_RD "s_waitcnt lgkmcnt(7)\n\t" RW_A_DOT RW_A_OPS(IN, ((I) >= 2 ? (I) - 2 : 0) * 1024)); \
                asm volatile("v_mul_f32 %2, %6, %10\n\tv_mul_f32 %3, %7, %10\n\t" \
                             "v_add_f32_dpp %0, %0, %0 quad_perm:[1,0,3,2] row_mask:0xf bank_mask:0xf bound_ctrl:1\n\t" \
                             "v_mul_f32 %1, %11, %15\n\tv_fma_f32 %1, %12, %16, %1\n\t" \
                             "v_add_f32_dpp %0, %0, %0 quad_perm:[2,3,0,1] row_mask:0xf bank_mask:0xf bound_ctrl:1\n\t" \
                             "v_fma_f32 %1, %13, %17, %1\n\tv_fma_f32 %1, %14, %18, %1\n\t" \
                             "v_add_f32_dpp %0, %0, %0 row_half_mirror row_mask:0xf bank_mask:0xf bound_ctrl:1\n\t" \
                             "v_mul_f32 %4, %8, %10\n\tv_mul_f32 %5, %9, %10\n\t" \
                             "v_add_f32_dpp %0, %0, %0 row_ror:8 row_mask:0xf bank_mask:0xf bound_ctrl:1" \
                             : "+v"(sa), "=&v"(q), "=&v"(t0), "=&v"(t1), "=&v"(t2), "=&v"(t3) \
                             : "v"(k2.x), "v"(k2.y), "v"(k2.z), "v"(k2.w), "v"(v), "v"(s.x), "v"(s.y), "v"(s.z), "v"(s.w), "v"(rp.x), "v"(rp.y), "v"(rp.z), "v"(rp.w)); \
                asm volatile("v_fma_f32 %4, -%8, %9, %4\n\tv_fma_f32 %5, -%8, %10, %5\n\tv_fma_f32 %6, -%8, %11, %6\n\tv_fma_f32 %7, -%8, %12, %7\n\t" \
                             "v_fma_f32 %0, %0, %13, %4\n\tv_fma_f32 %1, %1, %14, %5\n\tv_fma_f32 %2, %2, %15, %6\n\tv_fma_f32 %3, %3, %16, %7" \
                             : "+v"(s.x), "+v"(s.y), "+v"(s.z), "+v"(s.w), "+v"(t0), "+v"(t1), "+v"(t2), "+v"(t3) \
                             : "v"(sa), "v"(bv.x), "v"(bv.y), "v"(bv.z), "v"(bv.w), "v"(w.x), "v"(w.y), "v"(w.z), "v"(w.w)); \
                qpend = q; rp = r; w = nw; kk = nkk; bv = nbv; k2 = nk2; r = nr; v = nv; }
#define RW_STEP4(I) RW_STEP(I, (I) + 1) RW_STEP((I) + 1, (I) + 2) RW_STEP((I) + 2, (I) + 3) RW_STEP((I) + 3, ((I) + 4 < TC ? (I) + 4 : TC - 1))
#define RW_HALF_END(h0) do { asm volatile("s_waitcnt lgkmcnt(0)" :: "v"(w), "v"(kk), "v"(bv), "v"(k2), "v"(r), "v"(v) : "memory"); \
                ring[((h0) + 14) * 256] = qpend; ring[((h0) + 15) * 256] = dot4(s, rp); } while (0)
            RW_STEP4(0) RW_STEP4(4) RW_STEP4(8) RW_STEP4(12)
            RW_HALF_END(0);
            __syncthreads();
            RW_STEP4(16) RW_STEP4(20) RW_STEP4(24) RW_STEP4(28)
            RW_HALF_END(16);
#undef RW_HALF_END
#undef RW_STEP4
#undef RW_STEP
#undef RW_A_OPS
#undef RW_A_RD
#undef RW_A_DOT
        } else {
            __syncthreads();
            RW_FLUSH(c, 0);
        }
        if (c + 1 < T / TC) RW_STORE((c + 1) & 1);
        __syncthreads();
    }
    RW_FLUSH(T / TC - 1, 1);
#undef RW_LOAD
#undef RW_STORE
#undef RW_FLUSH
    if (wave < 4) *(f32x4*)(wkv_out + (((size_t)b * 4 + h) * 64 + row) * 64 + 4 * cq) = s;
    __syncthreads();
}
__device__ __forceinline__ void rwkv_sample_item(const RwkvPtrs& P, int item, const float* wkv_in, float* wkv_out, int lane) {
    const int rg = item & 15, h = (item >> 4) & 3, b = item >> 6, row = 4 * rg + (lane >> 4), cq = lane & 15;
    const size_t so = (((size_t)b * 4 + h) * 64 + row) * 64 + 4 * cq;
    f32x4 s = *(const f32x4*)(wkv_in + so);
#pragma unroll
    for (int i = 0; i < DS; ++i) { const size_t m = (size_t)MP + 4 * b + i, o = m * 256 + h * 64 + 4 * cq;
        float y; rwkv_step(s, *(const f32x4*)(P.W + o), ld_bf4(P.KK + o), ld_bf4(P.BV + o), ld_bf4(P.K + o), ld_bf4(P.R + o), bf1(P.V[m * 256 + h * 64 + row]), y);
        if (cq == 0) P.YR[m * 256 + h * 64 + row] = y; }
    *(f32x4*)(wkv_out + so) = s;
}
__device__ __forceinline__ void lru_prompt_item(const Ctx& C, int item, const float* AL, const float* U, const bf16* PROJ, bf16* MIXCAT, float* lru_out  ) {
    const int b = item >> 4, c = (item & 15) * 16 + (C.tid & 15), seg = C.tid >> 4; constexpr int SL = T / 32;
    const size_t m0 = (size_t)b * T + (size_t)seg * SL;
    LAS float* sA = (LAS float*)C.lds; LAS float* sH = sA + 512;
    float Ap = 1.f, H = 0.f;
#pragma unroll 8
    for (int i = 0; i < SL; ++i) { const float a = AL[(m0 + i) * 256 + c], u = U[(m0 + i) * 256 + c]; H = a * H + u; Ap *= a; }
    sA[C.tid] = Ap; sH[C.tid] = H;
    __syncthreads();
    float h = 0.f;
    for (int sp = 0; sp < seg; ++sp) h = sA[sp * 16 + (C.tid & 15)] * h + sH[sp * 16 + (C.tid & 15)];
#pragma unroll 8
    for (int i = 0; i < SL; ++i) { const float a = AL[(m0 + i) * 256 + c], u = U[(m0 + i) * 256 + c]; h = a * h + u;
        const float gb = bf1(PROJ[(m0 + i) * INC + C_GB + c]); MIXCAT[(m0 + i) * DM + 768 + c] = (bf16)f2bf(h * gelu_t(gb)); }
    if (seg == 31) lru_out[b * 256 + c] = h;
    __syncthreads();
}
__device__ __forceinline__ void swa_prompt_item(const Ctx& C, int item, const bf16* PROJ, bf16* MIXCAT, const float* sinks  ) {
    constexpr int KP = 72, VP = 264;
    const int kvh = item & 1, n = (item >> 1) & 31, b = item >> 6, tid = C.tid, lane = C.lane, wave = C.wave;
    LAS bf16* Ks = (LAS bf16*)C.lds; LAS bf16* Vt = Ks + 256 * KP;
    const size_t rowq0 = (size_t)b * T + (size_t)n * 128;
    { const int key = tid >> 1, hf = tid & 1; size_t kr = rowq0 + key; kr = (kr >= 128 + (size_t)b * T) ? kr - 128 : kr;
        const bf16* kp = PROJ + kr * INC + C_K + kvh * 64 + hf * 32;
#pragma unroll
        for (int i = 0; i < 4; ++i) *(LAS u32x4*)(Ks + key * KP + hf * 32 + 8 * i) = *(const u32x4*)(kp + 8 * i);
#pragma unroll
        for (int i = 0; i < 4; ++i) { const int ch = tid + 512 * i, vk = ch >> 3, d0 = (ch & 7) * 8; size_t vr = rowq0 + vk; vr = (vr >= 128 + (size_t)b * T) ? vr - 128 : vr;
            const u32x4 w = *(const u32x4*)(PROJ + vr * INC + C_V + kvh * 64 + d0);
            Vt[(d0 + 0) * VP + vk] = (bf16)(w.x & 0xffff); Vt[(d0 + 1) * VP + vk] = (bf16)(w.x >> 16); Vt[(d0 + 2) * VP + vk] = (bf16)(w.y & 0xffff); Vt[(d0 + 3) * VP + vk] = (bf16)(w.y >> 16);
            Vt[(d0 + 4) * VP + vk] = (bf16)(w.z & 0xffff); Vt[(d0 + 5) * VP + vk] = (bf16)(w.z >> 16); Vt[(d0 + 6) * VP + vk] = (bf16)(w.w & 0xffff); Vt[(d0 + 7) * VP + vk] = (bf16)(w.w >> 16); } }
    __syncthreads();
    const int q = lane & 31, hi = lane >> 5;
#pragma unroll 1
    for (int qi = 0; qi < 2; ++qi) {
        const int qt = wave * 2 + qi, g = qt >> 2, j = qt & 3, hh = kvh * 4 + g;
        const size_t qrow = rowq0 + 32 * j + q;
        bf16x8 qf[4];
#pragma unroll
        for (int dk = 0; dk < 4; ++dk) qf[dk] = *(const bf16x8*)(PROJ + qrow * INC + hh * 64 + 16 * dk + 8 * hi);
        f32x16 sc[5];
#pragma unroll
        for (int kt = 0; kt < 5; ++kt) {
            f32x16 acc;
#pragma unroll
            for (int i = 0; i < 16; ++i) acc[i] = 0.f;
#pragma unroll
            for (int dk = 0; dk < 4; ++dk) { const bf16x8 kf = *(const LAS bf16x8*)(Ks + (32 * (j + kt) + q) * KP + 16 * dk + 8 * hi); acc = __builtin_amdgcn_mfma_f32_32x32x16_bf16(kf, qf[dk], acc, 0, 0, 0); }
            sc[kt] = acc;
        }
        const int qpos = 128 + 32 * j + q; float mx = -INFINITY;
#pragma unroll
        for (int kt = 0; kt < 5; ++kt)
#pragma unroll
            for (int i = 0; i < 16; ++i) { const int kj = 32 * (j + kt) + (i & 3) + 8 * (i >> 2) + 4 * hi, d = qpos - kj; const bool ok = d >= 0 && d <= 128 && (n > 0 || kj >= 128);
                const float sv = ok ? sc[kt][i] * 0.125f : -INFINITY; sc[kt][i] = sv; mx = fmaxf(mx, sv); }
        mx = fmaxf(mx, shx(mx, 32, lane)); const float sink = sinks[hh]; mx = fmaxf(mx, sink);
        float sum = 0.f;
#pragma unroll
        for (int kt = 0; kt < 5; ++kt)
#pragma unroll
            for (int i = 0; i < 16; ++i) { const float e = __expf(sc[kt][i] - mx); sc[kt][i] = e; sum += e; }
        sum += shx(sum, 32, lane);
        const float inv = 1.f / (sum + __expf(sink - mx));
#pragma unroll
        for (int dt = 0; dt < 2; ++dt) {
            f32x16 o;
#pragma unroll
            for (int i = 0; i < 16; ++i) o[i] = 0.f;
#pragma unroll
            for (int kt = 0; kt < 5; ++kt)
#pragma unroll
                for (int s2 = 0; s2 < 2; ++s2) {
                    u32x4 pw; pw.x = pk2(sc[kt][8 * s2 + 0], sc[kt][8 * s2 + 1]); pw.y = pk2(sc[kt][8 * s2 + 2], sc[kt][8 * s2 + 3]); pw.z = pk2(sc[kt][8 * s2 + 4], sc[kt][8 * s2 + 5]); pw.w = pk2(sc[kt][8 * s2 + 6], sc[kt][8 * s2 + 7]);
                    const LAS bf16* vp = Vt + (32 * dt + q) * VP + 32 * (j + kt) + 16 * s2 + 4 * hi;
                    const u32x2 v0 = *(const LAS u32x2*)vp, v1 = *(const LAS u32x2*)(vp + 8);
                    u32x4 vw; vw.x = v0.x; vw.y = v0.y; vw.z = v1.x; vw.w = v1.y;
                    o = __builtin_amdgcn_mfma_f32_32x32x16_bf16(__builtin_bit_cast(bf16x8, vw), __builtin_bit_cast(bf16x8, pw), o, 0, 0, 0);
                }
#pragma unroll
            for (int g4 = 0; g4 < 4; ++g4) st_bf4(MIXCAT + qrow * DM + hh * 64 + 32 * dt + 8 * g4 + 4 * hi, (f32x4){o[4 * g4] * inv, o[4 * g4 + 1] * inv, o[4 * g4 + 2] * inv, o[4 * g4 + 3] * inv});
        }
    }
    __syncthreads();
}
__device__ __forceinline__ void swa_sample_item(const Ctx& C, int item, const bf16* PROJ, bf16* MIXCAT, const float* sinks, const float* ck, const float* cv, float* ko, float* vo) {
    const int kvh = item & 1, b = item >> 1, tid = C.tid;
    LAS float* Kf = (LAS float*)C.lds; LAS float* Vf = Kf + 132 * 65; LAS float* Qf = Vf + 132 * 64; LAS float* Pf = Qf + 16 * 64;
    for (int e = tid; e < 132 * 64; e += 512) { const int key = e >> 6, d = e & 63; float kx, vx;
        if (key < 128) { const size_t o = (((size_t)b * 128 + key) * 2 + kvh) * 64 + d; kx = ck[o]; vx = cv[o]; }
        else { const size_t r = (size_t)MP + 4 * b + (key - 128); kx = bf1(PROJ[r * INC + C_K + kvh * 64 + d]); vx = bf1(PROJ[r * INC + C_V + kvh * 64 + d]); }
        Kf[key * 65 + d] = kx; Vf[key * 64 + d] = vx;
        if (key >= 4) { const size_t o = (((size_t)b * 128 + (key - 4)) * 2 + kvh) * 64 + d; ko[o] = kx; vo[o] = vx; } }
    for (int e = tid; e < 16 * 64; e += 512) { const int qr = e >> 6, d = e & 63, i = qr >> 2, g = qr & 3; Qf[e] = bf1(PROJ[((size_t)MP + 4 * b + i) * INC + (kvh * 4 + g) * 64 + d]); }
    __syncthreads();
    { const int qr = tid >> 5, kl = tid & 31, i = qr >> 2, g = qr & 3; float sc[5]; float mx = -INFINITY;
#pragma unroll
        for (int k5 = 0; k5 < 5; ++k5) { const int key = kl + 32 * k5; float sv = -INFINITY;
            if (key < 132 && key >= i && key <= i + 128) { float a = 0.f;
#pragma unroll 16
                for (int d = 0; d < 64; ++d) a += Qf[qr * 64 + d] * Kf[key * 65 + d];
                sv = a * 0.125f; }
            sc[k5] = sv; mx = fmaxf(mx, sv); }
#pragma unroll
        for (int o = 1; o < 32; o <<= 1) mx = fmaxf(mx, shx(mx, o, C.lane));
        const float sink = sinks[kvh * 4 + g]; mx = fmaxf(mx, sink); float sum = 0.f;
#pragma unroll
        for (int k5 = 0; k5 < 5; ++k5) { sc[k5] = __expf(sc[k5] - mx); sum += sc[k5]; }
#pragma unroll
        for (int o = 1; o < 32; o <<= 1) sum += shx(sum, o, C.lane);
        const float inv = 1.f / (sum + __expf(sink - mx));
#pragma unroll
        for (int k5 = 0; k5 < 5; ++k5) { const int key = kl + 32 * k5; if (key < 136) Pf[qr * 136 + key] = sc[k5] * inv; } }
    __syncthreads();
    { const int qr = tid >> 5, d = (tid & 31) * 2, i = qr >> 2, g = qr & 3; float o0 = 0.f, o1 = 0.f;
#pragma unroll 4
        for (int key = 0; key < 132; ++key) { const float p = Pf[qr * 136 + key]; o0 += p * Vf[key * 64 + d]; o1 += p * Vf[key * 64 + d + 1]; }
        *(unsigned*)(MIXCAT + ((size_t)MP + 4 * b + i) * DM + (kvh * 4 + g) * 64 + d) = pk2(o0, o1); }
    __syncthreads();
}

__device__ __forceinline__ void s_phase(const Ctx& C, const Args& A, int l) {
    const bf16* PROJ = (const bf16*)(C.ws + WS_R1); bf16* MIXCAT = (bf16*)(C.ws + WS_HN);
    float* R = (float*)(C.ws + WS_R2); const size_t S = (size_t)M * 256;
    RwkvPtrs P{(const bf16*)R, (const bf16*)(R + S), (const bf16*)(R + 2 * S), (const bf16*)(R + 3 * S), (const bf16*)(R + 4 * S), R + 5 * S, (float*)(C.ws + WS_R3)};
    const float* AL = (const float*)(C.ws + WS_R3) + S; const float* U = AL + S;
    float* out = C.out;
    constexpr int NSCAN = 64;
    if (C.bid < NSCAN) { rwkv_prompt(C, P, C.bid, out + OUT_WKVP + (size_t)l * NBP * 4 * 4096); return; }
    constexpr int N0 = 256, N1 = N0 + 64, N2_ = N1 + 256, N3 = N2_ + 1024, N4 = N3 + 64;
    for (int it = C.bid - NSCAN; it < N4; it += C.G - NSCAN) {
        if (it < N0) swa_prompt_item(C, it, PROJ, MIXCAT, INP(I_SINK) + l * 8);
        else if (it < N1) lru_prompt_item(C, it - N0, AL, U, PROJ, MIXCAT, out + OUT_LRP + (size_t)l * NBP * 256);
        else if (it < N2_) swa_sample_item(C, it - N1, PROJ, MIXCAT, INP(I_SINK) + l * 8, INP(I_CK) + (size_t)l * DB * 16384, INP(I_CV) + (size_t)l * DB * 16384,
                                          out + OUT_KS + (size_t)l * DB * 16384, out + OUT_VS + (size_t)l * DB * 16384);
        else if (it < N3) rwkv_sample_item(P, (it - N2_) * 8 + C.wave, INP(I_SWKV) + (size_t)l * DB * 4 * 4096, out + OUT_WKVS + (size_t)l * DB * 4 * 4096, C.lane);
        else { const int e = (it - N3) * 512 + C.tid, b = e >> 8, c = e & 255; float h = INP(I_SLRU)[((size_t)l * DB + b) * 256 + c];
#pragma unroll
            for (int i = 0; i < DS; ++i) { const size_t m = (size_t)MP + 4 * b + i; h = AL[m * 256 + c] * h + U[m * 256 + c];
                MIXCAT[m * DM + 768 + c] = (bf16)f2bf(h * gelu_t(bf1(PROJ[m * INC + C_GB + c]))); }
            out[OUT_LRS + ((size_t)l * DB + b) * 256 + c] = h; }
    }
    if (l + 1 < NL) convert_layer(C, A, l + 1, (C.bid - NSCAN) * 8 + C.wave, (C.G - NSCAN) * 8, (C.bid - NSCAN) * 512 + C.tid, (C.G - NSCAN) * 512);
    __syncthreads();
    { pg8::Gemm g{(const bf16*)(C.ws + WS_PB + (size_t)(l & 1) * SZ_PBL), (const bf16*)(C.ws + WS_W + (size_t)(l & 1) * WL + O_WP), M, DM, PLE}; pg8::StaticOrder So; So.init(M, DM, C.G - NSCAN, C.bid - NSCAN);
      pg8::EpiBf16<0> E{(bf16*)(C.ws + WS_PP), DM, nullptr, 0, 0, 1.f};
      pg8::gemm_phase<pg8::EpiBf16<0>, pg8::StaticOrder, true, true>(C.lds, g, So, E, C.tid); }
}

__device__ __forceinline__ void e3_post(const Ctx& C, const Args& A, int l) {
    const float* R = (const float*)(C.ws + WS_R2); const size_t S = (size_t)M * 256;
    const bf16 *Rb = (const bf16*)R, *K = (const bf16*)(R + S), *V = (const bf16*)(R + 2 * S), *G = (const bf16*)(R + 6 * S); const float* YR = (const float*)(C.ws + WS_R3);
    bf16* MIXCAT = (bf16*)(C.ws + WS_HN); const int c4 = 4 * C.lane;
    const f32x4 lw = *(const f32x4*)(INP(I_LNW) + l * 256 + c4), lb = *(const f32x4*)(INP(I_LNB) + l * 256 + c4), rk = *(const f32x4*)(INP(I_RK) + l * 256 + c4);
    for (int m = C.gw; m < M; m += C.NGW) {
        const size_t o = (size_t)m * 256 + c4;
        const f32x4 y = *(const f32x4*)(YR + o), r = ld_bf4(Rb + o), k = ld_bf4(K + o), v = ld_bf4(V + o), g = ld_bf4(G + o);
        const float mean = red16((y.x + y.y) + (y.z + y.w)) * (1.f / 64.f); const f32x4 d = y - mean;
        const float var = red16(dot4(d, d)) * (1.f / 64.f); const float rs = rsqrtf(var + 64e-5f);
        const float bonus = red16(dot4(r * k, rk));
        st_bf4(MIXCAT + (size_t)m * DM + 512 + c4, (d * rs * lw + lb + v * bonus) * g);
    }
}
constexpr int LDS_BYTES = 131072 + 64;
#ifndef MK_MULTI
#define MK_MULTI 0
#endif
#ifndef MK_DUP
#define MK_DUP 0
#endif
enum { PH_P0 = 0, PH_G1, PH_E1, PH_G2, PH_S, PH_E3, PH_G3, PH_E4, PH_G4, PH_G5, PH_E5, PH_G6, PH_E0, PH_G3B, PH_E4S, PH_G5B, PH_E5S, PH_N };
constexpr int NSPLIT = 16;

__device__ __forceinline__ Ctx make_ctx(int wave0, LAS unsigned char* lds) {
    Ctx D; int z_ = 0; asm volatile("" : "+v"(z_)); int ln_ = __builtin_amdgcn_mbcnt_hi(-1, __builtin_amdgcn_mbcnt_lo(-1, z_));
    D.lane = ln_; D.wave = wave0; D.tid = wave0 * 64 + ln_;
    int b_ = blockIdx.x; asm volatile("" : "+s"(b_)); D.bid = b_; D.gw = b_ * 8 + wave0; D.G = gridDim.x; D.NGW = D.G * 8;
    D.lds = lds; D.out = (float*)inp_ld(N_IN); D.ws = (unsigned char*)inp_ld(N_IN + 1);
    return D;
}
template <int PH> __device__ __forceinline__ void run_phase(const Args& A, int wave0, LAS unsigned char* lds, int l_in) {
    const Ctx C = make_ctx(wave0, lds);
    int l = l_in; asm volatile("" : "+s"(l));
    unsigned char* ws = C.ws; unsigned char* wl = ws + WS_W + (size_t)(l & 1) * WL; (void)wl;
    bf16* HN = (bf16*)(ws + WS_HN); float* MIX = (float*)(ws + WS_R1); float* R2 = (float*)(ws + WS_R2); float* R3 = (float*)(ws + WS_R3); bf16* X = (bf16*)(ws + WS_X16);
    const size_t S = (size_t)M * 256; (void)HN; (void)MIX; (void)R2; (void)R3; (void)X; (void)S;
    if constexpr (PH == PH_P0) p0_prologue(C, A);
    if constexpr (PH == PH_G1) {
        pg8::Gemm g{HN, (const bf16*)(wl + O_WIN), M, INC, DM}; pg8::StaticOrder So; So.init(M, INC, C.G, C.bid);
        pg8::EpiBf16<0> E{(bf16*)(ws + WS_R1), INC, INP(I_BIN) + (size_t)l * INC, 0, 0, 1.f};
        pg8::gemm_phase<pg8::EpiBf16<0>, pg8::StaticOrder, true, true>(C.lds, g, So, E, C.tid); }
    if constexpr (PH == PH_E1) e1_prep(C, A, l);
    if constexpr (PH == PH_G2) {
        pg8::Gemm g{(const bf16*)(ws + WS_R3), (const bf16*)(wl + O_W2), M, N2, K2 / 2, K2}; G2Order So; So.b.init(M, N2, C.G, C.bid);
        EpiMix E{INP(I_W0) + l * 256, INP(I_A0) + l * 256, INP(I_KA) + l * 256, INP(I_BA) + l * 256, INP(I_BI) + l * 256, INP(I_L) + l * 256,
                 R2 + 5 * S, (bf16*)(R2 + 1 * S), (bf16*)(R2 + 3 * S), (bf16*)(R2 + 4 * S), (bf16*)(R2 + 6 * S), R3 + S, R3 + 2 * S, (const bf16*)(ws + WS_R3)};
        pg8::gemm_phase<EpiMix, G2Order, true, true>(C.lds, g, So, E, C.tid); }
    if constexpr (PH == PH_S) s_phase(C, A, l);
    if constexpr (PH == PH_E3) e3_post(C, A, l);
    if constexpr (PH == PH_G3) {
        pg8::Gemm g{HN, (const bf16*)(wl + O_WOUT), MP, DM, DM}; pg8::StaticOrder So; So.init(MP, DM, C.G, C.bid);
        pg8::EpiBf16<0> E{(bf16*)MIX, DM, INP(I_BOUT) + (size_t)l * DM, 0, 0, 1.f};
        pg8::gemm_phase<pg8::EpiBf16<0>, pg8::StaticOrder, true, true>(C.lds, g, So, E, C.tid); }
    if constexpr (PH == PH_G3B) {
        if (C.bid < NSPLIT) { pg8::Gemm g{HN + (size_t)MP * DM, (const bf16*)(wl + O_WOUT), MS, DM, DM / 2, DM}; SplitOrder So{C.bid, NSPLIT, DM / 2}; EpiPart E{R3};
            pg8::gemm_phase<EpiPart, SplitOrder, true, true>(C.lds, g, So, E, C.tid); }
        else for (int m = (C.bid - NSPLIT) * 8 + C.wave; m < MP; m += (C.G - NSPLIT) * 8)
            row_update((const bf16*)MIX + (size_t)m * DM, INP(I_NMPOST) + l * DM, X + (size_t)m * DM, INP(I_NFPRE) + l * DM, HN + (size_t)m * DM, C.lane); }
    if constexpr (PH == PH_E4S)
        for (int m = MP + C.gw; m < M; m += C.NGW)
            row_update_parts(R3 + (size_t)(m - MP) * DM, R3 + (size_t)(MS + m - MP) * DM, INP(I_BOUT) + (size_t)l * DM, INP(I_NMPOST) + l * DM, X + (size_t)m * DM, INP(I_NFPRE) + l * DM, HN + (size_t)m * DM, C.lane);
    if constexpr (PH == PH_G4) {
        pg8::Gemm g{HN, (const bf16*)(wl + O_WGU), M, 2 * DFF, DM}; pg8::StaticOrder So; So.init(M, 2 * DFF, C.G, C.bid);
        EpiSwiglu E{(bf16*)(ws + WS_R2)};
        pg8::gemm_phase<EpiSwiglu, pg8::StaticOrder, true, true>(C.lds, g, So, E, C.tid); }
    if constexpr (PH == PH_G5) {
        pg8::Gemm g{(const bf16*)(ws + WS_R2), (const bf16*)(wl + O_WD), MP, DM, DFF}; pg8::StaticOrder So; So.init(MP, DM, C.G, C.bid);
        pg8::EpiBf16<0> E{(bf16*)MIX, DM, nullptr, 0, 0, 1.f};
        pg8::gemm_phase<pg8::EpiBf16<0>, pg8::StaticOrder, true, true>(C.lds, g, So, E, C.tid); }
    if constexpr (PH == PH_G5B) {
        if (C.bid < NSPLIT) { pg8::Gemm g{(const bf16*)(ws + WS_R2) + (size_t)MP * DFF, (const bf16*)(wl + O_WD), MS, DM, DFF / 2, DFF}; SplitOrder So{C.bid, NSPLIT, DFF / 2}; EpiPart E{R3};
            pg8::gemm_phase<EpiPart, SplitOrder, true, true>(C.lds, g, So, E, C.tid); }
        else for (int m = (C.bid - NSPLIT) * 8 + C.wave; m < MP; m += (C.G - NSPLIT) * 8)
            row_update((const bf16*)MIX + (size_t)m * DM, INP(I_NFPOST) + l * DM, X + (size_t)m * DM, nullptr, HN + (size_t)m * DM, C.lane); }
    if constexpr (PH == PH_E5S)
        for (int m = MP + C.gw; m < M; m += C.NGW)
            row_update_parts(R3 + (size_t)(m - MP) * DM, R3 + (size_t)(MS + m - MP) * DM, nullptr, INP(I_NFPOST) + l * DM, X + (size_t)m * DM, nullptr, HN + (size_t)m * DM, C.lane);
    if constexpr (PH == PH_G6) {
        pg8::StaticOrder So; So.init(M, DM, C.G, C.bid);
        pg8::Gemm g{HN, (const bf16*)(wl + O_WPG), M, DM, DM}; EpiPle E{X, (const bf16*)(ws + WS_PP), l == NL - 1 ? C.out : nullptr};
        pg8::gemm_phase<EpiPle, pg8::StaticOrder, true, true>(C.lds, g, So, E, C.tid); }
    if constexpr (PH == PH_E0)
        for (int m = C.gw; m < M; m += C.NGW) row_norm(X + (size_t)m * DM, INP(I_NMPRE) + (l + 1) * DM, HN + (size_t)m * DM, C.lane);
}

#if MK_MULTI
template <int PH> __global__ void __launch_bounds__(512, 2) mk_one(Args A, int l) {
    extern __shared__ __attribute__((aligned(16))) unsigned char lds_raw[];
    const int wave0 = __builtin_amdgcn_readfirstlane((int)threadIdx.x >> 6);
    run_phase<PH>(A, wave0, (LAS unsigned char*)lds_raw, l);
}
#else
__global__ void __launch_bounds__(512, 2) mk_fwd(Args A) {
    extern __shared__ __attribute__((aligned(16))) unsigned char lds_raw[];
    cg::grid_group grid = cg::this_grid();
    const int wave0 = __builtin_amdgcn_readfirstlane((int)threadIdx.x >> 6);
    LAS unsigned char* lds = (LAS unsigned char*)lds_raw;
    if (threadIdx.x < 16) ((LAS unsigned*)lds)[131072 / 4 + threadIdx.x] = 0u;
    __syncthreads();
    const unsigned xbar_x = __builtin_amdgcn_readfirstlane(xcd_barrier_post((unsigned*)inp_ld(N_IN + 1), (volatile LAS unsigned*)(lds + 131072), (int)threadIdx.x).x);
#define GRID_BAR() do { int z_ = 0; asm volatile("" : "+v"(z_)); int ln_ = __builtin_amdgcn_mbcnt_hi(-1, __builtin_amdgcn_mbcnt_lo(-1, z_)); XcdBarrier xb_; xb_.bar = (unsigned*)inp_ld(N_IN + 1); xb_.x = xbar_x; \
        xb_.st = (volatile LAS unsigned*)(lds + 131072); xcd_barrier(xb_, wave0 * 64 + ln_); } while (0)
    run_phase<PH_P0>(A, wave0, lds, 0);
    if (MK_DUP & 1) { GRID_BAR(); run_phase<PH_P0>(A, wave0, lds, 0); }
    grid.sync();
#pragma unroll 1
    for (int l = 0; l < NL; ++l) {
#define RP(PH) do { run_phase<PH>(A, wave0, lds, l); GRID_BAR(); if (MK_DUP & (1 << 20)) GRID_BAR(); if (MK_DUP & (1 << PH)) { run_phase<PH>(A, wave0, lds, l); GRID_BAR(); } } while (0)
        RP(PH_G1); RP(PH_E1); RP(PH_G2); RP(PH_S); RP(PH_E3); RP(PH_G3); RP(PH_G3B); RP(PH_E4S); RP(PH_G4); RP(PH_G5); RP(PH_G5B); RP(PH_E5S);
        run_phase<PH_G6>(A, wave0, lds, l);
        if (l + 1 < NL) { GRID_BAR(); RP(PH_E0); }
    }
}
#endif
}

#if MK_MULTI
template <int PH> static void launch_one(const mk::Args& a, int l, int grid, hipStream_t stream) {
    static bool attr = false;
    if (!attr) { (void)hipFuncSetAttribute((const void*)mk::mk_one<PH>, hipFuncAttributeMaxDynamicSharedMemorySize, mk::LDS_BYTES); attr = true; }
    hipLaunchKernelGGL(mk::mk_one<PH>, dim3(grid), dim3(512), mk::LDS_BYTES, stream, a, l);
}
#endif
extern "C" void kernel_launch(void* const* d_in, const int* in_sizes, int n_in, void* d_out, int out_size, void* d_ws, size_t ws_size, hipStream_t stream) {
    using namespace mk;
    static int grid = 0;
    if (grid == 0) {
        if (n_in != N_IN || (size_t)out_size != OUT_END || ws_size < WS_END) {
            fprintf(stderr, "kernel_launch: shape mismatch: n_in %d (want %d), out %d (want %zu), ws %zu (want >= %zu); nothing launched\n", n_in, (int)N_IN, out_size, (size_t)OUT_END, ws_size, (size_t)WS_END);
            grid = -1; return; }
        int dev = 0, cus = 0;
        (void)hipGetDevice(&dev); (void)hipDeviceGetAttribute(&cus, hipDeviceAttributeMultiprocessorCount, dev);
#if !MK_MULTI
        int per_cu = 0;
        if (hipFuncSetAttribute((const void*)mk_fwd, hipFuncAttributeMaxDynamicSharedMemorySize, LDS_BYTES) != hipSuccess) { fprintf(stderr, "kernel_launch: hipFuncSetAttribute failed\n"); grid = -1; return; }
        if (hipOccupancyMaxActiveBlocksPerMultiprocessor(&per_cu, (const void*)mk_fwd, 512, LDS_BYTES) != hipSuccess || per_cu < 1) fprintf(stderr, "kernel_launch: note: occupancy query gave %d\n", per_cu);
        (void)hipGetLastError();
#endif
        grid = cus;
        if (grid < 128) { fprintf(stderr, "kernel_launch: %d CUs: too few for this kernel\n", grid); grid = -1; return; }
    }
    if (grid < 0) return;
    Args a{};
    for (int i = 0; i < N_IN; ++i) a.in[i] = (const float*)d_in[i];
    a.out = (float*)d_out; a.ws = (unsigned char*)d_ws;
#if MK_MULTI
    launch_one<PH_P0>(a, 0, grid, stream);
    for (int l = 0; l < NL; ++l) {
        launch_one<PH_G1>(a, l, grid, stream); launch_one<PH_E1>(a, l, grid, stream); launch_one<PH_G2>(a, l, grid, stream); launch_one<PH_S>(a, l, grid, stream);
        launch_one<PH_E3>(a, l, grid, stream); launch_one<PH_G3>(a, l, grid, stream); launch_one<PH_E4>(a, l, grid, stream); launch_one<PH_G4>(a, l, grid, stream);
        launch_one<PH_G5>(a, l, grid, stream); launch_one<PH_E5>(a, l, grid, stream); launch_one<PH_G6>(a, l, grid, stream);
        if (l + 1 < NL) launch_one<PH_E0>(a, l, grid, stream);
    }
#else
    if (hipMemsetAsync(d_ws, 0, 65536, stream) != hipSuccess) { fprintf(stderr, "kernel_launch: hipMemsetAsync failed\n"); return; }
    void* args[] = {&a};
    const hipError_t e = hipLaunchCooperativeKernel((const void*)mk_fwd, dim3(grid), dim3(512), args, LDS_BYTES, stream);
    if (e != hipSuccess) fprintf(stderr, "kernel_launch: cooperative launch failed: %s (grid %d)\n", hipGetErrorString(e), grid);
#endif
}
```

```cpp
#include <hip/hip_runtime.h>
#include <hip/hip_cooperative_groups.h>
#include <cstdio>
#include <cstdint>
#include <cstddef>
#include <cmath>
namespace cg = cooperative_groups;
namespace pg8 {
#define PG8_LAS __attribute__((address_space(3)))
typedef unsigned short bf16_t;
typedef short bf16x8 __attribute__((ext_vector_type(8)));
typedef float f32x4 __attribute__((ext_vector_type(4)));
typedef unsigned u32x4 __attribute__((ext_vector_type(4)));
constexpr int BM = 256, BK = 64, HALF = 128, HTB = HALF * BK * 2  , STAGE_BYTES = 8 * HTB, NXCD = 8, WGM = 8;

__host__ __device__ __forceinline__ int lds_byte(int r, int c) { const int st = (r >> 4) * 2 + (c >> 5), rr = r & 15, cc = c & 31, ob = rr * 64 + cc * 2; return st * 1024 + (ob ^ (((ob >> 9) & 1) << 5)); }
__host__ __device__ __forceinline__ void stage_rc(int b, int& R, int& C) { const int st = b / 1024, sb = b % 1024, swz = sb ^ (((sb >> 9) & 1) << 5); R = (st >> 1) * 16 + swz / 64; C = (st & 1) * 32 + (swz % 64) / 2; }
__host__ __device__ __forceinline__ int perm32(int rho) { const int n = rho >> 4, i = rho & 15; return 8 * (i >> 2) + 4 * n + (i & 3); }

struct Unit { int pm, pn, ko = 0; };
struct Gemm { const bf16_t* A; const bf16_t* Bt; int M, N, K; int ld = 0; };

struct StaticOrder {
    int nM, nN, nwg, G, c;
    __host__ __device__ void init(int M, int N, int G_, int c_) { nM = M / BM; nN = N / BM; nwg = nM * nN; G = G_; c = c_; }
    __host__ __device__ bool next(int i, Unit& u) const {
        const long L = (long)i * G + c; if (L >= nwg) return false;
        int wgid = (int)L; { const int q = nwg / NXCD, r = nwg % NXCD, xcd = wgid % NXCD, off = wgid / NXCD; wgid = (xcd < r ? xcd * (q + 1) : r * (q + 1) + (xcd - r) * q) + off; }
        const int nig = WGM * nN, gid = wgid / nig, fm = gid * WGM, gsz = (nM - fm) < WGM ? (nM - fm) : WGM;
        u.pm = fm + ((wgid % nig) % gsz); u.pn = (wgid % nig) / gsz; return true;
    }
    __device__ __forceinline__ void a_ready(const Unit&) const {}
    __device__ __forceinline__ void done(const Unit&) const {}
};

__device__ __forceinline__ unsigned cvt_pk_bf16(float lo, float hi) { unsigned r; asm volatile("v_cvt_pk_bf16_f32 %0, %1, %2" : "=v"(r) : "v"(lo), "v"(hi)); return r; }
typedef float f32x2 __attribute__((ext_vector_type(2)));
__device__ __forceinline__ f32x2 gelu_pk(f32x2 v) {
    const f32x2 av = __builtin_elementwise_abs(v), d = av * 0.2316418882f + 1.0f;
    f32x2 t; t.x = __builtin_amdgcn_rcpf(d.x); t.y = __builtin_amdgcn_rcpf(d.y);
    f32x2 q = t * 0.5307027145f + (-0.7265760135f); q = q * t + 0.7107068705f; q = q * t + (-0.142248368f); q = q * t + 0.127414796f; q = q * t;
    const f32x2 s = (v * v) * (-0.72134752044f);
    f32x2 e; e.x = __builtin_amdgcn_exp2f(s.x); e.y = __builtin_amdgcn_exp2f(s.y);
    const f32x2 m = v * (q * e), r = v - m;
    f32x2 o; o.x = v.x < 0.f ? m.x : r.x; o.y = v.y < 0.f ? m.y : r.y; return o;
}

template <int ACT  > struct EpiBf16 {
    static constexpr bool PERM = true, AFTER_DRAIN = false; static_assert(ACT == 0 || ACT == 1, "EpiBf16: ACT is 0 (none) or 1 (gelu_pk)");
    bf16_t* O; int ldc; const float* bias; int split_cols; size_t split_stride; float scale0;
    __device__ __forceinline__ void operator()(const f32x4 (&acc)[2][2][4][2], const Unit& u, int wr, int wc, int fr, int fq) const {
        const int row0 = u.pm * BM + wr * 64 + fr; int colt = u.pn * BM; bf16_t* base = O;
        float sc = 1.f; if (split_cols) { const int t = colt / split_cols; base += (size_t)t * split_stride; colt -= t * split_cols; if (t == 0) sc = scale0; }
        const int col0 = colt + wc * 32 + 8 * fq, bcol0 = u.pn * BM + wc * 32 + 8 * fq;
        f32x4 bv[2][2];
#pragma unroll
        for (int bj = 0; bj < 2; ++bj)
#pragma unroll
            for (int n = 0; n < 2; ++n) bv[bj][n] = bias ? *(const f32x4*)(bias + bcol0 + bj * HALF + 4 * n) : (f32x4){0.f, 0.f, 0.f, 0.f};
#pragma unroll
        for (int ai = 0; ai < 2; ++ai)
#pragma unroll
            for (int m = 0; m < 4; ++m) { bf16_t* rowp = base + (size_t)(row0 + ai * HALF + m * 16) * ldc + col0;
#pragma unroll
                for (int bj = 0; bj < 2; ++bj) { f32x4 v0 = acc[ai][bj][m][0] + bv[bj][0], v1 = acc[ai][bj][m][1] + bv[bj][1];
                    if (ACT == 1) { f32x2 a = gelu_pk((f32x2){v0[0], v0[1]}), b = gelu_pk((f32x2){v0[2], v0[3]}), c = gelu_pk((f32x2){v1[0], v1[1]}), d = gelu_pk((f32x2){v1[2], v1[3]});
                        v0 = (f32x4){a.x, a.y, b.x, b.y}; v1 = (f32x4){c.x, c.y, d.x, d.y}; }
                    v0 = v0 * sc; v1 = v1 * sc; u32x4 w; w.x = cvt_pk_bf16(v0[0], v0[1]); w.y = cvt_pk_bf16(v0[2], v0[3]); w.z = cvt_pk_bf16(v1[0], v1[1]); w.w = cvt_pk_bf16(v1[2], v1[3]);
                    *(u32x4*)(rowp + bj * HALF) = w; } }
    }
};
template <class Epi, class Sched, bool ALIGN_EPI = false, bool SP2 = false>
__device__ __forceinline__ void gemm_phase(PG8_LAS unsigned char* lds, const Gemm g, const Sched& S, const Epi& E, int tid_in) {
    int tid_ = tid_in; asm volatile("" : "+v"(tid_));
    const int tid = tid_, wid = __builtin_amdgcn_readfirstlane(tid >> 6), lane = tid & 63, wr = wid >> 2, wc = wid & 3, fr = lane & 15, fq = lane >> 4;
    const int K = g.K, nt = K / BK, LD = g.ld ? g.ld : g.K;
    unsigned voffA[2], voffB[2];
#pragma unroll
    for (int i = 0; i < 2; ++i) { int R, C; stage_rc(tid * 16 + i * 8192, R, C); const int Rb = Epi::PERM ? ((R & ~31) + perm32(R & 31)) : R;
        voffA[i] = (unsigned)(R * LD + C) * 2u; voffB[i] = (unsigned)(Rb * LD + C) * 2u; }
    const size_t kstep = (size_t)(BK * 2);
    const size_t hstep = (size_t)HALF * LD * 2;
    const size_t tstep = 2 * hstep;
    const unsigned ldsw = (unsigned)wid * 1024u;
    const int aoff = lds_byte(wr * 64 + fr, fq * 8), boff = lds_byte(wc * 32 + fr, fq * 8);
#define PG8_SA(b, h) (((b) * 2 + (h)) * HTB)
#define PG8_SB(b, h) ((4 + (b) * 2 + (h)) * HTB)
#define PG8_STAGE(bufoff, gbase, voff) do { _Pragma("unroll") for (int _i = 0; _i < 2; ++_i) \
        __builtin_amdgcn_global_load_lds((const unsigned*)((const char*)(gbase) + (voff)[_i]), (PG8_LAS unsigned*)(lds + (bufoff) + ldsw + _i * 8192), 16, 0, 0); } while (0)
#define PG8_LDA(dst, b, h) do { _Pragma("unroll") for (int m = 0; m < 4; ++m) _Pragma("unroll") for (int k = 0; k < 2; ++k) dst[m][k] = *(const PG8_LAS bf16x8*)(lds + PG8_SA(b, h) + aoff + m * 2048 + k * 1024); } while (0)
#define PG8_LDB(dst, b, h) do { _Pragma("unroll") for (int n = 0; n < 2; ++n) _Pragma("unroll") for (int k = 0; k < 2; ++k) dst[n][k] = *(const PG8_LAS bf16x8*)(lds + PG8_SB(b, h) + boff + n * 2048 + k * 1024); } while (0)
#define PG8_MMA(ai, bj, At, Bt) do { __builtin_amdgcn_s_setprio(1); _Pragma("unroll") for (int m = 0; m < 4; ++m) _Pragma("unroll") for (int n = 0; n < 2; ++n) _Pragma("unroll") for (int k = 0; k < 2; ++k) \
        acc[ai][bj][m][n] = __builtin_amdgcn_mfma_f32_16x16x32_bf16(Bt[n][k], At[m][k], acc[ai][bj][m][n], 0, 0, 0); __builtin_amdgcn_s_setprio(0); } while (0)
#define PG8_WAIT_V(n) asm volatile("s_waitcnt vmcnt(" #n ")" ::: "memory")
#define PG8_WAIT_L(n) asm volatile("s_waitcnt lgkmcnt(" #n ")" ::: "memory")
#define PG8_BAR __builtin_amdgcn_s_barrier()
#define PG8_SCHED __builtin_amdgcn_sched_barrier(0)
    Unit cur, nxt; int ui = 0;
    if (!S.next(0, cur)) return;
    f32x4 acc[2][2][4][2];
#pragma unroll
    for (int a = 0; a < 2; ++a)
#pragma unroll
        for (int b = 0; b < 2; ++b)
#pragma unroll
            for (int m = 0; m < 4; ++m)
#pragma unroll
                for (int n = 0; n < 2; ++n) acc[a][b][m][n] = (f32x4){0.f, 0.f, 0.f, 0.f};
    bf16x8 At[4][2], B0[2][2], B1[2][2];
    const char* cA = (const char*)g.A + (size_t)cur.pm * tstep + (size_t)cur.ko * 2; const char* cB = (const char*)g.Bt + (size_t)cur.pn * tstep + (size_t)cur.ko * 2;
    S.a_ready(cur);
    if constexpr (SP2) {
        PG8_STAGE(PG8_SB(0, 0), cB, voffB); PG8_STAGE(PG8_SB(0, 1), cB + hstep, voffB); PG8_STAGE(PG8_SA(0, 0), cA, voffA); PG8_STAGE(PG8_SA(0, 1), cA + hstep, voffA);
        if (wr == 1) PG8_BAR;
        PG8_WAIT_V(2); PG8_BAR;
        PG8_STAGE(PG8_SB(1, 0), cB + kstep, voffB); PG8_STAGE(PG8_SA(1, 0), cA + kstep, voffA); PG8_STAGE(PG8_SB(1, 1), cB + hstep + kstep, voffB);
        PG8_WAIT_V(6); PG8_BAR;
    } else {
        PG8_STAGE(PG8_SB(0, 0), cB, voffB); PG8_STAGE(PG8_SA(0, 0), cA, voffA); PG8_STAGE(PG8_SB(0, 1), cB + hstep, voffB); PG8_STAGE(PG8_SA(0, 1), cA + hstep, voffA);
        if (wr == 1) PG8_BAR;
        PG8_WAIT_V(4); PG8_BAR;
        PG8_STAGE(PG8_SB(1, 0), cB + kstep, voffB); PG8_STAGE(PG8_SA(1, 0), cA + kstep, voffA); PG8_STAGE(PG8_SB(1, 1), cB + hstep + kstep, voffB);
        PG8_WAIT_V(6); PG8_BAR;
    }
    for (;;) {
        const bool has_next = S.next(ui + 1, nxt);
        const char* nA = has_next ? (const char*)g.A + (size_t)nxt.pm * tstep + (size_t)nxt.ko * 2 : cA; const char* nB = has_next ? (const char*)g.Bt + (size_t)nxt.pn * tstep + (size_t)nxt.ko * 2 : cB;
        for (int t = 0; t < nt; t += 2) {
            const bool last = (t == nt - 2);
            const char* a1 = cA + (size_t)(t + 1) * kstep;
            const char* a2 = last ? nA : cA + (size_t)(t + 2) * kstep; const char* b2 = last ? nB : cB + (size_t)(t + 2) * kstep;
            const char* a3 = a2 + kstep; const char* b3 = b2 + kstep;
            if (last && has_next) S.a_ready(nxt);
            if constexpr (SP2) {
            PG8_LDB(B0, 0, 0); PG8_LDB(B1, 0, 1); PG8_SCHED; PG8_LDA(At, 0, 0); PG8_STAGE(PG8_SA(1, 1), a1 + hstep, voffA);
            PG8_WAIT_V(8); PG8_WAIT_L(0); PG8_BAR; PG8_MMA(0, 0, At, B0); PG8_MMA(0, 1, At, B1); PG8_BAR; PG8_SCHED;
            PG8_LDA(At, 0, 1); PG8_STAGE(PG8_SB(0, 0), b2, voffB); PG8_STAGE(PG8_SB(0, 1), b2 + hstep, voffB); PG8_STAGE(PG8_SA(0, 0), a2, voffA);
            PG8_WAIT_V(8); PG8_WAIT_L(0); PG8_BAR; PG8_MMA(1, 0, At, B0); PG8_MMA(1, 1, At, B1); PG8_BAR; PG8_SCHED;
            PG8_LDB(B0, 1, 0); PG8_LDB(B1, 1, 1); PG8_SCHED; PG8_LDA(At, 1, 0); PG8_STAGE(PG8_SA(0, 1), a2 + hstep, voffA);
            PG8_WAIT_V(8); PG8_WAIT_L(0); PG8_BAR; PG8_MMA(0, 0, At, B0); PG8_MMA(0, 1, At, B1); PG8_BAR; PG8_SCHED;
            PG8_LDA(At, 1, 1); PG8_STAGE(PG8_SB(1, 0), b3, voffB); PG8_STAGE(PG8_SB(1, 1), b3 + hstep, voffB); PG8_STAGE(PG8_SA(1, 0), a3, voffA);
            PG8_WAIT_V(8); PG8_WAIT_L(0); PG8_BAR; PG8_MMA(1, 0, At, B0); PG8_MMA(1, 1, At, B1); PG8_BAR; PG8_SCHED;
            } else {
            PG8_LDB(B0, 0, 0); PG8_SCHED; PG8_LDA(At, 0, 0); PG8_STAGE(PG8_SA(1, 1), a1 + hstep, voffA);
            PG8_WAIT_L(8); PG8_BAR; PG8_WAIT_L(0); PG8_MMA(0, 0, At, B0); PG8_BAR; PG8_SCHED;
            PG8_LDB(B1, 0, 1); PG8_STAGE(PG8_SB(0, 0), b2, voffB);
            PG8_BAR; PG8_WAIT_L(0); PG8_MMA(0, 1, At, B1); PG8_BAR;
            PG8_LDA(At, 0, 1); PG8_STAGE(PG8_SA(0, 0), a2, voffA);
            PG8_BAR; PG8_WAIT_L(0); PG8_MMA(1, 0, At, B0); PG8_BAR; PG8_SCHED;
            PG8_STAGE(PG8_SB(0, 1), b2 + hstep, voffB);
            PG8_WAIT_V(6); PG8_BAR; PG8_MMA(1, 1, At, B1); PG8_BAR;
            PG8_LDB(B0, 1, 0); PG8_SCHED; PG8_LDA(At, 1, 0); PG8_STAGE(PG8_SA(0, 1), a2 + hstep, voffA);
            PG8_WAIT_L(8); PG8_BAR; PG8_WAIT_L(0); PG8_MMA(0, 0, At, B0); PG8_BAR; PG8_SCHED;
            PG8_LDB(B1, 1, 1); PG8_STAGE(PG8_SB(1, 0), b3, voffB);
            PG8_BAR; PG8_WAIT_L(0); PG8_MMA(0, 1, At, B1); PG8_BAR;
            PG8_LDA(At, 1, 1); PG8_STAGE(PG8_SA(1, 0), a3, voffA);
            PG8_BAR; PG8_WAIT_L(0); PG8_MMA(1, 0, At, B0); PG8_BAR; PG8_SCHED;
            PG8_STAGE(PG8_SB(1, 1), b3 + hstep, voffB);
            PG8_WAIT_V(6); PG8_BAR; PG8_MMA(1, 1, At, B1); PG8_BAR;
            }
        }
        if constexpr (ALIGN_EPI) { if (wr == 0) PG8_BAR; }
        if constexpr (!Epi::AFTER_DRAIN) { int z_ = 0; asm volatile("" : "+v"(z_)); const int ln_ = __builtin_amdgcn_mbcnt_hi(-1, __builtin_amdgcn_mbcnt_lo(-1, z_)); E(acc, cur, wr, wc, ln_ & 15, ln_ >> 4); S.done(cur); }
        if (!has_next) break;
#pragma unroll
        for (int a = 0; a < 2; ++a)
#pragma unroll
            for (int b = 0; b < 2; ++b)
#pragma unroll
                for (int m = 0; m < 4; ++m)
#pragma unroll
                    for (int n = 0; n < 2; ++n) acc[a][b][m][n] = (f32x4){0.f, 0.f, 0.f, 0.f};
        cur = nxt; cA = nA; cB = nB; ++ui;
        if constexpr (ALIGN_EPI) { if (wr == 1) PG8_BAR; }
    }
    PG8_WAIT_V(0);
    if constexpr (!ALIGN_EPI) { if (wr == 0) PG8_BAR; }
    PG8_BAR;
    if constexpr (Epi::AFTER_DRAIN) { E.fused(acc, cur, wr, wc, fr, fq, lds, wid, lane); S.done(cur); }
#undef PG8_SA
#undef PG8_SB
#undef PG8_STAGE
#undef PG8_LDA
#undef PG8_LDB
#undef PG8_MMA
#undef PG8_WAIT_V
#undef PG8_WAIT_L
#undef PG8_BAR
#undef PG8_SCHED
}
}
namespace mk {
typedef pg8::bf16_t bf16;
typedef pg8::f32x4 f32x4;
typedef pg8::u32x4 u32x4;
typedef pg8::bf16x8 bf16x8;
typedef pg8::Unit Unit;
typedef float f32x16 __attribute__((ext_vector_type(16)));
typedef unsigned u32x2 __attribute__((ext_vector_type(2)));
typedef float f32x2 __attribute__((ext_vector_type(2)));
#define LAS __attribute__((address_space(3)))
#define LDS_WAIT() asm volatile("s_waitcnt lgkmcnt(0)" ::: "memory")

constexpr int DM = 1024, T = 4096, NBP = 4, MP = NBP * T, DB = 128, DS = 4, MS = DB * DS, M = MP + MS, NL = 4;
constexpr int INC = 2304, DFF = 2816, K2 = 512, N2 = 1280, PLE = 256;
constexpr int C_K = 512, C_V = 640, C_RW = 768, C_XB = 1792, C_GB = 2048;

constexpr size_t SZ_WIN = (size_t)INC * DM * 2, SZ_W2 = (size_t)N2 * K2 * 2, SZ_WOUT = (size_t)DM * DM * 2, SZ_WGU = (size_t)2 * DFF * DM * 2,
                 SZ_WD = (size_t)DM * DFF * 2, SZ_WPG = (size_t)DM * DM * 2, SZ_WP = (size_t)DM * PLE * 2;
constexpr size_t O_WIN = 0, O_W2 = O_WIN + SZ_WIN, O_WOUT = O_W2 + SZ_W2, O_WGU = O_WOUT + SZ_WOUT, O_WD = O_WGU + SZ_WGU, O_WPG = O_WD + SZ_WD,
                 O_WP = O_WPG + SZ_WPG, WL = O_WP + SZ_WP;
constexpr size_t WS_W = 1u << 20  , SZ_PBL = (size_t)M * PLE * 2, WS_X16 = WS_W + 2 * WL  , WS_PB = WS_X16 + (size_t)M * DM * 2  , SZ_ACT = (size_t)M * DM * 2, WS_PP = WS_PB + 2 * SZ_PBL  , WS_HN = WS_PP + SZ_ACT,
                 WS_R1 = WS_HN + SZ_ACT, SZ_R1 = (size_t)M * INC * 2, WS_R2 = WS_R1 + SZ_R1, SZ_F256 = (size_t)M * 256 * 4, WS_R3 = WS_R2 + 7 * SZ_F256,
                 WS_END = WS_R3 + 3 * SZ_F256;
static_assert(WL % 256 == 0 && SZ_R1 >= (size_t)M * DM * 4 && 7 * SZ_F256 >= (size_t)M * DFF * 2, "ws map");

constexpr size_t OUT_Y = 0, OUT_KP = (size_t)M * DM, OUT_VP = OUT_KP + (size_t)NL * NBP * 128 * 128, OUT_SHP = OUT_VP + (size_t)NL * NBP * 128 * 128,
                 OUT_WKVP = OUT_SHP + (size_t)NL * NBP * 1024, OUT_CVP = OUT_WKVP + (size_t)NL * NBP * 4 * 4096, OUT_LRP = OUT_CVP + (size_t)NL * NBP * 768,
                 OUT_KS = OUT_LRP + (size_t)NL * NBP * 256, OUT_VS = OUT_KS + (size_t)NL * DB * 128 * 128, OUT_SHS = OUT_VS + (size_t)NL * DB * 128 * 128,
                 OUT_WKVS = OUT_SHS + (size_t)NL * DB * 1024, OUT_CVS = OUT_WKVS + (size_t)NL * DB * 4 * 4096, OUT_LRS = OUT_CVS + (size_t)NL * DB * 768,
                 OUT_END = OUT_LRS + (size_t)NL * DB * 256;

enum { I_XP = 0, I_XS, I_CK, I_CV, I_SSH, I_SWKV, I_SCV, I_SLRU, I_PP, I_PS, I_NMPRE, I_NMPOST, I_NFPRE, I_NFPOST, I_WIN, I_BIN, I_SINK, I_MU, I_W0, I_WUP,
       I_A0, I_AUP, I_GUP, I_KK, I_KA, I_RK, I_LNW, I_LNB, I_CW, I_CB, I_WA, I_BA, I_WI, I_BI, I_L, I_WOUT, I_BOUT, I_WG, I_WU, I_WDN, I_PW, I_PGW, N_IN };

__device__ __forceinline__ unsigned f2bf(float f) { unsigned u = __float_as_uint(f); return (u + 0x7fffu + ((u >> 16) & 1u)) >> 16; }
__device__ __forceinline__ unsigned pk2(float lo, float hi) { return f2bf(lo) | (f2bf(hi) << 16); }
__device__ __forceinline__ float bflo(unsigned w) { return __uint_as_float(w << 16); }
__device__ __forceinline__ float bfhi(unsigned w) { return __uint_as_float(w & 0xffff0000u); }
__device__ __forceinline__ float bf1(bf16 b) { return __uint_as_float((unsigned)b << 16); }
__device__ __forceinline__ f32x4 ld_bf4(const bf16* p) { const u32x2 w = *(const u32x2*)p; return (f32x4){bflo(w.x), bfhi(w.x), bflo(w.y), bfhi(w.y)}; }
__device__ __forceinline__ void st_bf4(bf16* p, f32x4 v) { u32x2 w; w.x = pk2(v.x, v.y); w.y = pk2(v.z, v.w); *(u32x2*)p = w; }
__device__ __forceinline__ void ld_bf8(const bf16* p, f32x4& lo, f32x4& hi) { const u32x4 w = *(const u32x4*)p; lo = (f32x4){bflo(w.x), bfhi(w.x), bflo(w.y), bfhi(w.y)}; hi = (f32x4){bflo(w.z), bfhi(w.z), bflo(w.w), bfhi(w.w)}; }
__device__ __forceinline__ void st_bf8(bf16* p, f32x4 lo, f32x4 hi) { u32x4 w; w.x = pk2(lo.x, lo.y); w.y = pk2(lo.z, lo.w); w.z = pk2(hi.x, hi.y); w.w = pk2(hi.z, hi.w); *(u32x4*)p = w; }
__device__ __forceinline__ float sigm(float x) { return __builtin_amdgcn_rcpf(1.f + __expf(-x)); }
__device__ __forceinline__ float tanh_(float x) { return 1.f - 2.f * __builtin_amdgcn_rcpf(__expf(2.f * x) + 1.f); }
__device__ __forceinline__ float gelu_t(float x) { return 0.5f * x * (1.f + tanh_(0.7978845608f * (x + 0.044715f * x * x * x))); }
template <int CTRL> __device__ __forceinline__ float dppf(float x) { return __builtin_bit_cast(float, __builtin_amdgcn_mov_dpp(__builtin_bit_cast(int, x), CTRL, 0xf, 0xf, true)); }
__device__ __forceinline__ float red16(float x) { x += dppf<0xB1>(x); x += dppf<0x4E>(x); x += dppf<0x141>(x); x += dppf<0x128>(x); return x; }
__device__ __forceinline__ float red8(float x) { x += dppf<0xB1>(x); x += dppf<0x4E>(x); x += dppf<0x141>(x); return x; }
__device__ __forceinline__ float wave_sum(float v) {
    v = red16(v);
    v += __builtin_bit_cast(float, __builtin_amdgcn_update_dpp(0, __builtin_bit_cast(int, v), 0x142, 0xa, 0xf, false));
    v += __builtin_bit_cast(float, __builtin_amdgcn_update_dpp(0, __builtin_bit_cast(int, v), 0x143, 0xc, 0xf, false));
    return __builtin_bit_cast(float, __builtin_amdgcn_readlane(__builtin_bit_cast(int, v), 63));
}
__device__ __forceinline__ float vmul(float a, float b) { float d; asm("v_mul_f32 %0, %1, %2" : "=v"(d) : "v"(a), "v"(b)); return d; }
__device__ __forceinline__ float vfma(float a, float b, float c) { float d; asm("v_fma_f32 %0, %1, %2, %3" : "=v"(d) : "v"(a), "v"(b), "v"(c)); return d; }
__device__ __forceinline__ float vfnma(float a, float b, float c) { float d; asm("v_fma_f32 %0, -%1, %2, %3" : "=v"(d) : "v"(a), "v"(b), "v"(c)); return d; }
__device__ __forceinline__ void red16x2(float& p, float& q) {
    asm volatile("v_add_f32_dpp %0, %0, %0 quad_perm:[1,0,3,2] row_mask:0xf bank_mask:0xf bound_ctrl:1\n\t"
                 "v_add_f32_dpp %1, %1, %1 quad_perm:[1,0,3,2] row_mask:0xf bank_mask:0xf bound_ctrl:1\n\ts_nop 0\n\t"
                 "v_add_f32_dpp %0, %0, %0 quad_perm:[2,3,0,1] row_mask:0xf bank_mask:0xf bound_ctrl:1\n\t"
                 "v_add_f32_dpp %1, %1, %1 quad_perm:[2,3,0,1] row_mask:0xf bank_mask:0xf bound_ctrl:1\n\ts_nop 0\n\t"
                 "v_add_f32_dpp %0, %0, %0 row_half_mirror row_mask:0xf bank_mask:0xf bound_ctrl:1\n\t"
                 "v_add_f32_dpp %1, %1, %1 row_half_mirror row_mask:0xf bank_mask:0xf bound_ctrl:1\n\ts_nop 0\n\t"
                 "v_add_f32_dpp %0, %0, %0 row_ror:8 row_mask:0xf bank_mask:0xf bound_ctrl:1\n\t"
                 "v_add_f32_dpp %1, %1, %1 row_ror:8 row_mask:0xf bank_mask:0xf bound_ctrl:1\n\ts_nop 1"
                 : "+v"(p), "+v"(q));
}
__device__ __forceinline__ float shx(float v, int mask, int lane) { return __builtin_bit_cast(float, __builtin_amdgcn_ds_bpermute((lane ^ mask) << 2, __builtin_bit_cast(int, v))); }
__device__ __forceinline__ float dot4(f32x4 a, f32x4 b) { return (a.x * b.x + a.y * b.y) + (a.z * b.z + a.w * b.w); }

struct EpiF32 {
    static constexpr bool PERM = false, AFTER_DRAIN = false;
    float* O; int ldc; const float* bias;
    __device__ __forceinline__ void operator()(const f32x4 (&acc)[2][2][4][2], const Unit& u, int wr, int wc, int fr, int fq) const {
        asm volatile("" : "+v"(fr), "+v"(fq));
        const int row0 = u.pm * 256 + wr * 64 + fr, col0 = u.pn * 256 + wc * 32 + 4 * fq;
        f32x4 bv[2][2];
#pragma unroll
        for (int bj = 0; bj < 2; ++bj)
#pragma unroll
            for (int n = 0; n < 2; ++n) bv[bj][n] = bias ? *(const f32x4*)(bias + col0 + bj * 128 + n * 16) : (f32x4){0.f, 0.f, 0.f, 0.f};
#pragma unroll
        for (int ai = 0; ai < 2; ++ai)
#pragma unroll
            for (int m = 0; m < 4; ++m) { float* rowp = O + (size_t)(row0 + ai * 128 + m * 16) * ldc + col0;
#pragma unroll
                for (int bj = 0; bj < 2; ++bj)
#pragma unroll
                    for (int n = 0; n < 2; ++n) *(f32x4*)(rowp + bj * 128 + n * 16) = acc[ai][bj][m][n] + bv[bj][n]; }
    }
};
struct EpiPle {
    static constexpr bool PERM = true, AFTER_DRAIN = false;
    bf16* X; const bf16* PP; float* Y;
    __device__ __forceinline__ void operator()(const f32x4 (&acc)[2][2][4][2], const Unit& u, int wr, int wc, int fr, int fq) const {
        asm volatile("" : "+v"(fr), "+v"(fq));
        const int row0 = u.pm * 256 + wr * 64 + fr, col0 = u.pn * 256 + wc * 32 + 8 * fq;
#pragma unroll
        for (int ai = 0; ai < 2; ++ai)
#pragma unroll
            for (int m = 0; m < 4; ++m) { const size_t off = (size_t)(row0 + ai * 128 + m * 16) * DM + col0;
#pragma unroll
                for (int bj = 0; bj < 2; ++bj) { const size_t o = off + bj * 128; f32x4 x0, x1, p0, p1; ld_bf8(X + o, x0, x1); ld_bf8(PP + o, p0, p1); const f32x4 a0 = acc[ai][bj][m][0], a1 = acc[ai][bj][m][1];
                    const f32x4 r0 = (f32x4){x0.x + sigm(a0.x) * p0.x, x0.y + sigm(a0.y) * p0.y, x0.z + sigm(a0.z) * p0.z, x0.w + sigm(a0.w) * p0.w},
                                r1 = (f32x4){x1.x + sigm(a1.x) * p1.x, x1.y + sigm(a1.y) * p1.y, x1.z + sigm(a1.z) * p1.z, x1.w + sigm(a1.w) * p1.w};
                    if (Y) { *(f32x4*)(Y + o) = r0; *(f32x4*)(Y + o + 4) = r1; } else st_bf8(X + o, r0, r1); }
                asm volatile("" ::: "memory"); }
    }
};
struct EpiSwiglu {
    static constexpr bool PERM = true, AFTER_DRAIN = false;
    bf16* O;
    __device__ __forceinline__ void operator()(const f32x4 (&acc)[2][2][4][2], const Unit& u, int wr, int wc, int fr, int fq) const {
        asm volatile("" : "+v"(fr), "+v"(fq));
        const int row0 = u.pm * 256 + wr * 64 + fr, col0 = u.pn * 128 + wc * 32 + 8 * fq;
#pragma unroll
        for (int ai = 0; ai < 2; ++ai)
#pragma unroll
            for (int m = 0; m < 4; ++m) { bf16* p = O + (size_t)(row0 + ai * 128 + m * 16) * DFF + col0;
                const f32x4 g0 = acc[ai][0][m][0], g1 = acc[ai][0][m][1], u0 = acc[ai][1][m][0], u1 = acc[ai][1][m][1];
                u32x4 w; w.x = pk2(g0.x * sigm(g0.x) * u0.x, g0.y * sigm(g0.y) * u0.y); w.y = pk2(g0.z * sigm(g0.z) * u0.z, g0.w * sigm(g0.w) * u0.w);
                w.z = pk2(g1.x * sigm(g1.x) * u1.x, g1.y * sigm(g1.y) * u1.y); w.w = pk2(g1.z * sigm(g1.z) * u1.z, g1.w * sigm(g1.w) * u1.w);
                *(u32x4*)p = w; }
    }
};
struct G2Order {
    pg8::StaticOrder b;
    __device__ bool next(int i, Unit& u) const { if (!b.next(i, u)) return false; u.ko = u.pn < 3 ? 0 : 256; return true; }
    __device__ __forceinline__ void a_ready(const Unit&) const {}
    __device__ __forceinline__ void done(const Unit&) const {}
};
struct SplitOrder {
    int c, G, kh;
    __device__ bool next(int i, Unit& u) const { const long L = (long)i * G + c; if (L >= 16) return false; u.pm = (int)L >> 3; u.pn = ((int)L >> 1) & 3; u.ko = ((int)L & 1) * kh; return true; }
    __device__ __forceinline__ void a_ready(const Unit&) const {}
    __device__ __forceinline__ void done(const Unit&) const {}
};
struct EpiPart {
    static constexpr bool PERM = false, AFTER_DRAIN = false;
    float* P;
    __device__ __forceinline__ void operator()(const f32x4 (&acc)[2][2][4][2], const Unit& u, int wr, int wc, int fr, int fq) const {
        asm volatile("" : "+v"(fr), "+v"(fq));
        const int row0 = u.pm * 256 + wr * 64 + fr, col0 = u.pn * 256 + wc * 32 + 4 * fq; float* O = P + (u.ko ? (size_t)MS * DM : 0);
#pragma unroll
        for (int ai = 0; ai < 2; ++ai)
#pragma unroll
            for (int m = 0; m < 4; ++m) { float* rowp = O + (size_t)(row0 + ai * 128 + m * 16) * DM + col0;
#pragma unroll
                for (int bj = 0; bj < 2; ++bj)
#pragma unroll
                    for (int n = 0; n < 2; ++n) *(f32x4*)(rowp + bj * 128 + n * 16) = acc[ai][bj][m][n]; }
    }
};
struct EpiMix {
    static constexpr bool PERM = true, AFTER_DRAIN = false;
    const float *w0, *a0, *k_a, *b_a, *b_i, *Lp; float* Wd; bf16 *Ks, *KK, *BV, *G; float *AL, *U; const bf16* A2;
    __device__ __forceinline__ void operator()(const f32x4 (&acc)[2][2][4][2], const Unit& u, int wr, int wc, int fr, int fq) const {
        asm volatile("" : "+v"(fr), "+v"(fq));
        const int row0 = u.pm * 256 + wr * 64 + fr;
        if (u.pn < 3) {
#pragma unroll
            for (int ai = 0; ai < 2; ++ai)
#pragma unroll
                for (int m = 0; m < 4; ++m) { const size_t ro = (size_t)(row0 + ai * 128 + m * 16) * 256;
#pragma unroll
                    for (int bj = 0; bj < 2; ++bj) { const int c = bj * 128 + wc * 32 + 8 * fq; const f32x4 z0 = acc[ai][bj][m][0], z1 = acc[ai][bj][m][1];
                        if (u.pn == 0) { const f32x4 b0 = *(const f32x4*)(w0 + c), b1 = *(const f32x4*)(w0 + c + 4); f32x4 d0, d1;
                            d0.x = __expf(-0.60653066f * sigm(z0.x + b0.x)); d0.y = __expf(-0.60653066f * sigm(z0.y + b0.y)); d0.z = __expf(-0.60653066f * sigm(z0.z + b0.z)); d0.w = __expf(-0.60653066f * sigm(z0.w + b0.w));
                            d1.x = __expf(-0.60653066f * sigm(z1.x + b1.x)); d1.y = __expf(-0.60653066f * sigm(z1.y + b1.y)); d1.z = __expf(-0.60653066f * sigm(z1.z + b1.z)); d1.w = __expf(-0.60653066f * sigm(z1.w + b1.w));
                            *(f32x4*)(Wd + ro + c) = d0; *(f32x4*)(Wd + ro + c + 4) = d1; }
                        else if (u.pn == 1) { const f32x4 b0 = *(const f32x4*)(a0 + c), b1 = *(const f32x4*)(a0 + c + 4), ka0 = *(const f32x4*)(k_a + c), ka1 = *(const f32x4*)(k_a + c + 4);
                            f32x4 ks0, ks1, kk0, kk1; ld_bf8(Ks + ro + c, ks0, ks1); ld_bf8(KK + ro + c, kk0, kk1);
                            f32x4 av0, av1; av0.x = sigm(z0.x + b0.x); av0.y = sigm(z0.y + b0.y); av0.z = sigm(z0.z + b0.z); av0.w = sigm(z0.w + b0.w);
                            av1.x = sigm(z1.x + b1.x); av1.y = sigm(z1.y + b1.y); av1.z = sigm(z1.z + b1.z); av1.w = sigm(z1.w + b1.w);
                            st_bf8(Ks + ro + c, ks0 * (1.f + (av0 - 1.f) * ka0), ks1 * (1.f + (av1 - 1.f) * ka1)); st_bf8(BV + ro + c, kk0 * av0, kk1 * av1); }
                        else { st_bf8(G + ro + c, z0, z1); }
                        asm volatile("" ::: "memory"); } }
        } else {
            const int t = u.pn - 3;
#pragma unroll
            for (int ai = 0; ai < 2; ++ai)
#pragma unroll
                for (int m = 0; m < 4; ++m) { const size_t r = (size_t)(row0 + ai * 128 + m * 16); const int cc0 = 128 * t + wc * 32 + 8 * fq;
                    f32x4 xc0, xc1; ld_bf8(A2 + r * K2 + 256 + cc0, xc0, xc1);
#pragma unroll
                    for (int n = 0; n < 2; ++n) { const int cc = cc0 + 4 * n;
                        const f32x4 zr = acc[ai][0][m][n] + *(const f32x4*)(b_a + cc), zi = acc[ai][1][m][n] + *(const f32x4*)(b_i + cc), Lv = *(const f32x4*)(Lp + cc), xc = n ? xc1 : xc0;
                        f32x4 al, uu;
#define LRU1(e) { const float xe = __expf(-Lv.e); const float ls = -xe * (1.f + xe * (-0.5f + xe * 0.33333334f)); const float la = 8.f * sigm(zr.e) * ls; al.e = __expf(la); const float z2 = 2.f * la; \
    const float om = -z2 * (1.f + z2 * (0.5f + z2 * (0.16666667f + z2 * (0.041666668f + z2 * 0.0083333338f)))); uu.e = __builtin_amdgcn_sqrtf(om) * sigm(zi.e) * xc.e; }
                        LRU1(x) LRU1(y) LRU1(z) LRU1(w)
#undef LRU1
                        *(f32x4*)(AL + r * 256 + cc) = al; *(f32x4*)(U + r * 256 + cc) = uu; asm volatile("" ::: "memory"); } }
        }
    }
};

#define RLX_AGENT __ATOMIC_RELAXED, __HIP_MEMORY_SCOPE_AGENT
#define XB_TMO      128
#define XB_XCNT(j)  (256  + 64 * (j))
#define XB_XSUB(j)  (1280 + 64 * (j))
#define XB_XGEN(j)  (2304 + 64 * (j))
#define XB_TOP      3328
#define XB_TOPGEN   3392
#define XCD_BAR_WORDS 3456
#define XB_SPIN_CAP (1u << 18)

__device__ __forceinline__ unsigned xb_ld(unsigned* p)              { return __hip_atomic_load(p, __ATOMIC_RELAXED, __HIP_MEMORY_SCOPE_AGENT); }
__device__ __forceinline__ unsigned xb_add(unsigned* p, unsigned v) { return __hip_atomic_fetch_add(p, v, __ATOMIC_RELAXED, __HIP_MEMORY_SCOPE_AGENT); }
__device__ __forceinline__ unsigned xb_xcc_id() { return (unsigned)__builtin_amdgcn_s_getreg((3 << 11) | 20) & 0xFu; }
#define XB_SPIN(cond, bar) do { unsigned _sp = 0; while (cond) { __builtin_amdgcn_s_sleep(1); \
    if ((++_sp & 255u) == 0u) { if (xb_ld(&(bar)[XB_TMO])) break; if (_sp > XB_SPIN_CAP) { atomicAdd(&(bar)[XB_TMO], 1u); break; } } } } while (0)

struct XcdBarrier {
    unsigned* bar; unsigned x;
    volatile LAS unsigned* st;
};

__device__ __forceinline__ XcdBarrier xcd_barrier_post(unsigned* bar, volatile LAS unsigned* st, int tid) {
    XcdBarrier b; b.bar = bar; b.x = xb_xcc_id(); b.st = st;
    if (tid == 0) (void)xb_add(&bar[XB_XCNT(b.x)], 1u);
    return b;
}
__device__ __forceinline__ void xcd_barrier_complete(unsigned* bar, unsigned x, unsigned& nloc, unsigned& nx) {
    const unsigned G = gridDim.x * gridDim.y * gridDim.z;
    unsigned sum, cnt, mine, sp = 0u;
    for (;;) {
        sum = 0u; cnt = 0u; mine = 0u;
#pragma unroll
        for (unsigned j = 0; j < 16; ++j) { const unsigned c = xb_ld(&bar[XB_XCNT(j)]); sum += c; cnt += (c > 0u) ? 1u : 0u; mine = (j == x) ? c : mine; }
        if (sum == G) break;
        __builtin_amdgcn_s_sleep(1);
        if ((++sp & 255u) == 0u) { if (xb_ld(&bar[XB_TMO])) break; if (sp > XB_SPIN_CAP) { atomicAdd(&bar[XB_TMO], 1u); break; } }
    }
    nloc = mine > 0u ? mine : 1u; nx = cnt > 0u ? cnt : 1u;
}

__device__ __forceinline__ void xcd_barrier(const XcdBarrier& b, int tid) {
    asm volatile("s_waitcnt vmcnt(0)" ::: "memory");
    __syncthreads();
    if (tid == 0) {
        unsigned* bar = b.bar;
        __builtin_amdgcn_s_waitcnt(0);
        unsigned nloc = b.st[0], nx = b.st[1];
        if (nloc == 0u) { xcd_barrier_complete(bar, b.x, nloc, nx); b.st[0] = nloc; b.st[1] = nx; }
        const unsigned old = xb_add(&bar[XB_XSUB(b.x)], 1u);
        const unsigned gen = old / nloc;
        if (old + 1u == (gen + 1u) * nloc) {
            __builtin_amdgcn_fence(__ATOMIC_RELEASE, "agent");
            asm volatile("s_waitcnt vmcnt(0)" ::: "memory");
            const unsigned og = xb_add(&bar[XB_TOP], 1u);
            const unsigned tg = og / nx;
            if (og + 1u == (tg + 1u) * nx) xb_add(&bar[XB_TOPGEN], 1u);
            else XB_SPIN(xb_ld(&bar[XB_TOPGEN]) == tg, bar);
            __builtin_amdgcn_fence(__ATOMIC_ACQUIRE, "agent");
            xb_add(&bar[XB_XGEN(b.x)], 1u);
            asm volatile("s_waitcnt vmcnt(0)" ::: "memory");
        } else {
            XB_SPIN(xb_ld(&bar[XB_XGEN(b.x)]) == gen, bar);
            __builtin_amdgcn_fence(__ATOMIC_ACQUIRE, "agent");
            asm volatile("s_waitcnt vmcnt(0)" ::: "memory");
        }
    }
    __syncthreads();
}
struct Args { const float* in[N_IN]; float* out; unsigned char* ws; };
struct Ctx {
    LAS unsigned char* lds; unsigned char* ws; float* out;
    int tid, lane, wave, bid, G, gw, NGW;
};
__device__ __forceinline__ const float* inp_ld(int k) {
    asm volatile("" : "+s"(k));
    const __attribute__((address_space(4))) unsigned long long* tab = (const __attribute__((address_space(4))) unsigned long long*)__builtin_amdgcn_kernarg_segment_ptr();
    return (const float*)tab[k];
}
#define INP(k) inp_ld(k)
__device__ __forceinline__ int opq(int v) { asm volatile("" : "+v"(v)); return v; }

__device__ __forceinline__ void tr_item(const float* W, int ldw, bf16* WT, int ldt, int k0, int n0, int drow, int dcol, LAS float* scr, int lane) {
#pragma unroll 8
    for (int i = 0; i < 32; ++i) { const int kk = 2 * i + (lane >> 5); scr[kk * 33 + (lane & 31)] = W[(size_t)(k0 + kk) * ldw + n0 + (lane & 31)]; }
    LDS_WAIT(); asm volatile("" ::: "memory");
    const int c = lane & 7;
#pragma unroll
    for (int j = 0; j < 4; ++j) { const int n = (lane >> 3) + 8 * j; const LAS float* s = scr + (8 * c) * 33 + n;
        u32x4 o; o.x = pk2(s[0 * 33], s[1 * 33]); o.y = pk2(s[2 * 33], s[3 * 33]); o.z = pk2(s[4 * 33], s[5 * 33]); o.w = pk2(s[6 * 33], s[7 * 33]);
        *(u32x4*)(WT + (size_t)(drow + n) * ldt + dcol + 8 * c) = o; }
    LDS_WAIT(); asm volatile("" ::: "memory");
}
__device__ __forceinline__ void row_norm_in(const float* xrow, const float* g, bf16* orow, bf16* xcopy, int lane) {
    f32x4 v[4]; float ss = 0.f;
#pragma unroll
    for (int j = 0; j < 4; ++j) { v[j] = *(const f32x4*)(xrow + 4 * lane + 256 * j); ss += dot4(v[j], v[j]); }
    const float rs = rsqrtf(wave_sum(ss) * (1.f / DM) + 1e-6f);
#pragma unroll
    for (int j = 0; j < 4; ++j) { const f32x4 gg = *(const f32x4*)(g + 4 * lane + 256 * j); if (xcopy) st_bf4(xcopy + 4 * lane + 256 * j, v[j]); st_bf4(orow + 4 * lane + 256 * j, v[j] * rs * gg); }
}
__device__ __forceinline__ void row_norm(const bf16* xrow, const float* g, bf16* orow, int lane) {
    f32x4 v[4]; float ss = 0.f;
#pragma unroll
    for (int j = 0; j < 2; ++j) { ld_bf8(xrow + 8 * lane + 512 * j, v[2 * j], v[2 * j + 1]); ss += dot4(v[2 * j], v[2 * j]) + dot4(v[2 * j + 1], v[2 * j + 1]); }
    const float rs = rsqrtf(wave_sum(ss) * (1.f / DM) + 1e-6f);
#pragma unroll
    for (int j = 0; j < 2; ++j) { const float* gp = g + 8 * lane + 512 * j; st_bf8(orow + 8 * lane + 512 * j, v[2 * j] * rs * *(const f32x4*)gp, v[2 * j + 1] * rs * *(const f32x4*)(gp + 4)); }
}
__device__ __forceinline__ void row_update_parts(const float* p0, const float* p1, const float* bias, const float* gA, bf16* X, const float* gB, bf16* outB, int lane) {
    f32x4 a[4], x[4]; float ss = 0.f;
#pragma unroll
    for (int j = 0; j < 4; ++j) { a[j] = *(const f32x4*)(p0 + 4 * lane + 256 * j) + *(const f32x4*)(p1 + 4 * lane + 256 * j); if (bias) a[j] = a[j] + *(const f32x4*)(bias + 4 * lane + 256 * j);
        x[j] = ld_bf4(X + 4 * lane + 256 * j); ss += dot4(a[j], a[j]); }
    const float rs = rsqrtf(wave_sum(ss) * (1.f / DM) + 1e-6f); float s2 = 0.f;
#pragma unroll
    for (int j = 0; j < 4; ++j) { const f32x4 gg = *(const f32x4*)(gA + 4 * lane + 256 * j); x[j] = x[j] + a[j] * rs * gg; st_bf4(X + 4 * lane + 256 * j, x[j]); s2 += dot4(x[j], x[j]); }
    float r2 = 1.f;
    if (gB) r2 = rsqrtf(wave_sum(s2) * (1.f / DM) + 1e-6f);
#pragma unroll
    for (int j = 0; j < 4; ++j) { f32x4 o = x[j]; if (gB) o = o * r2 * *(const f32x4*)(gB + 4 * lane + 256 * j); st_bf4(outB + 4 * lane + 256 * j, o); }
}
__device__ __forceinline__ void row_update(const bf16* add, const float* gA, bf16* X, const float* gB, bf16* outB, int lane) {
    f32x4 a[4], x[4]; float ss = 0.f;
#pragma unroll
    for (int j = 0; j < 2; ++j) { ld_bf8(add + 8 * lane + 512 * j, a[2 * j], a[2 * j + 1]); ld_bf8(X + 8 * lane + 512 * j, x[2 * j], x[2 * j + 1]); ss += dot4(a[2 * j], a[2 * j]) + dot4(a[2 * j + 1], a[2 * j + 1]); }
    const float rs = rsqrtf(wave_sum(ss) * (1.f / DM) + 1e-6f); float s2 = 0.f;
#pragma unroll
    for (int j = 0; j < 2; ++j) { const float* gp = gA + 8 * lane + 512 * j; x[2 * j] = x[2 * j] + a[2 * j] * rs * *(const f32x4*)gp; x[2 * j + 1] = x[2 * j + 1] + a[2 * j + 1] * rs * *(const f32x4*)(gp + 4);
        st_bf8(X + 8 * lane + 512 * j, x[2 * j], x[2 * j + 1]); s2 += dot4(x[2 * j], x[2 * j]) + dot4(x[2 * j + 1], x[2 * j + 1]); }
    float r2 = 1.f;
    if (gB) r2 = rsqrtf(wave_sum(s2) * (1.f / DM) + 1e-6f);
#pragma unroll
    for (int j = 0; j < 2; ++j) { f32x4 o0 = x[2 * j], o1 = x[2 * j + 1]; if (gB) { const float* gp = gB + 8 * lane + 512 * j; o0 = o0 * r2 * *(const f32x4*)gp; o1 = o1 * r2 * *(const f32x4*)(gp + 4); } st_bf8(outB + 8 * lane + 512 * j, o0, o1); }
}

__device__ __forceinline__ void convert_layer(const Ctx& C, const Args& A, int l, int gw0, int ngw, int gt, int NT) {
    LAS float* scr = (LAS float*)(C.lds + C.wave * 16384);
    constexpr int J0 = 16 * 72, J1 = 16 * 32, J2 = 16 * 88, J4 = 44 * 32, J5 = 16 * 32, J6 = 4 * 32, JL = J0 + J1 + 2 * J2 + J4 + J5 + J6;
    unsigned char* wl = C.ws + WS_W + (size_t)(l & 1) * WL;
    for (int it = gw0; it < JL; it += ngw) {
        int r = it;
        const float* W; int ldw, ldt, kb, nb, drow; bf16* WT;
        if (r < J0) { W = INP(I_WIN) + (size_t)l * DM * INC; ldw = INC; WT = (bf16*)(wl + O_WIN); ldt = DM; kb = r / 72; nb = r % 72; drow = 32 * nb; }
        else if ((r -= J0) < J1) { W = INP(I_WOUT) + (size_t)l * DM * DM; ldw = DM; WT = (bf16*)(wl + O_WOUT); ldt = DM; kb = r / 32; nb = r % 32; drow = 32 * nb; }
        else if ((r -= J1) < J2) { W = INP(I_WG) + (size_t)l * DM * DFF; ldw = DFF; WT = (bf16*)(wl + O_WGU); ldt = DM; kb = r / 88; nb = r % 88; drow = (nb >> 2) * 256 + (nb & 3) * 32; }
        else if ((r -= J2) < J2) { W = INP(I_WU) + (size_t)l * DM * DFF; ldw = DFF; WT = (bf16*)(wl + O_WGU); ldt = DM; kb = r / 88; nb = r % 88; drow = (nb >> 2) * 256 + 128 + (nb & 3) * 32; }
        else if ((r -= J2) < J4) { W = INP(I_WDN) + (size_t)l * DFF * DM; ldw = DM; WT = (bf16*)(wl + O_WD); ldt = DFF; kb = r / 32; nb = r % 32; drow = 32 * nb; }
        else if ((r -= J4) < J5) { W = INP(I_PGW) + (size_t)l * DM * DM; ldw = DM; WT = (bf16*)(wl + O_WPG); ldt = DM; kb = r / 32; nb = r % 32; drow = 32 * nb; }
        else { r -= J5; W = INP(I_PW) + (size_t)l * PLE * DM; ldw = DM; WT = (bf16*)(wl + O_WP); ldt = PLE; kb = r / 32; nb = r % 32; drow = 32 * nb; }
        tr_item(W, ldw, WT, ldt, 64 * kb, 32 * nb, drow, 64 * kb, scr, C.lane);
    }
#pragma unroll 1
    for (int r = gt; r < N2 * K2; r = opq(r + NT)) {
        const int n = r / K2, k = r % K2; float v = 0.f;
        if (n < 256) { if (k < 64) v = INP(I_WUP)[((size_t)l * 64 + k) * 256 + n]; }
        else if (n < 512) { if (k >= 64 && k < 128) v = INP(I_AUP)[((size_t)l * 64 + (k - 64)) * 256 + (n - 256)]; }
        else if (n < 768) { if (k >= 128 && k < 256) v = INP(I_GUP)[((size_t)l * 128 + (k - 128)) * 256 + (n - 512)]; }
        else { const int tt = (n - 768) >> 8, rr = (n - 768) & 255, cc = 128 * tt + (rr & 127), h = cc >> 6, j = cc & 63;
            if (k >= 256 && ((k - 256) >> 6) == h) v = ((rr >> 7) ? INP(I_WI) : INP(I_WA))[(((size_t)l * 4 + h) * 64 + ((k - 256) & 63)) * 64 + j]; }
        ((bf16*)(wl + O_W2))[r] = (bf16)f2bf(v);
    }
#pragma unroll 1
    for (int r = gt; r < M * (PLE / 4); r = opq(r + NT)) {
        const int m = r >> 6, c4 = (r & 63) * 4;
        const float* src = m < MP ? INP(I_PP) + ((size_t)l * MP + m) * PLE + c4 : INP(I_PS) + ((size_t)l * MS + (m - MP)) * PLE + c4;
        st_bf4((bf16*)(C.ws + WS_PB + (size_t)(l & 1) * SZ_PBL) + (size_t)m * PLE + c4, *(const f32x4*)src);
    }
}
__device__ __forceinline__ void p0_prologue(const Ctx& C, const Args& A) {
    convert_layer(C, A, 0, C.gw, C.NGW, C.bid * 512 + C.tid, C.G * 512);
    for (int m = C.gw; m < M; m += C.NGW) {
        const float* src = m < MP ? INP(I_XP) + (size_t)m * DM : INP(I_XS) + (size_t)(m - MP) * DM;
        row_norm_in(src, INP(I_NMPRE), (bf16*)(C.ws + WS_HN) + (size_t)m * DM, (bf16*)(C.ws + WS_X16) + (size_t)m * DM, C.lane);
    }
}

__device__ __forceinline__ void e1_prep(const Ctx& C, const Args& A, int l) {
    const bf16* PROJ = (const bf16*)(C.ws + WS_R1);
    bf16* R = (bf16*)(C.ws + WS_R2); bf16* Ks = (bf16*)(C.ws + WS_R2 + SZ_F256); bf16* V = (bf16*)(C.ws + WS_R2 + 2 * SZ_F256); bf16* KK = (bf16*)(C.ws + WS_R2 + 3 * SZ_F256);
    bf16* A2 = (bf16*)(C.ws + WS_R3);
    const int lane = C.lane, c4 = 4 * lane;
    for (int m = C.gw; m < M; m += C.NGW) {
        const bool samp = m >= MP; int b, t;
        if (!samp) { b = m >> 12; t = m & 4095; } else { b = (m - MP) >> 2; t = (m - MP) & 3; }
        const bf16* pr = PROJ + (size_t)m * INC;
        { const int half = lane >> 5, l32 = lane & 31, c8 = 8 * l32;
#pragma unroll
          for (int p = 0; p < 2; ++p) {
            const int cg = p == 0 ? 2 * half : 1 + 2 * half, col = 256 * cg + c8;
            f32x4 cur0, cur1, prv0 = (f32x4){0.f, 0.f, 0.f, 0.f}, prv1 = prv0; ld_bf8(pr + C_RW + col, cur0, cur1);
            if (t > 0) ld_bf8(pr - INC + C_RW + col, prv0, prv1);
            else if (samp) { const float* sp = INP(I_SSH) + ((size_t)l * DB + b) * 1024 + col; prv0 = *(const f32x4*)sp; prv1 = *(const f32x4*)(sp + 4); }
            const float* mp_ = INP(I_MU) + l * 1024 + col;
            const f32x4 xs0 = cur0 + (prv0 - cur0) * *(const f32x4*)mp_, xs1 = cur1 + (prv1 - cur1) * *(const f32x4*)(mp_ + 4);
            if (p == 0) st_bf8((half ? V : R) + (size_t)m * 256 + c8, xs0, xs1);
            else if (half == 0) { st_bf8(Ks + (size_t)m * 256 + c8, xs0, xs1); const float* kp = INP(I_KK) + l * 256 + c8; f32x4 kk0 = xs0 * *(const f32x4*)kp, kk1 = xs1 * *(const f32x4*)(kp + 4);
                const float sc = rsqrtf(fmaxf(red8(dot4(kk0, kk0) + dot4(kk1, kk1)), 1e-24f)); st_bf8(KK + (size_t)m * 256 + c8, kk0 * sc, kk1 * sc); }
            else { f32x4 o0, o1;
                if (l32 < 8) { o0 = (f32x4){tanh_(xs0.x), tanh_(xs0.y), tanh_(xs0.z), tanh_(xs0.w)}; o1 = (f32x4){tanh_(xs1.x), tanh_(xs1.y), tanh_(xs1.z), tanh_(xs1.w)}; }
                else if (l32 < 16) { o0 = xs0; o1 = xs1; }
                else { o0 = (f32x4){sigm(xs0.x), sigm(xs0.y), sigm(xs0.z), sigm(xs0.w)}; o1 = (f32x4){sigm(xs1.x), sigm(xs1.y), sigm(xs1.z), sigm(xs1.w)}; }
                st_bf8(A2 + (size_t)m * K2 + c8, o0, o1); }
          } }
        f32x4 xc = *(const f32x4*)(INP(I_CB) + l * 256 + c4);
#pragma unroll
        for (int j = 0; j < 4; ++j) { const int tt = t - 3 + j; f32x4 val = (f32x4){0.f, 0.f, 0.f, 0.f};
            if (tt >= 0) val = ld_bf4(pr + (ptrdiff_t)(j - 3) * INC + C_XB + c4);
            else if (samp) val = *(const f32x4*)(INP(I_SCV) + (((size_t)l * DB + b) * 3 + (tt + 3)) * 256 + c4);
            xc = xc + val * *(const f32x4*)(INP(I_CW) + ((size_t)l * 4 + j) * 256 + c4); }
        st_bf4(A2 + (size_t)m * K2 + 256 + c4, xc);
    }
    const int gt = C.bid * 512 + C.tid, NT = C.G * 512;
    float* out = C.out;
#pragma unroll 1
    for (int e = gt; e < 2 * NBP * 128 * 128; e = opq(e + NT)) {
        const int kv = e / (NBP * 16384), r = e % (NBP * 16384), b = r >> 14, rr = (r >> 7) & 127, c = r & 127;
        out[(kv ? OUT_VP : OUT_KP) + (size_t)l * NBP * 16384 + r] = bf1(PROJ[(size_t)(b * T + T - 128 + rr) * INC + (kv ? C_V : C_K) + c]);
    }
#pragma unroll 1
    for (int e = gt; e < NBP * 1024; e = opq(e + NT)) { const int b = e >> 10, c = e & 1023; out[OUT_SHP + (size_t)l * NBP * 1024 + e] = bf1(PROJ[(size_t)(b * T + T - 1) * INC + C_RW + c]); }
#pragma unroll 1
    for (int e = gt; e < DB * 1024; e = opq(e + NT)) { const int b = e >> 10, c = e & 1023; out[OUT_SHS + (size_t)l * DB * 1024 + e] = bf1(PROJ[(size_t)(MP + 4 * b + 3) * INC + C_RW + c]); }
#pragma unroll 1
    for (int e = gt; e < NBP * 768; e = opq(e + NT)) { const int b = e / 768, j = (e % 768) >> 8, c = e & 255; out[OUT_CVP + (size_t)l * NBP * 768 + e] = bf1(PROJ[(size_t)(b * T + T - 3 + j) * INC + C_XB + c]); }
#pragma unroll 1
    for (int e = gt; e < DB * 768; e = opq(e + NT)) { const int b = e / 768, j = (e % 768) >> 8, c = e & 255; out[OUT_CVS + (size_t)l * DB * 768 + e] = bf1(PROJ[(size_t)(MP + 4 * b + 1 + j) * INC + C_XB + c]); }
}

struct RwkvPtrs { const bf16 *R, *K, *V, *KK, *BV; const float* W; float* YR; };
__device__ __forceinline__ void rwkv_step(f32x4& s, const f32x4 w, const f32x4 kk, const f32x4 bv, const f32x4 k2, const f32x4 r, const float v, float& y) {
    const float sa = red16(dot4(s, kk));
    s = s * w + (k2 * v - bv * sa);
    y = red16(dot4(s, r));
}
__device__ __forceinline__ void rwkv_prompt(const Ctx& C, const RwkvPtrs& P, int wg, float* wkv_out  ) {
    constexpr int TC = 32, VEC = TC * 64 * 4, O_V = 5 * VEC, BUF = O_V + TC * 16 * 4, O_Q = 2 * BUF;
    static_assert(O_Q + TC * 1024 <= 131072, "LDS");
    const int chain = wg >> 2, b = chain >> 2, h = chain & 3, qr = wg & 3, tid = C.tid, lane = C.lane, wave = C.wave;
    const size_t m0 = (size_t)b * T;
    const int ltid = tid - 256, lstep = ltid >> 4, lq = tid & 15;
    const int vstep = ltid >> 2, vq = ltid & 3;
    f32x4 st[2][5], stv;
    f32x4 s = (f32x4){0.f, 0.f, 0.f, 0.f};
    const int row = 16 * qr + 4 * wave + (lane >> 4), cq = lane & 15;
#define RW_LOAD(c) do { if (wave >= 4) { _Pragma("unroll") for (int u = 0; u < 2; ++u) { const size_t o_ = (m0 + (size_t)(c) * TC + lstep + 16 * u) * 256 + h * 64 + 4 * lq; \
        st[u][0] = *(const f32x4*)(P.W + o_); st[u][1] = ld_bf4(P.KK + o_); st[u][2] = ld_bf4(P.BV + o_); st[u][3] = ld_bf4(P.K + o_); st[u][4] = ld_bf4(P.R + o_); } \
        if (ltid < 128) stv = ld_bf4(P.V + (m0 + (size_t)(c) * TC + vstep) * 256 + h * 64 + 16 * qr + 4 * vq); } } while (0)
#define RW_STORE(bufi) do { if (wave >= 4) { LAS unsigned char* bb = C.lds + (bufi) * BUF; _Pragma("unroll") for (int u = 0; u < 2; ++u) { const int ls = lstep + 16 * u; \
        _Pragma("unroll") for (int i = 0; i < 5; ++i) *(LAS f32x4*)(bb + i * VEC + (ls * 64 + 4 * lq) * 4) = st[u][i]; } \
        if (ltid < 128) *(LAS f32x4*)(bb + O_V + (vstep * 16 + 4 * vq) * 4) = stv; } } while (0)
#define RW_FLUSH(cc, half) do { if (wave >= 4) { const int stp = lstep + 16 * (half); const LAS f32x4* qp = (const LAS f32x4*)(C.lds + O_Q + stp * 1024 + (lq >> 2) * 256 + (lq & 3) * 64); \
        const f32x4 a0 = qp[0], a1_ = qp[1], a2_ = qp[2], a3 = qp[3]; const f32x4 t_ = (a0 + a1_) + (a2_ + a3); \
        P.YR[(m0 + (size_t)(cc) * TC + stp) * 256 + h * 64 + 16 * qr + lq] = (t_.x + t_.y) + (t_.z + t_.w); } } while (0)
    RW_LOAD(0); RW_STORE(0); __syncthreads();
    for (int c = 0; c < T / TC; ++c) {
        if (c > 0) RW_FLUSH(c - 1, 1);
        if (c + 1 < T / TC) RW_LOAD(c + 1);
        if (wave < 4) {
            const LAS unsigned char* bb = C.lds + (c & 1) * BUF;
            const int vo = O_V + (4 * wave + (lane >> 4)) * 4, lo = 16 * cq;
            LAS float* ring = (LAS float*)(C.lds + O_Q) + wave * 64 + lane;
            f32x4 w = *(const LAS f32x4*)(bb + 0 * VEC + lo), kk = *(const LAS f32x4*)(bb + 1 * VEC + lo), bv = *(const LAS f32x4*)(bb + 2 * VEC + lo),
                  k2 = *(const LAS f32x4*)(bb + 3 * VEC + lo), r = *(const LAS f32x4*)(bb + 4 * VEC + lo), rp = r;
            float v = *(const LAS float*)(bb + vo), qpend = 0.f;
            const unsigned b1 = (unsigned)(unsigned long long)(bb + lo), b2 = (unsigned)(unsigned long long)(bb + vo), qa = (unsigned)(unsigned long long)ring;
            f32x4 nw, nkk, nbv, nk2, nr; float nv;
#define RW_A_DOT "v_mul_f32 %6, %10, %14\n\tv_fma_f32 %6, %11, %15, %6\n\tv_fma_f32 %6, %12, %16, %6\n\tv_fma_f32 %6, %13, %17, %6"
#define RW_A_RD "ds_read_b128 %0, %7 offset:%c19\n\tds_read_b128 %1, %7 offset:%c20\n\tds_read_b128 %2, %7 offset:%c21\n\tds_read_b128 %3, %7 offset:%c22\n\tds_read_b128 %4, %7 offset:%c23\n\tds_read_b32 %5, %8 offset:%c24\n\t"
#define RW_A_OPS(IN, WO) : "=&v"(nw), "=&v"(nkk), "=&v"(nbv), "=&v"(nk2), "=&v"(nr), "=&v"(nv), "=&v"(sa) \
                 : "v"(b1), "v"(b2), "v"(qa), "v"(s.x), "v"(s.y), "v"(s.z), "v"(s.w), "v"(kk.x), "v"(kk.y), "v"(kk.z), "v"(kk.w), "v"(qpend), \
                   "n"(0 * VEC + (IN) * 256), "n"(1 * VEC + (IN) * 256), "n"(2 * VEC + (IN) * 256), "n"(3 * VEC + (IN) * 256), "n"(4 * VEC + (IN) * 256), "n"((IN) * 64), "n"(WO) : "memory"
#define RW_STEP(I, IN) { float sa, q, t0, t1, t2, t3; \
                if ((I) < 2 || (I) == 16 || (I) == 17) asm volatile(RW_A_RD "s_waitcnt lgkmcnt(6)\n\t" RW_A_DOT RW_A_OPS(IN, 0)); \
                else asm volatile("ds_write_b32 %9, %18 offset:%c25\n\t" RW_A_RD "s_waitcnt lgkmcnt(7)\n\t" RW_A_DOT RW_A_OPS(IN, ((I) >= 2 ? (I) - 2 : 0) * 1024)); \
                asm volatile("v_mul_f32 %2, %6, %10\n\tv_mul_f32 %3, %7, %10\n\t" \
                             "v_add_f32_dpp %0, %0, %0 quad_perm:[1,0,3,2] row_mask:0xf bank_mask:0xf bound_ctrl:1\n\t" \
                             "v_mul_f32 %1, %11, %15\n\tv_fma_f32 %1, %12, %16, %1\n\t" \
                             "v_add_f32_dpp %0, %0, %0 quad_perm:[2,3,0,1] row_mask:0xf bank_mask:0xf bound_ctrl:1\n\t" \
                             "v_fma_f32 %1, %13, %17, %1\n\tv_fma_f32 %1, %14, %18, %1\n\t" \
                             "v_add_f32_dpp %0, %0, %0 row_half_mirror row_mask:0xf bank_mask:0xf bound_ctrl:1\n\t" \
                             "v_mul_f32 %4, %8, %10\n\tv_mul_f32 %5, %9, %10\n\t" \
                             "v_add_f32_dpp %0, %0, %0 row_ror:8 row_mask:0xf bank_mask:0xf bound_ctrl:1" \
                             : "+v"(sa), "=&v"(q), "=&v"(t0), "=&v"(t1), "=&v"(t2), "=&v"(t3) \
                             : "v"(k2.x), "v"(k2.y), "v"(k2.z), "v"(k2.w), "v"(v), "v"(s.x), "v"(s.y), "v"(s.z), "v"(s.w), "v"(rp.x), "v"(rp.y), "v"(rp.z), "v"(rp.w)); \
                asm volatile("v_fma_f32 %4, -%8, %9, %4\n\tv_fma_f32 %5, -%8, %10, %5\n\tv_fma_f32 %6, -%8, %11, %6\n\tv_fma_f32 %7, -%8, %12, %7\n\t" \
                             "v_fma_f32 %0, %0, %13, %4\n\tv_fma_f32 %1, %1, %14, %5\n\tv_fma_f32 %2, %2, %15, %6\n\tv_fma_f32 %3, %3, %16, %7" \
                             : "+v"(s.x), "+v"(s.y), "+v"(s.z), "+v"(s.w), "+v"(t0), "+v"(t1), "+v"(t2), "+v"(t3) \
                             : "v"(sa), "v"(bv.x), "v"(bv.y), "v"(bv.z), "v"(bv.w), "v"(w.x), "v"(w.y), "v"(w.z), "v"(w.w)); \
                qpend = q; rp = r; w = nw; kk = nkk; bv = nbv; k2 = nk2; r = nr; v = nv; }
#define RW_STEP4(I) RW_STEP(I, (I) + 1) RW_STEP((I) + 1, (I) + 2) RW_STEP((I) + 2, (I) + 3) RW_STEP((I) + 3, ((I) + 4 < TC ? (I) + 4 : TC - 1))
#define RW_HALF_END(h0) do { asm volatile("s_waitcnt lgkmcnt(0)" :: "v"(w), "v"(kk), "v"(bv), "v"(k2), "v"(r), "v"(v) : "memory"); \
                ring[((h0) + 14) * 256] = qpend; ring[((h0) + 15) * 256] = dot4(s, rp); } while (0)
            RW_STEP4(0) RW_STEP4(4) RW_STEP4(8) RW_STEP4(12)
            RW_HALF_END(0);
            __syncthreads();
            RW_STEP4(16) RW_STEP4(20) RW_STEP4(24) RW_STEP4(28)
            RW_HALF_END(16);
#undef RW_HALF_END
#undef RW_STEP4
#undef RW_STEP
#undef RW_A_OPS
#undef RW_A_RD
#undef RW_A_DOT
        } else {
            __syncthreads();
            RW_FLUSH(c, 0);
        }
        if (c + 1 < T / TC) RW_STORE((c + 1) & 1);
        __syncthreads();
    }
    RW_FLUSH(T / TC - 1, 1);
#undef RW_LOAD
#undef RW_STORE
#undef RW_FLUSH
    if (wave < 4) *(f32x4*)(wkv_out + (((size_t)b * 4 + h) * 64 + row) * 64 + 4 * cq) = s;
    __syncthreads();
}
__device__ __forceinline__ void rwkv_sample_item(const RwkvPtrs& P, int item, const float* wkv_in, float* wkv_out, int lane) {
    const int rg = item & 15, h = (item >> 4) & 3, b = item >> 6, row = 4 * rg + (lane >> 4), cq = lane & 15;
    const size_t so = (((size_t)b * 4 + h) * 64 + row) * 64 + 4 * cq;
    f32x4 s = *(const f32x4*)(wkv_in + so);
#pragma unroll
    for (int i = 0; i < DS; ++i) { const size_t m = (size_t)MP + 4 * b + i, o = m * 256 + h * 64 + 4 * cq;
        float y; rwkv_step(s, *(const f32x4*)(P.W + o), ld_bf4(P.KK + o), ld_bf4(P.BV + o), ld_bf4(P.K + o), ld_bf4(P.R + o), bf1(P.V[m * 256 + h * 64 + row]), y);
        if (cq == 0) P.YR[m * 256 + h * 64 + row] = y; }
    *(f32x4*)(wkv_out + so) = s;
}
__device__ __forceinline__ void lru_prompt_item(const Ctx& C, int item, const float* AL, const float* U, const bf16* PROJ, bf16* MIXCAT, float* lru_out  ) {
    const int b = item >> 4, c = (item & 15) * 16 + (C.tid & 15), seg = C.tid >> 4; constexpr int SL = T / 32;
    const size_t m0 = (size_t)b * T + (size_t)seg * SL;
    LAS float* sA = (LAS float*)C.lds; LAS float* sH = sA + 512;
    float Ap = 1.f, H = 0.f;
#pragma unroll 8
    for (int i = 0; i < SL; ++i) { const float a = AL[(m0 + i) * 256 + c], u = U[(m0 + i) * 256 + c]; H = a * H + u; Ap *= a; }
    sA[C.tid] = Ap; sH[C.tid] = H;
    __syncthreads();
    float h = 0.f;
    for (int sp = 0; sp < seg; ++sp) h = sA[sp * 16 + (C.tid & 15)] * h + sH[sp * 16 + (C.tid & 15)];
#pragma unroll 8
    for (int i = 0; i < SL; ++i) { const float a = AL[(m0 + i) * 256 + c], u = U[(m0 + i) * 256 + c]; h = a * h + u;
        const float gb = bf1(PROJ[(m0 + i) * INC + C_GB + c]); MIXCAT[(m0 + i) * DM + 768 + c] = (bf16)f2bf(h * gelu_t(gb)); }
    if (seg == 31) lru_out[b * 256 + c] = h;
    __syncthreads();
}
__device__ __forceinline__ void swa_prompt_item(const Ctx& C, int item, const bf16* PROJ, bf16* MIXCAT, const float* sinks  ) {
    constexpr int KP = 72, VP = 264;
    const int kvh = item & 1, n = (item >> 1) & 31, b = item >> 6, tid = C.tid, lane = C.lane, wave = C.wave;
    LAS bf16* Ks = (LAS bf16*)C.lds; LAS bf16* Vt = Ks + 256 * KP;
    const size_t rowq0 = (size_t)b * T + (size_t)n * 128;
    { const int key = tid >> 1, hf = tid & 1; size_t kr = rowq0 + key; kr = (kr >= 128 + (size_t)b * T) ? kr - 128 : kr;
        const bf16* kp = PROJ + kr * INC + C_K + kvh * 64 + hf * 32;
#pragma unroll
        for (int i = 0; i < 4; ++i) *(LAS u32x4*)(Ks + key * KP + hf * 32 + 8 * i) = *(const u32x4*)(kp + 8 * i);
#pragma unroll
        for (int i = 0; i < 4; ++i) { const int ch = tid + 512 * i, vk = ch >> 3, d0 = (ch & 7) * 8; size_t vr = rowq0 + vk; vr = (vr >= 128 + (size_t)b * T) ? vr - 128 : vr;
            const u32x4 w = *(const u32x4*)(PROJ + vr * INC + C_V + kvh * 64 + d0);
            Vt[(d0 + 0) * VP + vk] = (bf16)(w.x & 0xffff); Vt[(d0 + 1) * VP + vk] = (bf16)(w.x >> 16); Vt[(d0 + 2) * VP + vk] = (bf16)(w.y & 0xffff); Vt[(d0 + 3) * VP + vk] = (bf16)(w.y >> 16);
            Vt[(d0 + 4) * VP + vk] = (bf16)(w.z & 0xffff); Vt[(d0 + 5) * VP + vk] = (bf16)(w.z >> 16); Vt[(d0 + 6) * VP + vk] = (bf16)(w.w & 0xffff); Vt[(d0 + 7) * VP + vk] = (bf16)(w.w >> 16); } }
    __syncthreads();
    const int q = lane & 31, hi = lane >> 5;
#pragma unroll 1
    for (int qi = 0; qi < 2; ++qi) {
        const int qt = wave * 2 + qi, g = qt >> 2, j = qt & 3, hh = kvh * 4 + g;
        const size_t qrow = rowq0 + 32 * j + q;
        bf16x8 qf[4];
#pragma unroll
        for (int dk = 0; dk < 4; ++dk) qf[dk] = *(const bf16x8*)(PROJ + qrow * INC + hh * 64 + 16 * dk + 8 * hi);
        f32x16 sc[5];
#pragma unroll
        for (int kt = 0; kt < 5; ++kt) {
            f32x16 acc;
#pragma unroll
            for (int i = 0; i < 16; ++i) acc[i] = 0.f;
#pragma unroll
            for (int dk = 0; dk < 4; ++dk) { const bf16x8 kf = *(const LAS bf16x8*)(Ks + (32 * (j + kt) + q) * KP + 16 * dk + 8 * hi); acc = __builtin_amdgcn_mfma_f32_32x32x16_bf16(kf, qf[dk], acc, 0, 0, 0); }
            sc[kt] = acc;
        }
        const int qpos = 128 + 32 * j + q; float mx = -INFINITY;
#pragma unroll
        for (int kt = 0; kt < 5; ++kt)
#pragma unroll
            for (int i = 0; i < 16; ++i) { const int kj = 32 * (j + kt) + (i & 3) + 8 * (i >> 2) + 4 * hi, d = qpos - kj; const bool ok = d >= 0 && d <= 128 && (n > 0 || kj >= 128);
                const float sv = ok ? sc[kt][i] * 0.125f : -INFINITY; sc[kt][i] = sv; mx = fmaxf(mx, sv); }
        mx = fmaxf(mx, shx(mx, 32, lane)); const float sink = sinks[hh]; mx = fmaxf(mx, sink);
        float sum = 0.f;
#pragma unroll
        for (int kt = 0; kt < 5; ++kt)
#pragma unroll
            for (int i = 0; i < 16; ++i) { const float e = __expf(sc[kt][i] - mx); sc[kt][i] = e; sum += e; }
        sum += shx(sum, 32, lane);
        const float inv = 1.f / (sum + __expf(sink - mx));
#pragma unroll
        for (int dt = 0; dt < 2; ++dt) {
            f32x16 o;
#pragma unroll
            for (int i = 0; i < 16; ++i) o[i] = 0.f;
#pragma unroll
            for (int kt = 0; kt < 5; ++kt)
#pragma unroll
                for (int s2 = 0; s2 < 2; ++s2) {
                    u32x4 pw; pw.x = pk2(sc[kt][8 * s2 + 0], sc[kt][8 * s2 + 1]); pw.y = pk2(sc[kt][8 * s2 + 2], sc[kt][8 * s2 + 3]); pw.z = pk2(sc[kt][8 * s2 + 4], sc[kt][8 * s2 + 5]); pw.w = pk2(sc[kt][8 * s2 + 6], sc[kt][8 * s2 + 7]);
                    const LAS bf16* vp = Vt + (32 * dt + q) * VP + 32 * (j + kt) + 16 * s2 + 4 * hi;
                    const u32x2 v0 = *(const LAS u32x2*)vp, v1 = *(const LAS u32x2*)(vp + 8);
                    u32x4 vw; vw.x = v0.x; vw.y = v0.y; vw.z = v1.x; vw.w = v1.y;
                    o = __builtin_amdgcn_mfma_f32_32x32x16_bf16(__builtin_bit_cast(bf16x8, vw), __builtin_bit_cast(bf16x8, pw), o, 0, 0, 0);
                }
#pragma unroll
            for (int g4 = 0; g4 < 4; ++g4) st_bf4(MIXCAT + qrow * DM + hh * 64 + 32 * dt + 8 * g4 + 4 * hi, (f32x4){o[4 * g4] * inv, o[4 * g4 + 1] * inv, o[4 * g4 + 2] * inv, o[4 * g4 + 3] * inv});
        }
    }
    __syncthreads();
}
__device__ __forceinline__ void swa_sample_item(const Ctx& C, int item, const bf16* PROJ, bf16* MIXCAT, const float* sinks, const float* ck, const float* cv, float* ko, float* vo) {
    const int kvh = item & 1, b = item >> 1, tid = C.tid;
    LAS float* Kf = (LAS float*)C.lds; LAS float* Vf = Kf + 132 * 65; LAS float* Qf = Vf + 132 * 64; LAS float* Pf = Qf + 16 * 64;
    for (int e = tid; e < 132 * 64; e += 512) { const int key = e >> 6, d = e & 63; float kx, vx;
        if (key < 128) { const size_t o = (((size_t)b * 128 + key) * 2 + kvh) * 64 + d; kx = ck[o]; vx = cv[o]; }
        else { const size_t r = (size_t)MP + 4 * b + (key - 128); kx = bf1(PROJ[r * INC + C_K + kvh * 64 + d]); vx = bf1(PROJ[r * INC + C_V + kvh * 64 + d]); }
        Kf[key * 65 + d] = kx; Vf[key * 64 + d] = vx;
        if (key >= 4) { const size_t o = (((size_t)b * 128 + (key - 4)) * 2 + kvh) * 64 + d; ko[o] = kx; vo[o] = vx; } }
    for (int e = tid; e < 16 * 64; e += 512) { const int qr = e >> 6, d = e & 63, i = qr >> 2, g = qr & 3; Qf[e] = bf1(PROJ[((size_t)MP + 4 * b + i) * INC + (kvh * 4 + g) * 64 + d]); }
    __syncthreads();
    { const int qr = tid >> 5, kl = tid & 31, i = qr >> 2, g = qr & 3; float sc[5]; float mx = -INFINITY;
#pragma unroll
        for (int k5 = 0; k5 < 5; ++k5) { const int key = kl + 32 * k5; float sv = -INFINITY;
            if (key < 132 && key >= i && key <= i + 128) { float a = 0.f;
#pragma unroll 16
                for (int d = 0; d < 64; ++d) a += Qf[qr * 64 + d] * Kf[key * 65 + d];
                sv = a * 0.125f; }
            sc[k5] = sv; mx = fmaxf(mx, sv); }
#pragma unroll
        for (int o = 1; o < 32; o <<= 1) mx = fmaxf(mx, shx(mx, o, C.lane));
        const float sink = sinks[kvh * 4 + g]; mx = fmaxf(mx, sink); float sum = 0.f;
#pragma unroll
        for (int k5 = 0; k5 < 5; ++k5) { sc[k5] = __expf(sc[k5] - mx); sum += sc[k5]; }
#pragma unroll
        for (int o = 1; o < 32; o <<= 1) sum += shx(sum, o, C.lane);
        const float inv = 1.f / (sum + __expf(sink - mx));
#pragma unroll
        for (int k5 = 0; k5 < 5; ++k5) { const int key = kl + 32 * k5; if (key < 136) Pf[qr * 136 + key] = sc[k5] * inv; } }
    __syncthreads();
    { const int qr = tid >> 5, d = (tid & 31) * 2, i = qr >> 2, g = qr & 3; float o0 = 0.f, o1 = 0.f;
#pragma unroll 4
        for (int key = 0; key < 132; ++key) { const float p = Pf[qr * 136 + key]; o0 += p * Vf[key * 64 + d]; o1 += p * Vf[key * 64 + d + 1]; }
        *(unsigned*)(MIXCAT + ((size_t)MP + 4 * b + i) * DM + (kvh * 4 + g) * 64 + d) = pk2(o0, o1); }
    __syncthreads();
}

__device__ __forceinline__ void s_phase(const Ctx& C, const Args& A, int l) {
    const bf16* PROJ = (const bf16*)(C.ws + WS_R1); bf16* MIXCAT = (bf16*)(C.ws + WS_HN);
    float* R = (float*)(C.ws + WS_R2); const size_t S = (size_t)M * 256;
    RwkvPtrs P{(const bf16*)R, (const bf16*)(R + S), (const bf16*)(R + 2 * S), (const bf16*)(R + 3 * S), (const bf16*)(R + 4 * S), R + 5 * S, (float*)(C.ws + WS_R3)};
    const float* AL = (const float*)(C.ws + WS_R3) + S; const float* U = AL + S;
    float* out = C.out;
    constexpr int NSCAN = 64;
    if (C.bid < NSCAN) { rwkv_prompt(C, P, C.bid, out + OUT_WKVP + (size_t)l * NBP * 4 * 4096); return; }
    constexpr int N0 = 256, N1 = N0 + 64, N2_ = N1 + 256, N3 = N2_ + 1024, N4 = N3 + 64;
    for (int it = C.bid - NSCAN; it < N4; it += C.G - NSCAN) {
        if (it < N0) swa_prompt_item(C, it, PROJ, MIXCAT, INP(I_SINK) + l * 8);
        else if (it < N1) lru_prompt_item(C, it - N0, AL, U, PROJ, MIXCAT, out + OUT_LRP + (size_t)l * NBP * 256);
        else if (it < N2_) swa_sample_item(C, it - N1, PROJ, MIXCAT, INP(I_SINK) + l * 8, INP(I_CK) + (size_t)l * DB * 16384, INP(I_CV) + (size_t)l * DB * 16384,
                                          out + OUT_KS + (size_t)l * DB * 16384, out + OUT_VS + (size_t)l * DB * 16384);
        else if (it < N3) rwkv_sample_item(P, (it - N2_) * 8 + C.wave, INP(I_SWKV) + (size_t)l * DB * 4 * 4096, out + OUT_WKVS + (size_t)l * DB * 4 * 4096, C.lane);
        else { const int e = (it - N3) * 512 + C.tid, b = e >> 8, c = e & 255; float h = INP(I_SLRU)[((size_t)l * DB + b) * 256 + c];
#pragma unroll
            for (int i = 0; i < DS; ++i) { const size_t m = (size_t)MP + 4 * b + i; h = AL[m * 256 + c] * h + U[m * 256 + c];
                MIXCAT[m * DM + 768 + c] = (bf16)f2bf(h * gelu_t(bf1(PROJ[m * INC + C_GB + c]))); }
            out[OUT_LRS + ((size_t)l * DB + b) * 256 + c] = h; }
    }
    if (l + 1 < NL) convert_layer(C, A, l + 1, (C.bid - NSCAN) * 8 + C.wave, (C.G - NSCAN) * 8, (C.bid - NSCAN) * 512 + C.tid, (C.G - NSCAN) * 512);
    __syncthreads();
    { pg8::Gemm g{(const bf16*)(C.ws + WS_PB + (size_t)(l & 1) * SZ_PBL), (const bf16*)(C.ws + WS_W + (size_t)(l & 1) * WL + O_WP), M, DM, PLE}; pg8::StaticOrder So; So.init(M, DM, C.G - NSCAN, C.bid - NSCAN);
      pg8::EpiBf16<0> E{(bf16*)(C.ws + WS_PP), DM, nullptr, 0, 0, 1.f};
      pg8::gemm_phase<pg8::EpiBf16<0>, pg8::StaticOrder, true, true>(C.lds, g, So, E, C.tid); }
}

__device__ __forceinline__ void e3_post(const Ctx& C, const Args& A, int l) {
    const float* R = (const float*)(C.ws + WS_R2); const size_t S = (size_t)M * 256;
    const bf16 *Rb = (const bf16*)R, *K = (const bf16*)(R + S), *V = (const bf16*)(R + 2 * S), *G = (const bf16*)(R + 6 * S); const float* YR = (const float*)(C.ws + WS_R3);
    bf16* MIXCAT = (bf16*)(C.ws + WS_HN); const int c4 = 4 * C.lane;
    const f32x4 lw = *(const f32x4*)(INP(I_LNW) + l * 256 + c4), lb = *(const f32x4*)(INP(I_LNB) + l * 256 + c4), rk = *(const f32x4*)(INP(I_RK) + l * 256 + c4);
    for (int m = C.gw; m < M; m += C.NGW) {
        const size_t o = (size_t)m * 256 + c4;
        const f32x4 y = *(const f32x4*)(YR + o), r = ld_bf4(Rb + o), k = ld_bf4(K + o), v = ld_bf4(V + o), g = ld_bf4(G + o);
        const float mean = red16((y.x + y.y) + (y.z + y.w)) * (1.f / 64.f); const f32x4 d = y - mean;
        const float var = red16(dot4(d, d)) * (1.f / 64.f); const float rs = rsqrtf(var + 64e-5f);
        const float bonus = red16(dot4(r * k, rk));
        st_bf4(MIXCAT + (size_t)m * DM + 512 + c4, (d * rs * lw + lb + v * bonus) * g);
    }
}
constexpr int LDS_BYTES = 131072 + 64;
#ifndef MK_MULTI
#define MK_MULTI 0
#endif
#ifndef MK_DUP
#define MK_DUP 0
#endif
enum { PH_P0 = 0, PH_G1, PH_E1, PH_G2, PH_S, PH_E3, PH_G3, PH_E4, PH_G4, PH_G5, PH_E5, PH_G6, PH_E0, PH_G3B, PH_E4S, PH_G5B, PH_E5S, PH_N };
constexpr int NSPLIT = 16;

__device__ __forceinline__ Ctx make_ctx(int wave0, LAS unsigned char* lds) {
    Ctx D; int z_ = 0; asm volatile("" : "+v"(z_)); int ln_ = __builtin_amdgcn_mbcnt_hi(-1, __builtin_amdgcn_mbcnt_lo(-1, z_));
    D.lane = ln_; D.wave = wave0; D.tid = wave0 * 64 + ln_;
    int b_ = blockIdx.x; asm volatile("" : "+s"(b_)); D.bid = b_; D.gw = b_ * 8 + wave0; D.G = gridDim.x; D.NGW = D.G * 8;
    D.lds = lds; D.out = (float*)inp_ld(N_IN); D.ws = (unsigned char*)inp_ld(N_IN + 1);
    return D;
}
template <int PH> __device__ __forceinline__ void run_phase(const Args& A, int wave0, LAS unsigned char* lds, int l_in) {
    const Ctx C = make_ctx(wave0, lds);
    int l = l_in; asm volatile("" : "+s"(l));
    unsigned char* ws = C.ws; unsigned char* wl = ws + WS_W + (size_t)(l & 1) * WL; (void)wl;
    bf16* HN = (bf16*)(ws + WS_HN); float* MIX = (float*)(ws + WS_R1); float* R2 = (float*)(ws + WS_R2); float* R3 = (float*)(ws + WS_R3); bf16* X = (bf16*)(ws + WS_X16);
    const size_t S = (size_t)M * 256; (void)HN; (void)MIX; (void)R2; (void)R3; (void)X; (void)S;
    if constexpr (PH == PH_P0) p0_prologue(C, A);
    if constexpr (PH == PH_G1) {
        pg8::Gemm g{HN, (const bf16*)(wl + O_WIN), M, INC, DM}; pg8::StaticOrder So; So.init(M, INC, C.G, C.bid);
        pg8::EpiBf16<0> E{(bf16*)(ws + WS_R1), INC, INP(I_BIN) + (size_t)l * INC, 0, 0, 1.f};
        pg8::gemm_phase<pg8::EpiBf16<0>, pg8::StaticOrder, true, true>(C.lds, g, So, E, C.tid); }
    if constexpr (PH == PH_E1) e1_prep(C, A, l);
    if constexpr (PH == PH_G2) {
        pg8::Gemm g{(const bf16*)(ws + WS_R3), (const bf16*)(wl + O_W2), M, N2, K2 / 2, K2}; G2Order So; So.b.init(M, N2, C.G, C.bid);
        EpiMix E{INP(I_W0) + l * 256, INP(I_A0) + l * 256, INP(I_KA) + l * 256, INP(I_BA) + l * 256, INP(I_BI) + l * 256, INP(I_L) + l * 256,
                 R2 + 5 * S, (bf16*)(R2 + 1 * S), (bf16*)(R2 + 3 * S), (bf16*)(R2 + 4 * S), (bf16*)(R2 + 6 * S), R3 + S, R3 + 2 * S, (const bf16*)(ws + WS_R3)};
        pg8::gemm_phase<EpiMix, G2Order, true, true>(C.lds, g, So, E, C.tid); }
    if constexpr (PH == PH_S) s_phase(C, A, l);
    if constexpr (PH == PH_E3) e3_post(C, A, l);
    if constexpr (PH == PH_G3) {
        pg8::Gemm g{HN, (const bf16*)(wl + O_WOUT), MP, DM, DM}; pg8::StaticOrder So; So.init(MP, DM, C.G, C.bid);
        pg8::EpiBf16<0> E{(bf16*)MIX, DM, INP(I_BOUT) + (size_t)l * DM, 0, 0, 1.f};
        pg8::gemm_phase<pg8::EpiBf16<0>, pg8::StaticOrder, true, true>(C.lds, g, So, E, C.tid); }
    if constexpr (PH == PH_G3B) {
        if (C.bid < NSPLIT) { pg8::Gemm g{HN + (size_t)MP * DM, (const bf16*)(wl + O_WOUT), MS, DM, DM / 2, DM}; SplitOrder So{C.bid, NSPLIT, DM / 2}; EpiPart E{R3};
            pg8::gemm_phase<EpiPart, SplitOrder, true, true>(C.lds, g, So, E, C.tid); }
        else for (int m = (C.bid - NSPLIT) * 8 + C.wave; m < MP; m += (C.G - NSPLIT) * 8)
            row_update((const bf16*)MIX + (size_t)m * DM, INP(I_NMPOST) + l * DM, X + (size_t)m * DM, INP(I_NFPRE) + l * DM, HN + (size_t)m * DM, C.lane); }
    if constexpr (PH == PH_E4S)
        for (int m = MP + C.gw; m < M; m += C.NGW)
            row_update_parts(R3 + (size_t)(m - MP) * DM, R3 + (size_t)(MS + m - MP) * DM, INP(I_BOUT) + (size_t)l * DM, INP(I_NMPOST) + l * DM, X + (size_t)m * DM, INP(I_NFPRE) + l * DM, HN + (size_t)m * DM, C.lane);
    if constexpr (PH == PH_G4) {
        pg8::Gemm g{HN, (const bf16*)(wl + O_WGU), M, 2 * DFF, DM}; pg8::StaticOrder So; So.init(M, 2 * DFF, C.G, C.bid);
        EpiSwiglu E{(bf16*)(ws + WS_R2)};
        pg8::gemm_phase<EpiSwiglu, pg8::StaticOrder, true, true>(C.lds, g, So, E, C.tid); }
    if constexpr (PH == PH_G5) {
        pg8::Gemm g{(const bf16*)(ws + WS_R2), (const bf16*)(wl + O_WD), MP, DM, DFF}; pg8::StaticOrder So; So.init(MP, DM, C.G, C.bid);
        pg8::EpiBf16<0> E{(bf16*)MIX, DM, nullptr, 0, 0, 1.f};
        pg8::gemm_phase<pg8::EpiBf16<0>, pg8::StaticOrder, true, true>(C.lds, g, So, E, C.tid); }
    if constexpr (PH == PH_G5B) {
        if (C.bid < NSPLIT) { pg8::Gemm g{(const bf16*)(ws + WS_R2) + (size_t)MP * DFF, (const bf16*)(wl + O_WD), MS, DM, DFF / 2, DFF}; SplitOrder So{C.bid, NSPLIT, DFF / 2}; EpiPart E{R3};
            pg8::gemm_phase<EpiPart, SplitOrder, true, true>(C.lds, g, So, E, C.tid); }
        else for (int m = (C.bid - NSPLIT) * 8 + C.wave; m < MP; m += (C.G - NSPLIT) * 8)
            row_update((const bf16*)MIX + (size_t)m * DM, INP(I_NFPOST) + l * DM, X + (size_t)m * DM, nullptr, HN + (size_t)m * DM, C.lane); }
    if constexpr (PH == PH_E5S)
        for (int m = MP + C.gw; m < M; m += C.NGW)
            row_update_parts(R3 + (size_t)(m - MP) * DM, R3 + (size_t)(MS + m - MP) * DM, nullptr, INP(I_NFPOST) + l * DM, X + (size_t)m * DM, nullptr, HN + (size_t)m * DM, C.lane);
    if constexpr (PH == PH_G6) {
        pg8::StaticOrder So; So.init(M, DM, C.G, C.bid);
        pg8::Gemm g{HN, (const bf16*)(wl + O_WPG), M, DM, DM}; EpiPle E{X, (const bf16*)(ws + WS_PP), l == NL - 1 ? C.out : nullptr};
        pg8::gemm_phase<EpiPle, pg8::StaticOrder, true, true>(C.lds, g, So, E, C.tid); }
    if constexpr (PH == PH_E0)
        for (int m = C.gw; m < M; m += C.NGW) row_norm(X + (size_t)m * DM, INP(I_NMPRE) + (l + 1) * DM, HN + (size_t)m * DM, C.lane);
}

#if MK_MULTI
template <int PH> __global__ void __launch_bounds__(512, 2) mk_one(Args A, int l) {
    extern __shared__ __attribute__((aligned(16))) unsigned char lds_raw[];
    const int wave0 = __builtin_amdgcn_readfirstlane((int)threadIdx.x >> 6);
    run_phase<PH>(A, wave0, (LAS unsigned char*)lds_raw, l);
}
#else
__global__ void __launch_bounds__(512, 2) mk_fwd(Args A) {
    extern __shared__ __attribute__((aligned(16))) unsigned char lds_raw[];
    cg::grid_group grid = cg::this_grid();
    const int wave0 = __builtin_amdgcn_readfirstlane((int)threadIdx.x >> 6);
    LAS unsigned char* lds = (LAS unsigned char*)lds_raw;
    if (threadIdx.x < 16) ((LAS unsigned*)lds)[131072 / 4 + threadIdx.x] = 0u;
    __syncthreads();
    const unsigned xbar_x = __builtin_amdgcn_readfirstlane(xcd_barrier_post((unsigned*)inp_ld(N_IN + 1), (volatile LAS unsigned*)(lds + 131072), (int)threadIdx.x).x);
#define GRID_BAR() do { int z_ = 0; asm volatile("" : "+v"(z_)); int ln_ = __builtin_amdgcn_mbcnt_hi(-1, __builtin_amdgcn_mbcnt_lo(-1, z_)); XcdBarrier xb_; xb_.bar = (unsigned*)inp_ld(N_IN + 1); xb_.x = xbar_x; \
        xb_.st = (volatile LAS unsigned*)(lds + 131072); xcd_barrier(xb_, wave0 * 64 + ln_); } while (0)
    run_phase<PH_P0>(A, wave0, lds, 0);
    if (MK_DUP & 1) { GRID_BAR(); run_phase<PH_P0>(A, wave0, lds, 0); }
    grid.sync();
#pragma unroll 1
    for (int l = 0; l < NL; ++l) {
#define RP(PH) do { run_phase<PH>(A, wave0, lds, l); GRID_BAR(); if (MK_DUP & (1 << 20)) GRID_BAR(); if (MK_DUP & (1 << PH)) { run_phase<PH>(A, wave0, lds, l); GRID_BAR(); } } while (0)
        RP(PH_G1); RP(PH_E1); RP(PH_G2); RP(PH_S); RP(PH_E3); RP(PH_G3); RP(PH_G3B); RP(PH_E4S); RP(PH_G4); RP(PH_G5); RP(PH_G5B); RP(PH_E5S);
        run_phase<PH_G6>(A, wave0, lds, l);
        if (l + 1 < NL) { GRID_BAR(); RP(PH_E0); }
    }
}
#endif
}

#if MK_MULTI
template <int PH> static void launch_one(const mk::Args& a, int l, int grid, hipStream_t stream) {
    static bool attr = false;
    if (!attr) { (void)hipFuncSetAttribute((const void*)mk::mk_one<PH>, hipFuncAttributeMaxDynamicSharedMemorySize, mk::LDS_BYTES); attr = true; }
    hipLaunchKernelGGL(mk::mk_one<PH>, dim3(grid), dim3(512), mk::LDS_BYTES, stream, a, l);
}
#endif
extern "C" void kernel_launch(void* const* d_in, const int* in_sizes, int n_in, void* d_out, int out_size, void* d_ws, size_t ws_size, hipStream_t stream) {
    using namespace mk;
    static int grid = 0;
    if (grid == 0) {
        if (n_in != N_IN || (size_t)out_size != OUT_END || ws_size < WS_END) {
            fprintf(stderr, "kernel_launch: shape mismatch: n_in %d (want %d), out %d (want %zu), ws %zu (want >= %zu); nothing launched\n", n_in, (int)N_IN, out_size, (size_t)OUT_END, ws_size, (size_t)WS_END);
            grid = -1; return; }
        int dev = 0, cus = 0;
        (void)hipGetDevice(&dev); (void)hipDeviceGetAttribute(&cus, hipDeviceAttributeMultiprocessorCount, dev);
#if !MK_MULTI
        int per_cu = 0;
        if (hipFuncSetAttribute((const void*)mk_fwd, hipFuncAttributeMaxDynamicSharedMemorySize, LDS_BYTES) != hipSuccess) { fprintf(stderr, "kernel_launch: hipFuncSetAttribute failed\n"); grid = -1; return; }
        if (hipOccupancyMaxActiveBlocksPerMultiprocessor(&per_cu, (const void*)mk_fwd, 512, LDS_BYTES) != hipSuccess || per_cu < 1) fprintf(stderr, "kernel_launch: note: occupancy query gave %d\n", per_cu);
        (void)hipGetLastError();
#endif
        grid = cus;
        if (grid < 128) { fprintf(stderr, "kernel_launch: %d CUs: too few for this kernel\n", grid); grid = -1; return; }
    }
    if (grid < 0) return;
    Args a{};
    for (int i = 0; i < N_IN; ++i) a.in[i] = (const float*)d_in[i];
    a.out = (float*)d_out; a.ws = (unsigned char*)d_ws;
#if MK_MULTI
    launch_one<PH_P0>(a, 0, grid, stream);
    for (int l = 0; l < NL; ++l) {
        launch_one<PH_G1>(a, l, grid, stream); launch_one<PH_E1>(a, l, grid, stream); launch_one<PH_G2>(a, l, grid, stream); launch_one<PH_S>(a, l, grid, stream);
        launch_one<PH_E3>(a, l, grid, stream); launch_one<PH_G3>(a, l, grid, stream); launch_one<PH_E4>(a, l, grid, stream); launch_one<PH_G4>(a, l, grid, stream);
        launch_one<PH_G5>(a, l, grid, stream); launch_one<PH_E5>(a, l, grid, stream); launch_one<PH_G6>(a, l, grid, stream);
        if (l + 1 < NL) launch_one<PH_E0>(a, l, grid, stream);
    }
#else
    if (hipMemsetAsync(d_ws, 0, 65536, stream) != hipSuccess) { fprintf(stderr, "kernel_launch: hipMemsetAsync failed\n"); return; }
    void* args[] = {&a};
    const hipError_t e = hipLaunchCooperativeKernel((const void*)mk_fwd, dim3(grid), dim3(512), args, LDS_BYTES, stream);
    if (e != hipSuccess) fprintf(stderr, "kernel_launch: cooperative launch failed: %s (grid %d)\n", hipGetErrorString(e), grid);
#endif
}
```

```cpp
#include <hip/hip_runtime.h>
#include <hip/hip_cooperative_groups.h>
#include <cstdio>
#include <cstdint>
#include <cstddef>
#include <cmath>
namespace cg = cooperative_groups;
namespace pg8 {
#define PG8_LAS __attribute__((address_space(3)))
typedef unsigned short bf16_t;
typedef short bf16x8 __attribute__((ext_vector_type(8)));
typedef float f32x4 __attribute__((ext_vector_type(4)));
typedef unsigned u32x4 __attribute__((ext_vector_type(4)));
constexpr int BM = 256, BK = 64, HALF = 128, HTB = HALF * BK * 2  , STAGE_BYTES = 8 * HTB, NXCD = 8, WGM = 8;

__host__ __device__ __forceinline__ int lds_byte(int r, int c) { const int st = (r >> 4) * 2 + (c >> 5), rr = r & 15, cc = c & 31, ob = rr * 64 + cc * 2; return st * 1024 + (ob ^ (((ob >> 9) & 1) << 5)); }
__host__ __device__ __forceinline__ void stage_rc(int b, int& R, int& C) { const int st = b / 1024, sb = b % 1024, swz = sb ^ (((sb >> 9) & 1) << 5); R = (st >> 1) * 16 + swz / 64; C = (st & 1) * 32 + (swz % 64) / 2; }
__host__ __device__ __forceinline__ int perm32(int rho) { const int n = rho >> 4, i = rho & 15; return 8 * (i >> 2) + 4 * n + (i & 3); }

struct Unit { int pm, pn, ko = 0; };
struct Gemm { const bf16_t* A; const bf16_t* Bt; int M, N, K; int ld = 0; };

struct StaticOrder {
    int nM, nN, nwg, G, c;
    __host__ __device__ void init(int M, int N, int G_, int c_) { nM = M / BM; nN = N / BM; nwg = nM * nN; G = G_; c = c_; }
    __host__ __device__ bool next(int i, Unit& u) const {
        const long L = (long)i * G + c; if (L >= nwg) return false;
        int wgid = (int)L; { const int q = nwg / NXCD, r = nwg % NXCD, xcd = wgid % NXCD, off = wgid / NXCD; wgid = (xcd < r ? xcd * (q + 1) : r * (q + 1) + (xcd - r) * q) + off; }
        const int nig = WGM * nN, gid = wgid / nig, fm = gid * WGM, gsz = (nM - fm) < WGM ? (nM - fm) : WGM;
        u.pm = fm + ((wgid % nig) % gsz); u.pn = (wgid % nig) / gsz; return true;
    }
    __device__ __forceinline__ void a_ready(const Unit&) const {}
    __device__ __forceinline__ void done(const Unit&) const {}
};

__device__ __forceinline__ unsigned cvt_pk_bf16(float lo, float hi) { unsigned r; asm volatile("v_cvt_pk_bf16_f32 %0, %1, %2" : "=v"(r) : "v"(lo), "v"(hi)); return r; }
typedef float f32x2 __attribute__((ext_vector_type(2)));
__device__ __forceinline__ f32x2 gelu_pk(f32x2 v) {
    const f32x2 av = __builtin_elementwise_abs(v), d = av * 0.2316418882f + 1.0f;
    f32x2 t; t.x = __builtin_amdgcn_rcpf(d.x); t.y = __builtin_amdgcn_rcpf(d.y);
    f32x2 q = t * 0.5307027145f + (-0.7265760135f); q = q * t + 0.7107068705f; q = q * t + (-0.142248368f); q = q * t + 0.127414796f; q = q * t;
    const f32x2 s = (v * v) * (-0.72134752044f);
    f32x2 e; e.x = __builtin_amdgcn_exp2f(s.x); e.y = __builtin_amdgcn_exp2f(s.y);
    const f32x2 m = v * (q * e), r = v - m;
    f32x2 o; o.x = v.x < 0.f ? m.x : r.x; o.y = v.y < 0.f ? m.y : r.y; return o;
}

template <int ACT  > struct EpiBf16 {
    static constexpr bool PERM = true, AFTER_DRAIN = false; static_assert(ACT == 0 || ACT == 1, "EpiBf16: ACT is 0 (none) or 1 (gelu_pk)");
    bf16_t* O; int ldc; const float* bias; int split_cols; size_t split_stride; float scale0;
    __device__ __forceinline__ void operator()(const f32x4 (&acc)[2][2][4][2], const Unit& u, int wr, int wc, int fr, int fq) const {
        const int row0 = u.pm * BM + wr * 64 + fr; int colt = u.pn * BM; bf16_t* base = O;
        float sc = 1.f; if (split_cols) { const int t = colt / split_cols; base += (size_t)t * split_stride; colt -= t * split_cols; if (t == 0) sc = scale0; }
        const int col0 = colt + wc * 32 + 8 * fq, bcol0 = u.pn * BM + wc * 32 + 8 * fq;
        f32x4 bv[2][2];
#pragma unroll
        for (int bj = 0; bj < 2; ++bj)
#pragma unroll
            for (int n = 0; n < 2; ++n) bv[bj][n] = bias ? *(const f32x4*)(bias + bcol0 + bj * HALF + 4 * n) : (f32x4){0.f, 0.f, 0.f, 0.f};
#pragma unroll
        for (int ai = 0; ai < 2; ++ai)
#pragma unroll
            for (int m = 0; m < 4; ++m) { bf16_t* rowp = base + (size_t)(row0 + ai * HALF + m * 16) * ldc + col0;
#pragma unroll
                for (int bj = 0; bj < 2; ++bj) { f32x4 v0 = acc[ai][bj][m][0] + bv[bj][0], v1 = acc[ai][bj][m][1] + bv[bj][1];
                    if (ACT == 1) { f32x2 a = gelu_pk((f32x2){v0[0], v0[1]}), b = gelu_pk((f32x2){v0[2], v0[3]}), c = gelu_pk((f32x2){v1[0], v1[1]}), d = gelu_pk((f32x2){v1[2], v1[3]});
                        v0 = (f32x4){a.x, a.y, b.x, b.y}; v1 = (f32x4){c.x, c.y, d.x, d.y}; }
                    v0 = v0 * sc; v1 = v1 * sc; u32x4 w; w.x = cvt_pk_bf16(v0[0], v0[1]); w.y = cvt_pk_bf16(v0[2], v0[3]); w.z = cvt_pk_bf16(v1[0], v1[1]); w.w = cvt_pk_bf16(v1[2], v1[3]);
                    *(u32x4*)(rowp + bj * HALF) = w; } }
    }
};
template <class Epi, class Sched, bool ALIGN_EPI = false, bool SP2 = false>
__device__ __forceinline__ void gemm_phase(PG8_LAS unsigned char* lds, const Gemm g, const Sched& S, const Epi& E, int tid_in) {
    int tid_ = tid_in; asm volatile("" : "+v"(tid_));
    const int tid = tid_, wid = __builtin_amdgcn_readfirstlane(tid >> 6), lane = tid & 63, wr = wid >> 2, wc = wid & 3, fr = lane & 15, fq = lane >> 4;
    const int K = g.K, nt = K / BK, LD = g.ld ? g.ld : g.K;
    unsigned voffA[2], voffB[2];
#pragma unroll
    for (int i = 0; i < 2; ++i) { int R, C; stage_rc(tid * 16 + i * 8192, R, C); const int Rb = Epi::PERM ? ((R & ~31) + perm32(R & 31)) : R;
        voffA[i] = (unsigned)(R * LD + C) * 2u; voffB[i] = (unsigned)(Rb * LD + C) * 2u; }
    const size_t kstep = (size_t)(BK * 2);
    const size_t hstep = (size_t)HALF * LD * 2;
    const size_t tstep = 2 * hstep;
    const unsigned ldsw = (unsigned)wid * 1024u;
    const int aoff = lds_byte(wr * 64 + fr, fq * 8), boff = lds_byte(wc * 32 + fr, fq * 8);
#define PG8_SA(b, h) (((b) * 2 + (h)) * HTB)
#define PG8_SB(b, h) ((4 + (b) * 2 + (h)) * HTB)
#define PG8_STAGE(bufoff, gbase, voff) do { _Pragma("unroll") for (int _i = 0; _i < 2; ++_i) \
        __builtin_amdgcn_global_load_lds((const unsigned*)((const char*)(gbase) + (voff)[_i]), (PG8_LAS unsigned*)(lds + (bufoff) + ldsw + _i * 8192), 16, 0, 0); } while (0)
#define PG8_LDA(dst, b, h) do { _Pragma("unroll") for (int m = 0; m < 4; ++m) _Pragma("unroll") for (int k = 0; k < 2; ++k) dst[m][k] = *(const PG8_LAS bf16x8*)(lds + PG8_SA(b, h) + aoff + m * 2048 + k * 1024); } while (0)
#define PG8_LDB(dst, b, h) do { _Pragma("unroll") for (int n = 0; n < 2; ++n) _Pragma("unroll") for (int k = 0; k < 2; ++k) dst[n][k] = *(const PG8_LAS bf16x8*)(lds + PG8_SB(b, h) + boff + n * 2048 + k * 1024); } while (0)
#define PG8_MMA(ai, bj, At, Bt) do { __builtin_amdgcn_s_setprio(1); _Pragma("unroll") for (int m = 0; m < 4; ++m) _Pragma("unroll") for (int n = 0; n < 2; ++n) _Pragma("unroll") for (int k = 0; k < 2; ++k) \
        acc[ai][bj][m][n] = __builtin_amdgcn_mfma_f32_16x16x32_bf16(Bt[n][k], At[m][k], acc[ai][bj][m][n], 0, 0, 0); __builtin_amdgcn_s_setprio(0); } while (0)
#define PG8_WAIT_V(n) asm volatile("s_waitcnt vmcnt(" #n ")" ::: "memory")
#define PG8_WAIT_L(n) asm volatile("s_waitcnt lgkmcnt(" #n ")" ::: "memory")
#define PG8_BAR __builtin_amdgcn_s_barrier()
#define PG8_SCHED __builtin_amdgcn_sched_barrier(0)
    Unit cur, nxt; int ui = 0;
    if (!S.next(0, cur)) return;
    f32x4 acc[2][2][4][2];
#pragma unroll
    for (int a = 0; a < 2; ++a)
#pragma unroll
        for (int b = 0; b < 2; ++b)
#pragma unroll
            for (int m = 0; m < 4; ++m)
#pragma unroll
                for (int n = 0; n < 2; ++n) acc[a][b][m][n] = (f32x4){0.f, 0.f, 0.f, 0.f};
    bf16x8 At[4][2], B0[2][2], B1[2][2];
    const char* cA = (const char*)g.A + (size_t)cur.pm * tstep + (size_t)cur.ko * 2; const char* cB = (const char*)g.Bt + (size_t)cur.pn * tstep + (size_t)cur.ko * 2;
    S.a_ready(cur);
    if constexpr (SP2) {
        PG8_STAGE(PG8_SB(0, 0), cB, voffB); PG8_STAGE(PG8_SB(0, 1), cB + hstep, voffB); PG8_STAGE(PG8_SA(0, 0), cA, voffA); PG8_STAGE(PG8_SA(0, 1), cA + hstep, voffA);
        if (wr == 1) PG8_BAR;
        PG8_WAIT_V(2); PG8_BAR;
        PG8_STAGE(PG8_SB(1, 0), cB + kstep, voffB); PG8_STAGE(PG8_SA(1, 0), cA + kstep, voffA); PG8_STAGE(PG8_SB(1, 1), cB + hstep + kstep, voffB);
        PG8_WAIT_V(6); PG8_BAR;
    } else {
        PG8_STAGE(PG8_SB(0, 0), cB, voffB); PG8_STAGE(PG8_SA(0, 0), cA, voffA); PG8_STAGE(PG8_SB(0, 1), cB + hstep, voffB); PG8_STAGE(PG8_SA(0, 1), cA + hstep, voffA);
        if (wr == 1) PG8_BAR;
        PG8_WAIT_V(4); PG8_BAR;
        PG8_STAGE(PG8_SB(1, 0), cB + kstep, voffB); PG8_STAGE(PG8_SA(1, 0), cA + kstep, voffA); PG8_STAGE(PG8_SB(1, 1), cB + hstep + kstep, voffB);
        PG8_WAIT_V(6); PG8_BAR;
    }
    for (;;) {
        const bool has_next = S.next(ui + 1, nxt);
        const char* nA = has_next ? (const char*)g.A + (size_t)nxt.pm * tstep + (size_t)nxt.ko * 2 : cA; const char* nB = has_next ? (const char*)g.Bt + (size_t)nxt.pn * tstep + (size_t)nxt.ko * 2 : cB;
        for (int t = 0; t < nt; t += 2) {
            const bool last = (t == nt - 2);
            const char* a1 = cA + (size_t)(t + 1) * kstep;
            const char* a2 = last ? nA : cA + (size_t)(t + 2) * kstep; const char* b2 = last ? nB : cB + (size_t)(t + 2) * kstep;
            const char* a3 = a2 + kstep; const char* b3 = b2 + kstep;
            if (last && has_next) S.a_ready(nxt);
            if constexpr (SP2) {
            PG8_LDB(B0, 0, 0); PG8_LDB(B1, 0, 1); PG8_SCHED; PG8_LDA(At, 0, 0); PG8_STAGE(PG8_SA(1, 1), a1 + hstep, voffA);
            PG8_WAIT_V(8); PG8_WAIT_L(0); PG8_BAR; PG8_MMA(0, 0, At, B0); PG8_MMA(0, 1, At, B1); PG8_BAR; PG8_SCHED;
            PG8_LDA(At, 0, 1); PG8_STAGE(PG8_SB(0, 0), b2, voffB); PG8_STAGE(PG8_SB(0, 1), b2 + hstep, voffB); PG8_STAGE(PG8_SA(0, 0), a2, voffA);
            PG8_WAIT_V(8); PG8_WAIT_L(0); PG8_BAR; PG8_MMA(1, 0, At, B0); PG8_MMA(1, 1, At, B1); PG8_BAR; PG8_SCHED;
            PG8_LDB(B0, 1, 0); PG8_LDB(B1, 1, 1); PG8_SCHED; PG8_LDA(At, 1, 0); PG8_STAGE(PG8_SA(0, 1), a2 + hstep, voffA);
            PG8_WAIT_V(8); PG8_WAIT_L(0); PG8_BAR; PG8_MMA(0, 0, At, B0); PG8_MMA(0, 1, At, B1); PG8_BAR; PG8_SCHED;
            PG8_LDA(At, 1, 1); PG8_STAGE(PG8_SB(1, 0), b3, voffB); PG8_STAGE(PG8_SB(1, 1), b3 + hstep, voffB); PG8_STAGE(PG8_SA(1, 0), a3, voffA);
            PG8_WAIT_V(8); PG8_WAIT_L(0); PG8_BAR; PG8_MMA(1, 0, At, B0); PG8_MMA(1, 1, At, B1); PG8_BAR; PG8_SCHED;
            } else {
            PG8_LDB(B0, 0, 0); PG8_SCHED; PG8_LDA(At, 0, 0); PG8_STAGE(PG8_SA(1, 1), a1 + hstep, voffA);
            PG8_WAIT_L(8); PG8_BAR; PG8_WAIT_L(0); PG8_MMA(0, 0, At, B0); PG8_BAR; PG8_SCHED;
            PG8_LDB(B1, 0, 1); PG8_STAGE(PG8_SB(0, 0), b2, voffB);
            PG8_BAR; PG8_WAIT_L(0); PG8_MMA(0, 1, At, B1); PG8_BAR;
            PG8_LDA(At, 0, 1); PG8_STAGE(PG8_SA(0, 0), a2, voffA);
            PG8_BAR; PG8_WAIT_L(0); PG8_MMA(1, 0, At, B0); PG8_BAR; PG8_SCHED;
            PG8_STAGE(PG8_SB(0, 1), b2 + hstep, voffB);
            PG8_WAIT_V(6); PG8_BAR; PG8_MMA(1, 1, At, B1); PG8_BAR;
            PG8_LDB(B0, 1, 0); PG8_SCHED; PG8_LDA(At, 1, 0); PG8_STAGE(PG8_SA(0, 1), a2 + hstep, voffA);
            PG8_WAIT_L(8); PG8_BAR; PG8_WAIT_L(0); PG8_MMA(0, 0, At, B0); PG8_BAR; PG8_SCHED;
            PG8_LDB(B1, 1, 1); PG8_STAGE(PG8_SB(1, 0), b3, voffB);
            PG8_BAR; PG8_WAIT_L(0); PG8_MMA(0, 1, At, B1); PG8_BAR;
            PG8_LDA(At, 1, 1); PG8_STAGE(PG8_SA(1, 0), a3, voffA);
            PG8_BAR; PG8_WAIT_L(0); PG8_MMA(1, 0, At, B0); PG8_BAR; PG8_SCHED;
            PG8_STAGE(PG8_SB(1, 1), b3 + hstep, voffB);
            PG8_WAIT_V(6); PG8_BAR; PG8_MMA(1, 1, At, B1); PG8_BAR;
            }
        }
        if constexpr (ALIGN_EPI) { if (wr == 0) PG8_BAR; }
        if constexpr (!Epi::AFTER_DRAIN) { int z_ = 0; asm volatile("" : "+v"(z_)); const int ln_ = __builtin_amdgcn_mbcnt_hi(-1, __builtin_amdgcn_mbcnt_lo(-1, z_)); E(acc, cur, wr, wc, ln_ & 15, ln_ >> 4); S.done(cur); }
        if (!has_next) break;
#pragma unroll
        for (int a = 0; a < 2; ++a)
#pragma unroll
            for (int b = 0; b < 2; ++b)
#pragma unroll
                for (int m = 0; m < 4; ++m)
#pragma unroll
                    for (int n = 0; n < 2; ++n) acc[a][b][m][n] = (f32x4){0.f, 0.f, 0.f, 0.f};
        cur = nxt; cA = nA; cB = nB; ++ui;
        if constexpr (ALIGN_EPI) { if (wr == 1) PG8_BAR; }
    }
    PG8_WAIT_V(0);
    if constexpr (!ALIGN_EPI) { if (wr == 0) PG8_BAR; }
    PG8_BAR;
    if constexpr (Epi::AFTER_DRAIN) { E.fused(acc, cur, wr, wc, fr, fq, lds, wid, lane); S.done(cur); }
#undef PG8_SA
#undef PG8_SB
#undef PG8_STAGE
#undef PG8_LDA
#undef PG8_LDB
#undef PG8_MMA
#undef PG8_WAIT_V
#undef PG8_WAIT_L
#undef PG8_BAR
#undef PG8_SCHED
}
}
namespace mk {
typedef pg8::bf16_t bf16;
typedef pg8::f32x4 f32x4;
typedef pg8::u32x4 u32x4;
typedef pg8::bf16x8 bf16x8;
typedef pg8::Unit Unit;
typedef float f32x16 __attribute__((ext_vector_type(16)));
typedef unsigned u32x2 __attribute__((ext_vector_type(2)));
typedef float f32x2 __attribute__((ext_vector_type(2)));
#define LAS __attribute__((address_space(3)))
#define LDS_WAIT() asm volatile("s_waitcnt lgkmcnt(0)" ::: "memory")

constexpr int DM = 1024, T = 4096, NBP = 4, MP = NBP * T, DB = 128, DS = 4, MS = DB * DS, M = MP + MS, NL = 4;
constexpr int INC = 2304, DFF = 2816, K2 = 512, N2 = 1280, PLE = 256;
constexpr int C_K = 512, C_V = 640, C_RW = 768, C_XB = 1792, C_GB = 2048;

constexpr size_t SZ_WIN = (size_t)INC * DM * 2, SZ_W2 = (size_t)N2 * K2 * 2, SZ_WOUT = (size_t)DM * DM * 2, SZ_WGU = (size_t)2 * DFF * DM * 2,
                 SZ_WD = (size_t)DM * DFF * 2, SZ_WPG = (size_t)DM * DM * 2, SZ_WP = (size_t)DM * PLE * 2;
constexpr size_t O_WIN = 0, O_W2 = O_WIN + SZ_WIN, O_WOUT = O_W2 + SZ_W2, O_WGU = O_WOUT + SZ_WOUT, O_WD = O_WGU + SZ_WGU, O_WPG = O_WD + SZ_WD,
                 O_WP = O_WPG + SZ_WPG, WL = O_WP + SZ_WP;
constexpr size_t WS_W = 1u << 20  , SZ_PBL = (size_t)M * PLE * 2, WS_X16 = WS_W + 2 * WL  , WS_PB = WS_X16 + (size_t)M * DM * 2  , SZ_ACT = (size_t)M * DM * 2, WS_PP = WS_PB + 2 * SZ_PBL  , WS_HN = WS_PP + SZ_ACT,
                 WS_R1 = WS_HN + SZ_ACT, SZ_R1 = (size_t)M * INC * 2, WS_R2 = WS_R1 + SZ_R1, SZ_F256 = (size_t)M * 256 * 4, WS_R3 = WS_R2 + 7 * SZ_F256,
                 WS_END = WS_R3 + 3 * SZ_F256;
static_assert(WL % 256 == 0 && SZ_R1 >= (size_t)M * DM * 4 && 7 * SZ_F256 >= (size_t)M * DFF * 2, "ws map");

constexpr size_t OUT_Y = 0, OUT_KP = (size_t)M * DM, OUT_VP = OUT_KP + (size_t)NL * NBP * 128 * 128, OUT_SHP = OUT_VP + (size_t)NL * NBP * 128 * 128,
                 OUT_WKVP = OUT_SHP + (size_t)NL * NBP * 1024, OUT_CVP = OUT_WKVP + (size_t)NL * NBP * 4 * 4096, OUT_LRP = OUT_CVP + (size_t)NL * NBP * 768,
                 OUT_KS = OUT_LRP + (size_t)NL * NBP * 256, OUT_VS = OUT_KS + (size_t)NL * DB * 128 * 128, OUT_SHS = OUT_VS + (size_t)NL * DB * 128 * 128,
                 OUT_WKVS = OUT_SHS + (size_t)NL * DB * 1024, OUT_CVS = OUT_WKVS + (size_t)NL * DB * 4 * 4096, OUT_LRS = OUT_CVS + (size_t)NL * DB * 768,
                 OUT_END = OUT_LRS + (size_t)NL * DB * 256;

enum { I_XP = 0, I_XS, I_CK, I_CV, I_SSH, I_SWKV, I_SCV, I_SLRU, I_PP, I_PS, I_NMPRE, I_NMPOST, I_NFPRE, I_NFPOST, I_WIN, I_BIN, I_SINK, I_MU, I_W0, I_WUP,
       I_A0, I_AUP, I_GUP, I_KK, I_KA, I_RK, I_LNW, I_LNB, I_CW, I_CB, I_WA, I_BA, I_WI, I_BI, I_L, I_WOUT, I_BOUT, I_WG, I_WU, I_WDN, I_PW, I_PGW, N_IN };

__device__ __forceinline__ unsigned f2bf(float f) { unsigned u = __float_as_uint(f); return (u + 0x7fffu + ((u >> 16) & 1u)) >> 16; }
__device__ __forceinline__ unsigned pk2(float lo, float hi) { return f2bf(lo) | (f2bf(hi) << 16); }
__device__ __forceinline__ float bflo(unsigned w) { return __uint_as_float(w << 16); }
__device__ __forceinline__ float bfhi(unsigned w) { return __uint_as_float(w & 0xffff0000u); }
__device__ __forceinline__ float bf1(bf16 b) { return __uint_as_float((unsigned)b << 16); }
__device__ __forceinline__ f32x4 ld_bf4(const bf16* p) { const u32x2 w = *(const u32x2*)p; return (f32x4){bflo(w.x), bfhi(w.x), bflo(w.y), bfhi(w.y)}; }
__device__ __forceinline__ void st_bf4(bf16* p, f32x4 v) { u32x2 w; w.x = pk2(v.x, v.y); w.y = pk2(v.z, v.w); *(u32x2*)p = w; }
__device__ __forceinline__ void ld_bf8(const bf16* p, f32x4& lo, f32x4& hi) { const u32x4 w = *(const u32x4*)p; lo = (f32x4){bflo(w.x), bfhi(w.x), bflo(w.y), bfhi(w.y)}; hi = (f32x4){bflo(w.z), bfhi(w.z), bflo(w.w), bfhi(w.w)}; }
__device__ __forceinline__ void st_bf8(bf16* p, f32x4 lo, f32x4 hi) { u32x4 w; w.x = pk2(lo.x, lo.y); w.y = pk2(lo.z, lo.w); w.z = pk2(hi.x, hi.y); w.w = pk2(hi.z, hi.w); *(u32x4*)p = w; }
__device__ __forceinline__ float sigm(float x) { return __builtin_amdgcn_rcpf(1.f + __expf(-x)); }
__device__ __forceinline__ float tanh_(float x) { return 1.f - 2.f * __builtin_amdgcn_rcpf(__expf(2.f * x) + 1.f); }
__device__ __forceinline__ float gelu_t(float x) { return 0.5f * x * (1.f + tanh_(0.7978845608f * (x + 0.044715f * x * x * x))); }
template <int CTRL> __device__ __forceinline__ float dppf(float x) { return __builtin_bit_cast(float, __builtin_amdgcn_mov_dpp(__builtin_bit_cast(int, x), CTRL, 0xf, 0xf, true)); }
__device__ __forceinline__ float red16(float x) { x += dppf<0xB1>(x); x += dppf<0x4E>(x); x += dppf<0x141>(x); x += dppf<0x128>(x); return x; }
__device__ __forceinline__ float red8(float x) { x += dppf<0xB1>(x); x += dppf<0x4E>(x); x += dppf<0x141>(x); return x; }
__device__ __forceinline__ float wave_sum(float v) {
    v = red16(v);
    v += __builtin_bit_cast(float, __builtin_amdgcn_update_dpp(0, __builtin_bit_cast(int, v), 0x142, 0xa, 0xf, false));
    v += __builtin_bit_cast(float, __builtin_amdgcn_update_dpp(0, __builtin_bit_cast(int, v), 0x143, 0xc, 0xf, false));
    return __builtin_bit_cast(float, __builtin_amdgcn_readlane(__builtin_bit_cast(int, v), 63));
}
__device__ __forceinline__ float vmul(float a, float b) { float d; asm("v_mul_f32 %0, %1, %2" : "=v"(d) : "v"(a), "v"(b)); return d; }
__device__ __forceinline__ float vfma(float a, float b, float c) { float d; asm("v_fma_f32 %0, %1, %2, %3" : "=v"(d) : "v"(a), "v"(b), "v"(c)); return d; }
__device__ __forceinline__ float vfnma(float a, float b, float c) { float d; asm("v_fma_f32 %0, -%1, %2, %3" : "=v"(d) : "v"(a), "v"(b), "v"(c)); return d; }
__device__ __forceinline__ void red16x2(float& p, float& q) {
    asm volatile("v_add_f32_dpp %0, %0, %0 quad_perm:[1,0,3,2] row_mask:0xf bank_mask:0xf bound_ctrl:1\n\t"
                 "v_add_f32_dpp %1, %1, %1 quad_perm:[1,0,3,2] row_mask:0xf bank_mask:0xf bound_ctrl:1\n\ts_nop 0\n\t"
                 "v_add_f32_dpp %0, %0, %0 quad_perm:[2,3,0,1] row_mask:0xf bank_mask:0xf bound_ctrl:1\n\t"
                 "v_add_f32_dpp %1, %1, %1 quad_perm:[2,3,0,1] row_mask:0xf bank_mask:0xf bound_ctrl:1\n\ts_nop 0\n\t"
                 "v_add_f32_dpp %0, %0, %0 row_half_mirror row_mask:0xf bank_mask:0xf bound_ctrl:1\n\t"
                 "v_add_f32_dpp %1, %1, %1 row_half_mirror row_mask:0xf bank_mask:0xf bound_ctrl:1\n\ts_nop 0\n\t"
                 "v_add_f32_dpp %0, %0, %0 row_ror:8 row_mask:0xf bank_mask:0xf bound_ctrl:1\n\t"
                 "v_add_f32_dpp %1, %1, %1 row_ror:8 row_mask:0xf bank_mask:0xf bound_ctrl:1\n\ts_nop 1"
                 : "+v"(p), "+v"(q));
}
__device__ __forceinline__ float shx(float v, int mask, int lane) { return __builtin_bit_cast(float, __builtin_amdgcn_ds_bpermute((lane ^ mask) << 2, __builtin_bit_cast(int, v))); }
__device__ __forceinline__ float dot4(f32x4 a, f32x4 b) { return (a.x * b.x + a.y * b.y) + (a.z * b.z + a.w * b.w); }

struct EpiF32 {
    static constexpr bool PERM = false, AFTER_DRAIN = false;
    float* O; int ldc; const float* bias;
    __device__ __forceinline__ void operator()(const f32x4 (&acc)[2][2][4][2], const Unit& u, int wr, int wc, int fr, int fq) const {
        asm volatile("" : "+v"(fr), "+v"(fq));
        const int row0 = u.pm * 256 + wr * 64 + fr, col0 = u.pn * 256 + wc * 32 + 4 * fq;
        f32x4 bv[2][2];
#pragma unroll
        for (int bj = 0; bj < 2; ++bj)
#pragma unroll
            for (int n = 0; n < 2; ++n) bv[bj][n] = bias ? *(const f32x4*)(bias + col0 + bj * 128 + n * 16) : (f32x4){0.f, 0.f, 0.f, 0.f};
#pragma unroll
        for (int ai = 0; ai < 2; ++ai)
#pragma unroll
            for (int m = 0; m < 4; ++m) { float* rowp = O + (size_t)(row0 + ai * 128 + m * 16) * ldc + col0;
#pragma unroll
                for (int bj = 0; bj < 2; ++bj)
#pragma unroll
                    for (int n = 0; n < 2; ++n) *(f32x4*)(rowp + bj * 128 + n * 16) = acc[ai][bj][m][n] + bv[bj][n]; }
    }
};
struct EpiPle {
    static constexpr bool PERM = true, AFTER_DRAIN = false;
    bf16* X; const bf16* PP; float* Y;
    __device__ __forceinline__ void operator()(const f32x4 (&acc)[2][2][4][2], const Unit& u, int wr, int wc, int fr, int fq) const {
        asm volatile("" : "+v"(fr), "+v"(fq));
        const int row0 = u.pm * 256 + wr * 64 + fr, col0 = u.pn * 256 + wc * 32 + 8 * fq;
#pragma unroll
        for (int ai = 0; ai < 2; ++ai)
#pragma unroll
            for (int m = 0; m < 4; ++m) { const size_t off = (size_t)(row0 + ai * 128 + m * 16) * DM + col0;
#pragma unroll
                for (int bj = 0; bj < 2; ++bj) { const size_t o = off + bj * 128; f32x4 x0, x1, p0, p1; ld_bf8(X + o, x0, x1); ld_bf8(PP + o, p0, p1); const f32x4 a0 = acc[ai][bj][m][0], a1 = acc[ai][bj][m][1];
                    const f32x4 r0 = (f32x4){x0.x + sigm(a0.x) * p0.x, x0.y + sigm(a0.y) * p0.y, x0.z + sigm(a0.z) * p0.z, x0.w + sigm(a0.w) * p0.w},
                                r1 = (f32x4){x1.x + sigm(a1.x) * p1.x, x1.y + sigm(a1.y) * p1.y, x1.z + sigm(a1.z) * p1.z, x1.w + sigm(a1.w) * p1.w};
                    if (Y) { *(f32x4*)(Y + o) = r0; *(f32x4*)(Y + o + 4) = r1; } else st_bf8(X + o, r0, r1); }
                asm volatile("" ::: "memory"); }
    }
};
struct EpiSwiglu {
    static constexpr bool PERM = true, AFTER_DRAIN = false;
    bf16* O;
    __device__ __forceinline__ void operator()(const f32x4 (&acc)[2][2][4][2], const Unit& u, int wr, int wc, int fr, int fq) const {
        asm volatile("" : "+v"(fr), "+v"(fq));
        const int row0 = u.pm * 256 + wr * 64 + fr, col0 = u.pn * 128 + wc * 32 + 8 * fq;
#pragma unroll
        for (int ai = 0; ai < 2; ++ai)
#pragma unroll
            for (int m = 0; m < 4; ++m) { bf16* p = O + (size_t)(row0 + ai * 128 + m * 16) * DFF + col0;
                const f32x4 g0 = acc[ai][0][m][0], g1 = acc[ai][0][m][1], u0 = acc[ai][1][m][0], u1 = acc[ai][1][m][1];
                u32x4 w; w.x = pk2(g0.x * sigm(g0.x) * u0.x, g0.y * sigm(g0.y) * u0.y); w.y = pk2(g0.z * sigm(g0.z) * u0.z, g0.w * sigm(g0.w) * u0.w);
                w.z = pk2(g1.x * sigm(g1.x) * u1.x, g1.y * sigm(g1.y) * u1.y); w.w = pk2(g1.z * sigm(g1.z) * u1.z, g1.w * sigm(g1.w) * u1.w);
                *(u32x4*)p = w; }
    }
};
struct G2Order {
    pg8::StaticOrder b;
    __device__ bool next(int i, Unit& u) const { if (!b.next(i, u)) return false; u.ko = u.pn < 3 ? 0 : 256; return true; }
    __device__ __forceinline__ void a_ready(const Unit&) const {}
    __device__ __forceinline__ void done(const Unit&) const {}
};
struct SplitOrder {
    int c, G, kh;
    __device__ bool next(int i, Unit& u) const { const long L = (long)i * G + c; if (L >= 16) return false; u.pm = (int)L >> 3; u.pn = ((int)L >> 1) & 3; u.ko = ((int)L & 1) * kh; return true; }
    __device__ __forceinline__ void a_ready(const Unit&) const {}
    __device__ __forceinline__ void done(const Unit&) const {}
};
struct EpiPart {
    static constexpr bool PERM = false, AFTER_DRAIN = false;
    float* P;
    __device__ __forceinline__ void operator()(const f32x4 (&acc)[2][2][4][2], const Unit& u, int wr, int wc, int fr, int fq) const {
        asm volatile("" : "+v"(fr), "+v"(fq));
        const int row0 = u.pm * 256 + wr * 64 + fr, col0 = u.pn * 256 + wc * 32 + 4 * fq; float* O = P + (u.ko ? (size_t)MS * DM : 0);
#pragma unroll
        for (int ai = 0; ai < 2; ++ai)
#pragma unroll
            for (int m = 0; m < 4; ++m) { float* rowp = O + (size_t)(row0 + ai * 128 + m * 16) * DM + col0;
#pragma unroll
                for (int bj = 0; bj < 2; ++bj)
#pragma unroll
                    for (int n = 0; n < 2; ++n) *(f32x4*)(rowp + bj * 128 + n * 16) = acc[ai][bj][m][n]; }
    }
};
struct EpiMix {
    static constexpr bool PERM = true, AFTER_DRAIN = false;
    const float *w0, *a0, *k_a, *b_a, *b_i, *Lp; float* Wd; bf16 *Ks, *KK, *BV, *G; float *AL, *U; const bf16* A2;
    __device__ __forceinline__ void operator()(const f32x4 (&acc)[2][2][4][2], const Unit& u, int wr, int wc, int fr, int fq) const {
        asm volatile("" : "+v"(fr), "+v"(fq));
        const int row0 = u.pm * 256 + wr * 64 + fr;
        if (u.pn < 3) {
#pragma unroll
            for (int ai = 0; ai < 2; ++ai)
#pragma unroll
                for (int m = 0; m < 4; ++m) { const size_t ro = (size_t)(row0 + ai * 128 + m * 16) * 256;
#pragma unroll
                    for (int bj = 0; bj < 2; ++bj) { const int c = bj * 128 + wc * 32 + 8 * fq; const f32x4 z0 = acc[ai][bj][m][0], z1 = acc[ai][bj][m][1];
                        if (u.pn == 0) { const f32x4 b0 = *(const f32x4*)(w0 + c), b1 = *(const f32x4*)(w0 + c + 4); f32x4 d0, d1;
                            d0.x = __expf(-0.60653066f * sigm(z0.x + b0.x)); d0.y = __expf(-0.60653066f * sigm(z0.y + b0.y)); d0.z = __expf(-0.60653066f * sigm(z0.z + b0.z)); d0.w = __expf(-0.60653066f * sigm(z0.w + b0.w));
                            d1.x = __expf(-0.60653066f * sigm(z1.x + b1.x)); d1.y = __expf(-0.60653066f * sigm(z1.y + b1.y)); d1.z = __expf(-0.60653066f * sigm(z1.z + b1.z)); d1.w = __expf(-0.60653066f * sigm(z1.w + b1.w));
                            *(f32x4*)(Wd + ro + c) = d0; *(f32x4*)(Wd + ro + c + 4) = d1; }
                        else if (u.pn == 1) { const f32x4 b0 = *(const f32x4*)(a0 + c), b1 = *(const f32x4*)(a0 + c + 4), ka0 = *(const f32x4*)(k_a + c), ka1 = *(const f32x4*)(k_a + c + 4);
                            f32x4 ks0, ks1, kk0, kk1; ld_bf8(Ks + ro + c, ks0, ks1); ld_bf8(KK + ro + c, kk0, kk1);
                            f32x4 av0, av1; av0.x = sigm(z0.x + b0.x); av0.y = sigm(z0.y + b0.y); av0.z = sigm(z0.z + b0.z); av0.w = sigm(z0.w + b0.w);
                            av1.x = sigm(z1.x + b1.x); av1.y = sigm(z1.y + b1.y); av1.z = sigm(z1.z + b1.z); av1.w = sigm(z1.w + b1.w);
                            st_bf8(Ks + ro + c, ks0 * (1.f + (av0 - 1.f) * ka0), ks1 * (1.f + (av1 - 1.f) * ka1)); st_bf8(BV + ro + c, kk0 * av0, kk1 * av1); }
                        else { st_bf8(G + ro + c, z0, z1); }
                        asm volatile("" ::: "memory"); } }
        } else {
            const int t = u.pn - 3;
#pragma unroll
            for (int ai = 0; ai < 2; ++ai)
#pragma unroll
                for (int m = 0; m < 4; ++m) { const size_t r = (size_t)(row0 + ai * 128 + m * 16); const int cc0 = 128 * t + wc * 32 + 8 * fq;
                    f32x4 xc0, xc1; ld_bf8(A2 + r * K2 + 256 + cc0, xc0, xc1);
#pragma unroll
                    for (int n = 0; n < 2; ++n) { const int cc = cc0 + 4 * n;
                        const f32x4 zr = acc[ai][0][m][n] + *(const f32x4*)(b_a + cc), zi = acc[ai][1][m][n] + *(const f32x4*)(b_i + cc), Lv = *(const f32x4*)(Lp + cc), xc = n ? xc1 : xc0;
                        f32x4 al, uu;
#define LRU1(e) { const float xe = __expf(-Lv.e); const float ls = -xe * (1.f + xe * (-0.5f + xe * 0.33333334f)); const float la = 8.f * sigm(zr.e) * ls; al.e = __expf(la); const float z2 = 2.f * la; \
    const float om = -z2 * (1.f + z2 * (0.5f + z2 * (0.16666667f + z2 * (0.041666668f + z2 * 0.0083333338f)))); uu.e = __builtin_amdgcn_sqrtf(om) * sigm(zi.e) * xc.e; }
                        LRU1(x) LRU1(y) LRU1(z) LRU1(w)
#undef LRU1
                        *(f32x4*)(AL + r * 256 + cc) = al; *(f32x4*)(U + r * 256 + cc) = uu; asm volatile("" ::: "memory"); } }
        }
    }
};

#define RLX_AGENT __ATOMIC_RELAXED, __HIP_MEMORY_SCOPE_AGENT
#define XB_TMO      128
#define XB_XCNT(j)  (256  + 64 * (j))
#define XB_XSUB(j)  (1280 + 64 * (j))
#define XB_XGEN(j)  (2304 + 64 * (j))
#define XB_TOP      3328
#define XB_TOPGEN   3392
#define XCD_BAR_WORDS 3456
#define XB_SPIN_CAP (1u << 18)

__device__ __forceinline__ unsigned xb_ld(unsigned* p)              { return __hip_atomic_load(p, __ATOMIC_RELAXED, __HIP_MEMORY_SCOPE_AGENT); }
__device__ __forceinline__ unsigned xb_add(unsigned* p, unsigned v) { return __hip_atomic_fetch_add(p, v, __ATOMIC_RELAXED, __HIP_MEMORY_SCOPE_AGENT); }
__device__ __forceinline__ unsigned xb_xcc_id() { return (unsigned)__builtin_amdgcn_s_getreg((3 << 11) | 20) & 0xFu; }
#define XB_SPIN(cond, bar) do { unsigned _sp = 0; while (cond) { __builtin_amdgcn_s_sleep(1); \
    if ((++_sp & 255u) == 0u) { if (xb_ld(&(bar)[XB_TMO])) break; if (_sp > XB_SPIN_CAP) { atomicAdd(&(bar)[XB_TMO], 1u); break; } } } } while (0)

struct XcdBarrier {
    unsigned* bar; unsigned x;
    volatile LAS unsigned* st;
};

__device__ __forceinline__ XcdBarrier xcd_barrier_post(unsigned* bar, volatile LAS unsigned* st, int tid) {
    XcdBarrier b; b.bar = bar; b.x = xb_xcc_id(); b.st = st;
    if (tid == 0) (void)xb_add(&bar[XB_XCNT(b.x)], 1u);
    return b;
}
__device__ __forceinline__ void xcd_barrier_complete(unsigned* bar, unsigned x, unsigned& nloc, unsigned& nx) {
    const unsigned G = gridDim.x * gridDim.y * gridDim.z;
    unsigned sum, cnt, mine, sp = 0u;
    for (;;) {
        sum = 0u; cnt = 0u; mine = 0u;
#pragma unroll
        for (unsigned j = 0; j < 16; ++j) { const unsigned c = xb_ld(&bar[XB_XCNT(j)]); sum += c; cnt += (c > 0u) ? 1u : 0u; mine = (j == x) ? c : mine; }
        if (sum == G) break;
        __builtin_amdgcn_s_sleep(1);
        if ((++sp & 255u) == 0u) { if (xb_ld(&bar[XB_TMO])) break; if (sp > XB_SPIN_CAP) { atomicAdd(&bar[XB_TMO], 1u); break; } }
    }
    nloc = mine > 0u ? mine : 1u; nx = cnt > 0u ? cnt : 1u;
}

__device__ __forceinline__ void xcd_barrier(const XcdBarrier& b, int tid) {
    asm volatile("s_waitcnt vmcnt(0)" ::: "memory");
    __syncthreads();
    if (tid == 0) {
        unsigned* bar = b.bar;
        __builtin_amdgcn_s_waitcnt(0);
        unsigned nloc = b.st[0], nx = b.st[1];
        if (nloc == 0u) { xcd_barrier_complete(bar, b.x, nloc, nx); b.st[0] = nloc; b.st[1] = nx; }
        const unsigned old = xb_add(&bar[XB_XSUB(b.x)], 1u);
        const unsigned gen = old / nloc;
        if (old + 1u == (gen + 1u) * nloc) {
            __builtin_amdgcn_fence(__ATOMIC_RELEASE, "agent");
            asm volatile("s_waitcnt vmcnt(0)" ::: "memory");
            const unsigned og = xb_add(&bar[XB_TOP], 1u);
            const unsigned tg = og / nx;
            if (og + 1u == (tg + 1u) * nx) xb_add(&bar[XB_TOPGEN], 1u);
            else XB_SPIN(xb_ld(&bar[XB_TOPGEN]) == tg, bar);
            __builtin_amdgcn_fence(__ATOMIC_ACQUIRE, "agent");
            xb_add(&bar[XB_XGEN(b.x)], 1u);
            asm volatile("s_waitcnt vmcnt(0)" ::: "memory");
        } else {
            XB_SPIN(xb_ld(&bar[XB_XGEN(b.x)]) == gen, bar);
            __builtin_amdgcn_fence(__ATOMIC_ACQUIRE, "agent");
            asm volatile("s_waitcnt vmcnt(0)" ::: "memory");
        }
    }
    __syncthreads();
}
struct Args { const float* in[N_IN]; float* out; unsigned char* ws; };
struct Ctx {
    LAS unsigned char* lds; unsigned char* ws; float* out;
    int tid, lane, wave, bid, G, gw, NGW;
};
__device__ __forceinline__ const float* inp_ld(int k) {
    asm volatile("" : "+s"(k));
    const __attribute__((address_space(4))) unsigned long long* tab = (const __attribute__((address_space(4))) unsigned long long*)__builtin_amdgcn_kernarg_segment_ptr();
    return (const float*)tab[k];
}
#define INP(k) inp_ld(k)
__device__ __forceinline__ int opq(int v) { asm volatile("" : "+v"(v)); return v; }

__device__ __forceinline__ void tr_item(const float* W, int ldw, bf16* WT, int ldt, int k0, int n0, int drow, int dcol, LAS float* scr, int lane) {
#pragma unroll 8
    for (int i = 0; i < 32; ++i) { const int kk = 2 * i + (lane >> 5); scr[kk * 33 + (lane & 31)] = W[(size_t)(k0 + kk) * ldw + n0 + (lane & 31)]; }
    LDS_WAIT(); asm volatile("" ::: "memory");
    const int c = lane & 7;
#pragma unroll
    for (int j = 0; j < 4; ++j) { const int n = (lane >> 3) + 8 * j; const LAS float* s = scr + (8 * c) * 33 + n;
        u32x4 o; o.x = pk2(s[0 * 33], s[1 * 33]); o.y = pk2(s[2 * 33], s[3 * 33]); o.z = pk2(s[4 * 33], s[5 * 33]); o.w = pk2(s[6 * 33], s[7 * 33]);
        *(u32x4*)(WT + (size_t)(drow + n) * ldt + dcol + 8 * c) = o; }
    LDS_WAIT(); asm volatile("" ::: "memory");
}
__device__ __forceinline__ void row_norm_in(const float* xrow, const float* g, bf16* orow, bf16* xcopy, int lane) {
    f32x4 v[4]; float ss = 0.f;
#pragma unroll
    for (int j = 0; j < 2; ++j) { v[2 * j] = *(const f32x4*)(xrow + 8 * lane + 512 * j); v[2 * j + 1] = *(const f32x4*)(xrow + 8 * lane + 512 * j + 4); ss += dot4(v[2 * j], v[2 * j]) + dot4(v[2 * j + 1], v[2 * j + 1]); }
    const float rs = rsqrtf(wave_sum(ss) * (1.f / DM) + 1e-6f);
#pragma unroll
    for (int j = 0; j < 2; ++j) { const float* gp = g + 8 * lane + 512 * j; if (xcopy) st_bf8(xcopy + 8 * lane + 512 * j, v[2 * j], v[2 * j + 1]);
        st_bf8(orow + 8 * lane + 512 * j, v[2 * j] * rs * *(const f32x4*)gp, v[2 * j + 1] * rs * *(const f32x4*)(gp + 4)); }
}
__device__ __forceinline__ void row_norm(const bf16* xrow, const float* g, bf16* orow, int lane) {
    f32x4 v[4]; float ss = 0.f;
#pragma unroll
    for (int j = 0; j < 2; ++j) { ld_bf8(xrow + 8 * lane + 512 * j, v[2 * j], v[2 * j + 1]); ss += dot4(v[2 * j], v[2 * j]) + dot4(v[2 * j + 1], v[2 * j + 1]); }
    const float rs = rsqrtf(wave_sum(ss) * (1.f / DM) + 1e-6f);
#pragma unroll
    for (int j = 0; j < 2; ++j) { const float* gp = g + 8 * lane + 512 * j; st_bf8(orow + 8 * lane + 512 * j, v[2 * j] * rs * *(const f32x4*)gp, v[2 * j + 1] * rs * *(const f32x4*)(gp + 4)); }
}
__device__ __forceinline__ void row_update_parts(const float* p0, const float* p1, const float* bias, const float* gA, bf16* X, const float* gB, bf16* outB, int lane) {
    f32x4 a[4], x[4]; float ss = 0.f;
#pragma unroll
    for (int j = 0; j < 2; ++j) { const int c = 8 * lane + 512 * j;
        a[2 * j] = *(const f32x4*)(p0 + c) + *(const f32x4*)(p1 + c); a[2 * j + 1] = *(const f32x4*)(p0 + c + 4) + *(const f32x4*)(p1 + c + 4);
        if (bias) { a[2 * j] = a[2 * j] + *(const f32x4*)(bias + c); a[2 * j + 1] = a[2 * j + 1] + *(const f32x4*)(bias + c + 4); }
        ld_bf8(X + c, x[2 * j], x[2 * j + 1]); ss += dot4(a[2 * j], a[2 * j]) + dot4(a[2 * j + 1], a[2 * j + 1]); }
    const float rs = rsqrtf(wave_sum(ss) * (1.f / DM) + 1e-6f); float s2 = 0.f;
#pragma unroll
    for (int j = 0; j < 2; ++j) { const int c = 8 * lane + 512 * j; x[2 * j] = x[2 * j] + a[2 * j] * rs * *(const f32x4*)(gA + c); x[2 * j + 1] = x[2 * j + 1] + a[2 * j + 1] * rs * *(const f32x4*)(gA + c + 4);
        st_bf8(X + c, x[2 * j], x[2 * j + 1]); s2 += dot4(x[2 * j], x[2 * j]) + dot4(x[2 * j + 1], x[2 * j + 1]); }
    float r2 = 1.f;
    if (gB) r2 = rsqrtf(wave_sum(s2) * (1.f / DM) + 1e-6f);
#pragma unroll
    for (int j = 0; j < 2; ++j) { const int c = 8 * lane + 512 * j; f32x4 o0 = x[2 * j], o1 = x[2 * j + 1]; if (gB) { o0 = o0 * r2 * *(const f32x4*)(gB + c); o1 = o1 * r2 * *(const f32x4*)(gB + c + 4); } st_bf8(outB + c, o0, o1); }
}
__device__ __forceinline__ void row_update(const bf16* add, const float* gA, bf16* X, const float* gB, bf16* outB, int lane) {
    f32x4 a[4], x[4]; float ss = 0.f;
#pragma unroll
    for (int j = 0; j < 2; ++j) { ld_bf8(add + 8 * lane + 512 * j, a[2 * j], a[2 * j + 1]); ld_bf8(X + 8 * lane + 512 * j, x[2 * j], x[2 * j + 1]); ss += dot4(a[2 * j], a[2 * j]) + dot4(a[2 * j + 1], a[2 * j + 1]); }
    const float rs = rsqrtf(wave_sum(ss) * (1.f / DM) + 1e-6f); float s2 = 0.f;
#pragma unroll
    for (int j = 0; j < 2; ++j) { const float* gp = gA + 8 * lane + 512 * j; x[2 * j] = x[2 * j] + a[2 * j] * rs * *(const f32x4*)gp; x[2 * j + 1] = x[2 * j + 1] + a[2 * j + 1] * rs * *(const f32x4*)(gp + 4);
        st_bf8(X + 8 * lane + 512 * j, x[2 * j], x[2 * j + 1]); s2 += dot4(x[2 * j], x[2 * j]) + dot4(x[2 * j + 1], x[2 * j + 1]); }
    float r2 = 1.f;
    if (gB) r2 = rsqrtf(wave_sum(s2) * (1.f / DM) + 1e-6f);
#pragma unroll
    for (int j = 0; j < 2; ++j) { f32x4 o0 = x[2 * j], o1 = x[2 * j + 1]; if (gB) { const float* gp = gB + 8 * lane + 512 * j; o0 = o0 * r2 * *(const f32x4*)gp; o1 = o1 * r2 * *(const f32x4*)(gp + 4); } st_bf8(outB + 8 * lane + 512 * j, o0, o1); }
}

__device__ __forceinline__ void convert_layer(const Ctx& C, const Args& A, int l, int gw0, int ngw, int gt, int NT) {
    LAS float* scr = (LAS float*)(C.lds + C.wave * 16384);
    constexpr int J0 = 16 * 72, J1 = 16 * 32, J2 = 16 * 88, J4 = 44 * 32, J5 = 16 * 32, J6 = 4 * 32, JL = J0 + J1 + 2 * J2 + J4 + J5 + J6;
    unsigned char* wl = C.ws + WS_W + (size_t)(l & 1) * WL;
    for (int it = gw0; it < JL; it += ngw) {
        int r = it;
        const float* W; int ldw, ldt, kb, nb, drow; bf16* WT;
        if (r < J0) { W = INP(I_WIN) + (size_t)l * DM * INC; ldw = INC; WT = (bf16*)(wl + O_WIN); ldt = DM; kb = r / 72; nb = r % 72; drow = 32 * nb; }
        else if ((r -= J0) < J1) { W = INP(I_WOUT) + (size_t)l * DM * DM; ldw = DM; WT = (bf16*)(wl + O_WOUT); ldt = DM; kb = r / 32; nb = r % 32; drow = 32 * nb; }
        else if ((r -= J1) < J2) { W = INP(I_WG) + (size_t)l * DM * DFF; ldw = DFF; WT = (bf16*)(wl + O_WGU); ldt = DM; kb = r / 88; nb = r % 88; drow = (nb >> 2) * 256 + (nb & 3) * 32; }
        else if ((r -= J2) < J2) { W = INP(I_WU) + (size_t)l * DM * DFF; ldw = DFF; WT = (bf16*)(wl + O_WGU); ldt = DM; kb = r / 88; nb = r % 88; drow = (nb >> 2) * 256 + 128 + (nb & 3) * 32; }
        else if ((r -= J2) < J4) { W = INP(I_WDN) + (size_t)l * DFF * DM; ldw = DM; WT = (bf16*)(wl + O_WD); ldt = DFF; kb = r / 32; nb = r % 32; drow = 32 * nb; }
        else if ((r -= J4) < J5) { W = INP(I_PGW) + (size_t)l * DM * DM; ldw = DM; WT = (bf16*)(wl + O_WPG); ldt = DM; kb = r / 32; nb = r % 32; drow = 32 * nb; }
        else { r -= J5; W = INP(I_PW) + (size_t)l * PLE * DM; ldw = DM; WT = (bf16*)(wl + O_WP); ldt = PLE; kb = r / 32; nb = r % 32; drow = 32 * nb; }
        tr_item(W, ldw, WT, ldt, 64 * kb, 32 * nb, drow, 64 * kb, scr, C.lane);
    }
#pragma unroll 1
    for (int r = gt; r < N2 * K2; r = opq(r + NT)) {
        const int n = r / K2, k = r % K2; float v = 0.f;
        if (n < 256) { if (k < 64) v = INP(I_WUP)[((size_t)l * 64 + k) * 256 + n]; }
        else if (n < 512) { if (k >= 64 && k < 128) v = INP(I_AUP)[((size_t)l * 64 + (k - 64)) * 256 + (n - 256)]; }
        else if (n < 768) { if (k >= 128 && k < 256) v = INP(I_GUP)[((size_t)l * 128 + (k - 128)) * 256 + (n - 512)]; }
        else { const int tt = (n - 768) >> 8, rr = (n - 768) & 255, cc = 128 * tt + (rr & 127), h = cc >> 6, j = cc & 63;
            if (k >= 256 && ((k - 256) >> 6) == h) v = ((rr >> 7) ? INP(I_WI) : INP(I_WA))[(((size_t)l * 4 + h) * 64 + ((k - 256) & 63)) * 64 + j]; }
        ((bf16*)(wl + O_W2))[r] = (bf16)f2bf(v);
    }
#pragma unroll 1
    for (int r = gt; r < M * (PLE / 4); r = opq(r + NT)) {
        const int m = r >> 6, c4 = (r & 63) * 4;
        const float* src = m < MP ? INP(I_PP) + ((size_t)l * MP + m) * PLE + c4 : INP(I_PS) + ((size_t)l * MS + (m - MP)) * PLE + c4;
        st_bf4((bf16*)(C.ws + WS_PB + (size_t)(l & 1) * SZ_PBL) + (size_t)m * PLE + c4, *(const f32x4*)src);
    }
}
__device__ __forceinline__ void p0_prologue(const Ctx& C, const Args& A) {
    convert_layer(C, A, 0, C.gw, C.NGW, C.bid * 512 + C.tid, C.G * 512);
    for (int m = C.gw; m < M; m += C.NGW) {
        const float* src = m < MP ? INP(I_XP) + (size_t)m * DM : INP(I_XS) + (size_t)(m - MP) * DM;
        row_norm_in(src, INP(I_NMPRE), (bf16*)(C.ws + WS_HN) + (size_t)m * DM, (bf16*)(C.ws + WS_X16) + (size_t)m * DM, C.lane);
    }
}

__device__ __forceinline__ void e1_prep(const Ctx& C, const Args& A, int l) {
    const bf16* PROJ = (const bf16*)(C.ws + WS_R1);
    bf16* R = (bf16*)(C.ws + WS_R2); bf16* Ks = (bf16*)(C.ws + WS_R2 + SZ_F256); bf16* V = (bf16*)(C.ws + WS_R2 + 2 * SZ_F256); bf16* KK = (bf16*)(C.ws + WS_R2 + 3 * SZ_F256);
    bf16* A2 = (bf16*)(C.ws + WS_R3);
    const int lane = C.lane, c4 = 4 * lane;
    for (int m = C.gw; m < M; m += C.NGW) {
        const bool samp = m >= MP; int b, t;
        if (!samp) { b = m >> 12; t = m & 4095; } else { b = (m - MP) >> 2; t = (m - MP) & 3; }
        const bf16* pr = PROJ + (size_t)m * INC;
        { const int half = lane >> 5, l32 = lane & 31, c8 = 8 * l32;
#pragma unroll
          for (int p = 0; p < 2; ++p) {
            const int cg = p == 0 ? 2 * half : 1 + 2 * half, col = 256 * cg + c8;
            f32x4 cur0, cur1, prv0 = (f32x4){0.f, 0.f, 0.f, 0.f}, prv1 = prv0; ld_bf8(pr + C_RW + col, cur0, cur1);
            if (t > 0) ld_bf8(pr - INC + C_RW + col, prv0, prv1);
            else if (samp) { const float* sp = INP(I_SSH) + ((size_t)l * DB + b) * 1024 + col; prv0 = *(const f32x4*)sp; prv1 = *(const f32x4*)(sp + 4); }
            const float* mp_ = INP(I_MU) + l * 1024 + col;
            const f32x4 xs0 = cur0 + (prv0 - cur0) * *(const f32x4*)mp_, xs1 = cur1 + (prv1 - cur1) * *(const f32x4*)(mp_ + 4);
            if (p == 0) st_bf8((half ? V : R) + (size_t)m * 256 + c8, xs0, xs1);
            else if (half == 0) { st_bf8(Ks + (size_t)m * 256 + c8, xs0, xs1); const float* kp = INP(I_KK) + l * 256 + c8; f32x4 kk0 = xs0 * *(const f32x4*)kp, kk1 = xs1 * *(const f32x4*)(kp + 4);
                const float sc = rsqrtf(fmaxf(red8(dot4(kk0, kk0) + dot4(kk1, kk1)), 1e-24f)); st_bf8(KK + (size_t)m * 256 + c8, kk0 * sc, kk1 * sc); }
            else { f32x4 o0, o1;
                if (l32 < 8) { o0 = (f32x4){tanh_(xs0.x), tanh_(xs0.y), tanh_(xs0.z), tanh_(xs0.w)}; o1 = (f32x4){tanh_(xs1.x), tanh_(xs1.y), tanh_(xs1.z), tanh_(xs1.w)}; }
                else if (l32 < 16) { o0 = xs0; o1 = xs1; }
                else { o0 = (f32x4){sigm(xs0.x), sigm(xs0.y), sigm(xs0.z), sigm(xs0.w)}; o1 = (f32x4){sigm(xs1.x), sigm(xs1.y), sigm(xs1.z), sigm(xs1.w)}; }
                st_bf8(A2 + (size_t)m * K2 + c8, o0, o1); }
          } }
        f32x4 xc = *(const f32x4*)(INP(I_CB) + l * 256 + c4);
#pragma unroll
        for (int j = 0; j < 4; ++j) { const int tt = t - 3 + j; f32x4 val = (f32x4){0.f, 0.f, 0.f, 0.f};
            if (tt >= 0) val = ld_bf4(pr + (ptrdiff_t)(j - 3) * INC + C_XB + c4);
            else if (samp) val = *(const f32x4*)(INP(I_SCV) + (((size_t)l * DB + b) * 3 + (tt + 3)) * 256 + c4);
            xc = xc + val * *(const f32x4*)(INP(I_CW) + ((size_t)l * 4 + j) * 256 + c4); }
        st_bf4(A2 + (size_t)m * K2 + 256 + c4, xc);
    }
    const int gt = C.bid * 512 + C.tid, NT = C.G * 512;
    float* out = C.out;
#pragma unroll 1
    for (int e = gt; e < 2 * NBP * 128 * 128; e = opq(e + NT)) {
        const int kv = e / (NBP * 16384), r = e % (NBP * 16384), b = r >> 14, rr = (r >> 7) & 127, c = r & 127;
        out[(kv ? OUT_VP : OUT_KP) + (size_t)l * NBP * 16384 + r] = bf1(PROJ[(size_t)(b * T + T - 128 + rr) * INC + (kv ? C_V : C_K) + c]);
    }
#pragma unroll 1
    for (int e = gt; e < NBP * 1024; e = opq(e + NT)) { const int b = e >> 10, c = e & 1023; out[OUT_SHP + (size_t)l * NBP * 1024 + e] = bf1(PROJ[(size_t)(b * T + T - 1) * INC + C_RW + c]); }
#pragma unroll 1
    for (int e = gt; e < DB * 1024; e = opq(e + NT)) { const int b = e >> 10, c = e & 1023; out[OUT_SHS + (size_t)l * DB * 1024 + e] = bf1(PROJ[(size_t)(MP + 4 * b + 3) * INC + C_RW + c]); }
#pragma unroll 1
    for (int e = gt; e < NBP * 768; e = opq(e + NT)) { const int b = e / 768, j = (e % 768) >> 8, c = e & 255; out[OUT_CVP + (size_t)l * NBP * 768 + e] = bf1(PROJ[(size_t)(b * T + T - 3 + j) * INC + C_XB + c]); }
#pragma unroll 1
    for (int e = gt; e < DB * 768; e = opq(e + NT)) { const int b = e / 768, j = (e % 768) >> 8, c = e & 255; out[OUT_CVS + (size_t)l * DB * 768 + e] = bf1(PROJ[(size_t)(MP + 4 * b + 1 + j) * INC + C_XB + c]); }
}

struct RwkvPtrs { const bf16 *R, *K, *V, *KK, *BV; const float* W; float* YR; };
__device__ __forceinline__ void rwkv_step(f32x4& s, const f32x4 w, const f32x4 kk, const f32x4 bv, const f32x4 k2, const f32x4 r, const float v, float& y) {
    const float sa = red16(dot4(s, kk));
    s = s * w + (k2 * v - bv * sa);
    y = red16(dot4(s, r));
}
__device__ __forceinline__ void rwkv_prompt(const Ctx& C, const RwkvPtrs& P, int wg, float* wkv_out  ) {
    constexpr int TC = 32, VEC = TC * 64 * 4, O_V = 5 * VEC, BUF = O_V + TC * 16 * 4, O_Q = 2 * BUF;
    static_assert(O_Q + TC * 1024 <= 131072, "LDS");
    const int chain = wg >> 2, b = chain >> 2, h = chain & 3, qr = wg & 3, tid = C.tid, lane = C.lane, wave = C.wave;
    const size_t m0 = (size_t)b * T;
    const int ltid = tid - 256, lstep = ltid >> 4, lq = tid & 15;
    const int vstep = ltid >> 2, vq = ltid & 3;
    f32x4 st[2][5], stv;
    f32x4 s = (f32x4){0.f, 0.f, 0.f, 0.f};
    const int row = 16 * qr + 4 * wave + (lane >> 4), cq = lane & 15;
#define RW_LOAD(c) do { if (wave >= 4) { _Pragma("unroll") for (int u = 0; u < 2; ++u) { const size_t o_ = (m0 + (size_t)(c) * TC + lstep + 16 * u) * 256 + h * 64 + 4 * lq; \
        st[u][0] = *(const f32x4*)(P.W + o_); st[u][1] = ld_bf4(P.KK + o_); st[u][2] = ld_bf4(P.BV + o_); st[u][3] = ld_bf4(P.K + o_); st[u][4] = ld_bf4(P.R + o_); } \
        if (ltid < 128) stv = ld_bf4(P.V + (m0 + (size_t)(c) * TC + vstep) * 256 + h * 64 + 16 * qr + 4 * vq); } } while (0)
#define RW_STORE(bufi) do { if (wave >= 4) { LAS unsigned char* bb = C.lds + (bufi) * BUF; _Pragma("unroll") for (int u = 0; u < 2; ++u) { const int ls = lstep + 16 * u; \
        _Pragma("unroll") for (int i = 0; i < 5; ++i) *(LAS f32x4*)(bb + i * VEC + (ls * 64 + 4 * lq) * 4) = st[u][i]; } \
        if (ltid < 128) *(LAS f32x4*)(bb + O_V + (vstep * 16 + 4 * vq) * 4) = stv; } } while (0)
#define RW_FLUSH(cc, half) do { if (wave >= 4) { const int stp = lstep + 16 * (half); const LAS f32x4* qp = (const LAS f32x4*)(C.lds + O_Q + stp * 1024 + (lq >> 2) * 256 + (lq & 3) * 64); \
        const f32x4 a0 = qp[0], a1_ = qp[1], a2_ = qp[2], a3 = qp[3]; const f32x4 t_ = (a0 + a1_) + (a2_ + a3); \
        P.YR[(m0 + (size_t)(cc) * TC + stp) * 256 + h * 64 + 16 * qr + lq] = (t_.x + t_.y) + (t_.z + t_.w); } } while (0)
    RW_LOAD(0); RW_STORE(0); __syncthreads();
    for (int c = 0; c < T / TC; ++c) {
        if (c > 0) RW_FLUSH(c - 1, 1);
        if (c + 1 < T / TC) RW_LOAD(c + 1);
        if (wave < 4) {
            const LAS unsigned char* bb = C.lds + (c & 1) * BUF;
            const int vo = O_V + (4 * wave + (lane >> 4)) * 4, lo = 16 * cq;
            LAS float* ring = (LAS float*)(C.lds + O_Q) + wave * 64 + lane;
            f32x4 w = *(const LAS f32x4*)(bb + 0 * VEC + lo), kk = *(const LAS f32x4*)(bb + 1 * VEC + lo), bv = *(const LAS f32x4*)(bb + 2 * VEC + lo),
                  k2 = *(const LAS f32x4*)(bb + 3 * VEC + lo), r = *(const LAS f32x4*)(bb + 4 * VEC + lo), rp = r;
            float v = *(const LAS float*)(bb + vo), qpend = 0.f;
            const unsigned b1 = (unsigned)(unsigned long long)(bb + lo), b2 = (unsigned)(unsigned long long)(bb + vo), qa = (unsigned)(unsigned long long)ring;
            f32x4 nw, nkk, nbv, nk2, nr; float nv;
#define RW_A_DOT "v_mul_f32 %6, %10, %14\n\tv_fma_f32 %6, %11, %15, %6\n\tv_fma_f32 %6, %12, %16, %6\n\tv_fma_f32 %6, %13, %17, %6"
#define RW_A_RD "ds_read_b128 %0, %7 offset:%c19\n\tds_read_b128 %1, %7 offset:%c20\n\tds_read_b128 %2, %7 offset:%c21\n\tds_read_b128 %3, %7 offset:%c22\n\tds_read_b128 %4, %7 offset:%c23\n\tds_read_b32 %5, %8 offset:%c24\n\t"
#define RW_A_OPS(IN, WO) : "=&v"(nw), "=&v"(nkk), "=&v"(nbv), "=&v"(nk2), "=&v"(nr), "=&v"(nv), "=&v"(sa) \
                 : "v"(b1), "v"(b2), "v"(qa), "v"(s.x), "v"(s.y), "v"(s.z), "v"(s.w), "v"(kk.x), "v"(kk.y), "v"(kk.z), "v"(kk.w), "v"(qpend), \
                   "n"(0 * VEC + (IN) * 256), "n"(1 * VEC + (IN) * 256), "n"(2 * VEC + (IN) * 256), "n"(3 * VEC + (IN) * 256), "n"(4 * VEC + (IN) * 256), "n"((IN) * 64), "n"(WO) : "memory"
#define RW_STEP(I, IN) { float sa, q, t0, t1, t2, t3; \
                if ((I) < 2 || (I) == 16 || (I) == 17) asm volatile(RW_A_RD "s_waitcnt lgkmcnt(6)\n\t" RW_A_DOT RW_A_OPS(IN, 0)); \
                else asm volatile("ds_write_b32 %9, %18 offset:%c25\n\t" RW_A_RD "s_waitcnt lgkmcnt(7)\n\t" RW_A_DOT RW_A_OPS(IN, ((I) >= 2 ? (I) - 2 : 0) * 1024)); \
                asm volatile("v_mul_f32 %2, %6, %10\n\tv_mul_f32 %3, %7, %10\n\t" \
                             "v_add_f32_dpp %0, %0, %0 quad_perm:[1,0,3,2] row_mask:0xf bank_mask:0xf bound_ctrl:1\n\t" \
                             "v_mul_f32 %1, %11, %15\n\tv_fma_f32 %1, %12, %16, %1\n\t" \
                             "v_add_f32_dpp %0, %0, %0 quad_perm:[2,3,0,1] row_mask:0xf bank_mask:0xf bound_ctrl:1\n\t" \
                             "v_fma_f32 %1, %13, %17, %1\n\tv_fma_f32 %1, %14, %18, %1\n\t" \
                             "v_add_f32_dpp %0, %0, %0 row_half_mirror row_mask:0xf bank_mask:0xf bound_ctrl:1\n\t" \
                             "v_mul_f32 %4, %8, %10\n\tv_mul_f32 %5, %9, %10\n\t" \
                             "v_add_f32_dpp %0, %0, %0 row_ror:8 row_mask:0xf bank_mask:0xf bound_ctrl:1" \
                             : "+v"(sa), "=&v"(q), "=&v"(t0), "=&v"(t1), "=&v"(t2), "=&v"(t3) \
                             : "v"(k2.x), "v"(k2.y), "v"(k2.z), "v"(k2.w), "v"(v), "v"(s.x), "v"(s.y), "v"(s.z), "v"(s.w), "v"(rp.x), "v"(rp.y), "v"(rp.z), "v"(rp.w)); \
                asm volatile("v_fma_f32 %4, -%8, %9, %4\n\tv_fma_f32 %5, -%8, %10, %5\n\tv_fma_f32 %6, -%8, %11, %6\n\tv_fma_f32 %7, -%8, %12, %7\n\t" \
                             "v_fma_f32 %0, %0, %13, %4\n\tv_fma_f32 %1, %1, %14, %5\n\tv_fma_f32 %2, %2, %15, %6\n\tv_fma_f32 %3, %3, %16, %7" \
                             : "+v"(s.x), "+v"(s.y), "+v"(s.z), "+v"(s.w), "+v"(t0), "+v"(t1), "+v"(t2), "+v"(t3) \
                             : "v"(sa), "v"(bv.x), "v"(bv.y), "v"(bv.z), "v"(bv.w), "v"(w.x), "v"(w.y), "v"(w.z), "v"(w.w)); \
                qpend = q; rp = r; w = nw; kk = nkk; bv = nbv; k2 = nk2; r = nr; v = nv; }
#define RW_STEP4(I) RW_STEP(I, (I) + 1) RW_STEP((I) + 1, (I) + 2) RW_STEP((I) + 2, (I) + 3) RW_STEP((I) + 3, ((I) + 4 < TC ? (I) + 4 : TC - 1))
#define RW_HALF_END(h0) do { asm volatile("s_waitcnt lgkmcnt(0)" :: "v"(w), "v"(kk), "v"(bv), "v"(k2), "v"(r), "v"(v) : "memory"); \
                ring[((h0) + 14) * 256] = qpend; ring[((h0) + 15) * 256] = dot4(s, rp); } while (0)
            RW_STEP4(0) RW_STEP4(4) RW_STEP4(8) RW_STEP4(12)
            RW_HALF_END(0);
            __syncthreads();
            RW_STEP4(16) RW_STEP4(20) RW_STEP4(24) RW_STEP4(28)
            RW_HALF_END(16);
#undef RW_HALF_END
#undef RW_STEP4
#undef RW_STEP
#undef RW_A_OPS
#undef RW_A_RD
#undef RW_A_DOT
        } else {
            __syncthreads();
            RW_FLUSH(c, 0);
        }
        if (c + 1 < T / TC) RW_STORE((c + 1) & 1);
        __syncthreads();
    }
    RW_FLUSH(T / TC - 1, 1);
#undef RW_LOAD
#undef RW_STORE
#undef RW_FLUSH
    if (wave < 4) *(f32x4*)(wkv_out + (((size_t)b * 4 + h) * 64 + row) * 64 + 4 * cq) = s;
    __syncthreads();
}
__device__ __forceinline__ void rwkv_sample_item(const RwkvPtrs& P, int item, const float* wkv_in, float* wkv_out, int lane) {
    const int rg = item & 15, h = (item >> 4) & 3, b = item >> 6, row = 4 * rg + (lane >> 4), cq = lane & 15;
    const size_t so = (((size_t)b * 4 + h) * 64 + row) * 64 + 4 * cq;
    f32x4 s = *(const f32x4*)(wkv_in + so);
#pragma unroll
    for (int i = 0; i < DS; ++i) { const size_t m = (size_t)MP + 4 * b + i, o = m * 256 + h * 64 + 4 * cq;
        float y; rwkv_step(s, *(const f32x4*)(P.W + o), ld_bf4(P.KK + o), ld_bf4(P.BV + o), ld_bf4(P.K + o), ld_bf4(P.R + o), bf1(P.V[m * 256 + h * 64 + row]), y);
        if (cq == 0) P.YR[m * 256 + h * 64 + row] = y; }
    *(f32x4*)(wkv_out + so) = s;
}
__device__ __forceinline__ void lru_prompt_item(const Ctx& C, int item, const float* AL, const float* U, const bf16* PROJ, bf16* MIXCAT, float* lru_out  ) {
    const int b = item >> 4, c = (item & 15) * 16 + (C.tid & 15), seg = C.tid >> 4; constexpr int SL = T / 32;
    const size_t m0 = (size_t)b * T + (size_t)seg * SL;
    LAS float* sA = (LAS float*)C.lds; LAS float* sH = sA + 512;
    float Ap = 1.f, H = 0.f;
#pragma unroll 8
    for (int i = 0; i < SL; ++i) { const float a = AL[(m0 + i) * 256 + c], u = U[(m0 + i) * 256 + c]; H = a * H + u; Ap *= a; }
    sA[C.tid] = Ap; sH[C.tid] = H;
    __syncthreads();
    float h = 0.f;
    for (int sp = 0; sp < seg; ++sp) h = sA[sp * 16 + (C.tid & 15)] * h + sH[sp * 16 + (C.tid & 15)];
#pragma unroll 8
    for (int i = 0; i < SL; ++i) { const float a = AL[(m0 + i) * 256 + c], u = U[(m0 + i) * 256 + c]; h = a * h + u;
        const float gb = bf1(PROJ[(m0 + i) * INC + C_GB + c]); MIXCAT[(m0 + i) * DM + 768 + c] = (bf16)f2bf(h * gelu_t(gb)); }
    if (seg == 31) lru_out[b * 256 + c] = h;
    __syncthreads();
}
__device__ __forceinline__ void swa_prompt_item(const Ctx& C, int item, const bf16* PROJ, bf16* MIXCAT, const float* sinks  ) {
    constexpr int KP = 72, VP = 264;
    const int kvh = item & 1, n = (item >> 1) & 31, b = item >> 6, tid = C.tid, lane = C.lane, wave = C.wave;
    LAS bf16* Ks = (LAS bf16*)C.lds; LAS bf16* Vt = Ks + 256 * KP;
    const size_t rowq0 = (size_t)b * T + (size_t)n * 128;
    { const int key = tid >> 1, hf = tid & 1; size_t kr = rowq0 + key; kr = (kr >= 128 + (size_t)b * T) ? kr - 128 : kr;
        const bf16* kp = PROJ + kr * INC + C_K + kvh * 64 + hf * 32;
#pragma unroll
        for (int i = 0; i < 4; ++i) *(LAS u32x4*)(Ks + key * KP + hf * 32 + 8 * i) = *(const u32x4*)(kp + 8 * i);
#pragma unroll
        for (int i = 0; i < 4; ++i) { const int ch = tid + 512 * i, vk = ch >> 3, d0 = (ch & 7) * 8; size_t vr = rowq0 + vk; vr = (vr >= 128 + (size_t)b * T) ? vr - 128 : vr;
            const u32x4 w = *(const u32x4*)(PROJ + vr * INC + C_V + kvh * 64 + d0);
            Vt[(d0 + 0) * VP + vk] = (bf16)(w.x & 0xffff); Vt[(d0 + 1) * VP + vk] = (bf16)(w.x >> 16); Vt[(d0 + 2) * VP + vk] = (bf16)(w.y & 0xffff); Vt[(d0 + 3) * VP + vk] = (bf16)(w.y >> 16);
            Vt[(d0 + 4) * VP + vk] = (bf16)(w.z & 0xffff); Vt[(d0 + 5) * VP + vk] = (bf16)(w.z >> 16); Vt[(d0 + 6) * VP + vk] = (bf16)(w.w & 0xffff); Vt[(d0 + 7) * VP + vk] = (bf16)(w.w >> 16); } }
    __syncthreads();
    const int q = lane & 31, hi = lane >> 5;
#pragma unroll 1
    for (int qi = 0; qi < 2; ++qi) {
        const int qt = wave * 2 + qi, g = qt >> 2, j = qt & 3, hh = kvh * 4 + g;
        const size_t qrow = rowq0 + 32 * j + q;
        bf16x8 qf[4];
#pragma unroll
        for (int dk = 0; dk < 4; ++dk) qf[dk] = *(const bf16x8*)(PROJ + qrow * INC + hh * 64 + 16 * dk + 8 * hi);
        f32x16 sc[5];
#pragma unroll
        for (int kt = 0; kt < 5; ++kt) {
            f32x16 acc;
#pragma unroll
            for (int i = 0; i < 16; ++i) acc[i] = 0.f;
#pragma unroll
            for (int dk = 0; dk < 4; ++dk) { const bf16x8 kf = *(const LAS bf16x8*)(Ks + (32 * (j + kt) + q) * KP + 16 * dk + 8 * hi); acc = __builtin_amdgcn_mfma_f32_32x32x16_bf16(kf, qf[dk], acc, 0, 0, 0); }
            sc[kt] = acc;
        }
        const int qpos = 128 + 32 * j + q; float mx = -INFINITY;
#pragma unroll
        for (int kt = 0; kt < 5; ++kt)
#pragma unroll
            for (int i = 0; i < 16; ++i) { const int kj = 32 * (j + kt) + (i & 3) + 8 * (i >> 2) + 4 * hi, d = qpos - kj; const bool ok = d >= 0 && d <= 128 && (n > 0 || kj >= 128);
                const float sv = ok ? sc[kt][i] * 0.125f : -INFINITY; sc[kt][i] = sv; mx = fmaxf(mx, sv); }
        mx = fmaxf(mx, shx(mx, 32, lane)); const float sink = sinks[hh]; mx = fmaxf(mx, sink);
        float sum = 0.f;
#pragma unroll
        for (int kt = 0; kt < 5; ++kt)
#pragma unroll
            for (int i = 0; i < 16; ++i) { const float e = __expf(sc[kt][i] - mx); sc[kt][i] = e; sum += e; }
        sum += shx(sum, 32, lane);
        const float inv = 1.f / (sum + __expf(sink - mx));
#pragma unroll
        for (int dt = 0; dt < 2; ++dt) {
            f32x16 o;
#pragma unroll
            for (int i = 0; i < 16; ++i) o[i] = 0.f;
#pragma unroll
            for (int kt = 0; kt < 5; ++kt)
#pragma unroll
                for (int s2 = 0; s2 < 2; ++s2) {
                    u32x4 pw; pw.x = pk2(sc[kt][8 * s2 + 0], sc[kt][8 * s2 + 1]); pw.y = pk2(sc[kt][8 * s2 + 2], sc[kt][8 * s2 + 3]); pw.z = pk2(sc[kt][8 * s2 + 4], sc[kt][8 * s2 + 5]); pw.w = pk2(sc[kt][8 * s2 + 6], sc[kt][8 * s2 + 7]);
                    const LAS bf16* vp = Vt + (32 * dt + q) * VP + 32 * (j + kt) + 16 * s2 + 4 * hi;
                    const u32x2 v0 = *(const LAS u32x2*)vp, v1 = *(const LAS u32x2*)(vp + 8);
                    u32x4 vw; vw.x = v0.x; vw.y = v0.y; vw.z = v1.x; vw.w = v1.y;
                    o = __builtin_amdgcn_mfma_f32_32x32x16_bf16(__builtin_bit_cast(bf16x8, vw), __builtin_bit_cast(bf16x8, pw), o, 0, 0, 0);
                }
#pragma unroll
            for (int g4 = 0; g4 < 4; ++g4) st_bf4(MIXCAT + qrow * DM + hh * 64 + 32 * dt + 8 * g4 + 4 * hi, (f32x4){o[4 * g4] * inv, o[4 * g4 + 1] * inv, o[4 * g4 + 2] * inv, o[4 * g4 + 3] * inv});
        }
    }
    __syncthreads();
}
__device__ __forceinline__ void swa_sample_item(const Ctx& C, int item, const bf16* PROJ, bf16* MIXCAT, const float* sinks, const float* ck, const float* cv, float* ko, float* vo) {
    const int kvh = item & 1, b = item >> 1, tid = C.tid;
    LAS float* Kf = (LAS float*)C.lds; LAS float* Vf = Kf + 132 * 65; LAS float* Qf = Vf + 132 * 64; LAS float* Pf = Qf + 16 * 64;
    for (int e = tid; e < 132 * 64; e += 512) { const int key = e >> 6, d = e & 63; float kx, vx;
        if (key < 128) { const size_t o = (((size_t)b * 128 + key) * 2 + kvh) * 64 + d; kx = ck[o]; vx = cv[o]; }
        else { const size_t r = (size_t)MP + 4 * b + (key - 128); kx = bf1(PROJ[r * INC + C_K + kvh * 64 + d]); vx = bf1(PROJ[r * INC + C_V + kvh * 64 + d]); }
        Kf[key * 65 + d] = kx; Vf[key * 64 + d] = vx;
        if (key >= 4) { const size_t o = (((size_t)b * 128 + (key - 4)) * 2 + kvh) * 64 + d; ko[o] = kx; vo[o] = vx; } }
    for (int e = tid; e < 16 * 64; e += 512) { const int qr = e >> 6, d = e & 63, i = qr >> 2, g = qr & 3; Qf[e] = bf1(PROJ[((size_t)MP + 4 * b + i) * INC + (kvh * 4 + g) * 64 + d]); }
    __syncthreads();
    { const int qr = tid >> 5, kl = tid & 31, i = qr >> 2, g = qr & 3; float sc[5]; float mx = -INFINITY;
#pragma unroll
        for (int k5 = 0; k5 < 5; ++k5) { const int key = kl + 32 * k5; float sv = -INFINITY;
            if (key < 132 && key >= i && key <= i + 128) { float a = 0.f;
#pragma unroll 16
                for (int d = 0; d < 64; ++d) a += Qf[qr * 64 + d] * Kf[key * 65 + d];
                sv = a * 0.125f; }
            sc[k5] = sv; mx = fmaxf(mx, sv); }
#pragma unroll
        for (int o = 1; o < 32; o <<= 1) mx = fmaxf(mx, shx(mx, o, C.lane));
        const float sink = sinks[kvh * 4 + g]; mx = fmaxf(mx, sink); float sum = 0.f;
#pragma unroll
        for (int k5 = 0; k5 < 5; ++k5) { sc[k5] = __expf(sc[k5] - mx); sum += sc[k5]; }
#pragma unroll
        for (int o = 1; o < 32; o <<= 1) sum += shx(sum, o, C.lane);
        const float inv = 1.f / (sum + __expf(sink - mx));
#pragma unroll
        for (int k5 = 0; k5 < 5; ++k5) { const int key = kl + 32 * k5; if (key < 136) Pf[qr * 136 + key] = sc[k5] * inv; } }
    __syncthreads();
    { const int qr = tid >> 5, d = (tid & 31) * 2, i = qr >> 2, g = qr & 3; float o0 = 0.f, o1 = 0.f;
#pragma unroll 4
        for (int key = 0; key < 132; ++key) { const float p = Pf[qr * 136 + key]; o0 += p * Vf[key * 64 + d]; o1 += p * Vf[key * 64 + d + 1]; }
        *(unsigned*)(MIXCAT + ((size_t)MP + 4 * b + i) * DM + (kvh * 4 + g) * 64 + d) = pk2(o0, o1); }
    __syncthreads();
}

__device__ __forceinline__ void s_phase(const Ctx& C, const Args& A, int l) {
    const bf16* PROJ = (const bf16*)(C.ws + WS_R1); bf16* MIXCAT = (bf16*)(C.ws + WS_HN);
    float* R = (float*)(C.ws + WS_R2); const size_t S = (size_t)M * 256;
    RwkvPtrs P{(const bf16*)R, (const bf16*)(R + S), (const bf16*)(R + 2 * S), (const bf16*)(R + 3 * S), (const bf16*)(R + 4 * S), R + 5 * S, (float*)(C.ws + WS_R3)};
    const float* AL = (const float*)(C.ws + WS_R3) + S; const float* U = AL + S;
    float* out = C.out;
    constexpr int NSCAN = 64;
    if (C.bid < NSCAN) { rwkv_prompt(C, P, C.bid, out + OUT_WKVP + (size_t)l * NBP * 4 * 4096); return; }
    constexpr int N0 = 256, N1 = N0 + 64, N2_ = N1 + 256, N3 = N2_ + 1024, N4 = N3 + 64;
    for (int it = C.bid - NSCAN; it < N4; it += C.G - NSCAN) {
        if (it < N0) swa_prompt_item(C, it, PROJ, MIXCAT, INP(I_SINK) + l * 8);
        else if (it < N1) lru_prompt_item(C, it - N0, AL, U, PROJ, MIXCAT, out + OUT_LRP + (size_t)l * NBP * 256);
        else if (it < N2_) swa_sample_item(C, it - N1, PROJ, MIXCAT, INP(I_SINK) + l * 8, INP(I_CK) + (size_t)l * DB * 16384, INP(I_CV) + (size_t)l * DB * 16384,
                                          out + OUT_KS + (size_t)l * DB * 16384, out + OUT_VS + (size_t)l * DB * 16384);
        else if (it < N3) rwkv_sample_item(P, (it - N2_) * 8 + C.wave, INP(I_SWKV) + (size_t)l * DB * 4 * 4096, out + OUT_WKVS + (size_t)l * DB * 4 * 4096, C.lane);
        else { const int e = (it - N3) * 512 + C.tid, b = e >> 8, c = e & 255; float h = INP(I_SLRU)[((size_t)l * DB + b) * 256 + c];
#pragma unroll
            for (int i = 0; i < DS; ++i) { const size_t m = (size_t)MP + 4 * b + i; h = AL[m * 256 + c] * h + U[m * 256 + c];
                MIXCAT[m * DM + 768 + c] = (bf16)f2bf(h * gelu_t(bf1(PROJ[m * INC + C_GB + c]))); }
            out[OUT_LRS + ((size_t)l * DB + b) * 256 + c] = h; }
    }
    if (l + 1 < NL) convert_layer(C, A, l + 1, (C.bid - NSCAN) * 8 + C.wave, (C.G - NSCAN) * 8, (C.bid - NSCAN) * 512 + C.tid, (C.G - NSCAN) * 512);
    __syncthreads();
    { pg8::Gemm g{(const bf16*)(C.ws + WS_PB + (size_t)(l & 1) * SZ_PBL), (const bf16*)(C.ws + WS_W + (size_t)(l & 1) * WL + O_WP), M, DM, PLE}; pg8::StaticOrder So; So.init(M, DM, C.G - NSCAN, C.bid - NSCAN);
      pg8::EpiBf16<0> E{(bf16*)(C.ws + WS_PP), DM, nullptr, 0, 0, 1.f};
      pg8::gemm_phase<pg8::EpiBf16<0>, pg8::StaticOrder, true, true>(C.lds, g, So, E, C.tid); }
}

__device__ __forceinline__ void e3_post(const Ctx& C, const Args& A, int l) {
    const float* R = (const float*)(C.ws + WS_R2); const size_t S = (size_t)M * 256;
    const bf16 *Rb = (const bf16*)R, *K = (const bf16*)(R + S), *V = (const bf16*)(R + 2 * S), *G = (const bf16*)(R + 6 * S); const float* YR = (const float*)(C.ws + WS_R3);
    bf16* MIXCAT = (bf16*)(C.ws + WS_HN); const int c4 = 4 * C.lane;
    const f32x4 lw = *(const f32x4*)(INP(I_LNW) + l * 256 + c4), lb = *(const f32x4*)(INP(I_LNB) + l * 256 + c4), rk = *(const f32x4*)(INP(I_RK) + l * 256 + c4);
    for (int m = C.gw; m < M; m += C.NGW) {
        const size_t o = (size_t)m * 256 + c4;
        const f32x4 y = *(const f32x4*)(YR + o), r = ld_bf4(Rb + o), k = ld_bf4(K + o), v = ld_bf4(V + o), g = ld_bf4(G + o);
        const float mean = red16((y.x + y.y) + (y.z + y.w)) * (1.f / 64.f); const f32x4 d = y - mean;
        const float var = red16(dot4(d, d)) * (1.f / 64.f); const float rs = rsqrtf(var + 64e-5f);
        const float bonus = red16(dot4(r * k, rk));
        st_bf4(MIXCAT + (size_t)m * DM + 512 + c4, (d * rs * lw + lb + v * bonus) * g);
    }
}
constexpr int LDS_BYTES = 131072 + 64;
#ifndef MK_MULTI
#define MK_MULTI 0
#endif
#ifndef MK_DUP
#define MK_DUP 0
#endif
enum { PH_P0 = 0, PH_G1, PH_E1, PH_G2, PH_S, PH_E3, PH_G3, PH_E4, PH_G4, PH_G5, PH_E5, PH_G6, PH_E0, PH_G3B, PH_E4S, PH_G5B, PH_E5S, PH_N };
constexpr int NSPLIT = 16;

__device__ __forceinline__ Ctx make_ctx(int wave0, LAS unsigned char* lds) {
    Ctx D; int z_ = 0; asm volatile("" : "+v"(z_)); int ln_ = __builtin_amdgcn_mbcnt_hi(-1, __builtin_amdgcn_mbcnt_lo(-1, z_));
    D.lane = ln_; D.wave = wave0; D.tid = wave0 * 64 + ln_;
    int b_ = blockIdx.x; asm volatile("" : "+s"(b_)); D.bid = b_; D.gw = b_ * 8 + wave0; D.G = gridDim.x; D.NGW = D.G * 8;
    D.lds = lds; D.out = (float*)inp_ld(N_IN); D.ws = (unsigned char*)inp_ld(N_IN + 1);
    return D;
}
template <int PH> __device__ __forceinline__ void run_phase(const Args& A, int wave0, LAS unsigned char* lds, int l_in) {
    const Ctx C = make_ctx(wave0, lds);
    int l = l_in; asm volatile("" : "+s"(l));
    unsigned char* ws = C.ws; unsigned char* wl = ws + WS_W + (size_t)(l & 1) * WL; (void)wl;
    bf16* HN = (bf16*)(ws + WS_HN); float* MIX = (float*)(ws + WS_R1); float* R2 = (float*)(ws + WS_R2); float* R3 = (float*)(ws + WS_R3); bf16* X = (bf16*)(ws + WS_X16);
    const size_t S = (size_t)M * 256; (void)HN; (void)MIX; (void)R2; (void)R3; (void)X; (void)S;
    if constexpr (PH == PH_P0) p0_prologue(C, A);
    if constexpr (PH == PH_G1) {
        pg8::Gemm g{HN, (const bf16*)(wl + O_WIN), M, INC, DM}; pg8::StaticOrder So; So.init(M, INC, C.G, C.bid);
        pg8::EpiBf16<0> E{(bf16*)(ws + WS_R1), INC, INP(I_BIN) + (size_t)l * INC, 0, 0, 1.f};
        pg8::gemm_phase<pg8::EpiBf16<0>, pg8::StaticOrder, true, true>(C.lds, g, So, E, C.tid); }
    if constexpr (PH == PH_E1) e1_prep(C, A, l);
    if constexpr (PH == PH_G2) {
        pg8::Gemm g{(const bf16*)(ws + WS_R3), (const bf16*)(wl + O_W2), M, N2, K2 / 2, K2}; G2Order So; So.b.init(M, N2, C.G, C.bid);
        EpiMix E{INP(I_W0) + l * 256, INP(I_A0) + l * 256, INP(I_KA) + l * 256, INP(I_BA) + l * 256, INP(I_BI) + l * 256, INP(I_L) + l * 256,
                 R2 + 5 * S, (bf16*)(R2 + 1 * S), (bf16*)(R2 + 3 * S), (bf16*)(R2 + 4 * S), (bf16*)(R2 + 6 * S), R3 + S, R3 + 2 * S, (const bf16*)(ws + WS_R3)};
        pg8::gemm_phase<EpiMix, G2Order, true, true>(C.lds, g, So, E, C.tid); }
    if constexpr (PH == PH_S) s_phase(C, A, l);
    if constexpr (PH == PH_E3) e3_post(C, A, l);
    if constexpr (PH == PH_G3) {
        pg8::Gemm g{HN, (const bf16*)(wl + O_WOUT), MP, DM, DM}; pg8::StaticOrder So; So.init(MP, DM, C.G, C.bid);
        pg8::EpiBf16<0> E{(bf16*)MIX, DM, INP(I_BOUT) + (size_t)l * DM, 0, 0, 1.f};
        pg8::gemm_phase<pg8::EpiBf16<0>, pg8::StaticOrder, true, true>(C.lds, g, So, E, C.tid); }
    if constexpr (PH == PH_G3B) {
        if (C.bid < NSPLIT) { pg8::Gemm g{HN + (size_t)MP * DM, (const bf16*)(wl + O_WOUT), MS, DM, DM / 2, DM}; SplitOrder So{C.bid, NSPLIT, DM / 2}; EpiPart E{R3};
            pg8::gemm_phase<EpiPart, SplitOrder, true, true>(C.lds, g, So, E, C.tid); }
        else for (int m = (C.bid - NSPLIT) * 8 + C.wave; m < MP; m += (C.G - NSPLIT) * 8)
            row_update((const bf16*)MIX + (size_t)m * DM, INP(I_NMPOST) + l * DM, X + (size_t)m * DM, INP(I_NFPRE) + l * DM, HN + (size_t)m * DM, C.lane); }
    if constexpr (PH == PH_E4S)
        for (int m = MP + C.gw; m < M; m += C.NGW)
            row_update_parts(R3 + (size_t)(m - MP) * DM, R3 + (size_t)(MS + m - MP) * DM, INP(I_BOUT) + (size_t)l * DM, INP(I_NMPOST) + l * DM, X + (size_t)m * DM, INP(I_NFPRE) + l * DM, HN + (size_t)m * DM, C.lane);
    if constexpr (PH == PH_G4) {
        pg8::Gemm g{HN, (const bf16*)(wl + O_WGU), M, 2 * DFF, DM}; pg8::StaticOrder So; So.init(M, 2 * DFF, C.G, C.bid);
        EpiSwiglu E{(bf16*)(ws + WS_R2)};
        pg8::gemm_phase<EpiSwiglu, pg8::StaticOrder, true, true>(C.lds, g, So, E, C.tid); }
    if constexpr (PH == PH_G5) {
        pg8::Gemm g{(const bf16*)(ws + WS_R2), (const bf16*)(wl + O_WD), MP, DM, DFF}; pg8::StaticOrder So; So.init(MP, DM, C.G, C.bid);
        pg8::EpiBf16<0> E{(bf16*)MIX, DM, nullptr, 0, 0, 1.f};
        pg8::gemm_phase<pg8::EpiBf16<0>, pg8::StaticOrder, true, true>(C.lds, g, So, E, C.tid); }
    if constexpr (PH == PH_G5B) {
        if (C.bid < NSPLIT) { pg8::Gemm g{(const bf16*)(ws + WS_R2) + (size_t)MP * DFF, (const bf16*)(wl + O_WD), MS, DM, DFF / 2, DFF}; SplitOrder So{C.bid, NSPLIT, DFF / 2}; EpiPart E{R3};
            pg8::gemm_phase<EpiPart, SplitOrder, true, true>(C.lds, g, So, E, C.tid); }
        else for (int m = (C.bid - NSPLIT) * 8 + C.wave; m < MP; m += (C.G - NSPLIT) * 8)
            row_update((const bf16*)MIX + (size_t)m * DM, INP(I_NFPOST) + l * DM, X + (size_t)m * DM, nullptr, HN + (size_t)m * DM, C.lane); }
    if constexpr (PH == PH_E5S)
        for (int m = MP + C.gw; m < M; m += C.NGW)
            row_update_parts(R3 + (size_t)(m - MP) * DM, R3 + (size_t)(MS + m - MP) * DM, nullptr, INP(I_NFPOST) + l * DM, X + (size_t)m * DM, nullptr, HN + (size_t)m * DM, C.lane);
    if constexpr (PH == PH_G6) {
        pg8::StaticOrder So; So.init(M, DM, C.G, C.bid);
        pg8::Gemm g{HN, (const bf16*)(wl + O_WPG), M, DM, DM}; EpiPle E{X, (const bf16*)(ws + WS_PP), l == NL - 1 ? C.out : nullptr};
        pg8::gemm_phase<EpiPle, pg8::StaticOrder, true, true>(C.lds, g, So, E, C.tid); }
    if constexpr (PH == PH_E0)
        for (int m = C.gw; m < M; m += C.NGW) row_norm(X + (size_t)m * DM, INP(I_NMPRE) + (l + 1) * DM, HN + (size_t)m * DM, C.lane);
}

#if MK_MULTI
template <int PH> __global__ void __launch_bounds__(512, 2) mk_one(Args A, int l) {
    extern __shared__ __attribute__((aligned(16))) unsigned char lds_raw[];
    const int wave0 = __builtin_amdgcn_readfirstlane((int)threadIdx.x >> 6);
    run_phase<PH>(A, wave0, (LAS unsigned char*)lds_raw, l);
}
#else
__global__ void __launch_bounds__(512, 2) mk_fwd(Args A) {
    extern __shared__ __attribute__((aligned(16))) unsigned char lds_raw[];
    cg::grid_group grid = cg::this_grid();
    const int wave0 = __builtin_amdgcn_readfirstlane((int)threadIdx.x >> 6);
    LAS unsigned char* lds = (LAS unsigned char*)lds_raw;
    if (threadIdx.x < 16) ((LAS unsigned*)lds)[131072 / 4 + threadIdx.x] = 0u;
    __syncthreads();
    const unsigned xbar_x = __builtin_amdgcn_readfirstlane(xcd_barrier_post((unsigned*)inp_ld(N_IN + 1), (volatile LAS unsigned*)(lds + 131072), (int)threadIdx.x).x);
#define GRID_BAR() do { int z_ = 0; asm volatile("" : "+v"(z_)); int ln_ = __builtin_amdgcn_mbcnt_hi(-1, __builtin_amdgcn_mbcnt_lo(-1, z_)); XcdBarrier xb_; xb_.bar = (unsigned*)inp_ld(N_IN + 1); xb_.x = xbar_x; \
        xb_.st = (volatile LAS unsigned*)(lds + 131072); xcd_barrier(xb_, wave0 * 64 + ln_); } while (0)
    run_phase<PH_P0>(A, wave0, lds, 0);
    if (MK_DUP & 1) { GRID_BAR(); run_phase<PH_P0>(A, wave0, lds, 0); }
    grid.sync();
#pragma unroll 1
    for (int l = 0; l < NL; ++l) {
#define RP(PH) do { run_phase<PH>(A, wave0, lds, l); GRID_BAR(); if (MK_DUP & (1 << 20)) GRID_BAR(); if (MK_DUP & (1 << PH)) { run_phase<PH>(A, wave0, lds, l); GRID_BAR(); } } while (0)
        RP(PH_G1); RP(PH_E1); RP(PH_G2); RP(PH_S); RP(PH_E3); RP(PH_G3); RP(PH_G3B); RP(PH_E4S); RP(PH_G4); RP(PH_G5); RP(PH_G5B); RP(PH_E5S);
        run_phase<PH_G6>(A, wave0, lds, l);
        if (l + 1 < NL) { GRID_BAR(); RP(PH_E0); }
    }
}
#endif
}

#if MK_MULTI
template <int PH> static void launch_one(const mk::Args& a, int l, int grid, hipStream_t stream) {
    static bool attr = false;
    if (!attr) { (void)hipFuncSetAttribute((const void*)mk::mk_one<PH>, hipFuncAttributeMaxDynamicSharedMemorySize, mk::LDS_BYTES); attr = true; }
    hipLaunchKernelGGL(mk::mk_one<PH>, dim3(grid), dim3(512), mk::LDS_BYTES, stream, a, l);
}
#endif
extern "C" void kernel_launch(void* const* d_in, const int* in_sizes, int n_in, void* d_out, int out_size, void* d_ws, size_t ws_size, hipStream_t stream) {
    using namespace mk;
    static int grid = 0;
    if (grid == 0) {
        if (n_in != N_IN || (size_t)out_size != OUT_END || ws_size < WS_END) {
            fprintf(stderr, "kernel_launch: shape mismatch: n_in %d (want %d), out %d (want %zu), ws %zu (want >= %zu); nothing launched\n", n_in, (int)N_IN, out_size, (size_t)OUT_END, ws_size, (size_t)WS_END);
            grid = -1; return; }
        int dev = 0, cus = 0;
        (void)hipGetDevice(&dev); (void)hipDeviceGetAttribute(&cus, hipDeviceAttributeMultiprocessorCount, dev);
#if !MK_MULTI
        int per_cu = 0;
        if (hipFuncSetAttribute((const void*)mk_fwd, hipFuncAttributeMaxDynamicSharedMemorySize, LDS_BYTES) != hipSuccess) { fprintf(stderr, "kernel_launch: hipFuncSetAttribute failed\n"); grid = -1; return; }
        if (hipOccupancyMaxActiveBlocksPerMultiprocessor(&per_cu, (const void*)mk_fwd, 512, LDS_BYTES) != hipSuccess || per_cu < 1) fprintf(stderr, "kernel_launch: note: occupancy query gave %d\n", per_cu);
        (void)hipGetLastError();
#endif
        grid = cus;
        if (grid < 128) { fprintf(stderr, "kernel_launch: %d CUs: too few for this kernel\n", grid); grid = -1; return; }
    }
    if (grid < 0) return;
    Args a{};
    for (int i = 0; i < N_IN; ++i) a.in[i] = (const float*)d_in[i];
    a.out = (float*)d_out; a.ws = (unsigned char*)d_ws;
#if MK_MULTI
    launch_one<PH_P0>(a, 0, grid, stream);
    for (int l = 0; l < NL; ++l) {
        launch_one<PH_G1>(a, l, grid, stream); launch_one<PH_E1>(a, l, grid, stream); launch_one<PH_G2>(a, l, grid, stream); launch_one<PH_S>(a, l, grid, stream);
        launch_one<PH_E3>(a, l, grid, stream); launch_one<PH_G3>(a, l, grid, stream); launch_one<PH_E4>(a, l, grid, stream); launch_one<PH_G4>(a, l, grid, stream);
        launch_one<PH_G5>(a, l, grid, stream); launch_one<PH_E5>(a, l, grid, stream); launch_one<PH_G6>(a, l, grid, stream);
        if (l + 1 < NL) launch_one<PH_E0>(a, l, grid, stream);
    }
#else
    if (hipMemsetAsync(d_ws, 0, 65536, stream) != hipSuccess) { fprintf(stderr, "kernel_launch: hipMemsetAsync failed\n"); return; }
    void* args[] = {&a};
    const hipError_t e = hipLaunchCooperativeKernel((const void*)mk_fwd, dim3(grid), dim3(512), args, LDS_BYTES, stream);
    if (e != hipSuccess) fprintf(stderr, "kernel_launch: cooperative launch failed: %s (grid %d)\n", hipGetErrorString(e), grid);
#endif
}
```

```cpp
#include <hip/hip_runtime.h>
#include <hip/hip_cooperative_groups.h>
#include <cstdio>
#include <cstdint>
#include <cstddef>
#include <cmath>
namespace cg = cooperative_groups;
namespace pg8 {
#define PG8_LAS __attribute__((address_space(3)))
typedef unsigned short bf16_t;
typedef short bf16x8 __attribute__((ext_vector_type(8)));
typedef float f32x4 __attribute__((ext_vector_type(4)));
typedef unsigned u32x4 __attribute__((ext_vector_type(4)));
constexpr int BM = 256, BK = 64, HALF = 128, HTB = HALF * BK * 2  , STAGE_BYTES = 8 * HTB, NXCD = 8, WGM = 8;

__host__ __device__ __forceinline__ int lds_byte(int r, int c) { const int st = (r >> 4) * 2 + (c >> 5), rr = r & 15, cc = c & 31, ob = rr * 64 + cc * 2; return st * 1024 + (ob ^ (((ob >> 9) & 1) << 5)); }
__host__ __device__ __forceinline__ void stage_rc(int b, int& R, int& C) { const int st = b / 1024, sb = b % 1024, swz = sb ^ (((sb >> 9) & 1) << 5); R = (st >> 1) * 16 + swz / 64; C = (st & 1) * 32 + (swz % 64) / 2; }
__host__ __device__ __forceinline__ int perm32(int rho) { const int n = rho >> 4, i = rho & 15; return 8 * (i >> 2) + 4 * n + (i & 3); }

struct Unit { int pm, pn, ko = 0; };
struct Gemm { const bf16_t* A; const bf16_t* Bt; int M, N, K; int ld = 0; };

struct StaticOrder {
    int nM, nN, nwg, G, c;
    __host__ __device__ void init(int M, int N, int G_, int c_) { nM = M / BM; nN = N / BM; nwg = nM * nN; G = G_; c = c_; }
    __host__ __device__ bool next(int i, Unit& u) const {
        const long L = (long)i * G + c; if (L >= nwg) return false;
        int wgid = (int)L; { const int q = nwg / NXCD, r = nwg % NXCD, xcd = wgid % NXCD, off = wgid / NXCD; wgid = (xcd < r ? xcd * (q + 1) : r * (q + 1) + (xcd - r) * q) + off; }
        const int nig = WGM * nN, gid = wgid / nig, fm = gid * WGM, gsz = (nM - fm) < WGM ? (nM - fm) : WGM;
        u.pm = fm + ((wgid % nig) % gsz); u.pn = (wgid % nig) / gsz; return true;
    }
    __device__ __forceinline__ void a_ready(const Unit&) const {}
    __device__ __forceinline__ void done(const Unit&) const {}
};

__device__ __forceinline__ unsigned cvt_pk_bf16(float lo, float hi) { unsigned r; asm volatile("v_cvt_pk_bf16_f32 %0, %1, %2" : "=v"(r) : "v"(lo), "v"(hi)); return r; }
typedef float f32x2 __attribute__((ext_vector_type(2)));
__device__ __forceinline__ f32x2 gelu_pk(f32x2 v) {
    const f32x2 av = __builtin_elementwise_abs(v), d = av * 0.2316418882f + 1.0f;
    f32x2 t; t.x = __builtin_amdgcn_rcpf(d.x); t.y = __builtin_amdgcn_rcpf(d.y);
    f32x2 q = t * 0.5307027145f + (-0.7265760135f); q = q * t + 0.7107068705f; q = q * t + (-0.142248368f); q = q * t + 0.127414796f; q = q * t;
    const f32x2 s = (v * v) * (-0.72134752044f);
    f32x2 e; e.x = __builtin_amdgcn_exp2f(s.x); e.y = __builtin_amdgcn_exp2f(s.y);
    const f32x2 m = v * (q * e), r = v - m;
    f32x2 o; o.x = v.x < 0.f ? m.x : r.x; o.y = v.y < 0.f ? m.y : r.y; return o;
}

template <int ACT  > struct EpiBf16 {
    static constexpr bool PERM = true, AFTER_DRAIN = false; static_assert(ACT == 0 || ACT == 1, "EpiBf16: ACT is 0 (none) or 1 (gelu_pk)");
    bf16_t* O; int ldc; const float* bias; int split_cols; size_t split_stride; float scale0;
    __device__ __forceinline__ void operator()(const f32x4 (&acc)[2][2][4][2], const Unit& u, int wr, int wc, int fr, int fq) const {
        const int row0 = u.pm * BM + wr * 64 + fr; int colt = u.pn * BM; bf16_t* base = O;
        float sc = 1.f; if (split_cols) { const int t = colt / split_cols; base += (size_t)t * split_stride; colt -= t * split_cols; if (t == 0) sc = scale0; }
        const int col0 = colt + wc * 32 + 8 * fq, bcol0 = u.pn * BM + wc * 32 + 8 * fq;
        f32x4 bv[2][2];
#pragma unroll
        for (int bj = 0; bj < 2; ++bj)
#pragma unroll
            for (int n = 0; n < 2; ++n) bv[bj][n] = bias ? *(const f32x4*)(bias + bcol0 + bj * HALF + 4 * n) : (f32x4){0.f, 0.f, 0.f, 0.f};
#pragma unroll
        for (int ai = 0; ai < 2; ++ai)
#pragma unroll
            for (int m = 0; m < 4; ++m) { bf16_t* rowp = base + (size_t)(row0 + ai * HALF + m * 16) * ldc + col0;
#pragma unroll
                for (int bj = 0; bj < 2; ++bj) { f32x4 v0 = acc[ai][bj][m][0] + bv[bj][0], v1 = acc[ai][bj][m][1] + bv[bj][1];
                    if (ACT == 1) { f32x2 a = gelu_pk((f32x2){v0[0], v0[1]}), b = gelu_pk((f32x2){v0[2], v0[3]}), c = gelu_pk((f32x2){v1[0], v1[1]}), d = gelu_pk((f32x2){v1[2], v1[3]});
                        v0 = (f32x4){a.x, a.y, b.x, b.y}; v1 = (f32x4){c.x, c.y, d.x, d.y}; }
                    v0 = v0 * sc; v1 = v1 * sc; u32x4 w; w.x = cvt_pk_bf16(v0[0], v0[1]); w.y = cvt_pk_bf16(v0[2], v0[3]); w.z = cvt_pk_bf16(v1[0], v1[1]); w.w = cvt_pk_bf16(v1[2], v1[3]);
                    *(u32x4*)(rowp + bj * HALF) = w; } }
    }
};
template <class Epi, class Sched, bool ALIGN_EPI = false, bool SP2 = false>
__device__ __forceinline__ void gemm_phase(PG8_LAS unsigned char* lds, const Gemm g, const Sched& S, const Epi& E, int tid_in) {
    int tid_ = tid_in; asm volatile("" : "+v"(tid_));
    const int tid = tid_, wid = __builtin_amdgcn_readfirstlane(tid >> 6), lane = tid & 63, wr = wid >> 2, wc = wid & 3, fr = lane & 15, fq = lane >> 4;
    const int K = g.K, nt = K / BK, LD = g.ld ? g.ld : g.K;
    unsigned voffA[2], voffB[2];
#pragma unroll
    for (int i = 0; i < 2; ++i) { int R, C; stage_rc(tid * 16 + i * 8192, R, C); const int Rb = Epi::PERM ? ((R & ~31) + perm32(R & 31)) : R;
        voffA[i] = (unsigned)(R * LD + C) * 2u; voffB[i] = (unsigned)(Rb * LD + C) * 2u; }
    const size_t kstep = (size_t)(BK * 2);
    const size_t hstep = (size_t)HALF * LD * 2;
    const size_t tstep = 2 * hstep;
    const unsigned ldsw = (unsigned)wid * 1024u;
    const int aoff = lds_byte(wr * 64 + fr, fq * 8), boff = lds_byte(wc * 32 + fr, fq * 8);
#define PG8_SA(b, h) (((b) * 2 + (h)) * HTB)
#define PG8_SB(b, h) ((4 + (b) * 2 + (h)) * HTB)
#define PG8_STAGE(bufoff, gbase, voff) do { _Pragma("unroll") for (int _i = 0; _i < 2; ++_i) \
        __builtin_amdgcn_global_load_lds((const unsigned*)((const char*)(gbase) + (voff)[_i]), (PG8_LAS unsigned*)(lds + (bufoff) + ldsw + _i * 8192), 16, 0, 0); } while (0)
#define PG8_LDA(dst, b, h) do { _Pragma("unroll") for (int m = 0; m < 4; ++m) _Pragma("unroll") for (int k = 0; k < 2; ++k) dst[m][k] = *(const PG8_LAS bf16x8*)(lds + PG8_SA(b, h) + aoff + m * 2048 + k * 1024); } while (0)
#define PG8_LDB(dst, b, h) do { _Pragma("unroll") for (int n = 0; n < 2; ++n) _Pragma("unroll") for (int k = 0; k < 2; ++k) dst[n][k] = *(const PG8_LAS bf16x8*)(lds + PG8_SB(b, h) + boff + n * 2048 + k * 1024); } while (0)
#define PG8_MMA(ai, bj, At, Bt) do { __builtin_amdgcn_s_setprio(1); _Pragma("unroll") for (int m = 0; m < 4; ++m) _Pragma("unroll") for (int n = 0; n < 2; ++n) _Pragma("unroll") for (int k = 0; k < 2; ++k) \
        acc[ai][bj][m][n] = __builtin_amdgcn_mfma_f32_16x16x32_bf16(Bt[n][k], At[m][k], acc[ai][bj][m][n], 0, 0, 0); __builtin_amdgcn_s_setprio(0); } while (0)
#define PG8_WAIT_V(n) asm volatile("s_waitcnt vmcnt(" #n ")" ::: "memory")
#define PG8_WAIT_L(n) asm volatile("s_waitcnt lgkmcnt(" #n ")" ::: "memory")
#define PG8_BAR __builtin_amdgcn_s_barrier()
#define PG8_SCHED __builtin_amdgcn_sched_barrier(0)
    Unit cur, nxt; int ui = 0;
    if (!S.next(0, cur)) return;
    f32x4 acc[2][2][4][2];
#pragma unroll
    for (int a = 0; a < 2; ++a)
#pragma unroll
        for (int b = 0; b < 2; ++b)
#pragma unroll
            for (int m = 0; m < 4; ++m)
#pragma unroll
                for (int n = 0; n < 2; ++n) acc[a][b][m][n] = (f32x4){0.f, 0.f, 0.f, 0.f};
    bf16x8 At[4][2], B0[2][2], B1[2][2];
    const char* cA = (const char*)g.A + (size_t)cur.pm * tstep + (size_t)cur.ko * 2; const char* cB = (const char*)g.Bt + (size_t)cur.pn * tstep + (size_t)cur.ko * 2;
    S.a_ready(cur);
    if constexpr (SP2) {
        PG8_STAGE(PG8_SB(0, 0), cB, voffB); PG8_STAGE(PG8_SB(0, 1), cB + hstep, voffB); PG8_STAGE(PG8_SA(0, 0), cA, voffA); PG8_STAGE(PG8_SA(0, 1), cA + hstep, voffA);
        if (wr == 1) PG8_BAR;
        PG8_WAIT_V(2); PG8_BAR;
        PG8_STAGE(PG8_SB(1, 0), cB + kstep, voffB); PG8_STAGE(PG8_SA(1, 0), cA + kstep, voffA); PG8_STAGE(PG8_SB(1, 1), cB + hstep + kstep, voffB);
        PG8_WAIT_V(6); PG8_BAR;
    } else {
        PG8_STAGE(PG8_SB(0, 0), cB, voffB); PG8_STAGE(PG8_SA(0, 0), cA, voffA); PG8_STAGE(PG8_SB(0, 1), cB + hstep, voffB); PG8_STAGE(PG8_SA(0, 1), cA + hstep, voffA);
        if (wr == 1) PG8_BAR;
        PG8_WAIT_V(4); PG8_BAR;
        PG8_STAGE(PG8_SB(1, 0), cB + kstep, voffB); PG8_STAGE(PG8_SA(1, 0), cA + kstep, voffA); PG8_STAGE(PG8_SB(1, 1), cB + hstep + kstep, voffB);
        PG8_WAIT_V(6); PG8_BAR;
    }
    for (;;) {
        const bool has_next = S.next(ui + 1, nxt);
        const char* nA = has_next ? (const char*)g.A + (size_t)nxt.pm * tstep + (size_t)nxt.ko * 2 : cA; const char* nB = has_next ? (const char*)g.Bt + (size_t)nxt.pn * tstep + (size_t)nxt.ko * 2 : cB;
        for (int t = 0; t < nt; t += 2) {
            const bool last = (t == nt - 2);
            const char* a1 = cA + (size_t)(t + 1) * kstep;
            const char* a2 = last ? nA : cA + (size_t)(t + 2) * kstep; const char* b2 = last ? nB : cB + (size_t)(t + 2) * kstep;
            const char* a3 = a2 + kstep; const char* b3 = b2 + kstep;
            if (last && has_next) S.a_ready(nxt);
            if constexpr (SP2) {
            PG8_LDB(B0, 0, 0); PG8_LDB(B1, 0, 1); PG8_SCHED; PG8_LDA(At, 0, 0); PG8_STAGE(PG8_SA(1, 1), a1 + hstep, voffA);
            PG8_WAIT_V(8); PG8_WAIT_L(0); PG8_BAR; PG8_MMA(0, 0, At, B0); PG8_MMA(0, 1, At, B1); PG8_BAR; PG8_SCHED;
            PG8_LDA(At, 0, 1); PG8_STAGE(PG8_SB(0, 0), b2, voffB); PG8_STAGE(PG8_SB(0, 1), b2 + hstep, voffB); PG8_STAGE(PG8_SA(0, 0), a2, voffA);
            PG8_WAIT_V(8); PG8_WAIT_L(0); PG8_BAR; PG8_MMA(1, 0, At, B0); PG8_MMA(1, 1, At, B1); PG8_BAR; PG8_SCHED;
            PG8_LDB(B0, 1, 0); PG8_LDB(B1, 1, 1); PG8_SCHED; PG8_LDA(At, 1, 0); PG8_STAGE(PG8_SA(0, 1), a2 + hstep, voffA);
            PG8_WAIT_V(8); PG8_WAIT_L(0); PG8_BAR; PG8_MMA(0, 0, At, B0); PG8_MMA(0, 1, At, B1); PG8_BAR; PG8_SCHED;
            PG8_LDA(At, 1, 1); PG8_STAGE(PG8_SB(1, 0), b3, voffB); PG8_STAGE(PG8_SB(1, 1), b3 + hstep, voffB); PG8_STAGE(PG8_SA(1, 0), a3, voffA);
            PG8_WAIT_V(8); PG8_WAIT_L(0); PG8_BAR; PG8_MMA(1, 0, At, B0); PG8_MMA(1, 1, At, B1); PG8_BAR; PG8_SCHED;
            } else {
            PG8_LDB(B0, 0, 0); PG8_SCHED; PG8_LDA(At, 0, 0); PG8_STAGE(PG8_SA(1, 1), a1 + hstep, voffA);
            PG8_WAIT_L(8); PG8_BAR; PG8_WAIT_L(0); PG8_MMA(0, 0, At, B0); PG8_BAR; PG8_SCHED;
            PG8_LDB(B1, 0, 1); PG8_STAGE(PG8_SB(0, 0), b2, voffB);
            PG8_BAR; PG8_WAIT_L(0); PG8_MMA(0, 1, At, B1); PG8_BAR;
            PG8_LDA(At, 0, 1); PG8_STAGE(PG8_SA(0, 0), a2, voffA);
            PG8_BAR; PG8_WAIT_L(0); PG8_MMA(1, 0, At, B0); PG8_BAR; PG8_SCHED;
            PG8_STAGE(PG8_SB(0, 1), b2 + hstep, voffB);
            PG8_WAIT_V(6); PG8_BAR; PG8_MMA(1, 1, At, B1); PG8_BAR;
            PG8_LDB(B0, 1, 0); PG8_SCHED; PG8_LDA(At, 1, 0); PG8_STAGE(PG8_SA(0, 1), a2 + hstep, voffA);
            PG8_WAIT_L(8); PG8_BAR; PG8_WAIT_L(0); PG8_MMA(0, 0, At, B0); PG8_BAR; PG8_SCHED;
            PG8_LDB(B1, 1, 1); PG8_STAGE(PG8_SB(1, 0), b3, voffB);
            PG8_BAR; PG8_WAIT_L(0); PG8_MMA(0, 1, At, B1); PG8_BAR;
            PG8_LDA(At, 1, 1); PG8_STAGE(PG8_SA(1, 0), a3, voffA);
            PG8_BAR; PG8_WAIT_L(0); PG8_MMA(1, 0, At, B0); PG8_BAR; PG8_SCHED;
            PG8_STAGE(PG8_SB(1, 1), b3 + hstep, voffB);
            PG8_WAIT_V(6); PG8_BAR; PG8_MMA(1, 1, At, B1); PG8_BAR;
            }
        }
        if constexpr (ALIGN_EPI) { if (wr == 0) PG8_BAR; }
        if constexpr (!Epi::AFTER_DRAIN) { int z_ = 0; asm volatile("" : "+v"(z_)); const int ln_ = __builtin_amdgcn_mbcnt_hi(-1, __builtin_amdgcn_mbcnt_lo(-1, z_)); E(acc, cur, wr, wc, ln_ & 15, ln_ >> 4); S.done(cur); }
        if (!has_next) break;
#pragma unroll
        for (int a = 0; a < 2; ++a)
#pragma unroll
            for (int b = 0; b < 2; ++b)
#pragma unroll
                for (int m = 0; m < 4; ++m)
#pragma unroll
                    for (int n = 0; n < 2; ++n) acc[a][b][m][n] = (f32x4){0.f, 0.f, 0.f, 0.f};
        cur = nxt; cA = nA; cB = nB; ++ui;
        if constexpr (ALIGN_EPI) { if (wr == 1) PG8_BAR; }
    }
    PG8_WAIT_V(0);
    if constexpr (!ALIGN_EPI) { if (wr == 0) PG8_BAR; }
    PG8_BAR;
    if constexpr (Epi::AFTER_DRAIN) { E.fused(acc, cur, wr, wc, fr, fq, lds, wid, lane); S.done(cur); }
#undef PG8_SA
#undef PG8_SB
#undef PG8_STAGE
#undef PG8_LDA
#undef PG8_LDB
#undef PG8_MMA
#undef PG8_WAIT_V
#undef PG8_WAIT_L
#undef PG8_BAR
#undef PG8_SCHED
}
}
namespace mk {
typedef pg8::bf16_t bf16;
typedef pg8::f32x4 f32x4;
typedef pg8::u32x4 u32x4;
typedef pg8::bf16x8 bf16x8;
typedef pg8::Unit Unit;
typedef float f32x16 __attribute__((ext_vector_type(16)));
typedef unsigned u32x2 __attribute__((ext_vector_type(2)));
typedef float f32x2 __attribute__((ext_vector_type(2)));
#define LAS __attribute__((address_space(3)))
#define LDS_WAIT() asm volatile("s_waitcnt lgkmcnt(0)" ::: "memory")

constexpr int DM = 1024, T = 4096, NBP = 4, MP = NBP * T, DB = 128, DS = 4, MS = DB * DS, M = MP + MS, NL = 4;
constexpr int INC = 2304, DFF = 2816, K2 = 512, N2 = 1280, PLE = 256;
constexpr int C_K = 512, C_V = 640, C_RW = 768, C_XB = 1792, C_GB = 2048;

constexpr size_t SZ_WIN = (size_t)INC * DM * 2, SZ_W2 = (size_t)N2 * K2 * 2, SZ_WOUT = (size_t)DM * DM * 2, SZ_WGU = (size_t)2 * DFF * DM * 2,
                 SZ_WD = (size_t)DM * DFF * 2, SZ_WPG = (size_t)DM * DM * 2, SZ_WP = (size_t)DM * PLE * 2;
constexpr size_t O_WIN = 0, O_W2 = O_WIN + SZ_WIN, O_WOUT = O_W2 + SZ_W2, O_WGU = O_WOUT + SZ_WOUT, O_WD = O_WGU + SZ_WGU, O_WPG = O_WD + SZ_WD,
                 O_WP = O_WPG + SZ_WPG, WL = O_WP + SZ_WP;
constexpr size_t WS_W = 1u << 20  , SZ_PBL = (size_t)M * PLE * 2, WS_X16 = WS_W + 2 * WL  , WS_PB = WS_X16 + (size_t)M * DM * 2  , SZ_ACT = (size_t)M * DM * 2, WS_PP = WS_PB + 2 * SZ_PBL  , WS_HN = WS_PP + SZ_ACT,
                 WS_R1 = WS_HN + SZ_ACT, SZ_R1 = (size_t)M * INC * 2, WS_R2 = WS_R1 + SZ_R1, SZ_F256 = (size_t)M * 256 * 4, WS_R3 = WS_R2 + 7 * SZ_F256,
                 WS_END = WS_R3 + 3 * SZ_F256;
static_assert(WL % 256 == 0 && SZ_R1 >= (size_t)M * DM * 4 && 7 * SZ_F256 >= (size_t)M * DFF * 2, "ws map");

constexpr size_t OUT_Y = 0, OUT_KP = (size_t)M * DM, OUT_VP = OUT_KP + (size_t)NL * NBP * 128 * 128, OUT_SHP = OUT_VP + (size_t)NL * NBP * 128 * 128,
                 OUT_WKVP = OUT_SHP + (size_t)NL * NBP * 1024, OUT_CVP = OUT_WKVP + (size_t)NL * NBP * 4 * 4096, OUT_LRP = OUT_CVP + (size_t)NL * NBP * 768,
                 OUT_KS = OUT_LRP + (size_t)NL * NBP * 256, OUT_VS = OUT_KS + (size_t)NL * DB * 128 * 128, OUT_SHS = OUT_VS + (size_t)NL * DB * 128 * 128,
                 OUT_WKVS = OUT_SHS + (size_t)NL * DB * 1024, OUT_CVS = OUT_WKVS + (size_t)NL * DB * 4 * 4096, OUT_LRS = OUT_CVS + (size_t)NL * DB * 768,
                 OUT_END = OUT_LRS + (size_t)NL * DB * 256;

enum { I_XP = 0, I_XS, I_CK, I_CV, I_SSH, I_SWKV, I_SCV, I_SLRU, I_PP, I_PS, I_NMPRE, I_NMPOST, I_NFPRE, I_NFPOST, I_WIN, I_BIN, I_SINK, I_MU, I_W0, I_WUP,
       I_A0, I_AUP, I_GUP, I_KK, I_KA, I_RK, I_LNW, I_LNB, I_CW, I_CB, I_WA, I_BA, I_WI, I_BI, I_L, I_WOUT, I_BOUT, I_WG, I_WU, I_WDN, I_PW, I_PGW, N_IN };

__device__ __forceinline__ unsigned f2bf(float f) { unsigned u = __float_as_uint(f); return (u + 0x7fffu + ((u >> 16) & 1u)) >> 16; }
typedef float f32x2v_t __attribute__((ext_vector_type(2)));
typedef __bf16 bf16x2v_t __attribute__((ext_vector_type(2)));
__device__ __forceinline__ unsigned pk2(float lo, float hi) { const f32x2v_t v = {lo, hi}; const bf16x2v_t b = __builtin_convertvector(v, bf16x2v_t); return __builtin_bit_cast(unsigned, b); }
__device__ __forceinline__ float bflo(unsigned w) { return __uint_as_float(w << 16); }
__device__ __forceinline__ float bfhi(unsigned w) { return __uint_as_float(w & 0xffff0000u); }
__device__ __forceinline__ float bf1(bf16 b) { return __uint_as_float((unsigned)b << 16); }
__device__ __forceinline__ f32x4 ld_bf4(const bf16* p) { const u32x2 w = *(const u32x2*)p; return (f32x4){bflo(w.x), bfhi(w.x), bflo(w.y), bfhi(w.y)}; }
__device__ __forceinline__ void st_bf4(bf16* p, f32x4 v) { u32x2 w; w.x = pk2(v.x, v.y); w.y = pk2(v.z, v.w); *(u32x2*)p = w; }
__device__ __forceinline__ void ld_bf8(const bf16* p, f32x4& lo, f32x4& hi) { const u32x4 w = *(const u32x4*)p; lo = (f32x4){bflo(w.x), bfhi(w.x), bflo(w.y), bfhi(w.y)}; hi = (f32x4){bflo(w.z), bfhi(w.z), bflo(w.w), bfhi(w.w)}; }
__device__ __forceinline__ void st_bf8(bf16* p, f32x4 lo, f32x4 hi) { u32x4 w; w.x = pk2(lo.x, lo.y); w.y = pk2(lo.z, lo.w); w.z = pk2(hi.x, hi.y); w.w = pk2(hi.z, hi.w); *(u32x4*)p = w; }
__device__ __forceinline__ float sigm(float x) { return __builtin_amdgcn_rcpf(1.f + __expf(-x)); }
__device__ __forceinline__ float tanh_(float x) { return 1.f - 2.f * __builtin_amdgcn_rcpf(__expf(2.f * x) + 1.f); }
__device__ __forceinline__ float gelu_t(float x) { return 0.5f * x * (1.f + tanh_(0.7978845608f * (x + 0.044715f * x * x * x))); }
template <int CTRL> __device__ __forceinline__ float dppf(float x) { return __builtin_bit_cast(float, __builtin_amdgcn_mov_dpp(__builtin_bit_cast(int, x), CTRL, 0xf, 0xf, true)); }
__device__ __forceinline__ float red16(float x) { x += dppf<0xB1>(x); x += dppf<0x4E>(x); x += dppf<0x141>(x); x += dppf<0x128>(x); return x; }
__device__ __forceinline__ float red8(float x) { x += dppf<0xB1>(x); x += dppf<0x4E>(x); x += dppf<0x141>(x); return x; }
__device__ __forceinline__ float wave_sum(float v) {
    v = red16(v);
    v += __builtin_bit_cast(float, __builtin_amdgcn_update_dpp(0, __builtin_bit_cast(int, v), 0x142, 0xa, 0xf, false));
    v += __builtin_bit_cast(float, __builtin_amdgcn_update_dpp(0, __builtin_bit_cast(int, v), 0x143, 0xc, 0xf, false));
    return __builtin_bit_cast(float, __builtin_amdgcn_readlane(__builtin_bit_cast(int, v), 63));
}
__device__ __forceinline__ float vmul(float a, float b) { float d; asm("v_mul_f32 %0, %1, %2" : "=v"(d) : "v"(a), "v"(b)); return d; }
__device__ __forceinline__ float vfma(float a, float b, float c) { float d; asm("v_fma_f32 %0, %1, %2, %3" : "=v"(d) : "v"(a), "v"(b), "v"(c)); return d; }
__device__ __forceinline__ float vfnma(float a, float b, float c) { float d; asm("v_fma_f32 %0, -%1, %2, %3" : "=v"(d) : "v"(a), "v"(b), "v"(c)); return d; }
__device__ __forceinline__ void red16x2(float& p, float& q) {
    asm volatile("v_add_f32_dpp %0, %0, %0 quad_perm:[1,0,3,2] row_mask:0xf bank_mask:0xf bound_ctrl:1\n\t"
                 "v_add_f32_dpp %1, %1, %1 quad_perm:[1,0,3,2] row_mask:0xf bank_mask:0xf bound_ctrl:1\n\ts_nop 0\n\t"
                 "v_add_f32_dpp %0, %0, %0 quad_perm:[2,3,0,1] row_mask:0xf bank_mask:0xf bound_ctrl:1\n\t"
                 "v_add_f32_dpp %1, %1, %1 quad_perm:[2,3,0,1] row_mask:0xf bank_mask:0xf bound_ctrl:1\n\ts_nop 0\n\t"
                 "v_add_f32_dpp %0, %0, %0 row_half_mirror row_mask:0xf bank_mask:0xf bound_ctrl:1\n\t"
                 "v_add_f32_dpp %1, %1, %1 row_half_mirror row_mask:0xf bank_mask:0xf bound_ctrl:1\n\ts_nop 0\n\t"
                 "v_add_f32_dpp %0, %0, %0 row_ror:8 row_mask:0xf bank_mask:0xf bound_ctrl:1\n\t"
                 "v_add_f32_dpp %1, %1, %1 row_ror:8 row_mask:0xf bank_mask:0xf bound_ctrl:1\n\ts_nop 1"
                 : "+v"(p), "+v"(q));
}
__device__ __forceinline__ float shx(float v, int mask, int lane) { return __builtin_bit_cast(float, __builtin_amdgcn_ds_bpermute((lane ^ mask) << 2, __builtin_bit_cast(int, v))); }
__device__ __forceinline__ float dot4(f32x4 a, f32x4 b) { return (a.x * b.x + a.y * b.y) + (a.z * b.z + a.w * b.w); }

struct EpiF32 {
    static constexpr bool PERM = false, AFTER_DRAIN = false;
    float* O; int ldc; const float* bias;
    __device__ __forceinline__ void operator()(const f32x4 (&acc)[2][2][4][2], const Unit& u, int wr, int wc, int fr, int fq) const {
        asm volatile("" : "+v"(fr), "+v"(fq));
        const int row0 = u.pm * 256 + wr * 64 + fr, col0 = u.pn * 256 + wc * 32 + 4 * fq;
        f32x4 bv[2][2];
#pragma unroll
        for (int bj = 0; bj < 2; ++bj)
#pragma unroll
            for (int n = 0; n < 2; ++n) bv[bj][n] = bias ? *(const f32x4*)(bias + col0 + bj * 128 + n * 16) : (f32x4){0.f, 0.f, 0.f, 0.f};
#pragma unroll
        for (int ai = 0; ai < 2; ++ai)
#pragma unroll
            for (int m = 0; m < 4; ++m) { float* rowp = O + (size_t)(row0 + ai * 128 + m * 16) * ldc + col0;
#pragma unroll
                for (int bj = 0; bj < 2; ++bj)
#pragma unroll
                    for (int n = 0; n < 2; ++n) *(f32x4*)(rowp + bj * 128 + n * 16) = acc[ai][bj][m][n] + bv[bj][n]; }
    }
};
struct EpiPle {
    static constexpr bool PERM = true, AFTER_DRAIN = false;
    bf16* X; const bf16* PP; float* Y;
    __device__ __forceinline__ void operator()(const f32x4 (&acc)[2][2][4][2], const Unit& u, int wr, int wc, int fr, int fq) const {
        asm volatile("" : "+v"(fr), "+v"(fq));
        const int row0 = u.pm * 256 + wr * 64 + fr, col0 = u.pn * 256 + wc * 32 + 8 * fq;
#pragma unroll
        for (int ai = 0; ai < 2; ++ai)
#pragma unroll
            for (int m = 0; m < 4; ++m) { const size_t off = (size_t)(row0 + ai * 128 + m * 16) * DM + col0;
#pragma unroll
                for (int bj = 0; bj < 2; ++bj) { const size_t o = off + bj * 128; f32x4 x0, x1, p0, p1; ld_bf8(X + o, x0, x1); ld_bf8(PP + o, p0, p1); const f32x4 a0 = acc[ai][bj][m][0], a1 = acc[ai][bj][m][1];
                    const f32x4 r0 = (f32x4){x0.x + sigm(a0.x) * p0.x, x0.y + sigm(a0.y) * p0.y, x0.z + sigm(a0.z) * p0.z, x0.w + sigm(a0.w) * p0.w},
                                r1 = (f32x4){x1.x + sigm(a1.x) * p1.x, x1.y + sigm(a1.y) * p1.y, x1.z + sigm(a1.z) * p1.z, x1.w + sigm(a1.w) * p1.w};
                    if (Y) { *(f32x4*)(Y + o) = r0; *(f32x4*)(Y + o + 4) = r1; } else st_bf8(X + o, r0, r1); }
                asm volatile("" ::: "memory"); }
    }
};
struct EpiSwiglu {
    static constexpr bool PERM = true, AFTER_DRAIN = false;
    bf16* O;
    __device__ __forceinline__ void operator()(const f32x4 (&acc)[2][2][4][2], const Unit& u, int wr, int wc, int fr, int fq) const {
        asm volatile("" : "+v"(fr), "+v"(fq));
        const int row0 = u.pm * 256 + wr * 64 + fr, col0 = u.pn * 128 + wc * 32 + 8 * fq;
#pragma unroll
        for (int ai = 0; ai < 2; ++ai)
#pragma unroll
            for (int m = 0; m < 4; ++m) { bf16* p = O + (size_t)(row0 + ai * 128 + m * 16) * DFF + col0;
                const f32x4 g0 = acc[ai][0][m][0], g1 = acc[ai][0][m][1], u0 = acc[ai][1][m][0], u1 = acc[ai][1][m][1];
                u32x4 w; w.x = pk2(g0.x * sigm(g0.x) * u0.x, g0.y * sigm(g0.y) * u0.y); w.y = pk2(g0.z * sigm(g0.z) * u0.z, g0.w * sigm(g0.w) * u0.w);
                w.z = pk2(g1.x * sigm(g1.x) * u1.x, g1.y * sigm(g1.y) * u1.y); w.w = pk2(g1.z * sigm(g1.z) * u1.z, g1.w * sigm(g1.w) * u1.w);
                *(u32x4*)p = w; }
    }
};
struct G2Order {
    pg8::StaticOrder b;
    __device__ bool next(int i, Unit& u) const { if (!b.next(i, u)) return false; u.ko = u.pn < 3 ? 0 : 256; return true; }
    __device__ __forceinline__ void a_ready(const Unit&) const {}
    __device__ __forceinline__ void done(const Unit&) const {}
};
struct SplitOrder {
    int c, G, kh;
    __device__ bool next(int i, Unit& u) const { const long L = (long)i * G + c; if (L >= 16) return false; u.pm = (int)L >> 3; u.pn = ((int)L >> 1) & 3; u.ko = ((int)L & 1) * kh; return true; }
    __device__ __forceinline__ void a_ready(const Unit&) const {}
    __device__ __forceinline__ void done(const Unit&) const {}
};
struct EpiPart {
    static constexpr bool PERM = false, AFTER_DRAIN = false;
    float* P;
    __device__ __forceinline__ void operator()(const f32x4 (&acc)[2][2][4][2], const Unit& u, int wr, int wc, int fr, int fq) const {
        asm volatile("" : "+v"(fr), "+v"(fq));
        const int row0 = u.pm * 256 + wr * 64 + fr, col0 = u.pn * 256 + wc * 32 + 4 * fq; float* O = P + (u.ko ? (size_t)MS * DM : 0);
#pragma unroll
        for (int ai = 0; ai < 2; ++ai)
#pragma unroll
            for (int m = 0; m < 4; ++m) { float* rowp = O + (size_t)(row0 + ai * 128 + m * 16) * DM + col0;
#pragma unroll
                for (int bj = 0; bj < 2; ++bj)
#pragma unroll
                    for (int n = 0; n < 2; ++n) *(f32x4*)(rowp + bj * 128 + n * 16) = acc[ai][bj][m][n]; }
    }
};
struct EpiMix {
    static constexpr bool PERM = true, AFTER_DRAIN = false;
    const float *w0, *a0, *k_a, *b_a, *b_i, *Lp; float* Wd; bf16 *Ks, *KK, *BV, *G; float *AL, *U; const bf16* A2;
    __device__ __forceinline__ void operator()(const f32x4 (&acc)[2][2][4][2], const Unit& u, int wr, int wc, int fr, int fq) const {
        asm volatile("" : "+v"(fr), "+v"(fq));
        const int row0 = u.pm * 256 + wr * 64 + fr;
        if (u.pn < 3) {
#pragma unroll
            for (int ai = 0; ai < 2; ++ai)
#pragma unroll
                for (int m = 0; m < 4; ++m) { const size_t ro = (size_t)(row0 + ai * 128 + m * 16) * 256;
#pragma unroll
                    for (int bj = 0; bj < 2; ++bj) { const int c = bj * 128 + wc * 32 + 8 * fq; const f32x4 z0 = acc[ai][bj][m][0], z1 = acc[ai][bj][m][1];
                        if (u.pn == 0) { const f32x4 b0 = *(const f32x4*)(w0 + c), b1 = *(const f32x4*)(w0 + c + 4); f32x4 d0, d1;
                            d0.x = __expf(-0.60653066f * sigm(z0.x + b0.x)); d0.y = __expf(-0.60653066f * sigm(z0.y + b0.y)); d0.z = __expf(-0.60653066f * sigm(z0.z + b0.z)); d0.w = __expf(-0.60653066f * sigm(z0.w + b0.w));
                            d1.x = __expf(-0.60653066f * sigm(z1.x + b1.x)); d1.y = __expf(-0.60653066f * sigm(z1.y + b1.y)); d1.z = __expf(-0.60653066f * sigm(z1.z + b1.z)); d1.w = __expf(-0.60653066f * sigm(z1.w + b1.w));
                            *(f32x4*)(Wd + ro + c) = d0; *(f32x4*)(Wd + ro + c + 4) = d1; }
                        else if (u.pn == 1) { const f32x4 b0 = *(const f32x4*)(a0 + c), b1 = *(const f32x4*)(a0 + c + 4), ka0 = *(const f32x4*)(k_a + c), ka1 = *(const f32x4*)(k_a + c + 4);
                            f32x4 ks0, ks1, kk0, kk1; ld_bf8(Ks + ro + c, ks0, ks1); ld_bf8(KK + ro + c, kk0, kk1);
                            f32x4 av0, av1; av0.x = sigm(z0.x + b0.x); av0.y = sigm(z0.y + b0.y); av0.z = sigm(z0.z + b0.z); av0.w = sigm(z0.w + b0.w);
                            av1.x = sigm(z1.x + b1.x); av1.y = sigm(z1.y + b1.y); av1.z = sigm(z1.z + b1.z); av1.w = sigm(z1.w + b1.w);
                            st_bf8(Ks + ro + c, ks0 * (1.f + (av0 - 1.f) * ka0), ks1 * (1.f + (av1 - 1.f) * ka1)); st_bf8(BV + ro + c, kk0 * av0, kk1 * av1); }
                        else { st_bf8(G + ro + c, z0, z1); }
                        asm volatile("" ::: "memory"); } }
        } else {
            const int t = u.pn - 3;
#pragma unroll
            for (int ai = 0; ai < 2; ++ai)
#pragma unroll
                for (int m = 0; m < 4; ++m) { const size_t r = (size_t)(row0 + ai * 128 + m * 16); const int cc0 = 128 * t + wc * 32 + 8 * fq;
                    f32x4 xc0, xc1; ld_bf8(A2 + r * K2 + 256 + cc0, xc0, xc1);
#pragma unroll
                    for (int n = 0; n < 2; ++n) { const int cc = cc0 + 4 * n;
                        const f32x4 zr = acc[ai][0][m][n] + *(const f32x4*)(b_a + cc), zi = acc[ai][1][m][n] + *(const f32x4*)(b_i + cc), Lv = *(const f32x4*)(Lp + cc), xc = n ? xc1 : xc0;
                        f32x4 al, uu;
#define LRU1(e) { const float xe = __expf(-Lv.e); const float ls = -xe * (1.f + xe * (-0.5f + xe * 0.33333334f)); const float la = 8.f * sigm(zr.e) * ls; al.e = __expf(la); const float z2 = 2.f * la; \
    const float om = -z2 * (1.f + z2 * (0.5f + z2 * (0.16666667f + z2 * (0.041666668f + z2 * 0.0083333338f)))); uu.e = __builtin_amdgcn_sqrtf(om) * sigm(zi.e) * xc.e; }
                        LRU1(x) LRU1(y) LRU1(z) LRU1(w)
#undef LRU1
                        *(f32x4*)(AL + r * 256 + cc) = al; *(f32x4*)(U + r * 256 + cc) = uu; asm volatile("" ::: "memory"); } }
        }
    }
};

#define RLX_AGENT __ATOMIC_RELAXED, __HIP_MEMORY_SCOPE_AGENT
#define XB_TMO      128
#define XB_XCNT(j)  (256  + 64 * (j))
#define XB_XSUB(j)  (1280 + 64 * (j))
#define XB_XGEN(j)  (2304 + 64 * (j))
#define XB_TOP      3328
#define XB_TOPGEN   3392
#define XCD_BAR_WORDS 3456
#define XB_SPIN_CAP (1u << 18)

__device__ __forceinline__ unsigned xb_ld(unsigned* p)              { return __hip_atomic_load(p, __ATOMIC_RELAXED, __HIP_MEMORY_SCOPE_AGENT); }
__device__ __forceinline__ unsigned xb_add(unsigned* p, unsigned v) { return __hip_atomic_fetch_add(p, v, __ATOMIC_RELAXED, __HIP_MEMORY_SCOPE_AGENT); }
__device__ __forceinline__ unsigned xb_xcc_id() { return (unsigned)__builtin_amdgcn_s_getreg((3 << 11) | 20) & 0xFu; }
#define XB_SPIN(cond, bar) do { unsigned _sp = 0; while (cond) { __builtin_amdgcn_s_sleep(1); \
    if ((++_sp & 255u) == 0u) { if (xb_ld(&(bar)[XB_TMO])) break; if (_sp > XB_SPIN_CAP) { atomicAdd(&(bar)[XB_TMO], 1u); break; } } } } while (0)

struct XcdBarrier {
    unsigned* bar; unsigned x;
    volatile LAS unsigned* st;
};

__device__ __forceinline__ XcdBarrier xcd_barrier_post(unsigned* bar, volatile LAS unsigned* st, int tid) {
    XcdBarrier b; b.bar = bar; b.x = xb_xcc_id(); b.st = st;
    if (tid == 0) (void)xb_add(&bar[XB_XCNT(b.x)], 1u);
    return b;
}
__device__ __forceinline__ void xcd_barrier_complete(unsigned* bar, unsigned x, unsigned& nloc, unsigned& nx) {
    const unsigned G = gridDim.x * gridDim.y * gridDim.z;
    unsigned sum, cnt, mine, sp = 0u;
    for (;;) {
        sum = 0u; cnt = 0u; mine = 0u;
#pragma unroll
        for (unsigned j = 0; j < 16; ++j) { const unsigned c = xb_ld(&bar[XB_XCNT(j)]); sum += c; cnt += (c > 0u) ? 1u : 0u; mine = (j == x) ? c : mine; }
        if (sum == G) break;
        __builtin_amdgcn_s_sleep(1);
        if ((++sp & 255u) == 0u) { if (xb_ld(&bar[XB_TMO])) break; if (sp > XB_SPIN_CAP) { atomicAdd(&bar[XB_TMO], 1u); break; } }
    }
    nloc = mine > 0u ? mine : 1u; nx = cnt > 0u ? cnt : 1u;
}

__device__ __forceinline__ void xcd_barrier(const XcdBarrier& b, int tid) {
    asm volatile("s_waitcnt vmcnt(0)" ::: "memory");
    __syncthreads();
    if (tid == 0) {
        unsigned* bar = b.bar;
        __builtin_amdgcn_s_waitcnt(0);
        unsigned nloc = b.st[0], nx = b.st[1];
        if (nloc == 0u) { xcd_barrier_complete(bar, b.x, nloc, nx); b.st[0] = nloc; b.st[1] = nx; }
        const unsigned old = xb_add(&bar[XB_XSUB(b.x)], 1u);
        const unsigned gen = old / nloc;
        if (old + 1u == (gen + 1u) * nloc) {
            __builtin_amdgcn_fence(__ATOMIC_RELEASE, "agent");
            asm volatile("s_waitcnt vmcnt(0)" ::: "memory");
            const unsigned og = xb_add(&bar[XB_TOP], 1u);
            const unsigned tg = og / nx;
            if (og + 1u == (tg + 1u) * nx) xb_add(&bar[XB_TOPGEN], 1u);
            else XB_SPIN(xb_ld(&bar[XB_TOPGEN]) == tg, bar);
            __builtin_amdgcn_fence(__ATOMIC_ACQUIRE, "agent");
            xb_add(&bar[XB_XGEN(b.x)], 1u);
            asm volatile("s_waitcnt vmcnt(0)" ::: "memory");
        } else {
            XB_SPIN(xb_ld(&bar[XB_XGEN(b.x)]) == gen, bar);
            __builtin_amdgcn_fence(__ATOMIC_ACQUIRE, "agent");
            asm volatile("s_waitcnt vmcnt(0)" ::: "memory");
        }
    }
    __syncthreads();
}
struct Args { const float* in[N_IN]; float* out; unsigned char* ws; };
struct Ctx {
    LAS unsigned char* lds; unsigned char* ws; float* out;
    int tid, lane, wave, bid, G, gw, NGW;
};
__device__ __forceinline__ const float* inp_ld(int k) {
    asm volatile("" : "+s"(k));
    const __attribute__((address_space(4))) unsigned long long* tab = (const __attribute__((address_space(4))) unsigned long long*)__builtin_amdgcn_kernarg_segment_ptr();
    return (const float*)tab[k];
}
#define INP(k) inp_ld(k)
__device__ __forceinline__ int opq(int v) { asm volatile("" : "+v"(v)); return v; }

__device__ __forceinline__ void tr_item(const float* W, int ldw, bf16* WT, int ldt, int k0, int n0, int drow, int dcol, LAS float* scr, int lane) {
#pragma unroll 8
    for (int i = 0; i < 32; ++i) { const int kk = 2 * i + (lane >> 5); scr[kk * 33 + (lane & 31)] = W[(size_t)(k0 + kk) * ldw + n0 + (lane & 31)]; }
    LDS_WAIT(); asm volatile("" ::: "memory");
    const int c = lane & 7;
#pragma unroll
    for (int j = 0; j < 4; ++j) { const int n = (lane >> 3) + 8 * j; const LAS float* s = scr + (8 * c) * 33 + n;
        u32x4 o; o.x = pk2(s[0 * 33], s[1 * 33]); o.y = pk2(s[2 * 33], s[3 * 33]); o.z = pk2(s[4 * 33], s[5 * 33]); o.w = pk2(s[6 * 33], s[7 * 33]);
        *(u32x4*)(WT + (size_t)(drow + n) * ldt + dcol + 8 * c) = o; }
    LDS_WAIT(); asm volatile("" ::: "memory");
}
__device__ __forceinline__ void row_norm_in(const float* xrow, const float* g, bf16* orow, bf16* xcopy, int lane) {
    f32x4 v[4]; float ss = 0.f;
#pragma unroll
    for (int j = 0; j < 2; ++j) { v[2 * j] = *(const f32x4*)(xrow + 8 * lane + 512 * j); v[2 * j + 1] = *(const f32x4*)(xrow + 8 * lane + 512 * j + 4); ss += dot4(v[2 * j], v[2 * j]) + dot4(v[2 * j + 1], v[2 * j + 1]); }
    const float rs = rsqrtf(wave_sum(ss) * (1.f / DM) + 1e-6f);
#pragma unroll
    for (int j = 0; j < 2; ++j) { const float* gp = g + 8 * lane + 512 * j; if (xcopy) st_bf8(xcopy + 8 * lane + 512 * j, v[2 * j], v[2 * j + 1]);
        st_bf8(orow + 8 * lane + 512 * j, v[2 * j] * rs * *(const f32x4*)gp, v[2 * j + 1] * rs * *(const f32x4*)(gp + 4)); }
}
__device__ __forceinline__ void row_norm(const bf16* xrow, const float* g, bf16* orow, int lane) {
    f32x4 v[4]; float ss = 0.f;
#pragma unroll
    for (int j = 0; j < 2; ++j) { ld_bf8(xrow + 8 * lane + 512 * j, v[2 * j], v[2 * j + 1]); ss += dot4(v[2 * j], v[2 * j]) + dot4(v[2 * j + 1], v[2 * j + 1]); }
    const float rs = rsqrtf(wave_sum(ss) * (1.f / DM) + 1e-6f);
#pragma unroll
    for (int j = 0; j < 2; ++j) { const float* gp = g + 8 * lane + 512 * j; st_bf8(orow + 8 * lane + 512 * j, v[2 * j] * rs * *(const f32x4*)gp, v[2 * j + 1] * rs * *(const f32x4*)(gp + 4)); }
}
__device__ __forceinline__ void row_update_parts(const float* p0, const float* p1, const float* bias, const float* gA, bf16* X, const float* gB, bf16* outB, int lane) {
    f32x4 a[4], x[4]; float ss = 0.f;
#pragma unroll
    for (int j = 0; j < 2; ++j) { const int c = 8 * lane + 512 * j;
        a[2 * j] = *(const f32x4*)(p0 + c) + *(const f32x4*)(p1 + c); a[2 * j + 1] = *(const f32x4*)(p0 + c + 4) + *(const f32x4*)(p1 + c + 4);
        if (bias) { a[2 * j] = a[2 * j] + *(const f32x4*)(bias + c); a[2 * j + 1] = a[2 * j + 1] + *(const f32x4*)(bias + c + 4); }
        ld_bf8(X + c, x[2 * j], x[2 * j + 1]); ss += dot4(a[2 * j], a[2 * j]) + dot4(a[2 * j + 1], a[2 * j + 1]); }
    const float rs = rsqrtf(wave_sum(ss) * (1.f / DM) + 1e-6f); float s2 = 0.f;
#pragma unroll
    for (int j = 0; j < 2; ++j) { const int c = 8 * lane + 512 * j; x[2 * j] = x[2 * j] + a[2 * j] * rs * *(const f32x4*)(gA + c); x[2 * j + 1] = x[2 * j + 1] + a[2 * j + 1] * rs * *(const f32x4*)(gA + c + 4);
        st_bf8(X + c, x[2 * j], x[2 * j + 1]); s2 += dot4(x[2 * j], x[2 * j]) + dot4(x[2 * j + 1], x[2 * j + 1]); }
    float r2 = 1.f;
    if (gB) r2 = rsqrtf(wave_sum(s2) * (1.f / DM) + 1e-6f);
#pragma unroll
    for (int j = 0; j < 2; ++j) { const int c = 8 * lane + 512 * j; f32x4 o0 = x[2 * j], o1 = x[2 * j + 1]; if (gB) { o0 = o0 * r2 * *(const f32x4*)(gB + c); o1 = o1 * r2 * *(const f32x4*)(gB + c + 4); } st_bf8(outB + c, o0, o1); }
}
__device__ __forceinline__ void row_update(const bf16* add, const float* gA, bf16* X, const float* gB, bf16* outB, int lane) {
    f32x4 a[4], x[4]; float ss = 0.f;
#pragma unroll
    for (int j = 0; j < 2; ++j) { ld_bf8(add + 8 * lane + 512 * j, a[2 * j], a[2 * j + 1]); ld_bf8(X + 8 * lane + 512 * j, x[2 * j], x[2 * j + 1]); ss += dot4(a[2 * j], a[2 * j]) + dot4(a[2 * j + 1], a[2 * j + 1]); }
    const float rs = rsqrtf(wave_sum(ss) * (1.f / DM) + 1e-6f); float s2 = 0.f;
#pragma unroll
    for (int j = 0; j < 2; ++j) { const float* gp = gA + 8 * lane + 512 * j; x[2 * j] = x[2 * j] + a[2 * j] * rs * *(const f32x4*)gp; x[2 * j + 1] = x[2 * j + 1] + a[2 * j + 1] * rs * *(const f32x4*)(gp + 4);
        st_bf8(X + 8 * lane + 512 * j, x[2 * j], x[2 * j + 1]); s2 += dot4(x[2 * j], x[2 * j]) + dot4(x[2 * j + 1], x[2 * j + 1]); }
    float r2 = 1.f;
    if (gB) r2 = rsqrtf(wave_sum(s2) * (1.f / DM) + 1e-6f);
#pragma unroll
    for (int j = 0; j < 2; ++j) { f32x4 o0 = x[2 * j], o1 = x[2 * j + 1]; if (gB) { const float* gp = gB + 8 * lane + 512 * j; o0 = o0 * r2 * *(const f32x4*)gp; o1 = o1 * r2 * *(const f32x4*)(gp + 4); } st_bf8(outB + 8 * lane + 512 * j, o0, o1); }
}

__device__ __forceinline__ void convert_layer(const Ctx& C, const Args& A, int l, int gw0, int ngw, int gt, int NT) {
    LAS float* scr = (LAS float*)(C.lds + C.wave * 16384);
    constexpr int J0 = 16 * 72, J1 = 16 * 32, J2 = 16 * 88, J4 = 44 * 32, J5 = 16 * 32, J6 = 4 * 32, JL = J0 + J1 + 2 * J2 + J4 + J5 + J6;
    unsigned char* wl = C.ws + WS_W + (size_t)(l & 1) * WL;
    for (int it = gw0; it < JL; it += ngw) {
        int r = it;
        const float* W; int ldw, ldt, kb, nb, drow; bf16* WT;
        if (r < J0) { W = INP(I_WIN) + (size_t)l * DM * INC; ldw = INC; WT = (bf16*)(wl + O_WIN); ldt = DM; kb = r / 72; nb = r % 72; drow = 32 * nb; }
        else if ((r -= J0) < J1) { W = INP(I_WOUT) + (size_t)l * DM * DM; ldw = DM; WT = (bf16*)(wl + O_WOUT); ldt = DM; kb = r / 32; nb = r % 32; drow = 32 * nb; }
        else if ((r -= J1) < J2) { W = INP(I_WG) + (size_t)l * DM * DFF; ldw = DFF; WT = (bf16*)(wl + O_WGU); ldt = DM; kb = r / 88; nb = r % 88; drow = (nb >> 2) * 256 + (nb & 3) * 32; }
        else if ((r -= J2) < J2) { W = INP(I_WU) + (size_t)l * DM * DFF; ldw = DFF; WT = (bf16*)(wl + O_WGU); ldt = DM; kb = r / 88; nb = r % 88; drow = (nb >> 2) * 256 + 128 + (nb & 3) * 32; }
        else if ((r -= J2) < J4) { W = INP(I_WDN) + (size_t)l * DFF * DM; ldw = DM; WT = (bf16*)(wl + O_WD); ldt = DFF; kb = r / 32; nb = r % 32; drow = 32 * nb; }
        else if ((r -= J4) < J5) { W = INP(I_PGW) + (size_t)l * DM * DM; ldw = DM; WT = (bf16*)(wl + O_WPG); ldt = DM; kb = r / 32; nb = r % 32; drow = 32 * nb; }
        else { r -= J5; W = INP(I_PW) + (size_t)l * PLE * DM; ldw = DM; WT = (bf16*)(wl + O_WP); ldt = PLE; kb = r / 32; nb = r % 32; drow = 32 * nb; }
        tr_item(W, ldw, WT, ldt, 64 * kb, 32 * nb, drow, 64 * kb, scr, C.lane);
    }
#pragma unroll 1
    for (int r = gt; r < N2 * K2; r = opq(r + NT)) {
        const int n = r / K2, k = r % K2; float v = 0.f;
        if (n < 256) { if (k < 64) v = INP(I_WUP)[((size_t)l * 64 + k) * 256 + n]; }
        else if (n < 512) { if (k >= 64 && k < 128) v = INP(I_AUP)[((size_t)l * 64 + (k - 64)) * 256 + (n - 256)]; }
        else if (n < 768) { if (k >= 128 && k < 256) v = INP(I_GUP)[((size_t)l * 128 + (k - 128)) * 256 + (n - 512)]; }
        else { const int tt = (n - 768) >> 8, rr = (n - 768) & 255, cc = 128 * tt + (rr & 127), h = cc >> 6, j = cc & 63;
            if (k >= 256 && ((k - 256) >> 6) == h) v = ((rr >> 7) ? INP(I_WI) : INP(I_WA))[(((size_t)l * 4 + h) * 64 + ((k - 256) & 63)) * 64 + j]; }
        ((bf16*)(wl + O_W2))[r] = (bf16)f2bf(v);
    }
#pragma unroll 1
    for (int r = gt; r < M * (PLE / 4); r = opq(r + NT)) {
        const int m = r >> 6, c4 = (r & 63) * 4;
        const float* src = m < MP ? INP(I_PP) + ((size_t)l * MP + m) * PLE + c4 : INP(I_PS) + ((size_t)l * MS + (m - MP)) * PLE + c4;
        st_bf4((bf16*)(C.ws + WS_PB + (size_t)(l & 1) * SZ_PBL) + (size_t)m * PLE + c4, *(const f32x4*)src);
    }
}
__device__ __forceinline__ void p0_prologue(const Ctx& C, const Args& A) {
    convert_layer(C, A, 0, C.gw, C.NGW, C.bid * 512 + C.tid, C.G * 512);
    for (int m = C.gw; m < M; m += C.NGW) {
        const float* src = m < MP ? INP(I_XP) + (size_t)m * DM : INP(I_XS) + (size_t)(m - MP) * DM;
        row_norm_in(src, INP(I_NMPRE), (bf16*)(C.ws + WS_HN) + (size_t)m * DM, (bf16*)(C.ws + WS_X16) + (size_t)m * DM, C.lane);
    }
}

__device__ __forceinline__ void e1_prep(const Ctx& C, const Args& A, int l) {
    const bf16* PROJ = (const bf16*)(C.ws + WS_R1);
    bf16* R = (bf16*)(C.ws + WS_R2); bf16* Ks = (bf16*)(C.ws + WS_R2 + SZ_F256); bf16* V = (bf16*)(C.ws + WS_R2 + 2 * SZ_F256); bf16* KK = (bf16*)(C.ws + WS_R2 + 3 * SZ_F256);
    bf16* A2 = (bf16*)(C.ws + WS_R3);
    const int lane = C.lane, c4 = 4 * lane;
    for (int m = C.gw; m < M; m += C.NGW) {
        const bool samp = m >= MP; int b, t;
        if (!samp) { b = m >> 12; t = m & 4095; } else { b = (m - MP) >> 2; t = (m - MP) & 3; }
        const bf16* pr = PROJ + (size_t)m * INC;
        { const int half = lane >> 5, l32 = lane & 31, c8 = 8 * l32;
#pragma unroll
          for (int p = 0; p < 2; ++p) {
            const int cg = p == 0 ? 2 * half : 1 + 2 * half, col = 256 * cg + c8;
            f32x4 cur0, cur1, prv0 = (f32x4){0.f, 0.f, 0.f, 0.f}, prv1 = prv0; ld_bf8(pr + C_RW + col, cur0, cur1);
            if (t > 0) ld_bf8(pr - INC + C_RW + col, prv0, prv1);
            else if (samp) { const float* sp = INP(I_SSH) + ((size_t)l * DB + b) * 1024 + col; prv0 = *(const f32x4*)sp; prv1 = *(const f32x4*)(sp + 4); }
            const float* mp_ = INP(I_MU) + l * 1024 + col;
            const f32x4 xs0 = cur0 + (prv0 - cur0) * *(const f32x4*)mp_, xs1 = cur1 + (prv1 - cur1) * *(const f32x4*)(mp_ + 4);
            if (p == 0) st_bf8((half ? V : R) + (size_t)m * 256 + c8, xs0, xs1);
            else if (half == 0) { st_bf8(Ks + (size_t)m * 256 + c8, xs0, xs1); const float* kp = INP(I_KK) + l * 256 + c8; f32x4 kk0 = xs0 * *(const f32x4*)kp, kk1 = xs1 * *(const f32x4*)(kp + 4);
                const float sc = rsqrtf(fmaxf(red8(dot4(kk0, kk0) + dot4(kk1, kk1)), 1e-24f)); st_bf8(KK + (size_t)m * 256 + c8, kk0 * sc, kk1 * sc); }
            else { f32x4 o0, o1;
                if (l32 < 8) { o0 = (f32x4){tanh_(xs0.x), tanh_(xs0.y), tanh_(xs0.z), tanh_(xs0.w)}; o1 = (f32x4){tanh_(xs1.x), tanh_(xs1.y), tanh_(xs1.z), tanh_(xs1.w)}; }
                else if (l32 < 16) { o0 = xs0; o1 = xs1; }
                else { o0 = (f32x4){sigm(xs0.x), sigm(xs0.y), sigm(xs0.z), sigm(xs0.w)}; o1 = (f32x4){sigm(xs1.x), sigm(xs1.y), sigm(xs1.z), sigm(xs1.w)}; }
                st_bf8(A2 + (size_t)m * K2 + c8, o0, o1); }
          } }
        f32x4 xc = *(const f32x4*)(INP(I_CB) + l * 256 + c4);
#pragma unroll
        for (int j = 0; j < 4; ++j) { const int tt = t - 3 + j; f32x4 val = (f32x4){0.f, 0.f, 0.f, 0.f};
            if (tt >= 0) val = ld_bf4(pr + (ptrdiff_t)(j - 3) * INC + C_XB + c4);
            else if (samp) val = *(const f32x4*)(INP(I_SCV) + (((size_t)l * DB + b) * 3 + (tt + 3)) * 256 + c4);
            xc = xc + val * *(const f32x4*)(INP(I_CW) + ((size_t)l * 4 + j) * 256 + c4); }
        st_bf4(A2 + (size_t)m * K2 + 256 + c4, xc);
    }
    const int gt = C.bid * 512 + C.tid, NT = C.G * 512;
    float* out = C.out;
#pragma unroll 1
    for (int e = gt; e < 2 * NBP * 128 * 128; e = opq(e + NT)) {
        const int kv = e / (NBP * 16384), r = e % (NBP * 16384), b = r >> 14, rr = (r >> 7) & 127, c = r & 127;
        out[(kv ? OUT_VP : OUT_KP) + (size_t)l * NBP * 16384 + r] = bf1(PROJ[(size_t)(b * T + T - 128 + rr) * INC + (kv ? C_V : C_K) + c]);
    }
#pragma unroll 1
    for (int e = gt; e < NBP * 1024; e = opq(e + NT)) { const int b = e >> 10, c = e & 1023; out[OUT_SHP + (size_t)l * NBP * 1024 + e] = bf1(PROJ[(size_t)(b * T + T - 1) * INC + C_RW + c]); }
#pragma unroll 1
    for (int e = gt; e < DB * 1024; e = opq(e + NT)) { const int b = e >> 10, c = e & 1023; out[OUT_SHS + (size_t)l * DB * 1024 + e] = bf1(PROJ[(size_t)(MP + 4 * b + 3) * INC + C_RW + c]); }
#pragma unroll 1
    for (int e = gt; e < NBP * 768; e = opq(e + NT)) { const int b = e / 768, j = (e % 768) >> 8, c = e & 255; out[OUT_CVP + (size_t)l * NBP * 768 + e] = bf1(PROJ[(size_t)(b * T + T - 3 + j) * INC + C_XB + c]); }
#pragma unroll 1
    for (int e = gt; e < DB * 768; e = opq(e + NT)) { const int b = e / 768, j = (e % 768) >> 8, c = e & 255; out[OUT_CVS + (size_t)l * DB * 768 + e] = bf1(PROJ[(size_t)(MP + 4 * b + 1 + j) * INC + C_XB + c]); }
}

struct RwkvPtrs { const bf16 *R, *K, *V, *KK, *BV; const float* W; float* YR; };
__device__ __forceinline__ void rwkv_step(f32x4& s, const f32x4 w, const f32x4 kk, const f32x4 bv, const f32x4 k2, const f32x4 r, const float v, float& y) {
    const float sa = red16(dot4(s, kk));
    s = s * w + (k2 * v - bv * sa);
    y = red16(dot4(s, r));
}
__device__ __forceinline__ void rwkv_prompt(const Ctx& C, const RwkvPtrs& P, int wg, float* wkv_out  ) {
    constexpr int TC = 32, VEC = TC * 64 * 4, O_V = 5 * VEC, BUF = O_V + TC * 16 * 4, O_Q = 2 * BUF;
    static_assert(O_Q + TC * 1024 <= 131072, "LDS");
    const int chain = wg >> 2, b = chain >> 2, h = chain & 3, qr = wg & 3, tid = C.tid, lane = C.lane, wave = C.wave;
    const size_t m0 = (size_t)b * T;
    const int ltid = tid - 256, lstep = ltid >> 4, lq = tid & 15;
    const int vstep = ltid >> 2, vq = ltid & 3;
    f32x4 st[2][5], stv;
    f32x4 s = (f32x4){0.f, 0.f, 0.f, 0.f};
    const int row = 16 * qr + 4 * wave + (lane >> 4), cq = lane & 15;
#define RW_LOAD(c) do { if (wave >= 4) { _Pragma("unroll") for (int u = 0; u < 2; ++u) { const size_t o_ = (m0 + (size_t)(c) * TC + lstep + 16 * u) * 256 + h * 64 + 4 * lq; \
        st[u][0] = *(const f32x4*)(P.W + o_); st[u][1] = ld_bf4(P.KK + o_); st[u][2] = ld_bf4(P.BV + o_); st[u][3] = ld_bf4(P.K + o_); st[u][4] = ld_bf4(P.R + o_); } \
        if (ltid < 128) stv = ld_bf4(P.V + (m0 + (size_t)(c) * TC + vstep) * 256 + h * 64 + 16 * qr + 4 * vq); } } while (0)
#define RW_STORE(bufi) do { if (wave >= 4) { LAS unsigned char* bb = C.lds + (bufi) * BUF; _Pragma("unroll") for (int u = 0; u < 2; ++u) { const int ls = lstep + 16 * u; \
        _Pragma("unroll") for (int i = 0; i < 5; ++i) *(LAS f32x4*)(bb + i * VEC + (ls * 64 + 4 * lq) * 4) = st[u][i]; } \
        if (ltid < 128) *(LAS f32x4*)(bb + O_V + (vstep * 16 + 4 * vq) * 4) = stv; } } while (0)
#define RW_FLUSH(cc, half) do { if (wave >= 4) { const int stp = lstep + 16 * (half); const LAS f32x4* qp = (const LAS f32x4*)(C.lds + O_Q + stp * 1024 + (lq >> 2) * 256 + (lq & 3) * 64); \
        const f32x4 a0 = qp[0], a1_ = qp[1], a2_ = qp[2], a3 = qp[3]; const f32x4 t_ = (a0 + a1_) + (a2_ + a3); \
        P.YR[(m0 + (size_t)(cc) * TC + stp) * 256 + h * 64 + 16 * qr + lq] = (t_.x + t_.y) + (t_.z + t_.w); } } while (0)
    RW_LOAD(0); RW_STORE(0); __syncthreads();
    for (int c = 0; c < T / TC; ++c) {
        if (c > 0) RW_FLUSH(c - 1, 1);
        if (c + 1 < T / TC) RW_LOAD(c + 1);
        if (wave < 4) {
            const LAS unsigned char* bb = C.lds + (c & 1) * BUF;
            const int vo = O_V + (4 * wave + (lane >> 4)) * 4, lo = 16 * cq;
            LAS float* ring = (LAS float*)(C.lds + O_Q) + wave * 64 + lane;
            f32x4 w = *(const LAS f32x4*)(bb + 0 * VEC + lo), kk = *(const LAS f32x4*)(bb + 1 * VEC + lo), bv = *(const LAS f32x4*)(bb + 2 * VEC + lo),
                  k2 = *(const LAS f32x4*)(bb + 3 * VEC + lo), r = *(const LAS f32x4*)(bb + 4 * VEC + lo), rp = r;
            float v = *(const LAS float*)(bb + vo), qpend = 0.f;
            const unsigned b1 = (unsigned)(unsigned long long)(bb + lo), b2 = (unsigned)(unsigned long long)(bb + vo), qa = (unsigned)(unsigned long long)ring;
            f32x4 nw, nkk, nbv, nk2, nr; float nv;
#define RW_A_DOT "v_mul_f32 %6, %10, %14\n\tv_fma_f32 %6, %11, %15, %6\n\tv_fma_f32 %6, %12, %16, %6\n\tv_fma_f32 %6, %13, %17, %6"
#define RW_A_RD "ds_read_b128 %0, %7 offset:%c19\n\tds_read_b128 %1, %7 offset:%c20\n\tds_read_b128 %2, %7 offset:%c21\n\tds_read_b128 %3, %7 offset:%c22\n\tds_read_b128 %4, %7 offset:%c23\n\tds_read_b32 %5, %8 offset:%c24\n\t"
#define RW_A_OPS(IN, WO) : "=&v"(nw), "=&v"(nkk), "=&v"(nbv), "=&v"(nk2), "=&v"(nr), "=&v"(nv), "=&v"(sa) \
                 : "v"(b1), "v"(b2), "v"(qa), "v"(s.x), "v"(s.y), "v"(s.z), "v"(s.w), "v"(kk.x), "v"(kk.y), "v"(kk.z), "v"(kk.w), "v"(qpend), \
                   "n"(0 * VEC + (IN) * 256), "n"(1 * VEC + (IN) * 256), "n"(2 * VEC + (IN) * 256), "n"(3 * VEC + (IN) * 256), "n"(4 * VEC + (IN) * 256), "n"((IN) * 64), "n"(WO) : "memory"
#define RW_STEP(I, IN) { float sa, q, t0, t1, t2, t3; \
                if ((I) < 2 || (I) == 16 || (I) == 17) asm volatile(RW_A_RD "s_waitcnt lgkmcnt(6)\n\t" RW_A_DOT RW_A_OPS(IN, 0)); \
                else asm volatile("ds_write_b32 %9, %18 offset:%c25\n\t" RW_A_RD "s_waitcnt lgkmcnt(7)\n\t" RW_A_DOT RW_A_OPS(IN, ((I) >= 2 ? (I) - 2 : 0) * 1024)); \
                asm volatile("v_mul_f32 %2, %6, %10\n\tv_mul_f32 %3, %7, %10\n\t" \
                             "v_add_f32_dpp %0, %0, %0 quad_perm:[1,0,3,2] row_mask:0xf bank_mask:0xf bound_ctrl:1\n\t" \
                             "v_mul_f32 %1, %11, %15\n\tv_fma_f32 %1, %12, %16, %1\n\t" \
                             "v_add_f32_dpp %0, %0, %0 quad_perm:[2,3,0,1] row_mask:0xf bank_mask:0xf bound_ctrl:1\n\t" \
                             "v_fma_f32 %1, %13, %17, %1\n\tv_fma_f32 %1, %14, %18, %1\n\t" \
                             "v_add_f32_dpp %0, %0, %0 row_half_mirror row_mask:0xf bank_mask:0xf bound_ctrl:1\n\t" \
                             "v_mul_f32 %4, %8, %10\n\tv_mul_f32 %5, %9, %10\n\t" \
                             "v_add_f32_dpp %0, %0, %0 row_ror:8 row_mask:0xf bank_mask:0xf bound_ctrl:1" \
                             : "+v"(sa), "=&v"(q), "=&v"(t0), "=&v"(t1), "=&v"(t2), "=&v"(t3) \
                             : "v"(k2.x), "v"(k2.y), "v"(k2.z), "v"(k2.w), "v"(v), "v"(s.x), "v"(s.y), "v"(s.z), "v"(s.w), "v"(rp.x), "v"(rp.y), "v"(rp.z), "v"(rp.w)); \
                asm volatile("v_fma_f32 %4, -%8, %9, %4\n\tv_fma_f32 %5, -%8, %10, %5\n\tv_fma_f32 %6, -%8, %11, %6\n\tv_fma_f32 %7, -%8, %12, %7\n\t" \
                             "v_fma_f32 %0, %0, %13, %4\n\tv_fma_f32 %1, %1, %14, %5\n\tv_fma_f32 %2, %2, %15, %6\n\tv_fma_f32 %3, %3, %16, %7" \
                             : "+v"(s.x), "+v"(s.y), "+v"(s.z), "+v"(s.w), "+v"(t0), "+v"(t1), "+v"(t2), "+v"(t3) \
                             : "v"(sa), "v"(bv.x), "v"(bv.y), "v"(bv.z), "v"(bv.w), "v"(w.x), "v"(w.y), "v"(w.z), "v"(w.w)); \
                qpend = q; rp = r; w = nw; kk = nkk; bv = nbv; k2 = nk2; r = nr; v = nv; }
#define RW_STEP4(I) RW_STEP(I, (I) + 1) RW_STEP((I) + 1, (I) + 2) RW_STEP((I) + 2, (I) + 3) RW_STEP((I) + 3, ((I) + 4 < TC ? (I) + 4 : TC - 1))
#define RW_HALF_END(h0) do { asm volatile("s_waitcnt lgkmcnt(0)" :: "v"(w), "v"(kk), "v"(bv), "v"(k2), "v"(r), "v"(v) : "memory"); \
                ring[((h0) + 14) * 256] = qpend; ring[((h0) + 15) * 256] = dot4(s, rp); } while (0)
            RW_STEP4(0) RW_STEP4(4) RW_STEP4(8) RW_STEP4(12)
            RW_HALF_END(0);
            __syncthreads();
            RW_STEP4(16) RW_STEP4(20) RW_STEP4(24) RW_STEP4(28)
            RW_HALF_END(16);
#undef RW_HALF_END
#undef RW_STEP4
#undef RW_STEP
#undef RW_A_OPS
#undef RW_A_RD
#undef RW_A_DOT
        } else {
            __syncthreads();
            RW_FLUSH(c, 0);
        }
        if (c + 1 < T / TC) RW_STORE((c + 1) & 1);
        __syncthreads();
    }
    RW_FLUSH(T / TC - 1, 1);
#undef RW_LOAD
#undef RW_STORE
#undef RW_FLUSH
    if (wave < 4) *(f32x4*)(wkv_out + (((size_t)b * 4 + h) * 64 + row) * 64 + 4 * cq) = s;
    __syncthreads();
}
__device__ __forceinline__ void rwkv_sample_item(const RwkvPtrs& P, int item, const float* wkv_in, float* wkv_out, int lane) {
    const int rg = item & 15, h = (item >> 4) & 3, b = item >> 6, row = 4 * rg + (lane >> 4), cq = lane & 15;
    const size_t so = (((size_t)b * 4 + h) * 64 + row) * 64 + 4 * cq;
    f32x4 s = *(const f32x4*)(wkv_in + so);
#pragma unroll
    for (int i = 0; i < DS; ++i) { const size_t m = (size_t)MP + 4 * b + i, o = m * 256 + h * 64 + 4 * cq;
        float y; rwkv_step(s, *(const f32x4*)(P.W + o), ld_bf4(P.KK + o), ld_bf4(P.BV + o), ld_bf4(P.K + o), ld_bf4(P.R + o), bf1(P.V[m * 256 + h * 64 + row]), y);
        if (cq == 0) P.YR[m * 256 + h * 64 + row] = y; }
    *(f32x4*)(wkv_out + so) = s;
}
__device__ __forceinline__ void lru_prompt_item(const Ctx& C, int item, const float* AL, const float* U, const bf16* PROJ, bf16* MIXCAT, float* lru_out  ) {
    const int b = item >> 4, c = (item & 15) * 16 + (C.tid & 15), seg = C.tid >> 4; constexpr int SL = T / 32;
    const size_t m0 = (size_t)b * T + (size_t)seg * SL;
    LAS float* sA = (LAS float*)C.lds; LAS float* sH = sA + 512;
    float Ap = 1.f, H = 0.f;
#pragma unroll 8
    for (int i = 0; i < SL; ++i) { const float a = AL[(m0 + i) * 256 + c], u = U[(m0 + i) * 256 + c]; H = a * H + u; Ap *= a; }
    sA[C.tid] = Ap; sH[C.tid] = H;
    __syncthreads();
    float h = 0.f;
    for (int sp = 0; sp < seg; ++sp) h = sA[sp * 16 + (C.tid & 15)] * h + sH[sp * 16 + (C.tid & 15)];
#pragma unroll 8
    for (int i = 0; i < SL; ++i) { const float a = AL[(m0 + i) * 256 + c], u = U[(m0 + i) * 256 + c]; h = a * h + u;
        const float gb = bf1(PROJ[(m0 + i) * INC + C_GB + c]); MIXCAT[(m0 + i) * DM + 768 + c] = (bf16)f2bf(h * gelu_t(gb)); }
    if (seg == 31) lru_out[b * 256 + c] = h;
    __syncthreads();
}
__device__ __forceinline__ void swa_prompt_item(const Ctx& C, int item, const bf16* PROJ, bf16* MIXCAT, const float* sinks  ) {
    constexpr int KP = 72, VP = 264;
    const int kvh = item & 1, n = (item >> 1) & 31, b = item >> 6, tid = C.tid, lane = C.lane, wave = C.wave;
    LAS bf16* Ks = (LAS bf16*)C.lds; LAS bf16* Vt = Ks + 256 * KP;
    const size_t rowq0 = (size_t)b * T + (size_t)n * 128;
    { const int key = tid >> 1, hf = tid & 1; size_t kr = rowq0 + key; kr = (kr >= 128 + (size_t)b * T) ? kr - 128 : kr;
        const bf16* kp = PROJ + kr * INC + C_K + kvh * 64 + hf * 32;
#pragma unroll
        for (int i = 0; i < 4; ++i) *(LAS u32x4*)(Ks + key * KP + hf * 32 + 8 * i) = *(const u32x4*)(kp + 8 * i);
#pragma unroll
        for (int i = 0; i < 4; ++i) { const int ch = tid + 512 * i, vk = ch >> 3, d0 = (ch & 7) * 8; size_t vr = rowq0 + vk; vr = (vr >= 128 + (size_t)b * T) ? vr - 128 : vr;
            const u32x4 w = *(const u32x4*)(PROJ + vr * INC + C_V + kvh * 64 + d0);
            Vt[(d0 + 0) * VP + vk] = (bf16)(w.x & 0xffff); Vt[(d0 + 1) * VP + vk] = (bf16)(w.x >> 16); Vt[(d0 + 2) * VP + vk] = (bf16)(w.y & 0xffff); Vt[(d0 + 3) * VP + vk] = (bf16)(w.y >> 16);
            Vt[(d0 + 4) * VP + vk] = (bf16)(w.z & 0xffff); Vt[(d0 + 5) * VP + vk] = (bf16)(w.z >> 16); Vt[(d0 + 6) * VP + vk] = (bf16)(w.w & 0xffff); Vt[(d0 + 7) * VP + vk] = (bf16)(w.w >> 16); } }
    __syncthreads();
    const int q = lane & 31, hi = lane >> 5;
#pragma unroll 1
    for (int qi = 0; qi < 2; ++qi) {
        const int qt = wave * 2 + qi, g = qt >> 2, j = qt & 3, hh = kvh * 4 + g;
        const size_t qrow = rowq0 + 32 * j + q;
        bf16x8 qf[4];
#pragma unroll
        for (int dk = 0; dk < 4; ++dk) qf[dk] = *(const bf16x8*)(PROJ + qrow * INC + hh * 64 + 16 * dk + 8 * hi);
        f32x16 sc[5];
#pragma unroll
        for (int kt = 0; kt < 5; ++kt) {
            f32x16 acc;
#pragma unroll
            for (int i = 0; i < 16; ++i) acc[i] = 0.f;
#pragma unroll
            for (int dk = 0; dk < 4; ++dk) { const bf16x8 kf = *(const LAS bf16x8*)(Ks + (32 * (j + kt) + q) * KP + 16 * dk + 8 * hi); acc = __builtin_amdgcn_mfma_f32_32x32x16_bf16(kf, qf[dk], acc, 0, 0, 0); }
            sc[kt] = acc;
        }
        const int qpos = 128 + 32 * j + q; float mx = -INFINITY;
#pragma unroll
        for (int kt = 0; kt < 5; ++kt)
#pragma unroll
            for (int i = 0; i < 16; ++i) { const int kj = 32 * (j + kt) + (i & 3) + 8 * (i >> 2) + 4 * hi, d = qpos - kj; const bool ok = d >= 0 && d <= 128 && (n > 0 || kj >= 128);
                const float sv = ok ? sc[kt][i] * 0.125f : -INFINITY; sc[kt][i] = sv; mx = fmaxf(mx, sv); }
        mx = fmaxf(mx, shx(mx, 32, lane)); const float sink = sinks[hh]; mx = fmaxf(mx, sink);
        float sum = 0.f;
#pragma unroll
        for (int kt = 0; kt < 5; ++kt)
#pragma unroll
            for (int i = 0; i < 16; ++i) { const float e = __expf(sc[kt][i] - mx); sc[kt][i] = e; sum += e; }
        sum += shx(sum, 32, lane);
        const float inv = 1.f / (sum + __expf(sink - mx));
#pragma unroll
        for (int dt = 0; dt < 2; ++dt) {
            f32x16 o;
#pragma unroll
            for (int i = 0; i < 16; ++i) o[i] = 0.f;
#pragma unroll
            for (int kt = 0; kt < 5; ++kt)
#pragma unroll
                for (int s2 = 0; s2 < 2; ++s2) {
                    u32x4 pw; pw.x = pk2(sc[kt][8 * s2 + 0], sc[kt][8 * s2 + 1]); pw.y = pk2(sc[kt][8 * s2 + 2], sc[kt][8 * s2 + 3]); pw.z = pk2(sc[kt][8 * s2 + 4], sc[kt][8 * s2 + 5]); pw.w = pk2(sc[kt][8 * s2 + 6], sc[kt][8 * s2 + 7]);
                    const LAS bf16* vp = Vt + (32 * dt + q) * VP + 32 * (j + kt) + 16 * s2 + 4 * hi;
                    const u32x2 v0 = *(const LAS u32x2*)vp, v1 = *(const LAS u32x2*)(vp + 8);
                    u32x4 vw; vw.x = v0.x; vw.y = v0.y; vw.z = v1.x; vw.w = v1.y;
                    o = __builtin_amdgcn_mfma_f32_32x32x16_bf16(__builtin_bit_cast(bf16x8, vw), __builtin_bit_cast(bf16x8, pw), o, 0, 0, 0);
                }
#pragma unroll
            for (int g4 = 0; g4 < 4; ++g4) st_bf4(MIXCAT + qrow * DM + hh * 64 + 32 * dt + 8 * g4 + 4 * hi, (f32x4){o[4 * g4] * inv, o[4 * g4 + 1] * inv, o[4 * g4 + 2] * inv, o[4 * g4 + 3] * inv});
        }
    }
    __syncthreads();
}
__device__ __forceinline__ void swa_sample_item(const Ctx& C, int item, const bf16* PROJ, bf16* MIXCAT, const float* sinks, const float* ck, const float* cv, float* ko, float* vo) {
    const int kvh = item & 1, b = item >> 1, tid = C.tid;
    LAS float* Kf = (LAS float*)C.lds; LAS float* Vf = Kf + 132 * 65; LAS float* Qf = Vf + 132 * 64; LAS float* Pf = Qf + 16 * 64;
    for (int e = tid; e < 132 * 64; e += 512) { const int key = e >> 6, d = e & 63; float kx, vx;
        if (key < 128) { const size_t o = (((size_t)b * 128 + key) * 2 + kvh) * 64 + d; kx = ck[o]; vx = cv[o]; }
        else { const size_t r = (size_t)MP + 4 * b + (key - 128); kx = bf1(PROJ[r * INC + C_K + kvh * 64 + d]); vx = bf1(PROJ[r * INC + C_V + kvh * 64 + d]); }
        Kf[key * 65 + d] = kx; Vf[key * 64 + d] = vx;
        if (key >= 4) { const size_t o = (((size_t)b * 128 + (key - 4)) * 2 + kvh) * 64 + d; ko[o] = kx; vo[o] = vx; } }
    for (int e = tid; e < 16 * 64; e += 512) { const int qr = e >> 6, d = e & 63, i = qr >> 2, g = qr & 3; Qf[e] = bf1(PROJ[((size_t)MP + 4 * b + i) * INC + (kvh * 4 + g) * 64 + d]); }
    __syncthreads();
    { const int qr = tid >> 5, kl = tid & 31, i = qr >> 2, g = qr & 3; float sc[5]; float mx = -INFINITY;
#pragma unroll
        for (int k5 = 0; k5 < 5; ++k5) { const int key = kl + 32 * k5; float sv = -INFINITY;
            if (key < 132 && key >= i && key <= i + 128) { float a = 0.f;
#pragma unroll 16
                for (int d = 0; d < 64; ++d) a += Qf[qr * 64 + d] * Kf[key * 65 + d];
                sv = a * 0.125f; }
            sc[k5] = sv; mx = fmaxf(mx, sv); }
#pragma unroll
        for (int o = 1; o < 32; o <<= 1) mx = fmaxf(mx, shx(mx, o, C.lane));
        const float sink = sinks[kvh * 4 + g]; mx = fmaxf(mx, sink); float sum = 0.f;
#pragma unroll
        for (int k5 = 0; k5 < 5; ++k5) { sc[k5] = __expf(sc[k5] - mx); sum += sc[k5]; }
#pragma unroll
        for (int o = 1; o < 32; o <<= 1) sum += shx(sum, o, C.lane);
        const float inv = 1.f / (sum + __expf(sink - mx));
#pragma unroll
        for (int k5 = 0; k5 < 5; ++k5) { const int key = kl + 32 * k5; if (key < 136) Pf[qr * 136 + key] = sc[k5] * inv; } }
    __syncthreads();
    { const int qr = tid >> 5, d = (tid & 31) * 2, i = qr >> 2, g = qr & 3; float o0 = 0.f, o1 = 0.f;
#pragma unroll 4
        for (int key = 0; key < 132; ++key) { const float p = Pf[qr * 136 + key]; o0 += p * Vf[key * 64 + d]; o1 += p * Vf[key * 64 + d + 1]; }
        *(unsigned*)(MIXCAT + ((size_t)MP + 4 * b + i) * DM + (kvh * 4 + g) * 64 + d) = pk2(o0, o1); }
    __syncthreads();
}

__device__ __forceinline__ void s_phase(const Ctx& C, const Args& A, int l) {
    const bf16* PROJ = (const bf16*)(C.ws + WS_R1); bf16* MIXCAT = (bf16*)(C.ws + WS_HN);
    float* R = (float*)(C.ws + WS_R2); const size_t S = (size_t)M * 256;
    RwkvPtrs P{(const bf16*)R, (const bf16*)(R + S), (const bf16*)(R + 2 * S), (const bf16*)(R + 3 * S), (const bf16*)(R + 4 * S), R + 5 * S, (float*)(C.ws + WS_R3)};
    const float* AL = (const float*)(C.ws + WS_R3) + S; const float* U = AL + S;
    float* out = C.out;
    constexpr int NSCAN = 64;
    if (C.bid < NSCAN) { rwkv_prompt(C, P, C.bid, out + OUT_WKVP + (size_t)l * NBP * 4 * 4096); return; }
    constexpr int N0 = 256, N1 = N0 + 64, N2_ = N1 + 256, N3 = N2_ + 1024, N4 = N3 + 64;
    for (int it = C.bid - NSCAN; it < N4; it += C.G - NSCAN) {
        if (it < N0) swa_prompt_item(C, it, PROJ, MIXCAT, INP(I_SINK) + l * 8);
        else if (it < N1) lru_prompt_item(C, it - N0, AL, U, PROJ, MIXCAT, out + OUT_LRP + (size_t)l * NBP * 256);
        else if (it < N2_) swa_sample_item(C, it - N1, PROJ, MIXCAT, INP(I_SINK) + l * 8, INP(I_CK) + (size_t)l * DB * 16384, INP(I_CV) + (size_t)l * DB * 16384,
                                          out + OUT_KS + (size_t)l * DB * 16384, out + OUT_VS + (size_t)l * DB * 16384);
        else if (it < N3) rwkv_sample_item(P, (it - N2_) * 8 + C.wave, INP(I_SWKV) + (size_t)l * DB * 4 * 4096, out + OUT_WKVS + (size_t)l * DB * 4 * 4096, C.lane);
        else { const int e = (it - N3) * 512 + C.tid, b = e >> 8, c = e & 255; float h = INP(I_SLRU)[((size_t)l * DB + b) * 256 + c];
#pragma unroll
            for (int i = 0; i < DS; ++i) { const size_t m = (size_t)MP + 4 * b + i; h = AL[m * 256 + c] * h + U[m * 256 + c];
                MIXCAT[m * DM + 768 + c] = (bf16)f2bf(h * gelu_t(bf1(PROJ[m * INC + C_GB + c]))); }
            out[OUT_LRS + ((size_t)l * DB + b) * 256 + c] = h; }
    }
    if (l + 1 < NL) convert_layer(C, A, l + 1, (C.bid - NSCAN) * 8 + C.wave, (C.G - NSCAN) * 8, (C.bid - NSCAN) * 512 + C.tid, (C.G - NSCAN) * 512);
    __syncthreads();
    { pg8::Gemm g{(const bf16*)(C.ws + WS_PB + (size_t)(l & 1) * SZ_PBL), (const bf16*)(C.ws + WS_W + (size_t)(l & 1) * WL + O_WP), M, DM, PLE}; pg8::StaticOrder So; So.init(M, DM, C.G - NSCAN, C.bid - NSCAN);
      pg8::EpiBf16<0> E{(bf16*)(C.ws + WS_PP), DM, nullptr, 0, 0, 1.f};
      pg8::gemm_phase<pg8::EpiBf16<0>, pg8::StaticOrder, true, true>(C.lds, g, So, E, C.tid); }
}

__device__ __forceinline__ void e3_post(const Ctx& C, const Args& A, int l) {
    const float* R = (const float*)(C.ws + WS_R2); const size_t S = (size_t)M * 256;
    const bf16 *Rb = (const bf16*)R, *K = (const bf16*)(R + S), *V = (const bf16*)(R + 2 * S), *G = (const bf16*)(R + 6 * S); const float* YR = (const float*)(C.ws + WS_R3);
    bf16* MIXCAT = (bf16*)(C.ws + WS_HN); const int c4 = 4 * C.lane;
    const f32x4 lw = *(const f32x4*)(INP(I_LNW) + l * 256 + c4), lb = *(const f32x4*)(INP(I_LNB) + l * 256 + c4), rk = *(const f32x4*)(INP(I_RK) + l * 256 + c4);
    for (int m = C.gw; m < M; m += C.NGW) {
        const size_t o = (size_t)m * 256 + c4;
        const f32x4 y = *(const f32x4*)(YR + o), r = ld_bf4(Rb + o), k = ld_bf4(K + o), v = ld_bf4(V + o), g = ld_bf4(G + o);
        const float mean = red16((y.x + y.y) + (y.z + y.w)) * (1.f / 64.f); const f32x4 d = y - mean;
        const float var = red16(dot4(d, d)) * (1.f / 64.f); const float rs = rsqrtf(var + 64e-5f);
        const float bonus = red16(dot4(r * k, rk));
        st_bf4(MIXCAT + (size_t)m * DM + 512 + c4, (d * rs * lw + lb + v * bonus) * g);
    }
}
constexpr int LDS_BYTES = 131072 + 64;
#ifndef MK_MULTI
#define MK_MULTI 0
#endif
#ifndef MK_DUP
#define MK_DUP 0
#endif
enum { PH_P0 = 0, PH_G1, PH_E1, PH_G2, PH_S, PH_E3, PH_G3, PH_E4, PH_G4, PH_G5, PH_E5, PH_G6, PH_E0, PH_G3B, PH_E4S, PH_G5B, PH_E5S, PH_N };
constexpr int NSPLIT = 16;

__device__ __forceinline__ Ctx make_ctx(int wave0, LAS unsigned char* lds) {
    Ctx D; int z_ = 0; asm volatile("" : "+v"(z_)); int ln_ = __builtin_amdgcn_mbcnt_hi(-1, __builtin_amdgcn_mbcnt_lo(-1, z_));
    D.lane = ln_; D.wave = wave0; D.tid = wave0 * 64 + ln_;
    int b_ = blockIdx.x; asm volatile("" : "+s"(b_)); D.bid = b_; D.gw = b_ * 8 + wave0; D.G = gridDim.x; D.NGW = D.G * 8;
    D.lds = lds; D.out = (float*)inp_ld(N_IN); D.ws = (unsigned char*)inp_ld(N_IN + 1);
    return D;
}
template <int PH> __device__ __forceinline__ void run_phase(const Args& A, int wave0, LAS unsigned char* lds, int l_in) {
    const Ctx C = make_ctx(wave0, lds);
    int l = l_in; asm volatile("" : "+s"(l));
    unsigned char* ws = C.ws; unsigned char* wl = ws + WS_W + (size_t)(l & 1) * WL; (void)wl;
    bf16* HN = (bf16*)(ws + WS_HN); float* MIX = (float*)(ws + WS_R1); float* R2 = (float*)(ws + WS_R2); float* R3 = (float*)(ws + WS_R3); bf16* X = (bf16*)(ws + WS_X16);
    const size_t S = (size_t)M * 256; (void)HN; (void)MIX; (void)R2; (void)R3; (void)X; (void)S;
    if constexpr (PH == PH_P0) p0_prologue(C, A);
    if constexpr (PH == PH_G1) {
        pg8::Gemm g{HN, (const bf16*)(wl + O_WIN), M, INC, DM}; pg8::StaticOrder So; So.init(M, INC, C.G, C.bid);
        pg8::EpiBf16<0> E{(bf16*)(ws + WS_R1), INC, INP(I_BIN) + (size_t)l * INC, 0, 0, 1.f};
        pg8::gemm_phase<pg8::EpiBf16<0>, pg8::StaticOrder, true, true>(C.lds, g, So, E, C.tid); }
    if constexpr (PH == PH_E1) e1_prep(C, A, l);
    if constexpr (PH == PH_G2) {
        pg8::Gemm g{(const bf16*)(ws + WS_R3), (const bf16*)(wl + O_W2), M, N2, K2 / 2, K2}; G2Order So; So.b.init(M, N2, C.G, C.bid);
        EpiMix E{INP(I_W0) + l * 256, INP(I_A0) + l * 256, INP(I_KA) + l * 256, INP(I_BA) + l * 256, INP(I_BI) + l * 256, INP(I_L) + l * 256,
                 R2 + 5 * S, (bf16*)(R2 + 1 * S), (bf16*)(R2 + 3 * S), (bf16*)(R2 + 4 * S), (bf16*)(R2 + 6 * S), R3 + S, R3 + 2 * S, (const bf16*)(ws + WS_R3)};
        pg8::gemm_phase<EpiMix, G2Order, true, true>(C.lds, g, So, E, C.tid); }
    if constexpr (PH == PH_S) s_phase(C, A, l);
    if constexpr (PH == PH_E3) e3_post(C, A, l);
    if constexpr (PH == PH_G3) {
        pg8::Gemm g{HN, (const bf16*)(wl + O_WOUT), MP, DM, DM}; pg8::StaticOrder So; So.init(MP, DM, C.G, C.bid);
        pg8::EpiBf16<0> E{(bf16*)MIX, DM, INP(I_BOUT) + (size_t)l * DM, 0, 0, 1.f};
        pg8::gemm_phase<pg8::EpiBf16<0>, pg8::StaticOrder, true, true>(C.lds, g, So, E, C.tid); }
    if constexpr (PH == PH_G3B) {
        if (C.bid < NSPLIT) { pg8::Gemm g{HN + (size_t)MP * DM, (const bf16*)(wl + O_WOUT), MS, DM, DM / 2, DM}; SplitOrder So{C.bid, NSPLIT, DM / 2}; EpiPart E{R3};
            pg8::gemm_phase<EpiPart, SplitOrder, true, true>(C.lds, g, So, E, C.tid); }
        else for (int m = (C.bid - NSPLIT) * 8 + C.wave; m < MP; m += (C.G - NSPLIT) * 8)
            row_update((const bf16*)MIX + (size_t)m * DM, INP(I_NMPOST) + l * DM, X + (size_t)m * DM, INP(I_NFPRE) + l * DM, HN + (size_t)m * DM, C.lane); }
    if constexpr (PH == PH_E4S)
        for (int m = MP + C.gw; m < M; m += C.NGW)
            row_update_parts(R3 + (size_t)(m - MP) * DM, R3 + (size_t)(MS + m - MP) * DM, INP(I_BOUT) + (size_t)l * DM, INP(I_NMPOST) + l * DM, X + (size_t)m * DM, INP(I_NFPRE) + l * DM, HN + (size_t)m * DM, C.lane);
    if constexpr (PH == PH_G4) {
        pg8::Gemm g{HN, (const bf16*)(wl + O_WGU), M, 2 * DFF, DM}; pg8::StaticOrder So; So.init(M, 2 * DFF, C.G, C.bid);
        EpiSwiglu E{(bf16*)(ws + WS_R2)};
        pg8::gemm_phase<EpiSwiglu, pg8::StaticOrder, true, true>(C.lds, g, So, E, C.tid); }
    if constexpr (PH == PH_G5) {
        pg8::Gemm g{(const bf16*)(ws + WS_R2), (const bf16*)(wl + O_WD), MP, DM, DFF}; pg8::StaticOrder So; So.init(MP, DM, C.G, C.bid);
        pg8::EpiBf16<0> E{(bf16*)MIX, DM, nullptr, 0, 0, 1.f};
        pg8::gemm_phase<pg8::EpiBf16<0>, pg8::StaticOrder, true, true>(C.lds, g, So, E, C.tid); }
    if constexpr (PH == PH_G5B) {
        if (C.bid < NSPLIT) { pg8::Gemm g{(const bf16*)(ws + WS_R2) + (size_t)MP * DFF, (const bf16*)(wl + O_WD), MS, DM, DFF / 2, DFF}; SplitOrder So{C.bid, NSPLIT, DFF / 2}; EpiPart E{R3};
            pg8::gemm_phase<EpiPart, SplitOrder, true, true>(C.lds, g, So, E, C.tid); }
        else for (int m = (C.bid - NSPLIT) * 8 + C.wave; m < MP; m += (C.G - NSPLIT) * 8)
            row_update((const bf16*)MIX + (size_t)m * DM, INP(I_NFPOST) + l * DM, X + (size_t)m * DM, nullptr, HN + (size_t)m * DM, C.lane); }
    if constexpr (PH == PH_E5S)
        for (int m = MP + C.gw; m < M; m += C.NGW)
            row_update_parts(R3 + (size_t)(m - MP) * DM, R3 + (size_t)(MS + m - MP) * DM, nullptr, INP(I_NFPOST) + l * DM, X + (size_t)m * DM, nullptr, HN + (size_t)m * DM, C.lane);
    if constexpr (PH == PH_G6) {
        pg8::StaticOrder So; So.init(M, DM, C.G, C.bid);
        pg8::Gemm g{HN, (const bf16*)(wl + O_WPG), M, DM, DM}; EpiPle E{X, (const bf16*)(ws + WS_PP), l == NL - 1 ? C.out : nullptr};
        pg8::gemm_phase<EpiPle, pg8::StaticOrder, true, true>(C.lds, g, So, E, C.tid); }
    if constexpr (PH == PH_E0)
        for (int m = C.gw; m < M; m += C.NGW) row_norm(X + (size_t)m * DM, INP(I_NMPRE) + (l + 1) * DM, HN + (size_t)m * DM, C.lane);
}

#if MK_MULTI
template <int PH> __global__ void __launch_bounds__(512, 2) mk_one(Args A, int l) {
    extern __shared__ __attribute__((aligned(16))) unsigned char lds_raw[];
    const int wave0 = __builtin_amdgcn_readfirstlane((int)threadIdx.x >> 6);
    run_phase<PH>(A, wave0, (LAS unsigned char*)lds_raw, l);
}
#else
__global__ void __launch_bounds__(512, 2) mk_fwd(Args A) {
    extern __shared__ __attribute__((aligned(16))) unsigned char lds_raw[];
    cg::grid_group grid = cg::this_grid();
    const int wave0 = __builtin_amdgcn_readfirstlane((int)threadIdx.x >> 6);
    LAS unsigned char* lds = (LAS unsigned char*)lds_raw;
    if (threadIdx.x < 16) ((LAS unsigned*)lds)[131072 / 4 + threadIdx.x] = 0u;
    __syncthreads();
    const unsigned xbar_x = __builtin_amdgcn_readfirstlane(xcd_barrier_post((unsigned*)inp_ld(N_IN + 1), (volatile LAS unsigned*)(lds + 131072), (int)threadIdx.x).x);
#define GRID_BAR() do { int z_ = 0; asm volatile("" : "+v"(z_)); int ln_ = __builtin_amdgcn_mbcnt_hi(-1, __builtin_amdgcn_mbcnt_lo(-1, z_)); XcdBarrier xb_; xb_.bar = (unsigned*)inp_ld(N_IN + 1); xb_.x = xbar_x; \
        xb_.st = (volatile LAS unsigned*)(lds + 131072); xcd_barrier(xb_, wave0 * 64 + ln_); } while (0)
    run_phase<PH_P0>(A, wave0, lds, 0);
    if (MK_DUP & 1) { GRID_BAR(); run_phase<PH_P0>(A, wave0, lds, 0); }
    grid.sync();
#pragma unroll 1
    for (int l = 0; l < NL; ++l) {
#define RP(PH) do { run_phase<PH>(A, wave0, lds, l); GRID_BAR(); if (MK_DUP & (1 << 20)) GRID_BAR(); if (MK_DUP & (1 << PH)) { run_phase<PH>(A, wave0, lds, l); GRID_BAR(); } } while (0)
        RP(PH_G1); RP(PH_E1); RP(PH_G2); RP(PH_S); RP(PH_E3); RP(PH_G3); RP(PH_G3B); RP(PH_E4S); RP(PH_G4); RP(PH_G5); RP(PH_G5B); RP(PH_E5S);
        run_phase<PH_G6>(A, wave0, lds, l);
        if (l + 1 < NL) { GRID_BAR(); RP(PH_E0); }
    }
}
#endif
}

#if MK_MULTI
template <int PH> static void launch_one(const mk::Args& a, int l, int grid, hipStream_t stream) {
    static bool attr = false;
    if (!attr) { (void)hipFuncSetAttribute((const void*)mk::mk_one<PH>, hipFuncAttributeMaxDynamicSharedMemorySize, mk::LDS_BYTES); attr = true; }
    hipLaunchKernelGGL(mk::mk_one<PH>, dim3(grid), dim3(512), mk::LDS_BYTES, stream, a, l);
}
#endif
extern "C" void kernel_launch(void* const* d_in, const int* in_sizes, int n_in, void* d_out, int out_size, void* d_ws, size_t ws_size, hipStream_t stream) {
    using namespace mk;
    static int grid = 0;
    if (grid == 0) {
        if (n_in != N_IN || (size_t)out_size != OUT_END || ws_size < WS_END) {
            fprintf(stderr, "kernel_launch: shape mismatch: n_in %d (want %d), out %d (want %zu), ws %zu (want >= %zu); nothing launched\n", n_in, (int)N_IN, out_size, (size_t)OUT_END, ws_size, (size_t)WS_END);
            grid = -1; return; }
        int dev = 0, cus = 0;
        (void)hipGetDevice(&dev); (void)hipDeviceGetAttribute(&cus, hipDeviceAttributeMultiprocessorCount, dev);
#if !MK_MULTI
        int per_cu = 0;
        if (hipFuncSetAttribute((const void*)mk_fwd, hipFuncAttributeMaxDynamicSharedMemorySize, LDS_BYTES) != hipSuccess) { fprintf(stderr, "kernel_launch: hipFuncSetAttribute failed\n"); grid = -1; return; }
        if (hipOccupancyMaxActiveBlocksPerMultiprocessor(&per_cu, (const void*)mk_fwd, 512, LDS_BYTES) != hipSuccess || per_cu < 1) fprintf(stderr, "kernel_launch: note: occupancy query gave %d\n", per_cu);
        (void)hipGetLastError();
#endif
        grid = cus;
        if (grid < 128) { fprintf(stderr, "kernel_launch: %d CUs: too few for this kernel\n", grid); grid = -1; return; }
    }
    if (grid < 0) return;
    Args a{};
    for (int i = 0; i < N_IN; ++i) a.in[i] = (const float*)d_in[i];
    a.out = (float*)d_out; a.ws = (unsigned char*)d_ws;
#if MK_MULTI
    launch_one<PH_P0>(a, 0, grid, stream);
    for (int l = 0; l < NL; ++l) {
        launch_one<PH_G1>(a, l, grid, stream); launch_one<PH_E1>(a, l, grid, stream); launch_one<PH_G2>(a, l, grid, stream); launch_one<PH_S>(a, l, grid, stream);
        launch_one<PH_E3>(a, l, grid, stream); launch_one<PH_G3>(a, l, grid, stream); launch_one<PH_E4>(a, l, grid, stream); launch_one<PH_G4>(a, l, grid, stream);
        launch_one<PH_G5>(a, l, grid, stream); launch_one<PH_E5>(a, l, grid, stream); launch_one<PH_G6>(a, l, grid, stream);
        if (l + 1 < NL) launch_one<PH_E0>(a, l, grid, stream);
    }
#else
    if (hipMemsetAsync(d_ws, 0, 65536, stream) != hipSuccess) { fprintf(stderr, "kernel_launch: hipMemsetAsync failed\n"); return; }
    void* args[] = {&a};
    const hipError_t e = hipLaunchCooperativeKernel((const void*)mk_fwd, dim3(grid), dim3(512), args, LDS_BYTES, stream);
    if (e != hipSuccess) fprintf(stderr, "kernel_launch: cooperative launch failed: %s (grid %d)\n", hipGetErrorString(e), grid);
#endif
}
```
